# Optimizing an MI355X kernel written in HIP

```python
import jax, jax.numpy as jnp
from jax import lax
import numpy as np

D_MODEL = 2048
BATCH = 4
SEQ = 2048
DEPTH = 1
DEC_BATCH = 32
DEC_SEQ = 16
PAST_LEN = 1024

CHUNK = 64
MIX_WIDTH = D_MODEL
CONV_WIDTH = MIX_WIDTH // 2
CONV_KERNEL = 31
CONV_STATE = CONV_KERNEL - 1
HG_WIDTH = MIX_WIDTH - CONV_WIDTH
HG_HEAD_DIM = 128
HG_HEADS = HG_WIDTH // HG_HEAD_DIM
HG_BLOCK = CHUNK // 4
D_FF = ((8 * D_MODEL + 767) // 768) * 256
IN_COLS = 2 * CONV_WIDTH + 4 * HG_WIDTH
SPLITS = [CONV_WIDTH, 2 * CONV_WIDTH, 2 * CONV_WIDTH + HG_WIDTH,
          2 * CONV_WIDTH + 2 * HG_WIDTH, 2 * CONV_WIDTH + 3 * HG_WIDTH]
ALPHA = (2.0 * DEPTH) ** 0.25
BETA = (8.0 * DEPTH) ** -0.25
LN_EPS = 1e-5

kernel_name = "hymba_conformer_hgrn2_stream_step"


def layer_norm(x, g, b):
    xf = x.astype(jnp.float32)
    mu = jnp.mean(xf, -1, keepdims=True)
    var = jnp.mean(jnp.square(xf - mu), -1, keepdims=True)
    return ((xf - mu) * lax.rsqrt(var + LN_EPS) * g.astype(jnp.float32)
            + b.astype(jnp.float32)).astype(x.dtype)


def rms_norm(x, g):
    xf = x.astype(jnp.float32)
    return xf * lax.rsqrt(jnp.mean(jnp.square(xf), -1, keepdims=True) + LN_EPS) * g.astype(jnp.float32)


def conv_mixer(a, gate, hist, w_dw, b_dw, n_g, n_b):
    u = a * jax.nn.sigmoid(gate)
    u_ext = jnp.concatenate([hist.astype(u.dtype), u], axis=1)
    h = lax.conv_general_dilated(
        u_ext, w_dw[:, None, :].astype(u.dtype), window_strides=(1,), padding='VALID',
        dimension_numbers=('NWC', 'WIO', 'NWC'), feature_group_count=u.shape[-1])
    h = h + b_dw
    h = jax.nn.silu(layer_norm(h, n_g, n_b))
    return h, u_ext[:, -CONV_STATE:]


def hgrn2_block(S0, q, k, v, logf):
    L = q.shape[2]
    lc = jnp.cumsum(logf, axis=2)
    causal = jnp.tril(jnp.ones((L, L), dtype=bool))
    diff = lc[:, :, :, None, :] - lc[:, :, None, :, :]
    decay = jnp.exp(jnp.where(causal[None, None, :, :, None], diff, -jnp.inf))
    scores = jnp.einsum('bhtk,bhsk,bhtsk->bhts', q, k, decay)
    o = (jnp.einsum('bhts,bhsv->bhtv', scores, v)
         + jnp.einsum('bhtk,bhkv->bhtv', q * jnp.exp(lc), S0))
    lc_last = lc[:, :, -1:, :]
    k_to_end = k * jnp.exp(lc_last - lc)
    S1 = jnp.exp(lc_last[:, :, 0, :])[..., None] * S0 + jnp.einsum('bhsk,bhsv->bhkv', k_to_end, v)
    return S1, o


def hgrn2_scan(S0, q, k, v, logf):
    B, H, T, _ = q.shape
    n = T // HG_BLOCK

    def to_blocks(z):
        return jnp.moveaxis(z.reshape(B, H, n, HG_BLOCK, z.shape[-1]), 2, 0)

    def step(S, blk):
        return hgrn2_block(S, blk[0], blk[1], blk[2], blk[3])

    S_fin, o = lax.scan(step, S0, (to_blocks(q), to_blocks(k), to_blocks(v), to_blocks(logf)))
    o = jnp.moveaxis(o, 0, 2).reshape(B, H, T, HG_HEAD_DIM)
    return S_fin, o


def hgrn2_mixer(q_raw, f_raw, i_raw, g_raw, S0, lb, norm_g, seq_fn):
    B, T, _ = q_raw.shape

    def heads(z):
        return z.astype(jnp.float32).reshape(B, T, HG_HEADS, HG_HEAD_DIM).transpose(0, 2, 1, 3)

    f = lb + (1.0 - lb) * jax.nn.sigmoid(f_raw.astype(jnp.float32))
    f = heads(f)
    q = jax.nn.silu(heads(q_raw))
    S1, o = seq_fn(S0.astype(jnp.float32), q, 1.0 - f, heads(i_raw), jnp.log(f))
    o = rms_norm(o, norm_g)
    o = o.transpose(0, 2, 1, 3).reshape(B, T, HG_WIDTH) * jax.nn.silu(g_raw.astype(jnp.float32))
    return o.astype(q_raw.dtype), S1


def encoder_layer(x, conv_hist, hg_state, seq_fn, w_in, b_in, w_dw, b_dw, cn_g, cn_b, lb,
                  hg_norm_g, w_out, ln1_g, ln1_b, w_gate, w_up, w_down, ln2_g, ln2_b):
    proj = x @ w_in + b_in
    a, gate, q_raw, f_raw, i_raw, g_raw = jnp.split(proj, SPLITS, axis=-1)
    conv_out, conv_new = conv_mixer(a, gate, conv_hist, w_dw, b_dw, cn_g, cn_b)
    hg_out, hg_new = hgrn2_mixer(q_raw, f_raw, i_raw, g_raw, hg_state, lb, hg_norm_g, seq_fn)
    mixed = jnp.concatenate([conv_out, hg_out], axis=-1) @ w_out
    h = layer_norm(ALPHA * x + mixed, ln1_g, ln1_b)
    ffn = (jax.nn.silu(h @ w_gate) * (h @ w_up)) @ w_down
    y = layer_norm(ALPHA * h + ffn, ln2_g, ln2_b)
    return y, conv_new, hg_new


def setup_inputs(seed: int = 0) -> dict:
    key = jax.random.key(seed)
    ks = jax.random.split(key, 24)
    nrm = lambda k, s, sc: jax.random.normal(k, s, jnp.float32) * sc
    return {
        "x_prompt": nrm(ks[0], (BATCH, SEQ, D_MODEL), 1.0),
        "x_sample": nrm(ks[1], (DEC_BATCH, DEC_SEQ, D_MODEL), 1.0),
        "cache_conv": nrm(ks[2], (DEPTH, DEC_BATCH, CONV_STATE, CONV_WIDTH), 0.5),
        "state_hgrn": nrm(ks[3], (DEPTH, DEC_BATCH, HG_HEADS, HG_HEAD_DIM, HG_HEAD_DIM), 0.5),
        "w_in": nrm(ks[4], (DEPTH, D_MODEL, IN_COLS), D_MODEL ** -0.5),
        "b_in": nrm(ks[5], (DEPTH, IN_COLS), 0.02),
        "w_dw": nrm(ks[6], (DEPTH, CONV_KERNEL, CONV_WIDTH), CONV_KERNEL ** -0.5),
        "b_dw": nrm(ks[7], (DEPTH, CONV_WIDTH), 0.02),
        "conv_norm_g": 1.0 + nrm(ks[8], (DEPTH, CONV_WIDTH), 0.02),
        "conv_norm_b": nrm(ks[9], (DEPTH, CONV_WIDTH), 0.02),
        "hg_lower_bounds": nrm(ks[10], (DEPTH + 1, HG_WIDTH), 0.5),
        "hg_norm_g": 1.0 + nrm(ks[11], (DEPTH, HG_HEAD_DIM), 0.02),
        "w_out": nrm(ks[12], (DEPTH, MIX_WIDTH, D_MODEL), BETA * MIX_WIDTH ** -0.5),
        "ln1_g": 1.0 + nrm(ks[13], (DEPTH, D_MODEL), 0.02),
        "ln1_b": nrm(ks[14], (DEPTH, D_MODEL), 0.02),
        "w_gate": nrm(ks[15], (DEPTH, D_MODEL, D_FF), D_MODEL ** -0.5),
        "w_up": nrm(ks[16], (DEPTH, D_MODEL, D_FF), D_MODEL ** -0.5),
        "w_down": nrm(ks[17], (DEPTH, D_FF, D_MODEL), BETA * D_FF ** -0.5),
        "ln2_g": 1.0 + nrm(ks[18], (DEPTH, D_MODEL), 0.02),
        "ln2_b": nrm(ks[19], (DEPTH, D_MODEL), 0.02),
    }


def reference(x_prompt, x_sample, cache_conv, state_hgrn, w_in, b_in, w_dw, b_dw, conv_norm_g,
              conv_norm_b, hg_lower_bounds, hg_norm_g, w_out, ln1_g, ln1_b, w_gate, w_up, w_down,
              ln2_g, ln2_b):
    lb_all = jnp.cumsum(jax.nn.softmax(hg_lower_bounds.astype(jnp.float32), axis=0), axis=0)
    yp, ys = x_prompt, x_sample
    conv_p, hg_p, conv_s, hg_s = [], [], [], []
    for l in range(DEPTH):
        params = (w_in[l], b_in[l], w_dw[l], b_dw[l], conv_norm_g[l], conv_norm_b[l], lb_all[l],
                  hg_norm_g[l], w_out[l], ln1_g[l], ln1_b[l], w_gate[l], w_up[l], w_down[l],
                  ln2_g[l], ln2_b[l])
        hist0 = jnp.zeros((yp.shape[0], CONV_STATE, CONV_WIDTH), yp.dtype)
        S0 = jnp.zeros((yp.shape[0], HG_HEADS, HG_HEAD_DIM, HG_HEAD_DIM), jnp.float32)
        yp, cp, sp = encoder_layer(yp, hist0, S0, hgrn2_scan, *params)
        ys, cs, ss = encoder_layer(ys, cache_conv[l], state_hgrn[l], hgrn2_block, *params)
        conv_p.append(cp)
        hg_p.append(sp.astype(x_prompt.dtype))
        conv_s.append(cs.astype(cache_conv.dtype))
        hg_s.append(ss.astype(state_hgrn.dtype))
    return (yp, ys, jnp.stack(conv_p), jnp.stack(hg_p), jnp.stack(conv_s), jnp.stack(hg_s))
```

```cpp
#include <hip/hip_runtime.h>
#include <hip/hip_cooperative_groups.h>
#include <cstdio>
#include <cstdint>
namespace cg = cooperative_groups;

#ifndef MK_ONE_LAUNCH
#define MK_ONE_LAUNCH 0
#endif

namespace pg8 {
#define PG8_LAS __attribute__((address_space(3)))
typedef unsigned short bf16_t;
typedef short bf16x8 __attribute__((ext_vector_type(8)));
typedef float f32x4 __attribute__((ext_vector_type(4)));
typedef unsigned u32x4 __attribute__((ext_vector_type(4)));
typedef unsigned u32x2 __attribute__((ext_vector_type(2)));
constexpr int BM = 256, BK = 64, HALF = 128, HTB = HALF * BK * 2, STAGE_BYTES = 8 * HTB, NXCD = 8, WGM = 8;

__host__ __device__ __forceinline__ int lds_byte(int r, int c) { const int st = (r >> 4) * 2 + (c >> 5), rr = r & 15, cc = c & 31, ob = rr * 64 + cc * 2; return st * 1024 + (ob ^ (((ob >> 9) & 1) << 5)); }
__host__ __device__ __forceinline__ void stage_rc(int b, int& R, int& C) { const int st = b / 1024, sb = b % 1024, swz = sb ^ (((sb >> 9) & 1) << 5); R = (st >> 1) * 16 + swz / 64; C = (st & 1) * 32 + (swz % 64) / 2; }
__host__ __device__ __forceinline__ int perm32(int rho) { const int n = rho >> 4, i = rho & 15; return 8 * (i >> 2) + 4 * n + (i & 3); }

struct Unit { int pm, pn; };
struct Gemm { const bf16_t* A; const bf16_t* Bt; int M, N, K; };

struct StaticOrder {
    int nM, nN, nwg, G, c;
    __host__ __device__ void init(int M, int N, int G_, int c_) { nM = M / BM; nN = N / BM; nwg = nM * nN; G = G_; c = c_; }
    __host__ __device__ bool next(int i, Unit& u) const {
        const long L = (long)i * G + c; if (L >= nwg) return false;
        int wgid = (int)L; { const int q = nwg / NXCD, r = nwg % NXCD, xcd = wgid % NXCD, off = wgid / NXCD; wgid = (xcd < r ? xcd * (q + 1) : r * (q + 1) + (xcd - r) * q) + off; }
        const int nig = WGM * nN, gid = wgid / nig, fm = gid * WGM, gsz = (nM - fm) < WGM ? (nM - fm) : WGM;
        u.pm = fm + ((wgid % nig) % gsz); u.pn = (wgid % nig) / gsz; return true;
    }
    __device__ __forceinline__ void a_ready(const Unit&) const {}
    __device__ __forceinline__ void done(const Unit&) const {}
};

__device__ __forceinline__ unsigned cvt_pk_bf16(float lo, float hi) { unsigned r; asm volatile("v_cvt_pk_bf16_f32 %0, %1, %2" : "=v"(r) : "v"(lo), "v"(hi)); return r; }
__device__ __forceinline__ float sigm(float x) { return __builtin_amdgcn_rcpf(1.0f + __expf(-x)); }

struct EpiProj {
    static constexpr bool PERM = true, AFTER_DRAIN = false;
    bf16_t *U, *QIG; float* F; const float* bias; const float* lb;
    __device__ __forceinline__ void operator()(const f32x4 (&acc)[2][2][4][2], const Unit& u, int wr, int wc, int fr, int fq) const {
        const int row0 = u.pm * BM + wr * 64 + fr;
        const int cl = wc * 32 + 8 * fq;
        const int bcol = u.pn * BM + cl;
        f32x4 bv[2][2];
#pragma unroll
        for (int bj = 0; bj < 2; ++bj)
#pragma unroll
            for (int n = 0; n < 2; ++n) bv[bj][n] = *(const f32x4*)(bias + bcol + bj * HALF + 4 * n);
        if (u.pn < 8) {
#pragma unroll
            for (int ai = 0; ai < 2; ++ai)
#pragma unroll
                for (int m = 0; m < 4; ++m) {
                    const size_t row = (size_t)(row0 + ai * HALF + m * 16);
                    float o[8];
#pragma unroll
                    for (int n = 0; n < 2; ++n) { const f32x4 a = acc[ai][0][m][n] + bv[0][n], g = acc[ai][1][m][n] + bv[1][n];
#pragma unroll
                        for (int e = 0; e < 4; ++e) o[n * 4 + e] = a[e] * sigm(g[e]); }
                    u32x4 w; w.x = cvt_pk_bf16(o[0], o[1]); w.y = cvt_pk_bf16(o[2], o[3]); w.z = cvt_pk_bf16(o[4], o[5]); w.w = cvt_pk_bf16(o[6], o[7]);
                    *(u32x4*)(U + row * 1024 + u.pn * HALF + cl) = w;
                }
        } else {
            const int grp = (u.pn - 8) >> 2;
            const int cbase = ((u.pn - 8) & 3) * BM + cl;
            if (grp == 1) {
                f32x4 lv[2][2];
#pragma unroll
                for (int bj = 0; bj < 2; ++bj)
#pragma unroll
                    for (int n = 0; n < 2; ++n) lv[bj][n] = *(const f32x4*)(lb + cbase + bj * HALF + 4 * n);
#pragma unroll
                for (int ai = 0; ai < 2; ++ai)
#pragma unroll
                    for (int m = 0; m < 4; ++m) {
                        const size_t row = (size_t)(row0 + ai * HALF + m * 16);
#pragma unroll
                        for (int bj = 0; bj < 2; ++bj)
#pragma unroll
                            for (int n = 0; n < 2; ++n) { const f32x4 x = acc[ai][bj][m][n] + bv[bj][n]; const f32x4 l = lv[bj][n]; f32x4 o;
#pragma unroll
                                for (int e = 0; e < 4; ++e) o[e] = l[e] + (1.0f - l[e]) * sigm(x[e]);
                                *(f32x4*)(F + row * 1024 + cbase + bj * HALF + 4 * n) = o; }
                    }
            } else {
                bf16_t* O = QIG + (size_t)(grp - (grp > 0 ? 1 : 0)) * ((size_t)8704 * 1024);
                const bool act = grp != 2;
#pragma unroll
                for (int ai = 0; ai < 2; ++ai)
#pragma unroll
                    for (int m = 0; m < 4; ++m) {
                        const size_t row = (size_t)(row0 + ai * HALF + m * 16);
#pragma unroll
                        for (int bj = 0; bj < 2; ++bj) { float o[8];
#pragma unroll
                            for (int n = 0; n < 2; ++n) { const f32x4 x = acc[ai][bj][m][n] + bv[bj][n];
#pragma unroll
                                for (int e = 0; e < 4; ++e) o[n * 4 + e] = act ? x[e] * sigm(x[e]) : x[e]; }
                            u32x4 w; w.x = cvt_pk_bf16(o[0], o[1]); w.y = cvt_pk_bf16(o[2], o[3]); w.z = cvt_pk_bf16(o[4], o[5]); w.w = cvt_pk_bf16(o[6], o[7]);
                            *(u32x4*)(O + row * 1024 + cbase + bj * HALF) = w; }
                    }
            }
        }
    }
};
struct EpiRes {
    static constexpr bool PERM = false, AFTER_DRAIN = false;
    const float* baseP; const float* baseS; float* out; int split; float alpha;
    __device__ __forceinline__ void operator()(const f32x4 (&acc)[2][2][4][2], const Unit& u, int wr, int wc, int fr, int fq) const {
        const int row0 = u.pm * BM + wr * 64 + fr;
        const int col0 = u.pn * BM + wc * 32 + 4 * fq;
#pragma unroll
        for (int ai = 0; ai < 2; ++ai)
#pragma unroll
            for (int m = 0; m < 4; ++m) {
                const int row = row0 + ai * HALF + m * 16;
                const float* bp = row < split ? baseP + (size_t)row * 2048 : baseS + (size_t)(row - split) * 2048;
                float* op = out + (size_t)row * 2048;
#pragma unroll
                for (int bj = 0; bj < 2; ++bj)
#pragma unroll
                    for (int n = 0; n < 2; ++n) { const int c = col0 + bj * HALF + n * 16; const f32x4 b = *(const f32x4*)(bp + c); *(f32x4*)(op + c) = b * alpha + acc[ai][bj][m][n]; }
            }
    }
};
struct EpiGateUp {
    static constexpr bool PERM = true, AFTER_DRAIN = false;
    bf16_t* O; int ldc;
    __device__ __forceinline__ void operator()(const f32x4 (&acc)[2][2][4][2], const Unit& u, int wr, int wc, int fr, int fq) const {
        const int row0 = u.pm * BM + wr * 64 + fr;
        const int cl = wc * 32 + 8 * fq;
#pragma unroll
        for (int ai = 0; ai < 2; ++ai)
#pragma unroll
            for (int m = 0; m < 4; ++m) {
                const size_t row = (size_t)(row0 + ai * HALF + m * 16);
                float o[8];
#pragma unroll
                for (int n = 0; n < 2; ++n) { const f32x4 g = acc[ai][0][m][n], up = acc[ai][1][m][n];
#pragma unroll
                    for (int e = 0; e < 4; ++e) o[n * 4 + e] = g[e] * sigm(g[e]) * up[e]; }
                u32x4 w; w.x = cvt_pk_bf16(o[0], o[1]); w.y = cvt_pk_bf16(o[2], o[3]); w.z = cvt_pk_bf16(o[4], o[5]); w.w = cvt_pk_bf16(o[6], o[7]);
                *(u32x4*)(O + row * ldc + u.pn * HALF + cl) = w;
            }
    }
};

template <class Epi, class Sched, bool ALIGN_EPI = false, bool SP2 = false>
__device__ __forceinline__ void gemm_phase(PG8_LAS unsigned char* lds, const Gemm g, const Sched& S, const Epi& E) {
    int tid_ = threadIdx.x; asm volatile("" : "+v"(tid_));
    const int tid = tid_, wid = __builtin_amdgcn_readfirstlane(tid >> 6), lane = tid & 63, wr = wid >> 2, wc = wid & 3, fr = lane & 15, fq = lane >> 4;
    const int K = g.K, nt = K / BK;
    unsigned voffA[2], voffB[2];
#pragma unroll
    for (int i = 0; i < 2; ++i) { int R, C; stage_rc(tid * 16 + i * 8192, R, C); const int Rb = Epi::PERM ? ((R & ~31) + perm32(R & 31)) : R;
        voffA[i] = (unsigned)(R * K + C) * 2u; voffB[i] = (unsigned)(Rb * K + C) * 2u; }
    const size_t kstep = (size_t)(BK * 2);
    const size_t hstep = (size_t)HALF * K * 2;
    const size_t tstep = 2 * hstep;
    const unsigned ldsw = (unsigned)wid * 1024u;
    const int aoff = lds_byte(wr * 64 + fr, fq * 8), boff = lds_byte(wc * 32 + fr, fq * 8);
#define PG8_SA(b, h) (((b) * 2 + (h)) * HTB)
#define PG8_SB(b, h) ((4 + (b) * 2 + (h)) * HTB)
#define PG8_STAGE(bufoff, gbase, voff) do { _Pragma("unroll") for (int _i = 0; _i < 2; ++_i) \
        __builtin_amdgcn_global_load_lds((const unsigned*)((const char*)(gbase) + (voff)[_i]), (PG8_LAS unsigned*)(lds + (bufoff) + ldsw + _i * 8192), 16, 0, 0); } while (0)
#define PG8_LDA(dst, b, h) do { _Pragma("unroll") for (int m = 0; m < 4; ++m) _Pragma("unroll") for (int k = 0; k < 2; ++k) dst[m][k] = *(const PG8_LAS bf16x8*)(lds + PG8_SA(b, h) + aoff + m * 2048 + k * 1024); } while (0)
#define PG8_LDB(dst, b, h) do { _Pragma("unroll") for (int n = 0; n < 2; ++n) _Pragma("unroll") for (int k = 0; k < 2; ++k) dst[n][k] = *(const PG8_LAS bf16x8*)(lds + PG8_SB(b, h) + boff + n * 2048 + k * 1024); } while (0)
#define PG8_MMA(ai, bj, At, Bt) do { __builtin_amdgcn_s_setprio(1); _Pragma("unroll") for (int m = 0; m < 4; ++m) _Pragma("unroll") for (int n = 0; n < 2; ++n) _Pragma("unroll") for (int k = 0; k < 2; ++k) \
        acc[ai][bj][m][n] = __builtin_amdgcn_mfma_f32_16x16x32_bf16(Bt[n][k], At[m][k], acc[ai][bj][m][n], 0, 0, 0); __builtin_amdgcn_s_setprio(0); } while (0)
#define PG8_WAIT_V(n) asm volatile("s_waitcnt vmcnt(" #n ")" ::: "memory")
#define PG8_WAIT_L(n) asm volatile("s_waitcnt lgkmcnt(" #n ")" ::: "memory")
#define PG8_BAR __builtin_amdgcn_s_barrier()
#define PG8_SCHED __builtin_amdgcn_sched_barrier(0)
    Unit cur, nxt; int ui = 0;
    if (!S.next(0, cur)) return;
    f32x4 acc[2][2][4][2];
#pragma unroll
    for (int a = 0; a < 2; ++a)
#pragma unroll
        for (int b = 0; b < 2; ++b)
#pragma unroll
            for (int m = 0; m < 4; ++m)
#pragma unroll
                for (int n = 0; n < 2; ++n) acc[a][b][m][n] = (f32x4){0.f, 0.f, 0.f, 0.f};
    bf16x8 At[4][2], B0[2][2], B1[2][2];
    const char* cA = (const char*)g.A + (size_t)cur.pm * tstep; const char* cB = (const char*)g.Bt + (size_t)cur.pn * tstep;
    S.a_ready(cur);
    if constexpr (SP2) {
        PG8_STAGE(PG8_SB(0, 0), cB, voffB); PG8_STAGE(PG8_SB(0, 1), cB + hstep, voffB); PG8_STAGE(PG8_SA(0, 0), cA, voffA); PG8_STAGE(PG8_SA(0, 1), cA + hstep, voffA);
        if (wr == 1) PG8_BAR;
        PG8_WAIT_V(2); PG8_BAR;
        PG8_STAGE(PG8_SB(1, 0), cB + kstep, voffB); PG8_STAGE(PG8_SA(1, 0), cA + kstep, voffA); PG8_STAGE(PG8_SB(1, 1), cB + hstep + kstep, voffB);
        PG8_WAIT_V(6); PG8_BAR;
    } else {
        PG8_STAGE(PG8_SB(0, 0), cB, voffB); PG8_STAGE(PG8_SA(0, 0), cA, voffA); PG8_STAGE(PG8_SB(0, 1), cB + hstep, voffB); PG8_STAGE(PG8_SA(0, 1), cA + hstep, voffA);
        if (wr == 1) PG8_BAR;
        PG8_WAIT_V(4); PG8_BAR;
        PG8_STAGE(PG8_SB(1, 0), cB + kstep, voffB); PG8_STAGE(PG8_SA(1, 0), cA + kstep, voffA); PG8_STAGE(PG8_SB(1, 1), cB + hstep + kstep, voffB);
        PG8_WAIT_V(6); PG8_BAR;
    }
    for (;;) {
        const bool has_next = S.next(ui + 1, nxt);
        const char* nA = has_next ? (const char*)g.A + (size_t)nxt.pm * tstep : cA; const char* nB = has_next ? (const char*)g.Bt + (size_t)nxt.pn * tstep : cB;
        for (int t = 0; t < nt; t += 2) {
            const bool last = (t == nt - 2);
            const char* a1 = cA + (size_t)(t + 1) * kstep;
            const char* a2 = last ? nA : cA + (size_t)(t + 2) * kstep; const char* b2 = last ? nB : cB + (size_t)(t + 2) * kstep;
            const char* a3 = a2 + kstep; const char* b3 = b2 + kstep;
            if (last && has_next) S.a_ready(nxt);
            if constexpr (SP2) {
            PG8_LDB(B0, 0, 0); PG8_LDB(B1, 0, 1); PG8_SCHED; PG8_LDA(At, 0, 0); PG8_STAGE(PG8_SA(1, 1), a1 + hstep, voffA);
            PG8_WAIT_V(8); PG8_WAIT_L(0); PG8_BAR; PG8_MMA(0, 0, At, B0); PG8_MMA(0, 1, At, B1); PG8_BAR; PG8_SCHED;
            PG8_LDA(At, 0, 1); PG8_STAGE(PG8_SB(0, 0), b2, voffB); PG8_STAGE(PG8_SB(0, 1), b2 + hstep, voffB); PG8_STAGE(PG8_SA(0, 0), a2, voffA);
            PG8_WAIT_V(8); PG8_WAIT_L(0); PG8_BAR; PG8_MMA(1, 0, At, B0); PG8_MMA(1, 1, At, B1); PG8_BAR; PG8_SCHED;
            PG8_LDB(B0, 1, 0); PG8_LDB(B1, 1, 1); PG8_SCHED; PG8_LDA(At, 1, 0); PG8_STAGE(PG8_SA(0, 1), a2 + hstep, voffA);
            PG8_WAIT_V(8); PG8_WAIT_L(0); PG8_BAR; PG8_MMA(0, 0, At, B0); PG8_MMA(0, 1, At, B1); PG8_BAR; PG8_SCHED;
            PG8_LDA(At, 1, 1); PG8_STAGE(PG8_SB(1, 0), b3, voffB); PG8_STAGE(PG8_SB(1, 1), b3 + hstep, voffB); PG8_STAGE(PG8_SA(1, 0), a3, voffA);
            PG8_WAIT_V(8); PG8_WAIT_L(0); PG8_BAR; PG8_MMA(1, 0, At, B0); PG8_MMA(1, 1, At, B1); PG8_BAR; PG8_SCHED;
            } else {
            PG8_LDB(B0, 0, 0); PG8_SCHED; PG8_LDA(At, 0, 0); PG8_STAGE(PG8_SA(1, 1), a1 + hstep, voffA);
            PG8_WAIT_L(8); PG8_BAR; PG8_WAIT_L(0); PG8_MMA(0, 0, At, B0); PG8_BAR; PG8_SCHED;
            PG8_LDB(B1, 0, 1); PG8_STAGE(PG8_SB(0, 0), b2, voffB);
            PG8_BAR; PG8_WAIT_L(0); PG8_MMA(0, 1, At, B1); PG8_BAR;
            PG8_LDA(At, 0, 1); PG8_STAGE(PG8_SA(0, 0), a2, voffA);
            PG8_BAR; PG8_WAIT_L(0); PG8_MMA(1, 0, At, B0); PG8_BAR; PG8_SCHED;
            PG8_STAGE(PG8_SB(0, 1), b2 + hstep, voffB);
            PG8_WAIT_V(6); PG8_BAR; PG8_MMA(1, 1, At, B1); PG8_BAR;
            PG8_LDB(B0, 1, 0); PG8_SCHED; PG8_LDA(At, 1, 0); PG8_STAGE(PG8_SA(0, 1), a2 + hstep, voffA);
            PG8_WAIT_L(8); PG8_BAR; PG8_WAIT_L(0); PG8_MMA(0, 0, At, B0); PG8_BAR; PG8_SCHED;
            PG8_LDB(B1, 1, 1); PG8_STAGE(PG8_SB(1, 0), b3, voffB);
            PG8_BAR; PG8_WAIT_L(0); PG8_MMA(0, 1, At, B1); PG8_BAR;
            PG8_LDA(At, 1, 1); PG8_STAGE(PG8_SA(1, 0), a3, voffA);
            PG8_BAR; PG8_WAIT_L(0); PG8_MMA(1, 0, At, B0); PG8_BAR; PG8_SCHED;
            PG8_STAGE(PG8_SB(1, 1), b3 + hstep, voffB);
            PG8_WAIT_V(6); PG8_BAR; PG8_MMA(1, 1, At, B1); PG8_BAR;
            }
        }
        if constexpr (ALIGN_EPI) { if (wr == 0) PG8_BAR; }
        if constexpr (!Epi::AFTER_DRAIN) { E(acc, cur, wr, wc, fr, fq); S.done(cur); }
        if (!has_next) break;
#pragma unroll
        for (int a = 0; a < 2; ++a)
#pragma unroll
            for (int b = 0; b < 2; ++b)
#pragma unroll
                for (int m = 0; m < 4; ++m)
#pragma unroll
                    for (int n = 0; n < 2; ++n) acc[a][b][m][n] = (f32x4){0.f, 0.f, 0.f, 0.f};
        cur = nxt; cA = nA; cB = nB; ++ui;
        if constexpr (ALIGN_EPI) { if (wr == 1) PG8_BAR; }
    }
    PG8_WAIT_V(0);
    if constexpr (!ALIGN_EPI) { if (wr == 0) PG8_BAR; }
    PG8_BAR;
#undef PG8_SA
#undef PG8_SB
#undef PG8_STAGE
#undef PG8_LDA
#undef PG8_LDB
#undef PG8_MMA
#undef PG8_WAIT_V
#undef PG8_WAIT_L
#undef PG8_BAR
#undef PG8_SCHED
}
}

constexpr int D = 2048, MP = 8192, MS = 512, M = MP + MS, CW = 1024, NH = 8, HD = 128, FF = 5632, NIN = 6144;
constexpr float LN_EPS = 1e-5f;
constexpr float ALPHA = 1.189207115002721f;
constexpr int NWAVES = 8;
constexpr int LDS_BYTES = 147456;
constexpr int N_PHASES = 10;

constexpr size_t MiB = 1u << 20;
constexpr size_t WS_LB = 64 * 1024, WS_BIASP = 128 * 1024;
constexpr size_t WS_WIN = 1 * MiB, WS_WOUT = 25 * MiB, WS_WGU = 33 * MiB, WS_WDN = 77 * MiB;
constexpr size_t WS_XB = 99 * MiB, WS_MIX = 133 * MiB;
constexpr size_t WS_U = 167 * MiB, WS_Q = 184 * MiB, WS_I = 201 * MiB, WS_G = 218 * MiB, WS_F = 235 * MiB, WS_END = 269 * MiB;
constexpr size_t WS_ACT = 167 * MiB;
static_assert(WS_ACT + (size_t)M * FF * 2 <= WS_END, "act overlay");
constexpr size_t O_Y = 0, O_NCP = (size_t)M * D, O_NHP = O_NCP + 4 * 30 * 1024, O_NCS = O_NHP + 4 * 8 * 128 * 128, O_NHS = O_NCS + 32 * 30 * 1024;
constexpr size_t O_ST = 0, O_DC = (size_t)1024 * 16384;

#define LAS __attribute__((address_space(3)))
typedef unsigned short bf16;
typedef float f32x4 __attribute__((ext_vector_type(4)));
typedef float f32x2 __attribute__((ext_vector_type(2)));
typedef unsigned v4u __attribute__((ext_vector_type(4)));
typedef unsigned v2u __attribute__((ext_vector_type(2)));
#define LDS_WAIT() asm volatile("s_waitcnt lgkmcnt(0)" ::: "memory")

__device__ __forceinline__ unsigned f2bf(float f) { unsigned u = __builtin_bit_cast(unsigned, f); return (u + 0x7fffu + ((u >> 16) & 1u)) >> 16; }
__device__ __forceinline__ unsigned pk2(float lo, float hi) { return f2bf(lo) | (f2bf(hi) << 16); }
__device__ __forceinline__ float bf2f(unsigned short b) { return __uint_as_float((unsigned)b << 16); }
__device__ __forceinline__ float sigm(float x) { return __builtin_amdgcn_rcpf(1.0f + __expf(-x)); }
__device__ __forceinline__ float wave_sum(float v) {
#pragma unroll
    for (int o = 1; o < 64; o <<= 1) v += __shfl_xor(v, o);
    return v;
}

__device__ __forceinline__ void transpose_item(const float* W, int K, int N, bf16* WT, int k0, int n0, int dst_row0, LAS float* scr, int lane) {
#pragma unroll 8
    for (int i = 0; i < 32; ++i) { const int kk = 2 * i + (lane >> 5); scr[kk * 33 + (lane & 31)] = W[(size_t)(k0 + kk) * N + n0 + (lane & 31)]; }
    LDS_WAIT(); asm volatile("" ::: "memory");
    const int c = lane & 7;
#pragma unroll
    for (int j = 0; j < 4; ++j) { const int n = (lane >> 3) + 8 * j; const LAS float* s = scr + (8 * c) * 33 + n;
        v4u o; o.x = pk2(s[0 * 33], s[1 * 33]); o.y = pk2(s[2 * 33], s[3 * 33]); o.z = pk2(s[4 * 33], s[5 * 33]); o.w = pk2(s[6 * 33], s[7 * 33]);
        *(v4u*)(WT + (size_t)(dst_row0 + n) * K + k0 + 8 * c) = o; }
    LDS_WAIT(); asm volatile("" ::: "memory");
}

__device__ __forceinline__ void ln_row(const float* src, float* dstf, bf16* dstb, const float* g, const float* b, int lane) {
    const f32x4* xr = (const f32x4*)src + lane;
    f32x4 v[8]; float s = 0.f;
#pragma unroll
    for (int j = 0; j < 8; ++j) { v[j] = xr[64 * j]; s += (v[j].x + v[j].y) + (v[j].z + v[j].w); }
    const float mean = wave_sum(s) * (1.f / D); float s2 = 0.f;
#pragma unroll
    for (int j = 0; j < 8; ++j) { v[j] = v[j] - mean; s2 += (v[j].x * v[j].x + v[j].y * v[j].y) + (v[j].z * v[j].z + v[j].w * v[j].w); }
    const float rstd = 1.f / sqrtf(wave_sum(s2) * (1.f / D) + LN_EPS);
#pragma unroll
    for (int j = 0; j < 8; ++j) {
        const f32x4 gg = ((const f32x4*)g)[lane + 64 * j], bb = ((const f32x4*)b)[lane + 64 * j];
        const f32x4 o = v[j] * rstd * gg + bb;
        if (dstf) ((f32x4*)dstf)[lane + 64 * j] = o;
        if (dstb) { v2u w; w.x = pk2(o.x, o.y); w.y = pk2(o.z, o.w); ((v2u*)dstb)[lane + 64 * j] = w; }
    }
}

struct Args { const float* in[20]; float* out; unsigned char* ws; int ph_lo, ph_hi; };

__global__ void __launch_bounds__(NWAVES * 64, 2) fwd_kernel(Args args) {
    extern __shared__ __attribute__((aligned(16))) unsigned char lds_raw[];
    LAS unsigned char* lds = (LAS unsigned char*)lds_raw;
    const int tid = threadIdx.x, lane = tid & 63, wave = __builtin_amdgcn_readfirstlane(tid >> 6);
    const int G = gridDim.x, bx = blockIdx.x;
    const int gt = bx * 512 + tid, NT = G * 512;
    const int gw = bx * NWAVES + wave, NGW = G * NWAVES;

#define x_prompt (args.in[0])
#define x_sample (args.in[1])
#define cache_conv (args.in[2])
#define state_hgrn (args.in[3])
#define w_in (args.in[4])
#define b_in (args.in[5])
#define w_dw (args.in[6])
#define b_dw (args.in[7])
#define cn_g (args.in[8])
#define cn_b (args.in[9])
#define hlb (args.in[10])
#define hg_ng (args.in[11])
#define w_out (args.in[12])
#define ln1_g (args.in[13])
#define ln1_b (args.in[14])
#define w_gate (args.in[15])
#define w_up (args.in[16])
#define w_down (args.in[17])
#define ln2_g (args.in[18])
#define ln2_b (args.in[19])
#define out (args.out)
#define ws (args.ws)
#define LB ((float*)(ws + WS_LB))
#define BIASP ((float*)(ws + WS_BIASP))
#define WIN ((bf16*)(ws + WS_WIN))
#define WOUT ((bf16*)(ws + WS_WOUT))
#define WGU ((bf16*)(ws + WS_WGU))
#define WDN ((bf16*)(ws + WS_WDN))
#define XB ((bf16*)(ws + WS_XB))
#define MIX ((bf16*)(ws + WS_MIX))
#define U ((bf16*)(ws + WS_U))
#define Q ((bf16*)(ws + WS_Q))
#define F ((float*)(ws + WS_F))
#define I ((bf16*)(ws + WS_I))
#define Gt ((bf16*)(ws + WS_G))
#define ACT ((bf16*)(ws + WS_ACT))
#define ST (out + O_ST)
#define DC (out + O_DC)

    const int lo = args.ph_lo, hi = args.ph_hi;
#ifndef PH_MASK
#define PH_MASK 0x3ff
#endif
#define IN(k) (((PH_MASK >> (k)) & 1) && lo <= (k) && (k) < hi)
#define SEAM(k) do { if (IN(k) && IN((k) + 1)) { cg::this_grid().sync(); } } while (0)

    if (IN(0)) {
        LAS float* scr = (LAS float*)(lds + wave * 16384);
        constexpr int I_IN = 32 * 192, I_OUT = 32 * 64, I_G = 32 * 176, I_DN = 88 * 64;
        constexpr int NITEMS = I_IN + I_OUT + 2 * I_G + I_DN;
        for (int it = gw; it < NITEMS; it += NGW) {
            int r = it; const float* W; int K, N; bf16* WT; int kind;
            if (r < I_IN) { kind = 0; W = w_in; K = D; N = NIN; WT = WIN; }
            else if ((r -= I_IN) < I_OUT) { kind = 1; W = w_out; K = D; N = D; WT = WOUT; }
            else if ((r -= I_OUT) < I_G) { kind = 2; W = w_gate; K = D; N = FF; WT = WGU; }
            else if ((r -= I_G) < I_G) { kind = 3; W = w_up; K = D; N = FF; WT = WGU; }
            else { r -= I_G; kind = 4; W = w_down; K = FF; N = D; WT = WDN; }
            const int nblk = N / 32, kb = r / nblk, nb = r % nblk, k0 = 64 * kb, n0 = 32 * nb;
            int dst;
            if (kind == 0) dst = n0 < 2048 ? ((n0 & 1023) >> 7) * 256 + (n0 >> 10) * 128 + (n0 & 127) : n0;
            else if (kind == 2) dst = (n0 >> 7) * 256 + (n0 & 127);
            else if (kind == 3) dst = (n0 >> 7) * 256 + 128 + (n0 & 127);
            else dst = n0;
            transpose_item(W, K, N, WT, k0, n0, dst, scr, lane);
        }
        constexpr int NV = M * D / 8, NVP = MP * D / 8;
        for (int i = gt; i < NV; i += NT) {
            const float* src = i < NVP ? x_prompt + (size_t)i * 8 : x_sample + (size_t)(i - NVP) * 8;
            const f32x4 a = *(const f32x4*)src, b = *(const f32x4*)(src + 4);
            v4u o; o.x = pk2(a.x, a.y); o.y = pk2(a.z, a.w); o.z = pk2(b.x, b.y); o.w = pk2(b.z, b.w);
            *(v4u*)(XB + (size_t)i * 8) = o;
        }
        for (int i = gt; i < 1024; i += NT) LB[i] = sigm(hlb[i] - hlb[1024 + i]);
        for (int i = gt; i < NIN; i += NT) { const int orig = i < 2048 ? ((i & 255) >> 7) * 1024 + (i >> 8) * 128 + (i & 127) : i; BIASP[i] = b_in[orig]; }
    }
    SEAM(0);

    if (IN(1)) {
        pg8::Gemm g{XB, WIN, M, NIN, D}; pg8::StaticOrder S; S.init(M, NIN, G, bx);
        pg8::EpiProj E{U, Q, F, BIASP, LB};
        pg8::gemm_phase<pg8::EpiProj, pg8::StaticOrder, true, true>(lds, g, S, E);
    }
    SEAM(1);

    if (IN(2)) {
        LAS float* fl = (LAS float*)lds; LAS float* vl = (LAS float*)(lds + 8192);
        LAS float* redc = (LAS float*)(lds + 60000 / 16 * 16); LAS float* tot = redc + 128;
        const int kg = tid >> 7, v = tid & 127;
        for (int it = bx; it < 1024 + 1088; it += G) {
            __syncthreads();
            if (it < 1024) {
                const int bh = it >> 5, c = it & 31, b = bh >> 3, h = bh & 7;
                const int row0 = b * 2048 + c * 64;
                float S[32];
#pragma unroll
                for (int i = 0; i < 32; ++i) S[i] = 0.f;
                float dprod = 1.f;
                for (int sb = 0; sb < 4; ++sb) {
                    __syncthreads();
#pragma unroll
                    for (int e4 = 0; e4 < 4; ++e4) { const int e = tid + e4 * 512, t = e >> 7, k = e & 127; const size_t gi = (size_t)(row0 + sb * 16 + t) * 1024 + h * 128 + k;
                        fl[e] = F[gi]; vl[e] = bf2f(I[gi]); }
                    __syncthreads();
#pragma unroll 2
                    for (int t = 0; t < 16; ++t) {
                        const float vv = vl[t * 128 + v];
#pragma unroll
                        for (int k4 = 0; k4 < 8; ++k4) { const f32x4 f = *(const LAS f32x4*)(fl + t * 128 + kg * 32 + k4 * 4);
#pragma unroll
                            for (int e = 0; e < 4; ++e) S[k4 * 4 + e] = f[e] * (S[k4 * 4 + e] - vv) + vv; }
                    }
                    if (tid < 128) {
#pragma unroll
                        for (int t = 0; t < 16; ++t) dprod *= fl[t * 128 + tid];
                    }
                }
                float* sp = ST + (size_t)it * 16384 + (size_t)(kg * 32) * 128 + v;
#pragma unroll
                for (int i = 0; i < 32; ++i) sp[i * 128] = S[i];
                if (tid < 128) DC[it * 128 + tid] = dprod;
            } else {
                const int m0 = (it - 1024) * 8;
                const bool samp = m0 >= MP;
                int t0, seq0; const float* hist = cache_conv;
                if (!samp) { t0 = m0 & 2047; seq0 = m0 - t0; }
                else { const int sbi = (m0 - MP) >> 4; t0 = (m0 - MP) & 15; seq0 = MP + sbi * 16; hist = cache_conv + (size_t)sbi * 30 * 1024; }
                LAS float* hbuf = (LAS float*)(lds + 16384);
                float s1[8], s2[8];
#pragma unroll
                for (int t = 0; t < 8; ++t) { s1[t] = 0.f; s2[t] = 0.f; }
#pragma unroll 1
                for (int p = 0; p < 2; ++p) {
                    const int c = tid + p * 512;
                    const unsigned cb2 = (unsigned)c * 2u, cb4 = (unsigned)c * 4u;
                    float w0[38];
#pragma unroll
                    for (int jj = 0; jj < 38; ++jj) {
                        const int tr = t0 - 30 + jj;
                        float a = 0.f;
                        if (tr >= 0) a = bf2f(*(const bf16*)((const char*)(U + (size_t)(seq0 + tr) * 1024) + cb2));
                        else if (samp) a = *(const float*)((const char*)(hist + (30 + tr) * 1024) + cb4);
                        w0[jj] = a;
                    }
                    float a0[8];
                    { const float bb = *(const float*)((const char*)b_dw + cb4);
#pragma unroll
                      for (int t = 0; t < 8; ++t) a0[t] = bb; }
#pragma unroll
                    for (int j = 0; j < 31; ++j) { const float wv = *(const float*)((const char*)(w_dw + j * 1024) + cb4);
#pragma unroll
                        for (int t = 0; t < 8; ++t) a0[t] += wv * w0[t + j]; }
#pragma unroll
                    for (int t = 0; t < 8; ++t) { hbuf[t * 1024 + c] = a0[t]; s1[t] += a0[t]; s2[t] += a0[t] * a0[t]; }
                }
                float st[16];
#pragma unroll
                for (int t = 0; t < 8; ++t) { st[t] = wave_sum(s1[t]); st[8 + t] = wave_sum(s2[t]); }
                if (lane == 0) {
#pragma unroll
                    for (int i = 0; i < 16; ++i) redc[wave * 16 + i] = st[i];
                }
                __syncthreads();
                if (tid < 16) { float s = 0.f;
#pragma unroll
                    for (int w = 0; w < 8; ++w) s += redc[w * 16 + tid];
                    tot[tid] = s; }
                __syncthreads();
                const int c = 2 * tid;
                const f32x2 gg = *(const f32x2*)(cn_g + c), bb2 = *(const f32x2*)(cn_b + c);
#pragma unroll
                for (int t = 0; t < 8; ++t) {
                    const float mu = tot[t] * (1.f / 1024.f); float var = tot[8 + t] * (1.f / 1024.f) - mu * mu; var = var > 0.f ? var : 0.f;
                    const float rstd = 1.f / sqrtf(var + LN_EPS);
                    const f32x2 hv = *(const LAS f32x2*)(hbuf + t * 1024 + c);
                    float y0 = (hv.x - mu) * rstd * gg.x + bb2.x, y1 = (hv.y - mu) * rstd * gg.y + bb2.y;
                    y0 = y0 * sigm(y0); y1 = y1 * sigm(y1);
                    *(unsigned*)(MIX + (size_t)(m0 + t) * 2048 + c) = pk2(y0, y1);
                }
            }
        }
        for (int i = gt; i < 4 * 30 * 1024; i += NT) { const int b = i / 30720, j = (i >> 10) % 30, c = i & 1023;
            out[O_NCP + i] = bf2f(U[(size_t)(b * 2048 + 2018 + j) * 1024 + c]); }
        for (int i = gt; i < 32 * 30 * 1024; i += NT) { const int sb = i / 30720, j = (i >> 10) % 30, c = i & 1023;
            out[O_NCS + i] = j < 14 ? cache_conv[(size_t)sb * 30720 + (16 + j) * 1024 + c] : bf2f(U[(size_t)(MP + sb * 16 + j - 14) * 1024 + c]); }
    }
    SEAM(2);

    if (IN(3)) {
        for (int e = gt; e < 32 * 4096; e += NT) {
            const int bh = e >> 12, r = e & 4095, k = r >> 5, v4 = r & 31;
            f32x4 S = (f32x4){0.f, 0.f, 0.f, 0.f};
#pragma unroll 8
            for (int c = 0; c < 32; ++c) {
                f32x4* p = (f32x4*)(ST + ((size_t)(bh * 32 + c) * 128 + k) * 128 + v4 * 4);
                const f32x4 A = *p; const float d = DC[(bh * 32 + c) * 128 + k];
                *p = S; S = S * d + A;
            }
            *(f32x4*)(out + O_NHP + ((size_t)bh * 128 + k) * 128 + v4 * 4) = S;
        }
    }
    SEAM(3);

    if (IN(4)) {
        LAS float* fl = (LAS float*)lds; LAS float* vl = (LAS float*)(lds + 8192); LAS float* ql = (LAS float*)(lds + 16384); LAS float* red = (LAS float*)(lds + 24576);
        const int kg = tid >> 7, v = tid & 127;
        for (int it = bx; it < 1024 + 256; it += G) {
            int row0, h, nsb; const float* sinit; float* sfin = nullptr;
            if (it < 1024) { const int bh = it >> 5, c = it & 31; h = bh & 7; row0 = (bh >> 3) * 2048 + c * 64; nsb = 4; sinit = ST + (size_t)it * 16384; }
            else { const int j = it - 1024; h = j & 7; row0 = MP + (j >> 3) * 16; nsb = 1; sinit = state_hgrn + (size_t)j * 16384; sfin = out + O_NHS + (size_t)j * 16384; }
            float S[32];
            { const float* sp = sinit + (size_t)(kg * 32) * 128 + v;
#pragma unroll
              for (int i = 0; i < 32; ++i) S[i] = sp[i * 128]; }
            for (int sb = 0; sb < nsb; ++sb) {
                __syncthreads();
#pragma unroll
                for (int e4 = 0; e4 < 4; ++e4) { const int e = tid + e4 * 512, t = e >> 7, k = e & 127; const size_t gi = (size_t)(row0 + sb * 16 + t) * 1024 + h * 128 + k;
                    fl[e] = F[gi]; vl[e] = bf2f(I[gi]); ql[e] = bf2f(Q[gi]); }
                __syncthreads();
#pragma unroll 2
                for (int t = 0; t < 16; ++t) {
                    const float vv = vl[t * 128 + v]; float o = 0.f;
#pragma unroll
                    for (int k4 = 0; k4 < 8; ++k4) { const f32x4 f = *(const LAS f32x4*)(fl + t * 128 + kg * 32 + k4 * 4); const f32x4 q = *(const LAS f32x4*)(ql + t * 128 + kg * 32 + k4 * 4);
#pragma unroll
                        for (int e = 0; e < 4; ++e) { const float s = f[e] * (S[k4 * 4 + e] - vv) + vv; S[k4 * 4 + e] = s; o += q[e] * s; } }
                    red[(kg * 16 + t) * 128 + v] = o;
                }
                __syncthreads();
#pragma unroll
                for (int tt = 0; tt < 2; ++tt) {
                    const int t = wave * 2 + tt;
                    float o0 = 0.f, o1 = 0.f;
#pragma unroll
                    for (int q4 = 0; q4 < 4; ++q4) { o0 += red[(q4 * 16 + t) * 128 + lane]; o1 += red[(q4 * 16 + t) * 128 + 64 + lane]; }
                    const float ss = wave_sum(o0 * o0 + o1 * o1);
                    const float r = 1.f / sqrtf(ss * (1.f / 128.f) + LN_EPS);
                    const size_t m = (size_t)(row0 + sb * 16 + t);
                    const float g0 = bf2f(Gt[m * 1024 + h * 128 + lane]), g1 = bf2f(Gt[m * 1024 + h * 128 + 64 + lane]);
                    MIX[m * 2048 + 1024 + h * 128 + lane] = (bf16)f2bf(o0 * r * hg_ng[lane] * g0);
                    MIX[m * 2048 + 1024 + h * 128 + 64 + lane] = (bf16)f2bf(o1 * r * hg_ng[64 + lane] * g1);
                }
            }
            if (sfin) { float* sp = sfin + (size_t)(kg * 32) * 128 + v;
#pragma unroll
                for (int i = 0; i < 32; ++i) sp[i * 128] = S[i]; }
        }
        __syncthreads();
    }
    SEAM(4);

    if (IN(5)) {
        pg8::Gemm g{MIX, WOUT, M, D, D}; pg8::StaticOrder S; S.init(M, D, G, bx);
        pg8::EpiRes E{x_prompt, x_sample, out, MP, ALPHA};
        pg8::gemm_phase<pg8::EpiRes, pg8::StaticOrder, true, true>(lds, g, S, E);
    }
    SEAM(5);

    if (IN(6)) {
        for (int m = gw; m < M; m += NGW) ln_row(out + (size_t)m * D, out + (size_t)m * D, XB + (size_t)m * D, ln1_g, ln1_b, lane);
    }
    SEAM(6);

    if (IN(7)) {
        pg8::Gemm g{XB, WGU, M, 2 * FF, D}; pg8::StaticOrder S; S.init(M, 2 * FF, G, bx);
        pg8::EpiGateUp E{ACT, FF};
        pg8::gemm_phase<pg8::EpiGateUp, pg8::StaticOrder, true, true>(lds, g, S, E);
    }
    SEAM(7);

    if (IN(8)) {
        pg8::Gemm g{ACT, WDN, M, D, FF}; pg8::StaticOrder S; S.init(M, D, G, bx);
        pg8::EpiRes E{out, out + (size_t)MP * D, out, MP, ALPHA};
        pg8::gemm_phase<pg8::EpiRes, pg8::StaticOrder, true, true>(lds, g, S, E);
    }
    SEAM(8);

    if (IN(9)) {
        for (int m = gw; m < M; m += NGW) ln_row(out + (size_t)m * D, out + (size_t)m * D, nullptr, ln2_g, ln2_b, lane);
    }
#undef IN
#undef SEAM
}

#undef x_prompt
#undef x_sample
#undef cache_conv
#undef state_hgrn
#undef w_in
#undef b_in
#undef w_dw
#undef b_dw
#undef cn_g
#undef cn_b
#undef hlb
#undef hg_ng
#undef w_out
#undef ln1_g
#undef ln1_b
#undef w_gate
#undef w_up
#undef w_down
#undef ln2_g
#undef ln2_b
#undef out
#undef ws
#undef LB
#undef BIASP
#undef WIN
#undef WOUT
#undef WGU
#undef WDN
#undef XB
#undef MIX
#undef U
#undef Q
#undef F
#undef I
#undef Gt
#undef ACT
#undef ST
#undef DC

extern "C" void kernel_launch(void* const* d_in, const int* in_sizes, int n_in, void* d_out, int out_size, void* d_ws, size_t ws_size, hipStream_t stream) {
    static int grid = 0;
    if (grid == 0) {
        int dev = 0, cus = 0, per_cu = 0;
        if (n_in != 20 || ws_size < WS_END) { fprintf(stderr, "kernel_launch: unexpected n_in %d / ws_size %zu\n", n_in, ws_size); grid = -1; return; }
        if (hipGetDevice(&dev) != hipSuccess || hipDeviceGetAttribute(&cus, hipDeviceAttributeMultiprocessorCount, dev) != hipSuccess) { grid = -1; return; }
        if (hipFuncSetAttribute((const void*)fwd_kernel, hipFuncAttributeMaxDynamicSharedMemorySize, LDS_BYTES) != hipSuccess) { fprintf(stderr, "kernel_launch: hipFuncSetAttribute failed\n"); grid = -1; return; }
        if (hipOccupancyMaxActiveBlocksPerMultiprocessor(&per_cu, (const void*)fwd_kernel, NWAVES * 64, LDS_BYTES) != hipSuccess || per_cu < 1) { fprintf(stderr, "kernel_launch: occupancy query says %d\n", per_cu); }
        (void)hipGetLastError();
        grid = cus;
    }
    if (grid < 0) return;
    Args a{};
    for (int i = 0; i < 20; ++i) a.in[i] = (const float*)d_in[i];
    a.out = (float*)d_out; a.ws = (unsigned char*)d_ws;
#if MK_ONE_LAUNCH
    a.ph_lo = 0; a.ph_hi = N_PHASES;
    void* kargs[] = {&a};
    hipError_t e = hipLaunchCooperativeKernel((const void*)fwd_kernel, dim3(grid), dim3(NWAVES * 64), kargs, LDS_BYTES, stream);
    if (e != hipSuccess) fprintf(stderr, "cooperative launch failed: %s (grid %d)\n", hipGetErrorString(e), grid);
#else
    for (int p = 0; p < N_PHASES; ++p) {
        a.ph_lo = p; a.ph_hi = p + 1;
        hipLaunchKernelGGL(fwd_kernel, dim3(grid), dim3(NWAVES * 64), LDS_BYTES, stream, a);
    }
#endif
}
```

```cpp
#include <hip/hip_runtime.h>
#include <hip/hip_cooperative_groups.h>
#include <cstdio>
#include <cstdint>
namespace cg = cooperative_groups;

#ifndef MK_ONE_LAUNCH
#define MK_ONE_LAUNCH 1
#endif

namespace pg8 {
#define PG8_LAS __attribute__((address_space(3)))
typedef unsigned short bf16_t;
typedef short bf16x8 __attribute__((ext_vector_type(8)));
typedef float f32x4 __attribute__((ext_vector_type(4)));
typedef unsigned u32x4 __attribute__((ext_vector_type(4)));
typedef unsigned u32x2 __attribute__((ext_vector_type(2)));
constexpr int BM = 256, BK = 64, HALF = 128, HTB = HALF * BK * 2, STAGE_BYTES = 8 * HTB, NXCD = 8, WGM = 8;

__host__ __device__ __forceinline__ int lds_byte(int r, int c) { const int st = (r >> 4) * 2 + (c >> 5), rr = r & 15, cc = c & 31, ob = rr * 64 + cc * 2; return st * 1024 + (ob ^ (((ob >> 9) & 1) << 5)); }
__host__ __device__ __forceinline__ void stage_rc(int b, int& R, int& C) { const int st = b / 1024, sb = b % 1024, swz = sb ^ (((sb >> 9) & 1) << 5); R = (st >> 1) * 16 + swz / 64; C = (st & 1) * 32 + (swz % 64) / 2; }
__host__ __device__ __forceinline__ int perm32(int rho) { const int n = rho >> 4, i = rho & 15; return 8 * (i >> 2) + 4 * n + (i & 3); }

struct Unit { int pm, pn; };
struct Gemm { const bf16_t* A; const bf16_t* Bt; int M, N, K; };

struct StaticOrder {
    int nM, nN, nwg, G, c;
    __host__ __device__ void init(int M, int N, int G_, int c_) { nM = M / BM; nN = N / BM; nwg = nM * nN; G = G_; c = c_; }
    __host__ __device__ bool next(int i, Unit& u) const {
        const long L = (long)i * G + c; if (L >= nwg) return false;
        int wgid = (int)L; { const int q = nwg / NXCD, r = nwg % NXCD, xcd = wgid % NXCD, off = wgid / NXCD; wgid = (xcd < r ? xcd * (q + 1) : r * (q + 1) + (xcd - r) * q) + off; }
        const int nig = WGM * nN, gid = wgid / nig, fm = gid * WGM, gsz = (nM - fm) < WGM ? (nM - fm) : WGM;
        u.pm = fm + ((wgid % nig) % gsz); u.pn = (wgid % nig) / gsz; return true;
    }
    __device__ __forceinline__ void a_ready(const Unit&) const {}
    __device__ __forceinline__ void done(const Unit&) const {}
};

__device__ __forceinline__ unsigned cvt_pk_bf16(float lo, float hi) { unsigned r; asm volatile("v_cvt_pk_bf16_f32 %0, %1, %2" : "=v"(r) : "v"(lo), "v"(hi)); return r; }
__device__ __forceinline__ float sigm(float x) { return __builtin_amdgcn_rcpf(1.0f + __expf(-x)); }

struct EpiProj {
    static constexpr bool PERM = true, AFTER_DRAIN = false;
    bf16_t *U, *QIG; float* F; const float* bias; const float* lb;
    __device__ __forceinline__ void operator()(const f32x4 (&acc)[2][2][4][2], const Unit& u, int wr, int wc, int fr, int fq) const {
        const int row0 = u.pm * BM + wr * 64 + fr;
        const int cl = wc * 32 + 8 * fq;
        const int bcol = u.pn * BM + cl;
        f32x4 bv[2][2];
#pragma unroll
        for (int bj = 0; bj < 2; ++bj)
#pragma unroll
            for (int n = 0; n < 2; ++n) bv[bj][n] = *(const f32x4*)(bias + bcol + bj * HALF + 4 * n);
        if (u.pn < 8) {
#pragma unroll
            for (int ai = 0; ai < 2; ++ai)
#pragma unroll
                for (int m = 0; m < 4; ++m) {
                    const size_t row = (size_t)(row0 + ai * HALF + m * 16);
                    float o[8];
#pragma unroll
                    for (int n = 0; n < 2; ++n) { const f32x4 a = acc[ai][0][m][n] + bv[0][n], g = acc[ai][1][m][n] + bv[1][n];
#pragma unroll
                        for (int e = 0; e < 4; ++e) o[n * 4 + e] = a[e] * sigm(g[e]); }
                    u32x4 w; w.x = cvt_pk_bf16(o[0], o[1]); w.y = cvt_pk_bf16(o[2], o[3]); w.z = cvt_pk_bf16(o[4], o[5]); w.w = cvt_pk_bf16(o[6], o[7]);
                    *(u32x4*)(U + row * 1024 + u.pn * HALF + cl) = w;
                }
        } else {
            const int grp = (u.pn - 8) >> 2;
            const int cbase = ((u.pn - 8) & 3) * BM + cl;
            if (grp == 1) {
                f32x4 lv[2][2];
#pragma unroll
                for (int bj = 0; bj < 2; ++bj)
#pragma unroll
                    for (int n = 0; n < 2; ++n) lv[bj][n] = *(const f32x4*)(lb + cbase + bj * HALF + 4 * n);
#pragma unroll
                for (int ai = 0; ai < 2; ++ai)
#pragma unroll
                    for (int m = 0; m < 4; ++m) {
                        const size_t row = (size_t)(row0 + ai * HALF + m * 16);
#pragma unroll
                        for (int bj = 0; bj < 2; ++bj)
#pragma unroll
                            for (int n = 0; n < 2; ++n) { const f32x4 x = acc[ai][bj][m][n] + bv[bj][n]; const f32x4 l = lv[bj][n]; f32x4 o;
#pragma unroll
                                for (int e = 0; e < 4; ++e) o[e] = l[e] + (1.0f - l[e]) * sigm(x[e]);
                                *(f32x4*)(F + row * 1024 + cbase + bj * HALF + 4 * n) = o; }
                    }
            } else {
                bf16_t* O = QIG + (size_t)(grp - (grp > 0 ? 1 : 0)) * ((size_t)8704 * 1024);
                const bool act = grp != 2;
#pragma unroll
                for (int ai = 0; ai < 2; ++ai)
#pragma unroll
                    for (int m = 0; m < 4; ++m) {
                        const size_t row = (size_t)(row0 + ai * HALF + m * 16);
#pragma unroll
                        for (int bj = 0; bj < 2; ++bj) { float o[8];
#pragma unroll
                            for (int n = 0; n < 2; ++n) { const f32x4 x = acc[ai][bj][m][n] + bv[bj][n];
#pragma unroll
                                for (int e = 0; e < 4; ++e) o[n * 4 + e] = act ? x[e] * sigm(x[e]) : x[e]; }
                            u32x4 w; w.x = cvt_pk_bf16(o[0], o[1]); w.y = cvt_pk_bf16(o[2], o[3]); w.z = cvt_pk_bf16(o[4], o[5]); w.w = cvt_pk_bf16(o[6], o[7]);
                            *(u32x4*)(O + row * 1024 + cbase + bj * HALF) = w; }
                    }
            }
        }
    }
};
struct EpiRes {
    static constexpr bool PERM = false, AFTER_DRAIN = false;
    const float* baseP; const float* baseS; float* out; int split; float alpha;
    __device__ __forceinline__ void operator()(const f32x4 (&acc)[2][2][4][2], const Unit& u, int wr, int wc, int fr, int fq) const {
        const int row0 = u.pm * BM + wr * 64 + fr;
        const int col0 = u.pn * BM + wc * 32 + 4 * fq;
#pragma unroll
        for (int ai = 0; ai < 2; ++ai)
#pragma unroll
            for (int m = 0; m < 4; ++m) {
                const int row = row0 + ai * HALF + m * 16;
                const float* bp = row < split ? baseP + (size_t)row * 2048 : baseS + (size_t)(row - split) * 2048;
                float* op = out + (size_t)row * 2048;
#pragma unroll
                for (int bj = 0; bj < 2; ++bj)
#pragma unroll
                    for (int n = 0; n < 2; ++n) { const int c = col0 + bj * HALF + n * 16; const f32x4 b = *(const f32x4*)(bp + c); *(f32x4*)(op + c) = b * alpha + acc[ai][bj][m][n]; }
            }
    }
};
struct EpiGateUp {
    static constexpr bool PERM = true, AFTER_DRAIN = false;
    bf16_t* O; int ldc;
    __device__ __forceinline__ void operator()(const f32x4 (&acc)[2][2][4][2], const Unit& u, int wr, int wc, int fr, int fq) const {
        const int row0 = u.pm * BM + wr * 64 + fr;
        const int cl = wc * 32 + 8 * fq;
#pragma unroll
        for (int ai = 0; ai < 2; ++ai)
#pragma unroll
            for (int m = 0; m < 4; ++m) {
                const size_t row = (size_t)(row0 + ai * HALF + m * 16);
                float o[8];
#pragma unroll
                for (int n = 0; n < 2; ++n) { const f32x4 g = acc[ai][0][m][n], up = acc[ai][1][m][n];
#pragma unroll
                    for (int e = 0; e < 4; ++e) o[n * 4 + e] = g[e] * sigm(g[e]) * up[e]; }
                u32x4 w; w.x = cvt_pk_bf16(o[0], o[1]); w.y = cvt_pk_bf16(o[2], o[3]); w.z = cvt_pk_bf16(o[4], o[5]); w.w = cvt_pk_bf16(o[6], o[7]);
                *(u32x4*)(O + row * ldc + u.pn * HALF + cl) = w;
            }
    }
};

template <class Epi, class Sched, bool ALIGN_EPI = false, bool SP2 = false>
__device__ __forceinline__ void gemm_phase(PG8_LAS unsigned char* lds, const Gemm g, const Sched& S, const Epi& E) {
    int tid_ = threadIdx.x; asm volatile("" : "+v"(tid_));
    const int tid = tid_, wid = __builtin_amdgcn_readfirstlane(tid >> 6), lane = tid & 63, wr = wid >> 2, wc = wid & 3, fr = lane & 15, fq = lane >> 4;
    const int K = g.K, nt = K / BK;
    unsigned voffA[2], voffB[2];
#pragma unroll
    for (int i = 0; i < 2; ++i) { int R, C; stage_rc(tid * 16 + i * 8192, R, C); const int Rb = Epi::PERM ? ((R & ~31) + perm32(R & 31)) : R;
        voffA[i] = (unsigned)(R * K + C) * 2u; voffB[i] = (unsigned)(Rb * K + C) * 2u; }
    const size_t kstep = (size_t)(BK * 2);
    const size_t hstep = (size_t)HALF * K * 2;
    const size_t tstep = 2 * hstep;
    const unsigned ldsw = (unsigned)wid * 1024u;
    const int aoff = lds_byte(wr * 64 + fr, fq * 8), boff = lds_byte(wc * 32 + fr, fq * 8);
#define PG8_SA(b, h) (((b) * 2 + (h)) * HTB)
#define PG8_SB(b, h) ((4 + (b) * 2 + (h)) * HTB)
#define PG8_STAGE(bufoff, gbase, voff) do { _Pragma("unroll") for (int _i = 0; _i < 2; ++_i) \
        __builtin_amdgcn_global_load_lds((const unsigned*)((const char*)(gbase) + (voff)[_i]), (PG8_LAS unsigned*)(lds + (bufoff) + ldsw + _i * 8192), 16, 0, 0); } while (0)
#define PG8_LDA(dst, b, h) do { _Pragma("unroll") for (int m = 0; m < 4; ++m) _Pragma("unroll") for (int k = 0; k < 2; ++k) dst[m][k] = *(const PG8_LAS bf16x8*)(lds + PG8_SA(b, h) + aoff + m * 2048 + k * 1024); } while (0)
#define PG8_LDB(dst, b, h) do { _Pragma("unroll") for (int n = 0; n < 2; ++n) _Pragma("unroll") for (int k = 0; k < 2; ++k) dst[n][k] = *(const PG8_LAS bf16x8*)(lds + PG8_SB(b, h) + boff + n * 2048 + k * 1024); } while (0)
#define PG8_MMA(ai, bj, At, Bt) do { __builtin_amdgcn_s_setprio(1); _Pragma("unroll") for (int m = 0; m < 4; ++m) _Pragma("unroll") for (int n = 0; n < 2; ++n) _Pragma("unroll") for (int k = 0; k < 2; ++k) \
        acc[ai][bj][m][n] = __builtin_amdgcn_mfma_f32_16x16x32_bf16(Bt[n][k], At[m][k], acc[ai][bj][m][n], 0, 0, 0); __builtin_amdgcn_s_setprio(0); } while (0)
#define PG8_WAIT_V(n) asm volatile("s_waitcnt vmcnt(" #n ")" ::: "memory")
#define PG8_WAIT_L(n) asm volatile("s_waitcnt lgkmcnt(" #n ")" ::: "memory")
#define PG8_BAR __builtin_amdgcn_s_barrier()
#define PG8_SCHED __builtin_amdgcn_sched_barrier(0)
    Unit cur, nxt; int ui = 0;
    if (!S.next(0, cur)) return;
    f32x4 acc[2][2][4][2];
#pragma unroll
    for (int a = 0; a < 2; ++a)
#pragma unroll
        for (int b = 0; b < 2; ++b)
#pragma unroll
            for (int m = 0; m < 4; ++m)
#pragma unroll
                for (int n = 0; n < 2; ++n) acc[a][b][m][n] = (f32x4){0.f, 0.f, 0.f, 0.f};
    bf16x8 At[4][2], B0[2][2], B1[2][2];
    const char* cA = (const char*)g.A + (size_t)cur.pm * tstep; const char* cB = (const char*)g.Bt + (size_t)cur.pn * tstep;
    S.a_ready(cur);
    if constexpr (SP2) {
        PG8_STAGE(PG8_SB(0, 0), cB, voffB); PG8_STAGE(PG8_SB(0, 1), cB + hstep, voffB); PG8_STAGE(PG8_SA(0, 0), cA, voffA); PG8_STAGE(PG8_SA(0, 1), cA + hstep, voffA);
        if (wr == 1) PG8_BAR;
        PG8_WAIT_V(2); PG8_BAR;
        PG8_STAGE(PG8_SB(1, 0), cB + kstep, voffB); PG8_STAGE(PG8_SA(1, 0), cA + kstep, voffA); PG8_STAGE(PG8_SB(1, 1), cB + hstep + kstep, voffB);
        PG8_WAIT_V(6); PG8_BAR;
    } else {
        PG8_STAGE(PG8_SB(0, 0), cB, voffB); PG8_STAGE(PG8_SA(0, 0), cA, voffA); PG8_STAGE(PG8_SB(0, 1), cB + hstep, voffB); PG8_STAGE(PG8_SA(0, 1), cA + hstep, voffA);
        if (wr == 1) PG8_BAR;
        PG8_WAIT_V(4); PG8_BAR;
        PG8_STAGE(PG8_SB(1, 0), cB + kstep, voffB); PG8_STAGE(PG8_SA(1, 0), cA + kstep, voffA); PG8_STAGE(PG8_SB(1, 1), cB + hstep + kstep, voffB);
        PG8_WAIT_V(6); PG8_BAR;
    }
    for (;;) {
        const bool has_next = S.next(ui + 1, nxt);
        const char* nA = has_next ? (const char*)g.A + (size_t)nxt.pm * tstep : cA; const char* nB = has_next ? (const char*)g.Bt + (size_t)nxt.pn * tstep : cB;
        for (int t = 0; t < nt; t += 2) {
            const bool last = (t == nt - 2);
            const char* a1 = cA + (size_t)(t + 1) * kstep;
            const char* a2 = last ? nA : cA + (size_t)(t + 2) * kstep; const char* b2 = last ? nB : cB + (size_t)(t + 2) * kstep;
            const char* a3 = a2 + kstep; const char* b3 = b2 + kstep;
            if (last && has_next) S.a_ready(nxt);
            if constexpr (SP2) {
            PG8_LDB(B0, 0, 0); PG8_LDB(B1, 0, 1); PG8_SCHED; PG8_LDA(At, 0, 0); PG8_STAGE(PG8_SA(1, 1), a1 + hstep, voffA);
            PG8_WAIT_V(8); PG8_WAIT_L(0); PG8_BAR; PG8_MMA(0, 0, At, B0); PG8_MMA(0, 1, At, B1); PG8_BAR; PG8_SCHED;
            PG8_LDA(At, 0, 1); PG8_STAGE(PG8_SB(0, 0), b2, voffB); PG8_STAGE(PG8_SB(0, 1), b2 + hstep, voffB); PG8_STAGE(PG8_SA(0, 0), a2, voffA);
            PG8_WAIT_V(8); PG8_WAIT_L(0); PG8_BAR; PG8_MMA(1, 0, At, B0); PG8_MMA(1, 1, At, B1); PG8_BAR; PG8_SCHED;
            PG8_LDB(B0, 1, 0); PG8_LDB(B1, 1, 1); PG8_SCHED; PG8_LDA(At, 1, 0); PG8_STAGE(PG8_SA(0, 1), a2 + hstep, voffA);
            PG8_WAIT_V(8); PG8_WAIT_L(0); PG8_BAR; PG8_MMA(0, 0, At, B0); PG8_MMA(0, 1, At, B1); PG8_BAR; PG8_SCHED;
            PG8_LDA(At, 1, 1); PG8_STAGE(PG8_SB(1, 0), b3, voffB); PG8_STAGE(PG8_SB(1, 1), b3 + hstep, voffB); PG8_STAGE(PG8_SA(1, 0), a3, voffA);
            PG8_WAIT_V(8); PG8_WAIT_L(0); PG8_BAR; PG8_MMA(1, 0, At, B0); PG8_MMA(1, 1, At, B1); PG8_BAR; PG8_SCHED;
            } else {
            PG8_LDB(B0, 0, 0); PG8_SCHED; PG8_LDA(At, 0, 0); PG8_STAGE(PG8_SA(1, 1), a1 + hstep, voffA);
            PG8_WAIT_L(8); PG8_BAR; PG8_WAIT_L(0); PG8_MMA(0, 0, At, B0); PG8_BAR; PG8_SCHED;
            PG8_LDB(B1, 0, 1); PG8_STAGE(PG8_SB(0, 0), b2, voffB);
            PG8_BAR; PG8_WAIT_L(0); PG8_MMA(0, 1, At, B1); PG8_BAR;
            PG8_LDA(At, 0, 1); PG8_STAGE(PG8_SA(0, 0), a2, voffA);
            PG8_BAR; PG8_WAIT_L(0); PG8_MMA(1, 0, At, B0); PG8_BAR; PG8_SCHED;
            PG8_STAGE(PG8_SB(0, 1), b2 + hstep, voffB);
            PG8_WAIT_V(6); PG8_BAR; PG8_MMA(1, 1, At, B1); PG8_BAR;
            PG8_LDB(B0, 1, 0); PG8_SCHED; PG8_LDA(At, 1, 0); PG8_STAGE(PG8_SA(0, 1), a2 + hstep, voffA);
            PG8_WAIT_L(8); PG8_BAR; PG8_WAIT_L(0); PG8_MMA(0, 0, At, B0); PG8_BAR; PG8_SCHED;
            PG8_LDB(B1, 1, 1); PG8_STAGE(PG8_SB(1, 0), b3, voffB);
            PG8_BAR; PG8_WAIT_L(0); PG8_MMA(0, 1, At, B1); PG8_BAR;
            PG8_LDA(At, 1, 1); PG8_STAGE(PG8_SA(1, 0), a3, voffA);
            PG8_BAR; PG8_WAIT_L(0); PG8_MMA(1, 0, At, B0); PG8_BAR; PG8_SCHED;
            PG8_STAGE(PG8_SB(1, 1), b3 + hstep, voffB);
            PG8_WAIT_V(6); PG8_BAR; PG8_MMA(1, 1, At, B1); PG8_BAR;
            }
        }
        if constexpr (ALIGN_EPI) { if (wr == 0) PG8_BAR; }
        if constexpr (!Epi::AFTER_DRAIN) { E(acc, cur, wr, wc, fr, fq); S.done(cur); }
        if (!has_next) break;
#pragma unroll
        for (int a = 0; a < 2; ++a)
#pragma unroll
            for (int b = 0; b < 2; ++b)
#pragma unroll
                for (int m = 0; m < 4; ++m)
#pragma unroll
                    for (int n = 0; n < 2; ++n) acc[a][b][m][n] = (f32x4){0.f, 0.f, 0.f, 0.f};
        cur = nxt; cA = nA; cB = nB; ++ui;
        if constexpr (ALIGN_EPI) { if (wr == 1) PG8_BAR; }
    }
    PG8_WAIT_V(0);
    if constexpr (!ALIGN_EPI) { if (wr == 0) PG8_BAR; }
    PG8_BAR;
#undef PG8_SA
#undef PG8_SB
#undef PG8_STAGE
#undef PG8_LDA
#undef PG8_LDB
#undef PG8_MMA
#undef PG8_WAIT_V
#undef PG8_WAIT_L
#undef PG8_BAR
#undef PG8_SCHED
}
}

constexpr int D = 2048, MP = 8192, MS = 512, M = MP + MS, CW = 1024, NH = 8, HD = 128, FF = 5632, NIN = 6144;
constexpr float LN_EPS = 1e-5f;
constexpr float ALPHA = 1.189207115002721f;
constexpr int NWAVES = 8;
constexpr int LDS_BYTES = 147456;
constexpr int N_PHASES = 10;

constexpr size_t MiB = 1u << 20;
constexpr size_t WS_LB = 64 * 1024, WS_BIASP = 128 * 1024;
constexpr size_t WS_WIN = 1 * MiB, WS_WOUT = 25 * MiB, WS_WGU = 33 * MiB, WS_WDN = 77 * MiB;
constexpr size_t WS_XB = 99 * MiB, WS_MIX = 133 * MiB;
constexpr size_t WS_U = 167 * MiB, WS_Q = 184 * MiB, WS_I = 201 * MiB, WS_G = 218 * MiB, WS_F = 235 * MiB, WS_END = 269 * MiB;
constexpr size_t WS_ACT = 167 * MiB;
static_assert(WS_ACT + (size_t)M * FF * 2 <= WS_END, "act overlay");
constexpr size_t O_Y = 0, O_NCP = (size_t)M * D, O_NHP = O_NCP + 4 * 30 * 1024, O_NCS = O_NHP + 4 * 8 * 128 * 128, O_NHS = O_NCS + 32 * 30 * 1024;
constexpr size_t O_ST = 0, O_DC = (size_t)1024 * 16384;

#define LAS __attribute__((address_space(3)))
typedef unsigned short bf16;
typedef float f32x4 __attribute__((ext_vector_type(4)));
typedef float f32x2 __attribute__((ext_vector_type(2)));
typedef unsigned v4u __attribute__((ext_vector_type(4)));
typedef unsigned v2u __attribute__((ext_vector_type(2)));
#define LDS_WAIT() asm volatile("s_waitcnt lgkmcnt(0)" ::: "memory")

__device__ __forceinline__ unsigned f2bf(float f) { unsigned u = __builtin_bit_cast(unsigned, f); return (u + 0x7fffu + ((u >> 16) & 1u)) >> 16; }
__device__ __forceinline__ unsigned pk2(float lo, float hi) { return f2bf(lo) | (f2bf(hi) << 16); }
__device__ __forceinline__ float bf2f(unsigned short b) { return __uint_as_float((unsigned)b << 16); }
__device__ __forceinline__ float sigm(float x) { return __builtin_amdgcn_rcpf(1.0f + __expf(-x)); }
__device__ __forceinline__ float wave_sum(float v) {
#pragma unroll
    for (int o = 1; o < 64; o <<= 1) v += __shfl_xor(v, o);
    return v;
}

__device__ __forceinline__ void transpose_item(const float* W, int K, int N, bf16* WT, int k0, int n0, int dst_row0, LAS float* scr, int lane) {
#pragma unroll 8
    for (int i = 0; i < 32; ++i) { const int kk = 2 * i + (lane >> 5); scr[kk * 33 + (lane & 31)] = W[(size_t)(k0 + kk) * N + n0 + (lane & 31)]; }
    LDS_WAIT(); asm volatile("" ::: "memory");
    const int c = lane & 7;
#pragma unroll
    for (int j = 0; j < 4; ++j) { const int n = (lane >> 3) + 8 * j; const LAS float* s = scr + (8 * c) * 33 + n;
        v4u o; o.x = pk2(s[0 * 33], s[1 * 33]); o.y = pk2(s[2 * 33], s[3 * 33]); o.z = pk2(s[4 * 33], s[5 * 33]); o.w = pk2(s[6 * 33], s[7 * 33]);
        *(v4u*)(WT + (size_t)(dst_row0 + n) * K + k0 + 8 * c) = o; }
    LDS_WAIT(); asm volatile("" ::: "memory");
}

__device__ __forceinline__ void ln_row(const float* src, float* dstf, bf16* dstb, const float* g, const float* b, int lane) {
    const f32x4* xr = (const f32x4*)src + lane;
    f32x4 v[8]; float s = 0.f;
#pragma unroll
    for (int j = 0; j < 8; ++j) { v[j] = xr[64 * j]; s += (v[j].x + v[j].y) + (v[j].z + v[j].w); }
    const float mean = wave_sum(s) * (1.f / D); float s2 = 0.f;
#pragma unroll
    for (int j = 0; j < 8; ++j) { v[j] = v[j] - mean; s2 += (v[j].x * v[j].x + v[j].y * v[j].y) + (v[j].z * v[j].z + v[j].w * v[j].w); }
    const float rstd = 1.f / sqrtf(wave_sum(s2) * (1.f / D) + LN_EPS);
#pragma unroll
    for (int j = 0; j < 8; ++j) {
        const f32x4 gg = ((const f32x4*)g)[lane + 64 * j], bb = ((const f32x4*)b)[lane + 64 * j];
        const f32x4 o = v[j] * rstd * gg + bb;
        if (dstf) ((f32x4*)dstf)[lane + 64 * j] = o;
        if (dstb) { v2u w; w.x = pk2(o.x, o.y); w.y = pk2(o.z, o.w); ((v2u*)dstb)[lane + 64 * j] = w; }
    }
}

struct Args { const float* in[20]; float* out; unsigned char* ws; int ph_lo, ph_hi; };

__global__ void __launch_bounds__(NWAVES * 64, 2) fwd_kernel(Args args) {
    extern __shared__ __attribute__((aligned(16))) unsigned char lds_raw[];
    LAS unsigned char* lds = (LAS unsigned char*)lds_raw;
    const int tid = threadIdx.x, lane = tid & 63, wave = __builtin_amdgcn_readfirstlane(tid >> 6);
    const int G = gridDim.x, bx = blockIdx.x;
    const int gt = bx * 512 + tid, NT = G * 512;
    const int gw = bx * NWAVES + wave, NGW = G * NWAVES;

#define x_prompt (args.in[0])
#define x_sample (args.in[1])
#define cache_conv (args.in[2])
#define state_hgrn (args.in[3])
#define w_in (args.in[4])
#define b_in (args.in[5])
#define w_dw (args.in[6])
#define b_dw (args.in[7])
#define cn_g (args.in[8])
#define cn_b (args.in[9])
#define hlb (args.in[10])
#define hg_ng (args.in[11])
#define w_out (args.in[12])
#define ln1_g (args.in[13])
#define ln1_b (args.in[14])
#define w_gate (args.in[15])
#define w_up (args.in[16])
#define w_down (args.in[17])
#define ln2_g (args.in[18])
#define ln2_b (args.in[19])
#define out (args.out)
#define ws (args.ws)
#define LB ((float*)(ws + WS_LB))
#define BIASP ((float*)(ws + WS_BIASP))
#define WIN ((bf16*)(ws + WS_WIN))
#define WOUT ((bf16*)(ws + WS_WOUT))
#define WGU ((bf16*)(ws + WS_WGU))
#define WDN ((bf16*)(ws + WS_WDN))
#define XB ((bf16*)(ws + WS_XB))
#define MIX ((bf16*)(ws + WS_MIX))
#define U ((bf16*)(ws + WS_U))
#define Q ((bf16*)(ws + WS_Q))
#define F ((float*)(ws + WS_F))
#define I ((bf16*)(ws + WS_I))
#define Gt ((bf16*)(ws + WS_G))
#define ACT ((bf16*)(ws + WS_ACT))
#define ST (out + O_ST)
#define DC (out + O_DC)

    const int lo = args.ph_lo, hi = args.ph_hi;
#ifndef PH_MASK
#define PH_MASK 0x3ff
#endif
#define IN(k) (((PH_MASK >> (k)) & 1) && lo <= (k) && (k) < hi)
#define SEAM(k) do { if (IN(k) && IN((k) + 1)) { cg::this_grid().sync(); } } while (0)

    if (IN(0)) {
        LAS float* scr = (LAS float*)(lds + wave * 16384);
        constexpr int I_IN = 32 * 192, I_OUT = 32 * 64, I_G = 32 * 176, I_DN = 88 * 64;
        constexpr int NITEMS = I_IN + I_OUT + 2 * I_G + I_DN;
        for (int it = gw; it < NITEMS; it += NGW) {
            int r = it; const float* W; int K, N; bf16* WT; int kind;
            if (r < I_IN) { kind = 0; W = w_in; K = D; N = NIN; WT = WIN; }
            else if ((r -= I_IN) < I_OUT) { kind = 1; W = w_out; K = D; N = D; WT = WOUT; }
            else if ((r -= I_OUT) < I_G) { kind = 2; W = w_gate; K = D; N = FF; WT = WGU; }
            else if ((r -= I_G) < I_G) { kind = 3; W = w_up; K = D; N = FF; WT = WGU; }
            else { r -= I_G; kind = 4; W = w_down; K = FF; N = D; WT = WDN; }
            const int nblk = N / 32, kb = r / nblk, nb = r % nblk, k0 = 64 * kb, n0 = 32 * nb;
            int dst;
            if (kind == 0) dst = n0 < 2048 ? ((n0 & 1023) >> 7) * 256 + (n0 >> 10) * 128 + (n0 & 127) : n0;
            else if (kind == 2) dst = (n0 >> 7) * 256 + (n0 & 127);
            else if (kind == 3) dst = (n0 >> 7) * 256 + 128 + (n0 & 127);
            else dst = n0;
            transpose_item(W, K, N, WT, k0, n0, dst, scr, lane);
        }
        constexpr int NV = M * D / 8, NVP = MP * D / 8;
        for (int i = gt; i < NV; i += NT) {
            const float* src = i < NVP ? x_prompt + (size_t)i * 8 : x_sample + (size_t)(i - NVP) * 8;
            const f32x4 a = *(const f32x4*)src, b = *(const f32x4*)(src + 4);
            v4u o; o.x = pk2(a.x, a.y); o.y = pk2(a.z, a.w); o.z = pk2(b.x, b.y); o.w = pk2(b.z, b.w);
            *(v4u*)(XB + (size_t)i * 8) = o;
        }
        for (int i = gt; i < 1024; i += NT) LB[i] = sigm(hlb[i] - hlb[1024 + i]);
        for (int i = gt; i < NIN; i += NT) { const int orig = i < 2048 ? ((i & 255) >> 7) * 1024 + (i >> 8) * 128 + (i & 127) : i; BIASP[i] = b_in[orig]; }
    }
    SEAM(0);

    if (IN(1)) {
        pg8::Gemm g{XB, WIN, M, NIN, D}; pg8::StaticOrder S; S.init(M, NIN, G, bx);
        pg8::EpiProj E{U, Q, F, BIASP, LB};
        pg8::gemm_phase<pg8::EpiProj, pg8::StaticOrder, true, true>(lds, g, S, E);
    }
    SEAM(1);

    if (IN(2)) {
        LAS float* fl = (LAS float*)lds; LAS float* vl = (LAS float*)(lds + 8192);
        LAS float* redc = (LAS float*)(lds + 60000 / 16 * 16); LAS float* tot = redc + 128;
        const int kg = tid >> 7, v = tid & 127;
        for (int it = bx; it < 1024 + 1088; it += G) {
            __syncthreads();
            if (it < 1024) {
                const int bh = it >> 5, c = it & 31, b = bh >> 3, h = bh & 7;
                const int row0 = b * 2048 + c * 64;
                float S[32];
#pragma unroll
                for (int i = 0; i < 32; ++i) S[i] = 0.f;
                float dprod = 1.f;
                for (int sb = 0; sb < 4; ++sb) {
                    __syncthreads();
#pragma unroll
                    for (int e4 = 0; e4 < 4; ++e4) { const int e = tid + e4 * 512, t = e >> 7, k = e & 127; const size_t gi = (size_t)(row0 + sb * 16 + t) * 1024 + h * 128 + k;
                        fl[e] = F[gi]; vl[e] = bf2f(I[gi]); }
                    __syncthreads();
#pragma unroll 2
                    for (int t = 0; t < 16; ++t) {
                        const float vv = vl[t * 128 + v];
#pragma unroll
                        for (int k4 = 0; k4 < 8; ++k4) { const f32x4 f = *(const LAS f32x4*)(fl + t * 128 + kg * 32 + k4 * 4);
#pragma unroll
                            for (int e = 0; e < 4; ++e) S[k4 * 4 + e] = f[e] * (S[k4 * 4 + e] - vv) + vv; }
                    }
                    if (tid < 128) {
#pragma unroll
                        for (int t = 0; t < 16; ++t) dprod *= fl[t * 128 + tid];
                    }
                }
                float* sp = ST + (size_t)it * 16384 + (size_t)(kg * 32) * 128 + v;
#pragma unroll
                for (int i = 0; i < 32; ++i) sp[i * 128] = S[i];
                if (tid < 128) DC[it * 128 + tid] = dprod;
            } else {
                const int m0 = (it - 1024) * 8;
                const bool samp = m0 >= MP;
                int t0, seq0; const float* hist = cache_conv;
                if (!samp) { t0 = m0 & 2047; seq0 = m0 - t0; }
                else { const int sbi = (m0 - MP) >> 4; t0 = (m0 - MP) & 15; seq0 = MP + sbi * 16; hist = cache_conv + (size_t)sbi * 30 * 1024; }
                LAS float* hbuf = (LAS float*)(lds + 16384);
                float s1[8], s2[8];
#pragma unroll
                for (int t = 0; t < 8; ++t) { s1[t] = 0.f; s2[t] = 0.f; }
#pragma unroll 1
                for (int p = 0; p < 2; ++p) {
                    const int c = tid + p * 512;
                    const unsigned cb2 = (unsigned)c * 2u, cb4 = (unsigned)c * 4u;
                    float w0[38];
#pragma unroll
                    for (int jj = 0; jj < 38; ++jj) {
                        const int tr = t0 - 30 + jj;
                        float a = 0.f;
                        if (tr >= 0) a = bf2f(*(const bf16*)((const char*)(U + (size_t)(seq0 + tr) * 1024) + cb2));
                        else if (samp) a = *(const float*)((const char*)(hist + (30 + tr) * 1024) + cb4);
                        w0[jj] = a;
                    }
                    float a0[8];
                    { const float bb = *(const float*)((const char*)b_dw + cb4);
#pragma unroll
                      for (int t = 0; t < 8; ++t) a0[t] = bb; }
#pragma unroll
                    for (int j = 0; j < 31; ++j) { const float wv = *(const float*)((const char*)(w_dw + j * 1024) + cb4);
#pragma unroll
                        for (int t = 0; t < 8; ++t) a0[t] += wv * w0[t + j]; }
#pragma unroll
                    for (int t = 0; t < 8; ++t) { hbuf[t * 1024 + c] = a0[t]; s1[t] += a0[t]; s2[t] += a0[t] * a0[t]; }
                }
                float st[16];
#pragma unroll
                for (int t = 0; t < 8; ++t) { st[t] = wave_sum(s1[t]); st[8 + t] = wave_sum(s2[t]); }
                if (lane == 0) {
#pragma unroll
                    for (int i = 0; i < 16; ++i) redc[wave * 16 + i] = st[i];
                }
                __syncthreads();
                if (tid < 16) { float s = 0.f;
#pragma unroll
                    for (int w = 0; w < 8; ++w) s += redc[w * 16 + tid];
                    tot[tid] = s; }
                __syncthreads();
                const int c = 2 * tid;
                const f32x2 gg = *(const f32x2*)(cn_g + c), bb2 = *(const f32x2*)(cn_b + c);
#pragma unroll
                for (int t = 0; t < 8; ++t) {
                    const float mu = tot[t] * (1.f / 1024.f); float var = tot[8 + t] * (1.f / 1024.f) - mu * mu; var = var > 0.f ? var : 0.f;
                    const float rstd = 1.f / sqrtf(var + LN_EPS);
                    const f32x2 hv = *(const LAS f32x2*)(hbuf + t * 1024 + c);
                    float y0 = (hv.x - mu) * rstd * gg.x + bb2.x, y1 = (hv.y - mu) * rstd * gg.y + bb2.y;
                    y0 = y0 * sigm(y0); y1 = y1 * sigm(y1);
                    *(unsigned*)(MIX + (size_t)(m0 + t) * 2048 + c) = pk2(y0, y1);
                }
            }
        }
        for (int i = gt; i < 4 * 30 * 1024; i += NT) { const int b = i / 30720, j = (i >> 10) % 30, c = i & 1023;
            out[O_NCP + i] = bf2f(U[(size_t)(b * 2048 + 2018 + j) * 1024 + c]); }
        for (int i = gt; i < 32 * 30 * 1024; i += NT) { const int sb = i / 30720, j = (i >> 10) % 30, c = i & 1023;
            out[O_NCS + i] = j < 14 ? cache_conv[(size_t)sb * 30720 + (16 + j) * 1024 + c] : bf2f(U[(size_t)(MP + sb * 16 + j - 14) * 1024 + c]); }
    }
    SEAM(2);

    if (IN(3)) {
        for (int e = gt; e < 32 * 4096; e += NT) {
            const int bh = e >> 12, r = e & 4095, k = r >> 5, v4 = r & 31;
            f32x4 S = (f32x4){0.f, 0.f, 0.f, 0.f};
#pragma unroll 8
            for (int c = 0; c < 32; ++c) {
                f32x4* p = (f32x4*)(ST + ((size_t)(bh * 32 + c) * 128 + k) * 128 + v4 * 4);
                const f32x4 A = *p; const float d = DC[(bh * 32 + c) * 128 + k];
                *p = S; S = S * d + A;
            }
            *(f32x4*)(out + O_NHP + ((size_t)bh * 128 + k) * 128 + v4 * 4) = S;
        }
    }
    SEAM(3);

    if (IN(4)) {
        LAS float* fl = (LAS float*)lds; LAS float* vl = (LAS float*)(lds + 8192); LAS float* ql = (LAS float*)(lds + 16384); LAS float* red = (LAS float*)(lds + 24576);
        const int kg = tid >> 7, v = tid & 127;
        for (int it = bx; it < 1024 + 256; it += G) {
            int row0, h, nsb; const float* sinit; float* sfin = nullptr;
            if (it < 1024) { const int bh = it >> 5, c = it & 31; h = bh & 7; row0 = (bh >> 3) * 2048 + c * 64; nsb = 4; sinit = ST + (size_t)it * 16384; }
            else { const int j = it - 1024; h = j & 7; row0 = MP + (j >> 3) * 16; nsb = 1; sinit = state_hgrn + (size_t)j * 16384; sfin = out + O_NHS + (size_t)j * 16384; }
            float S[32];
            { const float* sp = sinit + (size_t)(kg * 32) * 128 + v;
#pragma unroll
              for (int i = 0; i < 32; ++i) S[i] = sp[i * 128]; }
            for (int sb = 0; sb < nsb; ++sb) {
                __syncthreads();
#pragma unroll
                for (int e4 = 0; e4 < 4; ++e4) { const int e = tid + e4 * 512, t = e >> 7, k = e & 127; const size_t gi = (size_t)(row0 + sb * 16 + t) * 1024 + h * 128 + k;
                    fl[e] = F[gi]; vl[e] = bf2f(I[gi]); ql[e] = bf2f(Q[gi]); }
                __syncthreads();
#pragma unroll 2
                for (int t = 0; t < 16; ++t) {
                    const float vv = vl[t * 128 + v]; float o = 0.f;
#pragma unroll
                    for (int k4 = 0; k4 < 8; ++k4) { const f32x4 f = *(const LAS f32x4*)(fl + t * 128 + kg * 32 + k4 * 4); const f32x4 q = *(const LAS f32x4*)(ql + t * 128 + kg * 32 + k4 * 4);
#pragma unroll
                        for (int e = 0; e < 4; ++e) { const float s = f[e] * (S[k4 * 4 + e] - vv) + vv; S[k4 * 4 + e] = s; o += q[e] * s; } }
                    red[(kg * 16 + t) * 128 + v] = o;
                }
                __syncthreads();
#pragma unroll
                for (int tt = 0; tt < 2; ++tt) {
                    const int t = wave * 2 + tt;
                    float o0 = 0.f, o1 = 0.f;
#pragma unroll
                    for (int q4 = 0; q4 < 4; ++q4) { o0 += red[(q4 * 16 + t) * 128 + lane]; o1 += red[(q4 * 16 + t) * 128 + 64 + lane]; }
                    const float ss = wave_sum(o0 * o0 + o1 * o1);
                    const float r = 1.f / sqrtf(ss * (1.f / 128.f) + LN_EPS);
                    const size_t m = (size_t)(row0 + sb * 16 + t);
                    const float g0 = bf2f(Gt[m * 1024 + h * 128 + lane]), g1 = bf2f(Gt[m * 1024 + h * 128 + 64 + lane]);
                    MIX[m * 2048 + 1024 + h * 128 + lane] = (bf16)f2bf(o0 * r * hg_ng[lane] * g0);
                    MIX[m * 2048 + 1024 + h * 128 + 64 + lane] = (bf16)f2bf(o1 * r * hg_ng[64 + lane] * g1);
                }
            }
            if (sfin) { float* sp = sfin + (size_t)(kg * 32) * 128 + v;
#pragma unroll
                for (int i = 0; i < 32; ++i) sp[i * 128] = S[i]; }
        }
        __syncthreads();
    }
    SEAM(4);

    if (IN(5)) {
        pg8::Gemm g{MIX, WOUT, M, D, D}; pg8::StaticOrder S; S.init(M, D, G, bx);
        pg8::EpiRes E{x_prompt, x_sample, out, MP, ALPHA};
        pg8::gemm_phase<pg8::EpiRes, pg8::StaticOrder, true, true>(lds, g, S, E);
    }
    SEAM(5);

    if (IN(6)) {
        for (int m = gw; m < M; m += NGW) ln_row(out + (size_t)m * D, out + (size_t)m * D, XB + (size_t)m * D, ln1_g, ln1_b, lane);
    }
    SEAM(6);

    if (IN(7)) {
        pg8::Gemm g{XB, WGU, M, 2 * FF, D}; pg8::StaticOrder S; S.init(M, 2 * FF, G, bx);
        pg8::EpiGateUp E{ACT, FF};
        pg8::gemm_phase<pg8::EpiGateUp, pg8::StaticOrder, true, true>(lds, g, S, E);
    }
    SEAM(7);

    if (IN(8)) {
        pg8::Gemm g{ACT, WDN, M, D, FF}; pg8::StaticOrder S; S.init(M, D, G, bx);
        pg8::EpiRes E{out, out + (size_t)MP * D, out, MP, ALPHA};
        pg8::gemm_phase<pg8::EpiRes, pg8::StaticOrder, true, true>(lds, g, S, E);
    }
    SEAM(8);

    if (IN(9)) {
        for (int m = gw; m < M; m += NGW) ln_row(out + (size_t)m * D, out + (size_t)m * D, nullptr, ln2_g, ln2_b, lane);
    }
#undef IN
#undef SEAM
}

#undef x_prompt
#undef x_sample
#undef cache_conv
#undef state_hgrn
#undef w_in
#undef b_in
#undef w_dw
#undef b_dw
#undef cn_g
#undef cn_b
#undef hlb
#undef hg_ng
#undef w_out
#undef ln1_g
#undef ln1_b
#undef w_gate
#undef w_up
#undef w_down
#undef ln2_g
#undef ln2_b
#undef out
#undef ws
#undef LB
#undef BIASP
#undef WIN
#undef WOUT
#undef WGU
#undef WDN
#undef XB
#undef MIX
#undef U
#undef Q
#undef F
#undef I
#undef Gt
#undef ACT
#undef ST
#undef DC

extern "C" void kernel_launch(void* const* d_in, const int* in_sizes, int n_in, void* d_out, int out_size, void* d_ws, size_t ws_size, hipStream_t stream) {
    static int grid = 0;
    if (grid == 0) {
        int dev = 0, cus = 0, per_cu = 0;
        if (n_in != 20 || ws_size < WS_END) { fprintf(stderr, "kernel_launch: unexpected n_in %d / ws_size %zu\n", n_in, ws_size); grid = -1; return; }
        if (hipGetDevice(&dev) != hipSuccess || hipDeviceGetAttribute(&cus, hipDeviceAttributeMultiprocessorCount, dev) != hipSuccess) { grid = -1; return; }
        if (hipFuncSetAttribute((const void*)fwd_kernel, hipFuncAttributeMaxDynamicSharedMemorySize, LDS_BYTES) != hipSuccess) { fprintf(stderr, "kernel_launch: hipFuncSetAttribute failed\n"); grid = -1; return; }
        if (hipOccupancyMaxActiveBlocksPerMultiprocessor(&per_cu, (const void*)fwd_kernel, NWAVES * 64, LDS_BYTES) != hipSuccess || per_cu < 1) { fprintf(stderr, "kernel_launch: occupancy query says %d\n", per_cu); }
        (void)hipGetLastError();
        grid = cus;
    }
    if (grid < 0) return;
    Args a{};
    for (int i = 0; i < 20; ++i) a.in[i] = (const float*)d_in[i];
    a.out = (float*)d_out; a.ws = (unsigned char*)d_ws;
#if MK_ONE_LAUNCH
    a.ph_lo = 0; a.ph_hi = N_PHASES;
    void* kargs[] = {&a};
    hipError_t e = hipLaunchCooperativeKernel((const void*)fwd_kernel, dim3(grid), dim3(NWAVES * 64), kargs, LDS_BYTES, stream);
    if (e != hipSuccess) fprintf(stderr, "cooperative launch failed: %s (grid %d)\n", hipGetErrorString(e), grid);
#else
    for (int p = 0; p < N_PHASES; ++p) {
        a.ph_lo = p; a.ph_hi = p + 1;
        hipLaunchKernelGGL(fwd_kernel, dim3(grid), dim3(NWAVES * 64), LDS_BYTES, stream, a);
    }
#endif
}
```

```cpp
#include <hip/hip_runtime.h>
#include <hip/hip_cooperative_groups.h>
#include <cstdio>
#include <cstdint>
namespace cg = cooperative_groups;

#ifndef MK_ONE_LAUNCH
#define MK_ONE_LAUNCH 1
#endif

namespace pg8 {
#define PG8_LAS __attribute__((address_space(3)))
typedef unsigned short bf16_t;
typedef short bf16x8 __attribute__((ext_vector_type(8)));
typedef float f32x4 __attribute__((ext_vector_type(4)));
typedef unsigned u32x4 __attribute__((ext_vector_type(4)));
typedef unsigned u32x2 __attribute__((ext_vector_type(2)));
constexpr int BM = 256, BK = 64, HALF = 128, HTB = HALF * BK * 2, STAGE_BYTES = 8 * HTB, NXCD = 8, WGM = 8;

__host__ __device__ __forceinline__ int lds_byte(int r, int c) { const int st = (r >> 4) * 2 + (c >> 5), rr = r & 15, cc = c & 31, ob = rr * 64 + cc * 2; return st * 1024 + (ob ^ (((ob >> 9) & 1) << 5)); }
__host__ __device__ __forceinline__ void stage_rc(int b, int& R, int& C) { const int st = b / 1024, sb = b % 1024, swz = sb ^ (((sb >> 9) & 1) << 5); R = (st >> 1) * 16 + swz / 64; C = (st & 1) * 32 + (swz % 64) / 2; }
__host__ __device__ __forceinline__ int perm32(int rho) { const int n = rho >> 4, i = rho & 15; return 8 * (i >> 2) + 4 * n + (i & 3); }

struct Unit { int pm, pn; };
struct Gemm { const bf16_t* A; const bf16_t* Bt; int M, N, K; };

struct StaticOrder {
    int nM, nN, nwg, G, c;
    __host__ __device__ void init(int M, int N, int G_, int c_) { nM = M / BM; nN = N / BM; nwg = nM * nN; G = G_; c = c_; }
    __host__ __device__ bool next(int i, Unit& u) const {
        const long L = (long)i * G + c; if (L >= nwg) return false;
        int wgid = (int)L; { const int q = nwg / NXCD, r = nwg % NXCD, xcd = wgid % NXCD, off = wgid / NXCD; wgid = (xcd < r ? xcd * (q + 1) : r * (q + 1) + (xcd - r) * q) + off; }
        const int nig = WGM * nN, gid = wgid / nig, fm = gid * WGM, gsz = (nM - fm) < WGM ? (nM - fm) : WGM;
        u.pm = fm + ((wgid % nig) % gsz); u.pn = (wgid % nig) / gsz; return true;
    }
    __device__ __forceinline__ void a_ready(const Unit&) const {}
    __device__ __forceinline__ void done(const Unit&) const {}
};

__device__ __forceinline__ unsigned cvt_pk_bf16(float lo, float hi) { unsigned r; asm volatile("v_cvt_pk_bf16_f32 %0, %1, %2" : "=v"(r) : "v"(lo), "v"(hi)); return r; }
__device__ __forceinline__ float sigm(float x) { return __builtin_amdgcn_rcpf(1.0f + __expf(-x)); }

struct EpiProj {
    static constexpr bool PERM = true, AFTER_DRAIN = false;
    bf16_t *U, *QIG; float* F; const float* bias; const float* lb;
    __device__ __forceinline__ void operator()(const f32x4 (&acc)[2][2][4][2], const Unit& u, int wr, int wc, int fr, int fq) const {
        const int row0 = u.pm * BM + wr * 64 + fr;
        const int cl = wc * 32 + 8 * fq;
        const int bcol = u.pn * BM + cl;
        f32x4 bv[2][2];
#pragma unroll
        for (int bj = 0; bj < 2; ++bj)
#pragma unroll
            for (int n = 0; n < 2; ++n) bv[bj][n] = *(const f32x4*)(bias + bcol + bj * HALF + 4 * n);
        if (u.pn < 8) {
#pragma unroll
            for (int ai = 0; ai < 2; ++ai)
#pragma unroll
                for (int m = 0; m < 4; ++m) {
                    const size_t row = (size_t)(row0 + ai * HALF + m * 16);
                    float o[8];
#pragma unroll
                    for (int n = 0; n < 2; ++n) { const f32x4 a = acc[ai][0][m][n] + bv[0][n], g = acc[ai][1][m][n] + bv[1][n];
#pragma unroll
                        for (int e = 0; e < 4; ++e) o[n * 4 + e] = a[e] * sigm(g[e]); }
                    u32x4 w; w.x = cvt_pk_bf16(o[0], o[1]); w.y = cvt_pk_bf16(o[2], o[3]); w.z = cvt_pk_bf16(o[4], o[5]); w.w = cvt_pk_bf16(o[6], o[7]);
                    *(u32x4*)(U + row * 1024 + u.pn * HALF + cl) = w;
                }
        } else {
            const int grp = (u.pn - 8) >> 2;
            const int cbase = ((u.pn - 8) & 3) * BM + cl;
            if (grp == 1) {
                f32x4 lv[2][2];
#pragma unroll
                for (int bj = 0; bj < 2; ++bj)
#pragma unroll
                    for (int n = 0; n < 2; ++n) lv[bj][n] = *(const f32x4*)(lb + cbase + bj * HALF + 4 * n);
#pragma unroll
                for (int ai = 0; ai < 2; ++ai)
#pragma unroll
                    for (int m = 0; m < 4; ++m) {
                        const size_t row = (size_t)(row0 + ai * HALF + m * 16);
#pragma unroll
                        for (int bj = 0; bj < 2; ++bj)
#pragma unroll
                            for (int n = 0; n < 2; ++n) { const f32x4 x = acc[ai][bj][m][n] + bv[bj][n]; const f32x4 l = lv[bj][n]; f32x4 o;
#pragma unroll
                                for (int e = 0; e < 4; ++e) o[e] = l[e] + (1.0f - l[e]) * sigm(x[e]);
                                *(f32x4*)(F + row * 1024 + cbase + bj * HALF + 4 * n) = o; }
                    }
            } else {
                bf16_t* O = QIG + (size_t)(grp - (grp > 0 ? 1 : 0)) * ((size_t)8704 * 1024);
                const bool act = grp != 2;
#pragma unroll
                for (int ai = 0; ai < 2; ++ai)
#pragma unroll
                    for (int m = 0; m < 4; ++m) {
                        const size_t row = (size_t)(row0 + ai * HALF + m * 16);
#pragma unroll
                        for (int bj = 0; bj < 2; ++bj) { float o[8];
#pragma unroll
                            for (int n = 0; n < 2; ++n) { const f32x4 x = acc[ai][bj][m][n] + bv[bj][n];
#pragma unroll
                                for (int e = 0; e < 4; ++e) o[n * 4 + e] = act ? x[e] * sigm(x[e]) : x[e]; }
                            u32x4 w; w.x = cvt_pk_bf16(o[0], o[1]); w.y = cvt_pk_bf16(o[2], o[3]); w.z = cvt_pk_bf16(o[4], o[5]); w.w = cvt_pk_bf16(o[6], o[7]);
                            *(u32x4*)(O + row * 1024 + cbase + bj * HALF) = w; }
                    }
            }
        }
    }
};
struct EpiRes {
    static constexpr bool PERM = false, AFTER_DRAIN = false;
    const float* baseP; const float* baseS; float* out; int split; float alpha;
    __device__ __forceinline__ void operator()(const f32x4 (&acc)[2][2][4][2], const Unit& u, int wr, int wc, int fr, int fq) const {
        const int row0 = u.pm * BM + wr * 64 + fr;
        const int col0 = u.pn * BM + wc * 32 + 4 * fq;
#pragma unroll
        for (int ai = 0; ai < 2; ++ai)
#pragma unroll
            for (int m = 0; m < 4; ++m) {
                const int row = row0 + ai * HALF + m * 16;
                const float* bp = row < split ? baseP + (size_t)row * 2048 : baseS + (size_t)(row - split) * 2048;
                float* op = out + (size_t)row * 2048;
#pragma unroll
                for (int bj = 0; bj < 2; ++bj)
#pragma unroll
                    for (int n = 0; n < 2; ++n) { const int c = col0 + bj * HALF + n * 16; const f32x4 b = *(const f32x4*)(bp + c); *(f32x4*)(op + c) = b * alpha + acc[ai][bj][m][n]; }
            }
    }
};
struct EpiGateUp {
    static constexpr bool PERM = true, AFTER_DRAIN = false;
    bf16_t* O; int ldc;
    __device__ __forceinline__ void operator()(const f32x4 (&acc)[2][2][4][2], const Unit& u, int wr, int wc, int fr, int fq) const {
        const int row0 = u.pm * BM + wr * 64 + fr;
        const int cl = wc * 32 + 8 * fq;
#pragma unroll
        for (int ai = 0; ai < 2; ++ai)
#pragma unroll
            for (int m = 0; m < 4; ++m) {
                const size_t row = (size_t)(row0 + ai * HALF + m * 16);
                float o[8];
#pragma unroll
                for (int n = 0; n < 2; ++n) { const f32x4 g = acc[ai][0][m][n], up = acc[ai][1][m][n];
#pragma unroll
                    for (int e = 0; e < 4; ++e) o[n * 4 + e] = g[e] * sigm(g[e]) * up[e]; }
                u32x4 w; w.x = cvt_pk_bf16(o[0], o[1]); w.y = cvt_pk_bf16(o[2], o[3]); w.z = cvt_pk_bf16(o[4], o[5]); w.w = cvt_pk_bf16(o[6], o[7]);
                *(u32x4*)(O + row * ldc + u.pn * HALF + cl) = w;
            }
    }
};

template <class Epi, class Sched, bool ALIGN_EPI = false, bool SP2 = false>
__device__ __forceinline__ void gemm_phase(PG8_LAS unsigned char* lds, const Gemm g, const Sched& S, const Epi& E) {
    int tid_ = threadIdx.x; asm volatile("" : "+v"(tid_));
    const int tid = tid_, wid = __builtin_amdgcn_readfirstlane(tid >> 6), lane = tid & 63, wr = wid >> 2, wc = wid & 3, fr = lane & 15, fq = lane >> 4;
    const int K = g.K, nt = K / BK;
    unsigned voffA[2], voffB[2];
#pragma unroll
    for (int i = 0; i < 2; ++i) { int R, C; stage_rc(tid * 16 + i * 8192, R, C); const int Rb = Epi::PERM ? ((R & ~31) + perm32(R & 31)) : R;
        voffA[i] = (unsigned)(R * K + C) * 2u; voffB[i] = (unsigned)(Rb * K + C) * 2u; }
    const size_t kstep = (size_t)(BK * 2);
    const size_t hstep = (size_t)HALF * K * 2;
    const size_t tstep = 2 * hstep;
    const unsigned ldsw = (unsigned)wid * 1024u;
    const int aoff = lds_byte(wr * 64 + fr, fq * 8), boff = lds_byte(wc * 32 + fr, fq * 8);
#define PG8_SA(b, h) (((b) * 2 + (h)) * HTB)
#define PG8_SB(b, h) ((4 + (b) * 2 + (h)) * HTB)
#define PG8_STAGE(bufoff, gbase, voff) do { _Pragma("unroll") for (int _i = 0; _i < 2; ++_i) \
        __builtin_amdgcn_global_load_lds((const unsigned*)((const char*)(gbase) + (voff)[_i]), (PG8_LAS unsigned*)(lds + (bufoff) + ldsw + _i * 8192), 16, 0, 0); } while (0)
#define PG8_LDA(dst, b, h) do { _Pragma("unroll") for (int m = 0; m < 4; ++m) _Pragma("unroll") for (int k = 0; k < 2; ++k) dst[m][k] = *(const PG8_LAS bf16x8*)(lds + PG8_SA(b, h) + aoff + m * 2048 + k * 1024); } while (0)
#define PG8_LDB(dst, b, h) do { _Pragma("unroll") for (int n = 0; n < 2; ++n) _Pragma("unroll") for (int k = 0; k < 2; ++k) dst[n][k] = *(const PG8_LAS bf16x8*)(lds + PG8_SB(b, h) + boff + n * 2048 + k * 1024); } while (0)
#define PG8_MMA(ai, bj, At, Bt) do { __builtin_amdgcn_s_setprio(1); _Pragma("unroll") for (int m = 0; m < 4; ++m) _Pragma("unroll") for (int n = 0; n < 2; ++n) _Pragma("unroll") for (int k = 0; k < 2; ++k) \
        acc[ai][bj][m][n] = __builtin_amdgcn_mfma_f32_16x16x32_bf16(Bt[n][k], At[m][k], acc[ai][bj][m][n], 0, 0, 0); __builtin_amdgcn_s_setprio(0); } while (0)
#define PG8_WAIT_V(n) asm volatile("s_waitcnt vmcnt(" #n ")" ::: "memory")
#define PG8_WAIT_L(n) asm volatile("s_waitcnt lgkmcnt(" #n ")" ::: "memory")
#define PG8_BAR __builtin_amdgcn_s_barrier()
#define PG8_SCHED __builtin_amdgcn_sched_barrier(0)
    Unit cur, nxt; int ui = 0;
    if (!S.next(0, cur)) return;
    f32x4 acc[2][2][4][2];
#pragma unroll
    for (int a = 0; a < 2; ++a)
#pragma unroll
        for (int b = 0; b < 2; ++b)
#pragma unroll
            for (int m = 0; m < 4; ++m)
#pragma unroll
                for (int n = 0; n < 2; ++n) acc[a][b][m][n] = (f32x4){0.f, 0.f, 0.f, 0.f};
    bf16x8 At[4][2], B0[2][2], B1[2][2];
    const char* cA = (const char*)g.A + (size_t)cur.pm * tstep; const char* cB = (const char*)g.Bt + (size_t)cur.pn * tstep;
    S.a_ready(cur);
    if constexpr (SP2) {
        PG8_STAGE(PG8_SB(0, 0), cB, voffB); PG8_STAGE(PG8_SB(0, 1), cB + hstep, voffB); PG8_STAGE(PG8_SA(0, 0), cA, voffA); PG8_STAGE(PG8_SA(0, 1), cA + hstep, voffA);
        if (wr == 1) PG8_BAR;
        PG8_WAIT_V(2); PG8_BAR;
        PG8_STAGE(PG8_SB(1, 0), cB + kstep, voffB); PG8_STAGE(PG8_SA(1, 0), cA + kstep, voffA); PG8_STAGE(PG8_SB(1, 1), cB + hstep + kstep, voffB);
        PG8_WAIT_V(6); PG8_BAR;
    } else {
        PG8_STAGE(PG8_SB(0, 0), cB, voffB); PG8_STAGE(PG8_SA(0, 0), cA, voffA); PG8_STAGE(PG8_SB(0, 1), cB + hstep, voffB); PG8_STAGE(PG8_SA(0, 1), cA + hstep, voffA);
        if (wr == 1) PG8_BAR;
        PG8_WAIT_V(4); PG8_BAR;
        PG8_STAGE(PG8_SB(1, 0), cB + kstep, voffB); PG8_STAGE(PG8_SA(1, 0), cA + kstep, voffA); PG8_STAGE(PG8_SB(1, 1), cB + hstep + kstep, voffB);
        PG8_WAIT_V(6); PG8_BAR;
    }
    for (;;) {
        const bool has_next = S.next(ui + 1, nxt);
        const char* nA = has_next ? (const char*)g.A + (size_t)nxt.pm * tstep : cA; const char* nB = has_next ? (const char*)g.Bt + (size_t)nxt.pn * tstep : cB;
        for (int t = 0; t < nt; t += 2) {
            const bool last = (t == nt - 2);
            const char* a1 = cA + (size_t)(t + 1) * kstep;
            const char* a2 = last ? nA : cA + (size_t)(t + 2) * kstep; const char* b2 = last ? nB : cB + (size_t)(t + 2) * kstep;
            const char* a3 = a2 + kstep; const char* b3 = b2 + kstep;
            if (last && has_next) S.a_ready(nxt);
            if constexpr (SP2) {
            PG8_LDB(B0, 0, 0); PG8_LDB(B1, 0, 1); PG8_SCHED; PG8_LDA(At, 0, 0); PG8_STAGE(PG8_SA(1, 1), a1 + hstep, voffA);
            PG8_WAIT_V(8); PG8_WAIT_L(0); PG8_BAR; PG8_MMA(0, 0, At, B0); PG8_MMA(0, 1, At, B1); PG8_BAR; PG8_SCHED;
            PG8_LDA(At, 0, 1); PG8_STAGE(PG8_SB(0, 0), b2, voffB); PG8_STAGE(PG8_SB(0, 1), b2 + hstep, voffB); PG8_STAGE(PG8_SA(0, 0), a2, voffA);
            PG8_WAIT_V(8); PG8_WAIT_L(0); PG8_BAR; PG8_MMA(1, 0, At, B0); PG8_MMA(1, 1, At, B1); PG8_BAR; PG8_SCHED;
            PG8_LDB(B0, 1, 0); PG8_LDB(B1, 1, 1); PG8_SCHED; PG8_LDA(At, 1, 0); PG8_STAGE(PG8_SA(0, 1), a2 + hstep, voffA);
            PG8_WAIT_V(8); PG8_WAIT_L(0); PG8_BAR; PG8_MMA(0, 0, At, B0); PG8_MMA(0, 1, At, B1); PG8_BAR; PG8_SCHED;
            PG8_LDA(At, 1, 1); PG8_STAGE(PG8_SB(1, 0), b3, voffB); PG8_STAGE(PG8_SB(1, 1), b3 + hstep, voffB); PG8_STAGE(PG8_SA(1, 0), a3, voffA);
            PG8_WAIT_V(8); PG8_WAIT_L(0); PG8_BAR; PG8_MMA(1, 0, At, B0); PG8_MMA(1, 1, At, B1); PG8_BAR; PG8_SCHED;
            } else {
            PG8_LDB(B0, 0, 0); PG8_SCHED; PG8_LDA(At, 0, 0); PG8_STAGE(PG8_SA(1, 1), a1 + hstep, voffA);
            PG8_WAIT_L(8); PG8_BAR; PG8_WAIT_L(0); PG8_MMA(0, 0, At, B0); PG8_BAR; PG8_SCHED;
            PG8_LDB(B1, 0, 1); PG8_STAGE(PG8_SB(0, 0), b2, voffB);
            PG8_BAR; PG8_WAIT_L(0); PG8_MMA(0, 1, At, B1); PG8_BAR;
            PG8_LDA(At, 0, 1); PG8_STAGE(PG8_SA(0, 0), a2, voffA);
            PG8_BAR; PG8_WAIT_L(0); PG8_MMA(1, 0, At, B0); PG8_BAR; PG8_SCHED;
            PG8_STAGE(PG8_SB(0, 1), b2 + hstep, voffB);
            PG8_WAIT_V(6); PG8_BAR; PG8_MMA(1, 1, At, B1); PG8_BAR;
            PG8_LDB(B0, 1, 0); PG8_SCHED; PG8_LDA(At, 1, 0); PG8_STAGE(PG8_SA(0, 1), a2 + hstep, voffA);
            PG8_WAIT_L(8); PG8_BAR; PG8_WAIT_L(0); PG8_MMA(0, 0, At, B0); PG8_BAR; PG8_SCHED;
            PG8_LDB(B1, 1, 1); PG8_STAGE(PG8_SB(1, 0), b3, voffB);
            PG8_BAR; PG8_WAIT_L(0); PG8_MMA(0, 1, At, B1); PG8_BAR;
            PG8_LDA(At, 1, 1); PG8_STAGE(PG8_SA(1, 0), a3, voffA);
            PG8_BAR; PG8_WAIT_L(0); PG8_MMA(1, 0, At, B0); PG8_BAR; PG8_SCHED;
            PG8_STAGE(PG8_SB(1, 1), b3 + hstep, voffB);
            PG8_WAIT_V(6); PG8_BAR; PG8_MMA(1, 1, At, B1); PG8_BAR;
            }
        }
        if constexpr (ALIGN_EPI) { if (wr == 0) PG8_BAR; }
        if constexpr (!Epi::AFTER_DRAIN) { E(acc, cur, wr, wc, fr, fq); S.done(cur); }
        if (!has_next) break;
#pragma unroll
        for (int a = 0; a < 2; ++a)
#pragma unroll
            for (int b = 0; b < 2; ++b)
#pragma unroll
                for (int m = 0; m < 4; ++m)
#pragma unroll
                    for (int n = 0; n < 2; ++n) acc[a][b][m][n] = (f32x4){0.f, 0.f, 0.f, 0.f};
        cur = nxt; cA = nA; cB = nB; ++ui;
        if constexpr (ALIGN_EPI) { if (wr == 1) PG8_BAR; }
    }
    PG8_WAIT_V(0);
    if constexpr (!ALIGN_EPI) { if (wr == 0) PG8_BAR; }
    PG8_BAR;
#undef PG8_SA
#undef PG8_SB
#undef PG8_STAGE
#undef PG8_LDA
#undef PG8_LDB
#undef PG8_MMA
#undef PG8_WAIT_V
#undef PG8_WAIT_L
#undef PG8_BAR
#undef PG8_SCHED
}
}

constexpr int D = 2048, MP = 8192, MS = 512, M = MP + MS, CW = 1024, NH = 8, HD = 128, FF = 5632, NIN = 6144;
constexpr float LN_EPS = 1e-5f;
constexpr float ALPHA = 1.189207115002721f;
constexpr int NWAVES = 8;
constexpr int LDS_BYTES = 147456;
constexpr int N_PHASES = 10;

constexpr size_t MiB = 1u << 20;
constexpr size_t WS_LB = 64 * 1024, WS_BIASP = 128 * 1024;
constexpr size_t WS_WIN = 1 * MiB, WS_WOUT = 25 * MiB, WS_WGU = 33 * MiB, WS_WDN = 77 * MiB;
constexpr size_t WS_XB = 99 * MiB, WS_MIX = 133 * MiB;
constexpr size_t WS_U = 167 * MiB, WS_Q = 184 * MiB, WS_I = 201 * MiB, WS_G = 218 * MiB, WS_F = 235 * MiB, WS_END = 269 * MiB;
constexpr size_t WS_ACT = 167 * MiB;
static_assert(WS_ACT + (size_t)M * FF * 2 <= WS_END, "act overlay");
constexpr size_t O_Y = 0, O_NCP = (size_t)M * D, O_NHP = O_NCP + 4 * 30 * 1024, O_NCS = O_NHP + 4 * 8 * 128 * 128, O_NHS = O_NCS + 32 * 30 * 1024;
constexpr size_t O_ST = 0, O_DC = (size_t)1024 * 16384;

#define LAS __attribute__((address_space(3)))
typedef unsigned short bf16;
typedef float f32x4 __attribute__((ext_vector_type(4)));
typedef float f32x2 __attribute__((ext_vector_type(2)));
typedef unsigned v4u __attribute__((ext_vector_type(4)));
typedef unsigned v2u __attribute__((ext_vector_type(2)));
typedef float f32x16 __attribute__((ext_vector_type(16)));
typedef unsigned u32x8 __attribute__((ext_vector_type(8)));
#define CAS __attribute__((address_space(4)))
#define LDS_WAIT() asm volatile("s_waitcnt lgkmcnt(0)" ::: "memory")

__device__ __forceinline__ unsigned f2bf(float f) { unsigned u = __builtin_bit_cast(unsigned, f); return (u + 0x7fffu + ((u >> 16) & 1u)) >> 16; }
__device__ __forceinline__ unsigned pk2(float lo, float hi) { return f2bf(lo) | (f2bf(hi) << 16); }
__device__ __forceinline__ float bf2f(unsigned short b) { return __uint_as_float((unsigned)b << 16); }
__device__ __forceinline__ float sigm(float x) { return __builtin_amdgcn_rcpf(1.0f + __expf(-x)); }
__device__ __forceinline__ float wave_sum(float v) {
#pragma unroll
    for (int o = 1; o < 64; o <<= 1) v += __shfl_xor(v, o);
    return v;
}

__device__ __forceinline__ void transpose_item(const float* W, int K, int N, bf16* WT, int k0, int n0, int dst_row0, LAS float* scr, int lane) {
#pragma unroll 8
    for (int i = 0; i < 32; ++i) { const int kk = 2 * i + (lane >> 5); scr[kk * 33 + (lane & 31)] = W[(size_t)(k0 + kk) * N + n0 + (lane & 31)]; }
    LDS_WAIT(); asm volatile("" ::: "memory");
    const int c = lane & 7;
#pragma unroll
    for (int j = 0; j < 4; ++j) { const int n = (lane >> 3) + 8 * j; const LAS float* s = scr + (8 * c) * 33 + n;
        v4u o; o.x = pk2(s[0 * 33], s[1 * 33]); o.y = pk2(s[2 * 33], s[3 * 33]); o.z = pk2(s[4 * 33], s[5 * 33]); o.w = pk2(s[6 * 33], s[7 * 33]);
        *(v4u*)(WT + (size_t)(dst_row0 + n) * K + k0 + 8 * c) = o; }
    LDS_WAIT(); asm volatile("" ::: "memory");
}

__device__ __forceinline__ void ln_row(const float* src, float* dstf, bf16* dstb, const float* g, const float* b, int lane) {
    const f32x4* xr = (const f32x4*)src + lane;
    f32x4 v[8]; float s = 0.f;
#pragma unroll
    for (int j = 0; j < 8; ++j) { v[j] = xr[64 * j]; s += (v[j].x + v[j].y) + (v[j].z + v[j].w); }
    const float mean = wave_sum(s) * (1.f / D); float s2 = 0.f;
#pragma unroll
    for (int j = 0; j < 8; ++j) { v[j] = v[j] - mean; s2 += (v[j].x * v[j].x + v[j].y * v[j].y) + (v[j].z * v[j].z + v[j].w * v[j].w); }
    const float rstd = 1.f / sqrtf(wave_sum(s2) * (1.f / D) + LN_EPS);
#pragma unroll
    for (int j = 0; j < 8; ++j) {
        const f32x4 gg = ((const f32x4*)g)[lane + 64 * j], bb = ((const f32x4*)b)[lane + 64 * j];
        const f32x4 o = v[j] * rstd * gg + bb;
        if (dstf) ((f32x4*)dstf)[lane + 64 * j] = o;
        if (dstb) { v2u w; w.x = pk2(o.x, o.y); w.y = pk2(o.z, o.w); ((v2u*)dstb)[lane + 64 * j] = w; }
    }
}


#define XB_TMO      128
#define XB_XCNT(j)  (256  + 64 * (j))
#define XB_XSUB(j)  (1280 + 64 * (j))
#define XB_XGEN(j)  (2304 + 64 * (j))
#define XB_TOP      3328
#define XB_TOPGEN   3392
#define XCD_BAR_WORDS 3456
#define XB_SPIN_CAP (1u << 18)
__device__ __forceinline__ unsigned xb_ld(unsigned* p)              { return __hip_atomic_load(p, __ATOMIC_RELAXED, __HIP_MEMORY_SCOPE_AGENT); }
__device__ __forceinline__ unsigned xb_add(unsigned* p, unsigned v) { return __hip_atomic_fetch_add(p, v, __ATOMIC_RELAXED, __HIP_MEMORY_SCOPE_AGENT); }
__device__ __forceinline__ unsigned xb_xcc_id() { return (unsigned)__builtin_amdgcn_s_getreg((3 << 11) | 20) & 0xFu; }
#define XB_SPIN(cond, bar) do { unsigned _sp = 0; while (cond) { __builtin_amdgcn_s_sleep(1); \
    if ((++_sp & 255u) == 0u) { if (xb_ld(&(bar)[XB_TMO])) break; if (_sp > XB_SPIN_CAP) { atomicAdd(&(bar)[XB_TMO], 1u); break; } } } } while (0)
struct XcdBarrier { unsigned* bar; unsigned x; volatile LAS unsigned* st; };
__device__ __forceinline__ XcdBarrier xcd_barrier_post(unsigned* bar, volatile LAS unsigned* st) {
    XcdBarrier b; b.bar = bar; b.x = xb_xcc_id(); b.st = st;
    if (threadIdx.x == 0) (void)xb_add(&bar[XB_XCNT(b.x)], 1u);
    return b;
}
__device__ __forceinline__ void xcd_barrier_complete(unsigned* bar, unsigned x, unsigned& nloc, unsigned& nx) {
    const unsigned G = gridDim.x * gridDim.y * gridDim.z;
    unsigned sum, cnt, mine, sp = 0u;
    for (;;) {
        sum = 0u; cnt = 0u; mine = 0u;
#pragma unroll
        for (unsigned j = 0; j < 16; ++j) { const unsigned c = xb_ld(&bar[XB_XCNT(j)]); sum += c; cnt += (c > 0u) ? 1u : 0u; mine = (j == x) ? c : mine; }
        if (sum == G) break;
        __builtin_amdgcn_s_sleep(1);
        if ((++sp & 255u) == 0u) { if (xb_ld(&bar[XB_TMO])) break; if (sp > XB_SPIN_CAP) { atomicAdd(&bar[XB_TMO], 1u); break; } }
    }
    nloc = mine > 0u ? mine : 1u; nx = cnt > 0u ? cnt : 1u;
}
__device__ __forceinline__ void xcd_barrier(const XcdBarrier& b) {
    asm volatile("s_waitcnt vmcnt(0)" ::: "memory");
    __syncthreads();
    if (threadIdx.x == 0) {
        unsigned* bar = b.bar;
        __builtin_amdgcn_s_waitcnt(0);
        unsigned nloc = b.st[0], nx = b.st[1];
        if (nloc == 0u) { xcd_barrier_complete(bar, b.x, nloc, nx); b.st[0] = nloc; b.st[1] = nx; }
        const unsigned old = xb_add(&bar[XB_XSUB(b.x)], 1u);
        const unsigned gen = old / nloc;
        if (old + 1u == (gen + 1u) * nloc) {
            __builtin_amdgcn_fence(__ATOMIC_RELEASE, "agent");
            asm volatile("s_waitcnt vmcnt(0)" ::: "memory");
            const unsigned og = xb_add(&bar[XB_TOP], 1u);
            const unsigned tg = og / nx;
            if (og + 1u == (tg + 1u) * nx) xb_add(&bar[XB_TOPGEN], 1u);
            else XB_SPIN(xb_ld(&bar[XB_TOPGEN]) == tg, bar);
            __builtin_amdgcn_fence(__ATOMIC_ACQUIRE, "agent");
            xb_add(&bar[XB_XGEN(b.x)], 1u);
            asm volatile("s_waitcnt vmcnt(0)" ::: "memory");
        } else {
            XB_SPIN(xb_ld(&bar[XB_XGEN(b.x)]) == gen, bar);
            __builtin_amdgcn_fence(__ATOMIC_ACQUIRE, "agent");
            asm volatile("s_waitcnt vmcnt(0)" ::: "memory");
        }
    }
    __syncthreads();
}

struct Args { const float* in[20]; float* out; unsigned char* ws; int ph_lo, ph_hi; };

__global__ void __launch_bounds__(NWAVES * 64, 2) fwd_kernel(Args args) {
    extern __shared__ __attribute__((aligned(16))) unsigned char lds_raw[];
    LAS unsigned char* lds = (LAS unsigned char*)lds_raw;
    const int tid = threadIdx.x, lane = tid & 63, wave = __builtin_amdgcn_readfirstlane(tid >> 6);
    const int G = gridDim.x, bx = blockIdx.x;
    const int gt = bx * 512 + tid, NT = G * 512;
    const int gw = bx * NWAVES + wave, NGW = G * NWAVES;

#define x_prompt (args.in[0])
#define x_sample (args.in[1])
#define cache_conv (args.in[2])
#define state_hgrn (args.in[3])
#define w_in (args.in[4])
#define b_in (args.in[5])
#define w_dw (args.in[6])
#define b_dw (args.in[7])
#define cn_g (args.in[8])
#define cn_b (args.in[9])
#define hlb (args.in[10])
#define hg_ng (args.in[11])
#define w_out (args.in[12])
#define ln1_g (args.in[13])
#define ln1_b (args.in[14])
#define w_gate (args.in[15])
#define w_up (args.in[16])
#define w_down (args.in[17])
#define ln2_g (args.in[18])
#define ln2_b (args.in[19])
#define out (args.out)
#define ws (args.ws)
#define LB ((float*)(ws + WS_LB))
#define BIASP ((float*)(ws + WS_BIASP))
#define WIN ((bf16*)(ws + WS_WIN))
#define WOUT ((bf16*)(ws + WS_WOUT))
#define WGU ((bf16*)(ws + WS_WGU))
#define WDN ((bf16*)(ws + WS_WDN))
#define XB ((bf16*)(ws + WS_XB))
#define MIX ((bf16*)(ws + WS_MIX))
#define U ((bf16*)(ws + WS_U))
#define Q ((bf16*)(ws + WS_Q))
#define F ((float*)(ws + WS_F))
#define I ((bf16*)(ws + WS_I))
#define Gt ((bf16*)(ws + WS_G))
#define ACT ((bf16*)(ws + WS_ACT))
#define ST (out + O_ST)
#define DC (out + O_DC)

    const int lo = args.ph_lo, hi = args.ph_hi;
    volatile LAS unsigned* MISC = (volatile LAS unsigned*)(lds + 131072);
    if (tid < 16) MISC[tid] = 0u;
    __syncthreads();
    XcdBarrier xbar = xcd_barrier_post((unsigned*)ws, MISC + 8);
#ifndef PH_MASK
#define PH_MASK 0x3ff
#endif
#define IN(k) (((PH_MASK >> (k)) & 1) && lo <= (k) && (k) < hi)
#ifndef REP_MASK
#define REP_MASK 0
#endif
#define NREP(k) (1 + ((REP_MASK >> (k)) & 1))
#define SEAM(k) do { if (IN(k) && IN((k) + 1)) { xcd_barrier(xbar); } } while (0)
    if (hi > 1000) cg::this_grid().sync();

    if (IN(0)) for (int rep_ = 0; rep_ < NREP(0); ++rep_) { if (rep_) xcd_barrier(xbar);
        LAS float* scr = (LAS float*)(lds + wave * 16384);
        constexpr int I_IN = 32 * 192, I_OUT = 32 * 64, I_G = 32 * 176, I_DN = 88 * 64;
        constexpr int NITEMS = I_IN + I_OUT + 2 * I_G + I_DN;
        for (int it = gw; it < NITEMS; it += NGW) {
            int r = it; const float* W; int K, N; bf16* WT; int kind;
            if (r < I_IN) { kind = 0; W = w_in; K = D; N = NIN; WT = WIN; }
            else if ((r -= I_IN) < I_OUT) { kind = 1; W = w_out; K = D; N = D; WT = WOUT; }
            else if ((r -= I_OUT) < I_G) { kind = 2; W = w_gate; K = D; N = FF; WT = WGU; }
            else if ((r -= I_G) < I_G) { kind = 3; W = w_up; K = D; N = FF; WT = WGU; }
            else { r -= I_G; kind = 4; W = w_down; K = FF; N = D; WT = WDN; }
            const int nblk = N / 32, kb = r / nblk, nb = r % nblk, k0 = 64 * kb, n0 = 32 * nb;
            int dst;
            if (kind == 0) dst = n0 < 2048 ? ((n0 & 1023) >> 7) * 256 + (n0 >> 10) * 128 + (n0 & 127) : n0;
            else if (kind == 2) dst = (n0 >> 7) * 256 + (n0 & 127);
            else if (kind == 3) dst = (n0 >> 7) * 256 + 128 + (n0 & 127);
            else dst = n0;
            transpose_item(W, K, N, WT, k0, n0, dst, scr, lane);
        }
        constexpr int NV = M * D / 8, NVP = MP * D / 8;
        for (int i = gt; i < NV; i += NT) {
            const float* src = i < NVP ? x_prompt + (size_t)i * 8 : x_sample + (size_t)(i - NVP) * 8;
            const f32x4 a = *(const f32x4*)src, b = *(const f32x4*)(src + 4);
            v4u o; o.x = pk2(a.x, a.y); o.y = pk2(a.z, a.w); o.z = pk2(b.x, b.y); o.w = pk2(b.z, b.w);
            *(v4u*)(XB + (size_t)i * 8) = o;
        }
        for (int i = gt; i < 1024; i += NT) LB[i] = sigm(hlb[i] - hlb[1024 + i]);
        for (int i = gt; i < NIN; i += NT) { const int orig = i < 2048 ? ((i & 255) >> 7) * 1024 + (i >> 8) * 128 + (i & 127) : i; BIASP[i] = b_in[orig]; }
    }
    SEAM(0);
#ifdef EXTRA_SYNCS
    for (int i_ = 0; i_ < EXTRA_SYNCS; ++i_) cg::this_grid().sync();
#endif

    if (IN(1)) for (int rep_ = 0; rep_ < NREP(1); ++rep_) { if (rep_) xcd_barrier(xbar);
        pg8::Gemm g{XB, WIN, M, NIN, D}; pg8::StaticOrder S; S.init(M, NIN, G, bx);
        pg8::EpiProj E{U, Q, F, BIASP, LB};
        pg8::gemm_phase<pg8::EpiProj, pg8::StaticOrder, true, true>(lds, g, S, E);
    }
    SEAM(1);

    if (IN(2)) for (int rep_ = 0; rep_ < NREP(2); ++rep_) { if (rep_) xcd_barrier(xbar);
        LAS float* fl = (LAS float*)lds; LAS float* vl = (LAS float*)(lds + 8192);
        LAS float* redc = (LAS float*)(lds + 60000 / 16 * 16); LAS float* tot = redc + 128;
        for (int it = bx; it < 1024 + 1088; it += G) {
            __syncthreads();
            if (it < 1024) {
                const int bh = it >> 5, c = it & 31, b = bh >> 3, h = bh & 7;
                const int row0 = b * 2048 + c * 64;
                f32x2 Sa[8], Sb[8];
#pragma unroll
                for (int i = 0; i < 8; ++i) { Sa[i] = (f32x2){0.f, 0.f}; Sb[i] = (f32x2){0.f, 0.f}; }
                float dprod = 1.f;
                for (int sb = 0; sb < 4; ++sb) {
                    __syncthreads();
#pragma unroll
                    for (int e4 = 0; e4 < 4; ++e4) { const int e = tid + e4 * 512, t = e >> 7, k = e & 127; const size_t gi = (size_t)(row0 + sb * 16 + t) * 1024 + h * 128 + k;
                        fl[e] = F[gi]; vl[e] = bf2f(I[gi]); }
                    __syncthreads();
                    const CAS float* fbase = (const CAS float*)(F + (size_t)(row0 + sb * 16) * 1024 + h * 128 + wave * 16);
#pragma unroll 2
                    for (int t = 0; t < 16; ++t) {
                        const f32x16 f = *(const CAS f32x16*)(fbase + t * 1024);
                        const float va = vl[t * 128 + lane], vb = vl[t * 128 + 64 + lane];
                        const f32x2 va2 = (f32x2){va, va}, vb2 = (f32x2){vb, vb};
#pragma unroll
                        for (int i = 0; i < 8; ++i) { const f32x2 f2 = (f32x2){f[2 * i], f[2 * i + 1]};
                            Sa[i] = f2 * (Sa[i] - va2) + va2; Sb[i] = f2 * (Sb[i] - vb2) + vb2; }
                    }
                    if (tid < 128) {
#pragma unroll
                        for (int t = 0; t < 16; ++t) dprod *= fl[t * 128 + tid];
                    }
                }
                float* sp = ST + (size_t)it * 16384 + (size_t)(wave * 16) * 128 + lane;
#pragma unroll
                for (int i = 0; i < 8; ++i) { sp[(2 * i) * 128] = Sa[i].x; sp[(2 * i + 1) * 128] = Sa[i].y; sp[(2 * i) * 128 + 64] = Sb[i].x; sp[(2 * i + 1) * 128 + 64] = Sb[i].y; }
                if (tid < 128) DC[it * 128 + tid] = dprod;
            } else {
                const int m0 = (it - 1024) * 8;
                const bool samp = m0 >= MP;
                int t0, seq0; const float* hist = cache_conv;
                if (!samp) { t0 = m0 & 2047; seq0 = m0 - t0; }
                else { const int sbi = (m0 - MP) >> 4; t0 = (m0 - MP) & 15; seq0 = MP + sbi * 16; hist = cache_conv + (size_t)sbi * 30 * 1024; }
                LAS float* hbuf = (LAS float*)(lds + 16384);
                float s1[8], s2[8];
#pragma unroll
                for (int t = 0; t < 8; ++t) { s1[t] = 0.f; s2[t] = 0.f; }
#pragma unroll 1
                for (int p = 0; p < 2; ++p) {
                    const int c = tid + p * 512;
                    const unsigned cb2 = (unsigned)c * 2u, cb4 = (unsigned)c * 4u;
                    float w0[38];
#pragma unroll
                    for (int jj = 0; jj < 38; ++jj) {
                        const int tr = t0 - 30 + jj;
                        float a = 0.f;
                        if (tr >= 0) a = bf2f(*(const bf16*)((const char*)(U + (size_t)(seq0 + tr) * 1024) + cb2));
                        else if (samp) a = *(const float*)((const char*)(hist + (30 + tr) * 1024) + cb4);
                        w0[jj] = a;
                    }
                    float a0[8];
                    { const float bb = *(const float*)((const char*)b_dw + cb4);
#pragma unroll
                      for (int t = 0; t < 8; ++t) a0[t] = bb; }
#pragma unroll
                    for (int j = 0; j < 31; ++j) { const float wv = *(const float*)((const char*)(w_dw + j * 1024) + cb4);
#pragma unroll
                        for (int t = 0; t < 8; ++t) a0[t] += wv * w0[t + j]; }
#pragma unroll
                    for (int t = 0; t < 8; ++t) { hbuf[t * 1024 + c] = a0[t]; s1[t] += a0[t]; s2[t] += a0[t] * a0[t]; }
                }
                float st[16];
#pragma unroll
                for (int t = 0; t < 8; ++t) { st[t] = wave_sum(s1[t]); st[8 + t] = wave_sum(s2[t]); }
                if (lane == 0) {
#pragma unroll
                    for (int i = 0; i < 16; ++i) redc[wave * 16 + i] = st[i];
                }
                __syncthreads();
                if (tid < 16) { float s = 0.f;
#pragma unroll
                    for (int w = 0; w < 8; ++w) s += redc[w * 16 + tid];
                    tot[tid] = s; }
                __syncthreads();
                const int c = 2 * tid;
                const f32x2 gg = *(const f32x2*)(cn_g + c), bb2 = *(const f32x2*)(cn_b + c);
#pragma unroll
                for (int t = 0; t < 8; ++t) {
                    const float mu = tot[t] * (1.f / 1024.f); float var = tot[8 + t] * (1.f / 1024.f) - mu * mu; var = var > 0.f ? var : 0.f;
                    const float rstd = 1.f / sqrtf(var + LN_EPS);
                    const f32x2 hv = *(const LAS f32x2*)(hbuf + t * 1024 + c);
                    float y0 = (hv.x - mu) * rstd * gg.x + bb2.x, y1 = (hv.y - mu) * rstd * gg.y + bb2.y;
                    y0 = y0 * sigm(y0); y1 = y1 * sigm(y1);
                    *(unsigned*)(MIX + (size_t)(m0 + t) * 2048 + c) = pk2(y0, y1);
                }
            }
        }
        for (int i = gt; i < 4 * 30 * 1024; i += NT) { const int b = i / 30720, j = (i >> 10) % 30, c = i & 1023;
            out[O_NCP + i] = bf2f(U[(size_t)(b * 2048 + 2018 + j) * 1024 + c]); }
        for (int i = gt; i < 32 * 30 * 1024; i += NT) { const int sb = i / 30720, j = (i >> 10) % 30, c = i & 1023;
            out[O_NCS + i] = j < 14 ? cache_conv[(size_t)sb * 30720 + (16 + j) * 1024 + c] : bf2f(U[(size_t)(MP + sb * 16 + j - 14) * 1024 + c]); }
    }
    SEAM(2);

    if (IN(3)) {
        for (int e = gt; e < 32 * 4096; e += NT) {
            const int bh = e >> 12, r = e & 4095, k = r >> 5, v4 = r & 31;
            f32x4 S = (f32x4){0.f, 0.f, 0.f, 0.f};
#pragma unroll 8
            for (int c = 0; c < 32; ++c) {
                f32x4* p = (f32x4*)(ST + ((size_t)(bh * 32 + c) * 128 + k) * 128 + v4 * 4);
                const f32x4 A = *p; const float d = DC[(bh * 32 + c) * 128 + k];
                *p = S; S = S * d + A;
            }
            *(f32x4*)(out + O_NHP + ((size_t)bh * 128 + k) * 128 + v4 * 4) = S;
        }
    }
    SEAM(3);

    if (IN(4)) for (int rep_ = 0; rep_ < NREP(4); ++rep_) { if (rep_) xcd_barrier(xbar);
        LAS float* vl = (LAS float*)lds; LAS float* red = (LAS float*)(lds + 8192);
        for (int it = bx; it < 1024 + 256; it += G) {
            int row0, h, nsb; const float* sinit; float* sfin = nullptr;
            if (it < 1024) { const int bh = it >> 5, c = it & 31; h = bh & 7; row0 = (bh >> 3) * 2048 + c * 64; nsb = 4; sinit = ST + (size_t)it * 16384; }
            else { const int j = it - 1024; h = j & 7; row0 = MP + (j >> 3) * 16; nsb = 1; sinit = state_hgrn + (size_t)j * 16384; sfin = out + O_NHS + (size_t)j * 16384; }
            f32x2 Sa[8], Sb[8];
            { const float* sp = sinit + (size_t)(wave * 16) * 128 + lane;
#pragma unroll
              for (int i = 0; i < 8; ++i) { Sa[i] = (f32x2){sp[(2 * i) * 128], sp[(2 * i + 1) * 128]}; Sb[i] = (f32x2){sp[(2 * i) * 128 + 64], sp[(2 * i + 1) * 128 + 64]}; } }
            for (int sb = 0; sb < nsb; ++sb) {
                __syncthreads();
#pragma unroll
                for (int e4 = 0; e4 < 4; ++e4) { const int e = tid + e4 * 512, t = e >> 7, k = e & 127; const size_t gi = (size_t)(row0 + sb * 16 + t) * 1024 + h * 128 + k;
                    vl[e] = bf2f(I[gi]); }
                __syncthreads();
                const CAS float* fbase = (const CAS float*)(F + (size_t)(row0 + sb * 16) * 1024 + h * 128 + wave * 16);
                const CAS unsigned* qbase = (const CAS unsigned*)(Q + (size_t)(row0 + sb * 16) * 1024 + h * 128 + wave * 16);
#pragma unroll 2
                for (int t = 0; t < 16; ++t) {
                    const f32x16 f = *(const CAS f32x16*)(fbase + t * 1024);
                    const u32x8 qp = *(const CAS u32x8*)(qbase + t * 512);
                    const float va = vl[t * 128 + lane], vb = vl[t * 128 + 64 + lane];
                    const f32x2 va2 = (f32x2){va, va}, vb2 = (f32x2){vb, vb};
                    f32x2 oa = (f32x2){0.f, 0.f}, ob = (f32x2){0.f, 0.f};
#pragma unroll
                    for (int i = 0; i < 8; ++i) { const f32x2 f2 = (f32x2){f[2 * i], f[2 * i + 1]};
                        const f32x2 q2 = (f32x2){__uint_as_float(qp[i] << 16), __uint_as_float(qp[i] & 0xffff0000u)};
                        Sa[i] = f2 * (Sa[i] - va2) + va2; Sb[i] = f2 * (Sb[i] - vb2) + vb2;
                        oa += q2 * Sa[i]; ob += q2 * Sb[i]; }
                    red[(wave * 16 + t) * 128 + lane] = oa.x + oa.y; red[(wave * 16 + t) * 128 + 64 + lane] = ob.x + ob.y;
                }
                __syncthreads();
#pragma unroll
                for (int tt = 0; tt < 2; ++tt) {
                    const int t = wave * 2 + tt;
                    float o0 = 0.f, o1 = 0.f;
#pragma unroll
                    for (int q8 = 0; q8 < 8; ++q8) { o0 += red[(q8 * 16 + t) * 128 + lane]; o1 += red[(q8 * 16 + t) * 128 + 64 + lane]; }
                    const float ss = wave_sum(o0 * o0 + o1 * o1);
                    const float r = 1.f / sqrtf(ss * (1.f / 128.f) + LN_EPS);
                    const size_t m = (size_t)(row0 + sb * 16 + t);
                    const float g0 = bf2f(Gt[m * 1024 + h * 128 + lane]), g1 = bf2f(Gt[m * 1024 + h * 128 + 64 + lane]);
                    MIX[m * 2048 + 1024 + h * 128 + lane] = (bf16)f2bf(o0 * r * hg_ng[lane] * g0);
                    MIX[m * 2048 + 1024 + h * 128 + 64 + lane] = (bf16)f2bf(o1 * r * hg_ng[64 + lane] * g1);
                }
            }
            if (sfin) { float* sp = sfin + (size_t)(wave * 16) * 128 + lane;
#pragma unroll
                for (int i = 0; i < 8; ++i) { sp[(2 * i) * 128] = Sa[i].x; sp[(2 * i + 1) * 128] = Sa[i].y; sp[(2 * i) * 128 + 64] = Sb[i].x; sp[(2 * i + 1) * 128 + 64] = Sb[i].y; } }
        }
        __syncthreads();
    }
    SEAM(4);

    if (IN(5)) for (int rep_ = 0; rep_ < NREP(5); ++rep_) { if (rep_) xcd_barrier(xbar);
        pg8::Gemm g{MIX, WOUT, M, D, D}; pg8::StaticOrder S; S.init(M, D, G, bx);
        pg8::EpiRes E{x_prompt, x_sample, out, MP, ALPHA};
        pg8::gemm_phase<pg8::EpiRes, pg8::StaticOrder, true, true>(lds, g, S, E);
    }
    SEAM(5);

    if (IN(6)) {
        for (int m = gw; m < M; m += NGW) ln_row(out + (size_t)m * D, out + (size_t)m * D, XB + (size_t)m * D, ln1_g, ln1_b, lane);
    }
    SEAM(6);

    if (IN(7)) for (int rep_ = 0; rep_ < NREP(7); ++rep_) { if (rep_) xcd_barrier(xbar);
        pg8::Gemm g{XB, WGU, M, 2 * FF, D}; pg8::StaticOrder S; S.init(M, 2 * FF, G, bx);
        pg8::EpiGateUp E{ACT, FF};
        pg8::gemm_phase<pg8::EpiGateUp, pg8::StaticOrder, true, true>(lds, g, S, E);
    }
    SEAM(7);

    if (IN(8)) {
        pg8::Gemm g{ACT, WDN, M, D, FF}; pg8::StaticOrder S; S.init(M, D, G, bx);
        pg8::EpiRes E{out, out + (size_t)MP * D, out, MP, ALPHA};
        pg8::gemm_phase<pg8::EpiRes, pg8::StaticOrder, true, true>(lds, g, S, E);
    }
    SEAM(8);

    if (IN(9)) {
        for (int m = gw; m < M; m += NGW) ln_row(out + (size_t)m * D, out + (size_t)m * D, nullptr, ln2_g, ln2_b, lane);
    }
#undef IN
#undef SEAM
}

#undef x_prompt
#undef x_sample
#undef cache_conv
#undef state_hgrn
#undef w_in
#undef b_in
#undef w_dw
#undef b_dw
#undef cn_g
#undef cn_b
#undef hlb
#undef hg_ng
#undef w_out
#undef ln1_g
#undef ln1_b
#undef w_gate
#undef w_up
#undef w_down
#undef ln2_g
#undef ln2_b
#undef out
#undef ws
#undef LB
#undef BIASP
#undef WIN
#undef WOUT
#undef WGU
#undef WDN
#undef XB
#undef MIX
#undef U
#undef Q
#undef F
#undef I
#undef Gt
#undef ACT
#undef ST
#undef DC

extern "C" void kernel_launch(void* const* d_in, const int* in_sizes, int n_in, void* d_out, int out_size, void* d_ws, size_t ws_size, hipStream_t stream) {
    static int grid = 0;
    if (grid == 0) {
        int dev = 0, cus = 0, per_cu = 0;
        if (n_in != 20 || ws_size < WS_END) { fprintf(stderr, "kernel_launch: unexpected n_in %d / ws_size %zu\n", n_in, ws_size); grid = -1; return; }
        if (hipGetDevice(&dev) != hipSuccess || hipDeviceGetAttribute(&cus, hipDeviceAttributeMultiprocessorCount, dev) != hipSuccess) { grid = -1; return; }
        if (hipFuncSetAttribute((const void*)fwd_kernel, hipFuncAttributeMaxDynamicSharedMemorySize, LDS_BYTES) != hipSuccess) { fprintf(stderr, "kernel_launch: hipFuncSetAttribute failed\n"); grid = -1; return; }
        if (hipOccupancyMaxActiveBlocksPerMultiprocessor(&per_cu, (const void*)fwd_kernel, NWAVES * 64, LDS_BYTES) != hipSuccess || per_cu < 1) { fprintf(stderr, "kernel_launch: occupancy query says %d\n", per_cu); }
        (void)hipGetLastError();
        grid = cus;
    }
    if (grid < 0) return;
    if (hipMemsetAsync(d_ws, 0, 16384, stream) != hipSuccess) { fprintf(stderr, "kernel_launch: memset failed\n"); return; }
    Args a{};
    for (int i = 0; i < 20; ++i) a.in[i] = (const float*)d_in[i];
    a.out = (float*)d_out; a.ws = (unsigned char*)d_ws;
#if MK_ONE_LAUNCH
    a.ph_lo = 0; a.ph_hi = N_PHASES;
    void* kargs[] = {&a};
    hipError_t e = hipLaunchCooperativeKernel((const void*)fwd_kernel, dim3(grid), dim3(NWAVES * 64), kargs, LDS_BYTES, stream);
    if (e != hipSuccess) fprintf(stderr, "cooperative launch failed: %s (grid %d)\n", hipGetErrorString(e), grid);
#else
    for (int p = 0; p < N_PHASES; ++p) {
        a.ph_lo = p; a.ph_hi = p + 1;
        hipLaunchKernelGGL(fwd_kernel, dim3(grid), dim3(NWAVES * 64), LDS_BYTES, stream, a);
    }
#endif
}
```

```cpp
#include <hip/hip_runtime.h>
#include <hip/hip_cooperative_groups.h>
#include <cstdio>
#include <cstdint>
namespace cg = cooperative_groups;

#ifndef MK_ONE_LAUNCH
#define MK_ONE_LAUNCH 1
#endif

namespace pg8 {
#define PG8_LAS __attribute__((address_space(3)))
typedef unsigned short bf16_t;
typedef short bf16x8 __attribute__((ext_vector_type(8)));
typedef float f32x4 __attribute__((ext_vector_type(4)));
typedef unsigned u32x4 __attribute__((ext_vector_type(4)));
typedef unsigned u32x2 __attribute__((ext_vector_type(2)));
constexpr int BM = 256, BK = 64, HALF = 128, HTB = HALF * BK * 2, STAGE_BYTES = 8 * HTB, NXCD = 8, WGM = 8;

__host__ __device__ __forceinline__ int lds_byte(int r, int c) { const int st = (r >> 4) * 2 + (c >> 5), rr = r & 15, cc = c & 31, ob = rr * 64 + cc * 2; return st * 1024 + (ob ^ (((ob >> 9) & 1) << 5)); }
__host__ __device__ __forceinline__ void stage_rc(int b, int& R, int& C) { const int st = b / 1024, sb = b % 1024, swz = sb ^ (((sb >> 9) & 1) << 5); R = (st >> 1) * 16 + swz / 64; C = (st & 1) * 32 + (swz % 64) / 2; }
__host__ __device__ __forceinline__ int perm32(int rho) { const int n = rho >> 4, i = rho & 15; return 8 * (i >> 2) + 4 * n + (i & 3); }

struct Unit { int pm, pn, kt0, nkt, ks; };
struct Gemm { const bf16_t* A; const bf16_t* Bt; int M, N, K; };

struct StaticOrder {
    int nM, nMf, nN, nfull, nitems, G, c, nt, nsplit;
    __host__ __device__ void init(int M, int N, int K, int G_, int c_, int Mfull = -1, int nsplit_ = 1) {
        nM = M / BM; nMf = Mfull < 0 ? nM : Mfull / BM; nN = N / BM; nt = K / BK; nsplit = nsplit_; nfull = nMf * nN; nitems = nfull + (nM - nMf) * nN * nsplit; G = G_; c = c_; }
    __host__ __device__ bool next(int i, Unit& u) const {
        const long L = (long)i * G + c; if (L >= nitems) return false;
        if (L >= nfull) { const int sidx = (int)L - nfull, un = sidx / nsplit, ks = sidx % nsplit, per = nt / nsplit;
            u.pm = nMf + un / nN; u.pn = un % nN; u.kt0 = ks * per; u.nkt = per; u.ks = ks; return true; }
        int wgid = (int)L; { const int q = nfull / NXCD, r = nfull % NXCD, xcd = wgid % NXCD, off = wgid / NXCD; wgid = (xcd < r ? xcd * (q + 1) : r * (q + 1) + (xcd - r) * q) + off; }
        const int nig = WGM * nN, gid = wgid / nig, fm = gid * WGM, gsz = (nMf - fm) < WGM ? (nMf - fm) : WGM;
        u.pm = fm + ((wgid % nig) % gsz); u.pn = (wgid % nig) / gsz; u.kt0 = 0; u.nkt = nt; u.ks = -1; return true;
    }
    __device__ __forceinline__ void a_ready(const Unit&) const {}
    __device__ __forceinline__ void done(const Unit&) const {}
};

__device__ __forceinline__ unsigned cvt_pk_bf16(float lo, float hi) { unsigned r; asm volatile("v_cvt_pk_bf16_f32 %0, %1, %2" : "=v"(r) : "v"(lo), "v"(hi)); return r; }
__device__ __forceinline__ float sigm(float x) { return __builtin_amdgcn_rcpf(1.0f + __expf(-x)); }

struct EpiProj {
    static constexpr bool PERM = true, AFTER_DRAIN = false;
    bf16_t *U, *QIG; float* F; const float* bias; const float* lb;
    __device__ __forceinline__ void operator()(const f32x4 (&acc)[2][2][4][2], const Unit& u, int wr, int wc, int fr, int fq) const {
        const int row0 = u.pm * BM + wr * 64 + fr;
        const int cl = wc * 32 + 8 * fq;
        const int bcol = u.pn * BM + cl;
        f32x4 bv[2][2];
#pragma unroll
        for (int bj = 0; bj < 2; ++bj)
#pragma unroll
            for (int n = 0; n < 2; ++n) bv[bj][n] = *(const f32x4*)(bias + bcol + bj * HALF + 4 * n);
        if (u.pn < 8) {
#pragma unroll
            for (int ai = 0; ai < 2; ++ai)
#pragma unroll
                for (int m = 0; m < 4; ++m) {
                    const size_t row = (size_t)(row0 + ai * HALF + m * 16);
                    float o[8];
#pragma unroll
                    for (int n = 0; n < 2; ++n) { const f32x4 a = acc[ai][0][m][n] + bv[0][n], g = acc[ai][1][m][n] + bv[1][n];
#pragma unroll
                        for (int e = 0; e < 4; ++e) o[n * 4 + e] = a[e] * sigm(g[e]); }
                    u32x4 w; w.x = cvt_pk_bf16(o[0], o[1]); w.y = cvt_pk_bf16(o[2], o[3]); w.z = cvt_pk_bf16(o[4], o[5]); w.w = cvt_pk_bf16(o[6], o[7]);
                    *(u32x4*)(U + row * 1024 + u.pn * HALF + cl) = w;
                }
        } else {
            const int grp = (u.pn - 8) >> 2;
            const int cbase = ((u.pn - 8) & 3) * BM + cl;
            if (grp == 1) {
                f32x4 lv[2][2];
#pragma unroll
                for (int bj = 0; bj < 2; ++bj)
#pragma unroll
                    for (int n = 0; n < 2; ++n) lv[bj][n] = *(const f32x4*)(lb + cbase + bj * HALF + 4 * n);
#pragma unroll
                for (int ai = 0; ai < 2; ++ai)
#pragma unroll
                    for (int m = 0; m < 4; ++m) {
                        const size_t row = (size_t)(row0 + ai * HALF + m * 16);
#pragma unroll
                        for (int bj = 0; bj < 2; ++bj)
#pragma unroll
                            for (int n = 0; n < 2; ++n) { const f32x4 x = acc[ai][bj][m][n] + bv[bj][n]; const f32x4 l = lv[bj][n]; f32x4 o;
#pragma unroll
                                for (int e = 0; e < 4; ++e) o[e] = l[e] + (1.0f - l[e]) * sigm(x[e]);
                                *(f32x4*)(F + row * 1024 + cbase + bj * HALF + 4 * n) = o; }
                    }
            } else {
                bf16_t* O = QIG + (size_t)(grp - (grp > 0 ? 1 : 0)) * ((size_t)8704 * 1024);
                const bool act = grp != 2;
#pragma unroll
                for (int ai = 0; ai < 2; ++ai)
#pragma unroll
                    for (int m = 0; m < 4; ++m) {
                        const size_t row = (size_t)(row0 + ai * HALF + m * 16);
#pragma unroll
                        for (int bj = 0; bj < 2; ++bj) { float o[8];
#pragma unroll
                            for (int n = 0; n < 2; ++n) { const f32x4 x = acc[ai][bj][m][n] + bv[bj][n];
#pragma unroll
                                for (int e = 0; e < 4; ++e) o[n * 4 + e] = act ? x[e] * sigm(x[e]) : x[e]; }
                            u32x4 w; w.x = cvt_pk_bf16(o[0], o[1]); w.y = cvt_pk_bf16(o[2], o[3]); w.z = cvt_pk_bf16(o[4], o[5]); w.w = cvt_pk_bf16(o[6], o[7]);
                            *(u32x4*)(O + row * 1024 + cbase + bj * HALF) = w; }
                    }
            }
        }
    }
};
struct EpiRes {
    static constexpr bool PERM = false, AFTER_DRAIN = false;
    const float* baseP; const float* baseS; float* out; int split; float alpha; float* part;
    __device__ __forceinline__ void operator()(const f32x4 (&acc)[2][2][4][2], const Unit& u, int wr, int wc, int fr, int fq) const {
        const int row0 = u.pm * BM + wr * 64 + fr;
        const int col0 = u.pn * BM + wc * 32 + 4 * fq;
        if (u.ks >= 0) {
            float* pb = part + (size_t)u.ks * 512 * 2048;
#pragma unroll
            for (int ai = 0; ai < 2; ++ai)
#pragma unroll
                for (int m = 0; m < 4; ++m) { float* op = pb + (size_t)(row0 + ai * HALF + m * 16 - split) * 2048;
#pragma unroll
                    for (int bj = 0; bj < 2; ++bj)
#pragma unroll
                        for (int n = 0; n < 2; ++n) *(f32x4*)(op + col0 + bj * HALF + n * 16) = acc[ai][bj][m][n]; }
            return;
        }
#pragma unroll
        for (int ai = 0; ai < 2; ++ai)
#pragma unroll
            for (int m = 0; m < 4; ++m) {
                const int row = row0 + ai * HALF + m * 16;
                const float* bp = row < split ? baseP + (size_t)row * 2048 : baseS + (size_t)(row - split) * 2048;
                float* op = out + (size_t)row * 2048;
#pragma unroll
                for (int bj = 0; bj < 2; ++bj)
#pragma unroll
                    for (int n = 0; n < 2; ++n) { const int c = col0 + bj * HALF + n * 16; const f32x4 b = *(const f32x4*)(bp + c); *(f32x4*)(op + c) = b * alpha + acc[ai][bj][m][n]; }
            }
    }
};
struct EpiGateUp {
    static constexpr bool PERM = true, AFTER_DRAIN = false;
    bf16_t* O; int ldc;
    __device__ __forceinline__ void operator()(const f32x4 (&acc)[2][2][4][2], const Unit& u, int wr, int wc, int fr, int fq) const {
        const int row0 = u.pm * BM + wr * 64 + fr;
        const int cl = wc * 32 + 8 * fq;
#pragma unroll
        for (int ai = 0; ai < 2; ++ai)
#pragma unroll
            for (int m = 0; m < 4; ++m) {
                const size_t row = (size_t)(row0 + ai * HALF + m * 16);
                float o[8];
#pragma unroll
                for (int n = 0; n < 2; ++n) { const f32x4 g = acc[ai][0][m][n], up = acc[ai][1][m][n];
#pragma unroll
                    for (int e = 0; e < 4; ++e) o[n * 4 + e] = g[e] * sigm(g[e]) * up[e]; }
                u32x4 w; w.x = cvt_pk_bf16(o[0], o[1]); w.y = cvt_pk_bf16(o[2], o[3]); w.z = cvt_pk_bf16(o[4], o[5]); w.w = cvt_pk_bf16(o[6], o[7]);
                *(u32x4*)(O + row * ldc + u.pn * HALF + cl) = w;
            }
    }
};

template <class Epi, class Sched, bool ALIGN_EPI = false, bool SP2 = false>
__device__ __forceinline__ void gemm_phase(PG8_LAS unsigned char* lds, const Gemm g, const Sched& S, const Epi& E) {
    int tid_ = threadIdx.x; asm volatile("" : "+v"(tid_));
    const int tid = tid_, wid = __builtin_amdgcn_readfirstlane(tid >> 6), lane = tid & 63, wr = wid >> 2, wc = wid & 3, fr = lane & 15, fq = lane >> 4;
    const int K = g.K;
    unsigned voffA[2], voffB[2];
#pragma unroll
    for (int i = 0; i < 2; ++i) { int R, C; stage_rc(tid * 16 + i * 8192, R, C); const int Rb = Epi::PERM ? ((R & ~31) + perm32(R & 31)) : R;
        voffA[i] = (unsigned)(R * K + C) * 2u; voffB[i] = (unsigned)(Rb * K + C) * 2u; }
    const size_t kstep = (size_t)(BK * 2);
    const size_t hstep = (size_t)HALF * K * 2;
    const size_t tstep = 2 * hstep;
    const unsigned ldsw = (unsigned)wid * 1024u;
    const int aoff = lds_byte(wr * 64 + fr, fq * 8), boff = lds_byte(wc * 32 + fr, fq * 8);
#define PG8_SA(b, h) (((b) * 2 + (h)) * HTB)
#define PG8_SB(b, h) ((4 + (b) * 2 + (h)) * HTB)
#define PG8_STAGE(bufoff, gbase, voff) do { _Pragma("unroll") for (int _i = 0; _i < 2; ++_i) \
        __builtin_amdgcn_global_load_lds((const unsigned*)((const char*)(gbase) + (voff)[_i]), (PG8_LAS unsigned*)(lds + (bufoff) + ldsw + _i * 8192), 16, 0, 0); } while (0)
#define PG8_LDA(dst, b, h) do { _Pragma("unroll") for (int m = 0; m < 4; ++m) _Pragma("unroll") for (int k = 0; k < 2; ++k) dst[m][k] = *(const PG8_LAS bf16x8*)(lds + PG8_SA(b, h) + aoff + m * 2048 + k * 1024); } while (0)
#define PG8_LDB(dst, b, h) do { _Pragma("unroll") for (int n = 0; n < 2; ++n) _Pragma("unroll") for (int k = 0; k < 2; ++k) dst[n][k] = *(const PG8_LAS bf16x8*)(lds + PG8_SB(b, h) + boff + n * 2048 + k * 1024); } while (0)
#define PG8_MMA(ai, bj, At, Bt) do { __builtin_amdgcn_s_setprio(1); _Pragma("unroll") for (int m = 0; m < 4; ++m) _Pragma("unroll") for (int n = 0; n < 2; ++n) _Pragma("unroll") for (int k = 0; k < 2; ++k) \
        acc[ai][bj][m][n] = __builtin_amdgcn_mfma_f32_16x16x32_bf16(Bt[n][k], At[m][k], acc[ai][bj][m][n], 0, 0, 0); __builtin_amdgcn_s_setprio(0); } while (0)
#define PG8_WAIT_V(n) asm volatile("s_waitcnt vmcnt(" #n ")" ::: "memory")
#define PG8_WAIT_L(n) asm volatile("s_waitcnt lgkmcnt(" #n ")" ::: "memory")
#define PG8_BAR __builtin_amdgcn_s_barrier()
#define PG8_SCHED __builtin_amdgcn_sched_barrier(0)
    Unit cur, nxt; int ui = 0;
    if (!S.next(0, cur)) return;
    f32x4 acc[2][2][4][2];
#pragma unroll
    for (int a = 0; a < 2; ++a)
#pragma unroll
        for (int b = 0; b < 2; ++b)
#pragma unroll
            for (int m = 0; m < 4; ++m)
#pragma unroll
                for (int n = 0; n < 2; ++n) acc[a][b][m][n] = (f32x4){0.f, 0.f, 0.f, 0.f};
    bf16x8 At[4][2], B0[2][2], B1[2][2];
    const char* cA = (const char*)g.A + (size_t)cur.pm * tstep + (size_t)cur.kt0 * kstep; const char* cB = (const char*)g.Bt + (size_t)cur.pn * tstep + (size_t)cur.kt0 * kstep;
    S.a_ready(cur);
    if constexpr (SP2) {
        PG8_STAGE(PG8_SB(0, 0), cB, voffB); PG8_STAGE(PG8_SB(0, 1), cB + hstep, voffB); PG8_STAGE(PG8_SA(0, 0), cA, voffA); PG8_STAGE(PG8_SA(0, 1), cA + hstep, voffA);
        if (wr == 1) PG8_BAR;
        PG8_WAIT_V(2); PG8_BAR;
        PG8_STAGE(PG8_SB(1, 0), cB + kstep, voffB); PG8_STAGE(PG8_SA(1, 0), cA + kstep, voffA); PG8_STAGE(PG8_SB(1, 1), cB + hstep + kstep, voffB);
        PG8_WAIT_V(6); PG8_BAR;
    } else {
        PG8_STAGE(PG8_SB(0, 0), cB, voffB); PG8_STAGE(PG8_SA(0, 0), cA, voffA); PG8_STAGE(PG8_SB(0, 1), cB + hstep, voffB); PG8_STAGE(PG8_SA(0, 1), cA + hstep, voffA);
        if (wr == 1) PG8_BAR;
        PG8_WAIT_V(4); PG8_BAR;
        PG8_STAGE(PG8_SB(1, 0), cB + kstep, voffB); PG8_STAGE(PG8_SA(1, 0), cA + kstep, voffA); PG8_STAGE(PG8_SB(1, 1), cB + hstep + kstep, voffB);
        PG8_WAIT_V(6); PG8_BAR;
    }
    for (;;) {
        const bool has_next = S.next(ui + 1, nxt);
        const char* nA = has_next ? (const char*)g.A + (size_t)nxt.pm * tstep + (size_t)nxt.kt0 * kstep : cA; const char* nB = has_next ? (const char*)g.Bt + (size_t)nxt.pn * tstep + (size_t)nxt.kt0 * kstep : cB;
        const int nt = cur.nkt;
        for (int t = 0; t < nt; t += 2) {
            const bool last = (t == nt - 2);
            const char* a1 = cA + (size_t)(t + 1) * kstep;
            const char* a2 = last ? nA : cA + (size_t)(t + 2) * kstep; const char* b2 = last ? nB : cB + (size_t)(t + 2) * kstep;
            const char* a3 = a2 + kstep; const char* b3 = b2 + kstep;
            if (last && has_next) S.a_ready(nxt);
            if constexpr (SP2) {
            PG8_LDB(B0, 0, 0); PG8_LDB(B1, 0, 1); PG8_SCHED; PG8_LDA(At, 0, 0); PG8_STAGE(PG8_SA(1, 1), a1 + hstep, voffA);
            PG8_WAIT_V(8); PG8_WAIT_L(0); PG8_BAR; PG8_MMA(0, 0, At, B0); PG8_MMA(0, 1, At, B1); PG8_BAR; PG8_SCHED;
            PG8_LDA(At, 0, 1); PG8_STAGE(PG8_SB(0, 0), b2, voffB); PG8_STAGE(PG8_SB(0, 1), b2 + hstep, voffB); PG8_STAGE(PG8_SA(0, 0), a2, voffA);
            PG8_WAIT_V(8); PG8_WAIT_L(0); PG8_BAR; PG8_MMA(1, 0, At, B0); PG8_MMA(1, 1, At, B1); PG8_BAR; PG8_SCHED;
            PG8_LDB(B0, 1, 0); PG8_LDB(B1, 1, 1); PG8_SCHED; PG8_LDA(At, 1, 0); PG8_STAGE(PG8_SA(0, 1), a2 + hstep, voffA);
            PG8_WAIT_V(8); PG8_WAIT_L(0); PG8_BAR; PG8_MMA(0, 0, At, B0); PG8_MMA(0, 1, At, B1); PG8_BAR; PG8_SCHED;
            PG8_LDA(At, 1, 1); PG8_STAGE(PG8_SB(1, 0), b3, voffB); PG8_STAGE(PG8_SB(1, 1), b3 + hstep, voffB); PG8_STAGE(PG8_SA(1, 0), a3, voffA);
            PG8_WAIT_V(8); PG8_WAIT_L(0); PG8_BAR; PG8_MMA(1, 0, At, B0); PG8_MMA(1, 1, At, B1); PG8_BAR; PG8_SCHED;
            } else {
            PG8_LDB(B0, 0, 0); PG8_SCHED; PG8_LDA(At, 0, 0); PG8_STAGE(PG8_SA(1, 1), a1 + hstep, voffA);
            PG8_WAIT_L(8); PG8_BAR; PG8_WAIT_L(0); PG8_MMA(0, 0, At, B0); PG8_BAR; PG8_SCHED;
            PG8_LDB(B1, 0, 1); PG8_STAGE(PG8_SB(0, 0), b2, voffB);
            PG8_BAR; PG8_WAIT_L(0); PG8_MMA(0, 1, At, B1); PG8_BAR;
            PG8_LDA(At, 0, 1); PG8_STAGE(PG8_SA(0, 0), a2, voffA);
            PG8_BAR; PG8_WAIT_L(0); PG8_MMA(1, 0, At, B0); PG8_BAR; PG8_SCHED;
            PG8_STAGE(PG8_SB(0, 1), b2 + hstep, voffB);
            PG8_WAIT_V(6); PG8_BAR; PG8_MMA(1, 1, At, B1); PG8_BAR;
            PG8_LDB(B0, 1, 0); PG8_SCHED; PG8_LDA(At, 1, 0); PG8_STAGE(PG8_SA(0, 1), a2 + hstep, voffA);
            PG8_WAIT_L(8); PG8_BAR; PG8_WAIT_L(0); PG8_MMA(0, 0, At, B0); PG8_BAR; PG8_SCHED;
            PG8_LDB(B1, 1, 1); PG8_STAGE(PG8_SB(1, 0), b3, voffB);
            PG8_BAR; PG8_WAIT_L(0); PG8_MMA(0, 1, At, B1); PG8_BAR;
            PG8_LDA(At, 1, 1); PG8_STAGE(PG8_SA(1, 0), a3, voffA);
            PG8_BAR; PG8_WAIT_L(0); PG8_MMA(1, 0, At, B0); PG8_BAR; PG8_SCHED;
            PG8_STAGE(PG8_SB(1, 1), b3 + hstep, voffB);
            PG8_WAIT_V(6); PG8_BAR; PG8_MMA(1, 1, At, B1); PG8_BAR;
            }
        }
        if constexpr (ALIGN_EPI) { if (wr == 0) PG8_BAR; }
        if constexpr (!Epi::AFTER_DRAIN) { E(acc, cur, wr, wc, fr, fq); S.done(cur); }
        if (!has_next) break;
#pragma unroll
        for (int a = 0; a < 2; ++a)
#pragma unroll
            for (int b = 0; b < 2; ++b)
#pragma unroll
                for (int m = 0; m < 4; ++m)
#pragma unroll
                    for (int n = 0; n < 2; ++n) acc[a][b][m][n] = (f32x4){0.f, 0.f, 0.f, 0.f};
        cur = nxt; cA = nA; cB = nB; ++ui;
        if constexpr (ALIGN_EPI) { if (wr == 1) PG8_BAR; }
    }
    PG8_WAIT_V(0);
    if constexpr (!ALIGN_EPI) { if (wr == 0) PG8_BAR; }
    PG8_BAR;
#undef PG8_SA
#undef PG8_SB
#undef PG8_STAGE
#undef PG8_LDA
#undef PG8_LDB
#undef PG8_MMA
#undef PG8_WAIT_V
#undef PG8_WAIT_L
#undef PG8_BAR
#undef PG8_SCHED
}
}

constexpr int D = 2048, MP = 8192, MS = 512, M = MP + MS, CW = 1024, NH = 8, HD = 128, FF = 5632, NIN = 6144;
constexpr float LN_EPS = 1e-5f;
constexpr float ALPHA = 1.189207115002721f;
constexpr int NWAVES = 8;
constexpr int LDS_BYTES = 147456;
constexpr int N_PHASES = 10;

constexpr size_t MiB = 1u << 20;
constexpr size_t WS_LB = 64 * 1024, WS_BIASP = 128 * 1024;
constexpr size_t WS_WIN = 1 * MiB, WS_WOUT = 25 * MiB, WS_WGU = 33 * MiB, WS_WDN = 77 * MiB;
constexpr size_t WS_XB = 99 * MiB, WS_MIX = 133 * MiB;
constexpr size_t WS_U = 167 * MiB, WS_Q = 184 * MiB, WS_I = 201 * MiB, WS_G = 218 * MiB, WS_F = 235 * MiB, WS_END = 269 * MiB;
constexpr size_t WS_ACT = 167 * MiB;
constexpr int SPLIT5 = 8, SPLIT8 = 11;
constexpr size_t WS_PB5 = 167 * MiB;
constexpr size_t WS_PB8 = 99 * MiB;
static_assert(WS_PB8 + (size_t)SPLIT8 * 512 * 2048 * 4 <= 167 * MiB && (32 % SPLIT5) == 0 && (88 % SPLIT8) == 0 && (32 / SPLIT5) % 2 == 0 && (88 / SPLIT8) % 2 == 0 && 32 / SPLIT5 >= 4 && 88 / SPLIT8 >= 4, "split-K layout");
static_assert(WS_ACT + (size_t)M * FF * 2 <= WS_END, "act overlay");
constexpr size_t O_Y = 0, O_NCP = (size_t)M * D, O_NHP = O_NCP + 4 * 30 * 1024, O_NCS = O_NHP + 4 * 8 * 128 * 128, O_NHS = O_NCS + 32 * 30 * 1024;
constexpr size_t O_ST = 0, O_DC = (size_t)1024 * 16384;

#define LAS __attribute__((address_space(3)))
typedef unsigned short bf16;
typedef float f32x4 __attribute__((ext_vector_type(4)));
typedef float f32x2 __attribute__((ext_vector_type(2)));
typedef unsigned v4u __attribute__((ext_vector_type(4)));
typedef unsigned v2u __attribute__((ext_vector_type(2)));
typedef float f32x16 __attribute__((ext_vector_type(16)));
typedef unsigned u32x8 __attribute__((ext_vector_type(8)));
#define CAS __attribute__((address_space(4)))
#define LDS_WAIT() asm volatile("s_waitcnt lgkmcnt(0)" ::: "memory")

__device__ __forceinline__ unsigned f2bf(float f) { unsigned u = __builtin_bit_cast(unsigned, f); return (u + 0x7fffu + ((u >> 16) & 1u)) >> 16; }
__device__ __forceinline__ unsigned pk2(float lo, float hi) { return f2bf(lo) | (f2bf(hi) << 16); }
__device__ __forceinline__ float bf2f(unsigned short b) { return __uint_as_float((unsigned)b << 16); }
__device__ __forceinline__ float sigm(float x) { return __builtin_amdgcn_rcpf(1.0f + __expf(-x)); }
__device__ __forceinline__ float wave_sum(float v) {
#pragma unroll
    for (int o = 1; o < 64; o <<= 1) v += __shfl_xor(v, o);
    return v;
}

__device__ __forceinline__ void transpose_item(const float* W, int K, int N, bf16* WT, int k0, int n0, int dst_row0, LAS float* scr, int lane) {
#pragma unroll 8
    for (int i = 0; i < 32; ++i) { const int kk = 2 * i + (lane >> 5); scr[kk * 33 + (lane & 31)] = W[(size_t)(k0 + kk) * N + n0 + (lane & 31)]; }
    LDS_WAIT(); asm volatile("" ::: "memory");
    const int c = lane & 7;
#pragma unroll
    for (int j = 0; j < 4; ++j) { const int n = (lane >> 3) + 8 * j; const LAS float* s = scr + (8 * c) * 33 + n;
        v4u o; o.x = pk2(s[0 * 33], s[1 * 33]); o.y = pk2(s[2 * 33], s[3 * 33]); o.z = pk2(s[4 * 33], s[5 * 33]); o.w = pk2(s[6 * 33], s[7 * 33]);
        *(v4u*)(WT + (size_t)(dst_row0 + n) * K + k0 + 8 * c) = o; }
    LDS_WAIT(); asm volatile("" ::: "memory");
}

__device__ __forceinline__ void ln_row(const float* src, const float* part, int npart, size_t pstride, float alpha, float* dstf, bf16* dstb, const float* g, const float* b, int lane) {
    const f32x4* xr = (const f32x4*)src + lane;
    f32x4 v[8]; float s = 0.f;
#pragma unroll
    for (int j = 0; j < 8; ++j) v[j] = xr[64 * j];
    if (npart > 0) {
#pragma unroll
        for (int j = 0; j < 8; ++j) v[j] = v[j] * alpha;
        for (int p = 0; p < npart; ++p) { const f32x4* pr = (const f32x4*)(part + (size_t)p * pstride) + lane;
#pragma unroll
            for (int j = 0; j < 8; ++j) v[j] += pr[64 * j]; }
    }
#pragma unroll
    for (int j = 0; j < 8; ++j) s += (v[j].x + v[j].y) + (v[j].z + v[j].w);
    const float mean = wave_sum(s) * (1.f / D); float s2 = 0.f;
#pragma unroll
    for (int j = 0; j < 8; ++j) { v[j] = v[j] - mean; s2 += (v[j].x * v[j].x + v[j].y * v[j].y) + (v[j].z * v[j].z + v[j].w * v[j].w); }
    const float rstd = 1.f / sqrtf(wave_sum(s2) * (1.f / D) + LN_EPS);
#pragma unroll
    for (int j = 0; j < 8; ++j) {
        const f32x4 gg = ((const f32x4*)g)[lane + 64 * j], bb = ((const f32x4*)b)[lane + 64 * j];
        const f32x4 o = v[j] * rstd * gg + bb;
        if (dstf) ((f32x4*)dstf)[lane + 64 * j] = o;
        if (dstb) { v2u w; w.x = pk2(o.x, o.y); w.y = pk2(o.z, o.w); ((v2u*)dstb)[lane + 64 * j] = w; }
    }
}

#define XB_TMO      128
#define XB_XCNT(j)  (256  + 64 * (j))
#define XB_XSUB(j)  (1280 + 64 * (j))
#define XB_XGEN(j)  (2304 + 64 * (j))
#define XB_TOP      3328
#define XB_TOPGEN   3392
#define XCD_BAR_WORDS 3456
#define XB_SPIN_CAP (1u << 18)
__device__ __forceinline__ unsigned xb_ld(unsigned* p)              { return __hip_atomic_load(p, __ATOMIC_RELAXED, __HIP_MEMORY_SCOPE_AGENT); }
__device__ __forceinline__ unsigned xb_add(unsigned* p, unsigned v) { return __hip_atomic_fetch_add(p, v, __ATOMIC_RELAXED, __HIP_MEMORY_SCOPE_AGENT); }
__device__ __forceinline__ unsigned xb_xcc_id() { return (unsigned)__builtin_amdgcn_s_getreg((3 << 11) | 20) & 0xFu; }
#define XB_SPIN(cond, bar) do { unsigned _sp = 0; while (cond) { __builtin_amdgcn_s_sleep(1); \
    if ((++_sp & 255u) == 0u) { if (xb_ld(&(bar)[XB_TMO])) break; if (_sp > XB_SPIN_CAP) { atomicAdd(&(bar)[XB_TMO], 1u); break; } } } } while (0)
struct XcdBarrier { unsigned* bar; unsigned x; volatile LAS unsigned* st; };
__device__ __forceinline__ XcdBarrier xcd_barrier_post(unsigned* bar, volatile LAS unsigned* st) {
    XcdBarrier b; b.bar = bar; b.x = xb_xcc_id(); b.st = st;
    if (threadIdx.x == 0) (void)xb_add(&bar[XB_XCNT(b.x)], 1u);
    return b;
}
__device__ __forceinline__ void xcd_barrier_complete(unsigned* bar, unsigned x, unsigned& nloc, unsigned& nx) {
    const unsigned G = gridDim.x * gridDim.y * gridDim.z;
    unsigned sum, cnt, mine, sp = 0u;
    for (;;) {
        sum = 0u; cnt = 0u; mine = 0u;
#pragma unroll
        for (unsigned j = 0; j < 16; ++j) { const unsigned c = xb_ld(&bar[XB_XCNT(j)]); sum += c; cnt += (c > 0u) ? 1u : 0u; mine = (j == x) ? c : mine; }
        if (sum == G) break;
        __builtin_amdgcn_s_sleep(1);
        if ((++sp & 255u) == 0u) { if (xb_ld(&bar[XB_TMO])) break; if (sp > XB_SPIN_CAP) { atomicAdd(&bar[XB_TMO], 1u); break; } }
    }
    nloc = mine > 0u ? mine : 1u; nx = cnt > 0u ? cnt : 1u;
}
__device__ __forceinline__ void xcd_barrier(const XcdBarrier& b) {
    asm volatile("s_waitcnt vmcnt(0)" ::: "memory");
    __syncthreads();
    if (threadIdx.x == 0) {
        unsigned* bar = b.bar;
        __builtin_amdgcn_s_waitcnt(0);
        unsigned nloc = b.st[0], nx = b.st[1];
        if (nloc == 0u) { xcd_barrier_complete(bar, b.x, nloc, nx); b.st[0] = nloc; b.st[1] = nx; }
        const unsigned old = xb_add(&bar[XB_XSUB(b.x)], 1u);
        const unsigned gen = old / nloc;
        if (old + 1u == (gen + 1u) * nloc) {
            __builtin_amdgcn_fence(__ATOMIC_RELEASE, "agent");
            asm volatile("s_waitcnt vmcnt(0)" ::: "memory");
            const unsigned og = xb_add(&bar[XB_TOP], 1u);
            const unsigned tg = og / nx;
            if (og + 1u == (tg + 1u) * nx) xb_add(&bar[XB_TOPGEN], 1u);
            else XB_SPIN(xb_ld(&bar[XB_TOPGEN]) == tg, bar);
            __builtin_amdgcn_fence(__ATOMIC_ACQUIRE, "agent");
            xb_add(&bar[XB_XGEN(b.x)], 1u);
            asm volatile("s_waitcnt vmcnt(0)" ::: "memory");
        } else {
            XB_SPIN(xb_ld(&bar[XB_XGEN(b.x)]) == gen, bar);
            __builtin_amdgcn_fence(__ATOMIC_ACQUIRE, "agent");
            asm volatile("s_waitcnt vmcnt(0)" ::: "memory");
        }
    }
    __syncthreads();
}

struct Args { const float* in[20]; float* out; unsigned char* ws; int ph_lo, ph_hi; };

__global__ void __launch_bounds__(NWAVES * 64, 2) fwd_kernel(Args args) {
    extern __shared__ __attribute__((aligned(16))) unsigned char lds_raw[];
    LAS unsigned char* lds = (LAS unsigned char*)lds_raw;
    const int tid = threadIdx.x, lane = tid & 63, wave = __builtin_amdgcn_readfirstlane(tid >> 6);
    const int G = gridDim.x, bx = blockIdx.x;
    const int gt = bx * 512 + tid, NT = G * 512;
    const int gw = bx * NWAVES + wave, NGW = G * NWAVES;

#define x_prompt (args.in[0])
#define x_sample (args.in[1])
#define cache_conv (args.in[2])
#define state_hgrn (args.in[3])
#define w_in (args.in[4])
#define b_in (args.in[5])
#define w_dw (args.in[6])
#define b_dw (args.in[7])
#define cn_g (args.in[8])
#define cn_b (args.in[9])
#define hlb (args.in[10])
#define hg_ng (args.in[11])
#define w_out (args.in[12])
#define ln1_g (args.in[13])
#define ln1_b (args.in[14])
#define w_gate (args.in[15])
#define w_up (args.in[16])
#define w_down (args.in[17])
#define ln2_g (args.in[18])
#define ln2_b (args.in[19])
#define out (args.out)
#define ws (args.ws)
#define LB ((float*)(ws + WS_LB))
#define BIASP ((float*)(ws + WS_BIASP))
#define WIN ((bf16*)(ws + WS_WIN))
#define WOUT ((bf16*)(ws + WS_WOUT))
#define WGU ((bf16*)(ws + WS_WGU))
#define WDN ((bf16*)(ws + WS_WDN))
#define XB ((bf16*)(ws + WS_XB))
#define MIX ((bf16*)(ws + WS_MIX))
#define U ((bf16*)(ws + WS_U))
#define Q ((bf16*)(ws + WS_Q))
#define F ((float*)(ws + WS_F))
#define I ((bf16*)(ws + WS_I))
#define Gt ((bf16*)(ws + WS_G))
#define ACT ((bf16*)(ws + WS_ACT))
#define ST (out + O_ST)
#define DC (out + O_DC)

    const int lo = args.ph_lo, hi = args.ph_hi;
    volatile LAS unsigned* MISC = (volatile LAS unsigned*)(lds + 131072);
    if (tid < 16) MISC[tid] = 0u;
    __syncthreads();
    XcdBarrier xbar = xcd_barrier_post((unsigned*)ws, MISC + 8);
#ifndef PH_MASK
#define PH_MASK 0x3ff
#endif
#define IN(k) (((PH_MASK >> (k)) & 1) && lo <= (k) && (k) < hi)
#ifndef REP_MASK
#define REP_MASK 0
#endif
#define NREP(k) (1 + ((REP_MASK >> (k)) & 1))
#define SEAM(k) do { if (IN(k) && IN((k) + 1)) { xcd_barrier(xbar); } } while (0)
    if (hi > 1000) cg::this_grid().sync();

    if (IN(0)) for (int rep_ = 0; rep_ < NREP(0); ++rep_) { if (rep_) xcd_barrier(xbar);
        LAS float* scr = (LAS float*)(lds + wave * 16384);
        constexpr int I_IN = 32 * 192, I_OUT = 32 * 64, I_G = 32 * 176, I_DN = 88 * 64;
        constexpr int NITEMS = I_IN + I_OUT + 2 * I_G + I_DN;
        for (int it = gw; it < NITEMS; it += NGW) {
            int r = it; const float* W; int K, N; bf16* WT; int kind;
            if (r < I_IN) { kind = 0; W = w_in; K = D; N = NIN; WT = WIN; }
            else if ((r -= I_IN) < I_OUT) { kind = 1; W = w_out; K = D; N = D; WT = WOUT; }
            else if ((r -= I_OUT) < I_G) { kind = 2; W = w_gate; K = D; N = FF; WT = WGU; }
            else if ((r -= I_G) < I_G) { kind = 3; W = w_up; K = D; N = FF; WT = WGU; }
            else { r -= I_G; kind = 4; W = w_down; K = FF; N = D; WT = WDN; }
            const int nblk = N / 32, kb = r / nblk, nb = r % nblk, k0 = 64 * kb, n0 = 32 * nb;
            int dst;
            if (kind == 0) dst = n0 < 2048 ? ((n0 & 1023) >> 7) * 256 + (n0 >> 10) * 128 + (n0 & 127) : n0;
            else if (kind == 2) dst = (n0 >> 7) * 256 + (n0 & 127);
            else if (kind == 3) dst = (n0 >> 7) * 256 + 128 + (n0 & 127);
            else dst = n0;
            transpose_item(W, K, N, WT, k0, n0, dst, scr, lane);
        }
        constexpr int NV = M * D / 8, NVP = MP * D / 8;
        for (int i = gt; i < NV; i += NT) {
            const float* src = i < NVP ? x_prompt + (size_t)i * 8 : x_sample + (size_t)(i - NVP) * 8;
            const f32x4 a = *(const f32x4*)src, b = *(const f32x4*)(src + 4);
            v4u o; o.x = pk2(a.x, a.y); o.y = pk2(a.z, a.w); o.z = pk2(b.x, b.y); o.w = pk2(b.z, b.w);
            *(v4u*)(XB + (size_t)i * 8) = o;
        }
        for (int i = gt; i < 1024; i += NT) LB[i] = sigm(hlb[i] - hlb[1024 + i]);
        for (int i = gt; i < NIN; i += NT) { const int orig = i < 2048 ? ((i & 255) >> 7) * 1024 + (i >> 8) * 128 + (i & 127) : i; BIASP[i] = b_in[orig]; }
    }
    SEAM(0);
#ifdef EXTRA_SYNCS
    for (int i_ = 0; i_ < EXTRA_SYNCS; ++i_) cg::this_grid().sync();
#endif

    if (IN(1)) for (int rep_ = 0; rep_ < NREP(1); ++rep_) { if (rep_) xcd_barrier(xbar);
        pg8::Gemm g{XB, WIN, M, NIN, D}; pg8::StaticOrder S; S.init(M, NIN, D, G, bx);
        pg8::EpiProj E{U, Q, F, BIASP, LB};
        pg8::gemm_phase<pg8::EpiProj, pg8::StaticOrder, true, true>(lds, g, S, E);
    }
    SEAM(1);

    if (IN(2)) for (int rep_ = 0; rep_ < NREP(2); ++rep_) { if (rep_) xcd_barrier(xbar);
        LAS float* fl = (LAS float*)lds; LAS float* vl = (LAS float*)(lds + 8192);
        LAS float* redc = (LAS float*)(lds + 60000 / 16 * 16); LAS float* tot = redc + 128;
        for (int it = bx; it < 1024 + 1088; it += G) {
            __syncthreads();
            if (it < 1024) {
                const int bh = it >> 5, c = it & 31, b = bh >> 3, h = bh & 7;
                const int row0 = b * 2048 + c * 64;
                f32x2 Sa[8], Sb[8];
#pragma unroll
                for (int i = 0; i < 8; ++i) { Sa[i] = (f32x2){0.f, 0.f}; Sb[i] = (f32x2){0.f, 0.f}; }
                float dprod = 1.f;
                for (int sb = 0; sb < 4; ++sb) {
                    __syncthreads();
#pragma unroll
                    for (int e4 = 0; e4 < 4; ++e4) { const int e = tid + e4 * 512, t = e >> 7, k = e & 127; const size_t gi = (size_t)(row0 + sb * 16 + t) * 1024 + h * 128 + k;
                        fl[e] = F[gi]; vl[e] = bf2f(I[gi]); }
                    __syncthreads();
                    const CAS float* fbase = (const CAS float*)(F + (size_t)(row0 + sb * 16) * 1024 + h * 128 + wave * 16);
#pragma unroll 2
                    for (int t = 0; t < 16; ++t) {
                        const f32x16 f = *(const CAS f32x16*)(fbase + t * 1024);
                        const float va = vl[t * 128 + lane], vb = vl[t * 128 + 64 + lane];
                        const f32x2 va2 = (f32x2){va, va}, vb2 = (f32x2){vb, vb};
#pragma unroll
                        for (int i = 0; i < 8; ++i) { const f32x2 f2 = (f32x2){f[2 * i], f[2 * i + 1]};
                            Sa[i] = f2 * (Sa[i] - va2) + va2; Sb[i] = f2 * (Sb[i] - vb2) + vb2; }
                    }
                    if (tid < 128) {
#pragma unroll
                        for (int t = 0; t < 16; ++t) dprod *= fl[t * 128 + tid];
                    }
                }
                float* sp = ST + (size_t)it * 16384 + (size_t)(wave * 16) * 128 + lane;
#pragma unroll
                for (int i = 0; i < 8; ++i) { sp[(2 * i) * 128] = Sa[i].x; sp[(2 * i + 1) * 128] = Sa[i].y; sp[(2 * i) * 128 + 64] = Sb[i].x; sp[(2 * i + 1) * 128 + 64] = Sb[i].y; }
                if (tid < 128) DC[it * 128 + tid] = dprod;
            } else {
                const int m0 = (it - 1024) * 8;
                const bool samp = m0 >= MP;
                int t0, seq0; const float* hist = cache_conv;
                if (!samp) { t0 = m0 & 2047; seq0 = m0 - t0; }
                else { const int sbi = (m0 - MP) >> 4; t0 = (m0 - MP) & 15; seq0 = MP + sbi * 16; hist = cache_conv + (size_t)sbi * 30 * 1024; }
                LAS float* hbuf = (LAS float*)(lds + 16384);
                float s1[8], s2[8];
#pragma unroll
                for (int t = 0; t < 8; ++t) { s1[t] = 0.f; s2[t] = 0.f; }
#pragma unroll 1
                for (int p = 0; p < 2; ++p) {
                    const int c = tid + p * 512;
                    const unsigned cb2 = (unsigned)c * 2u, cb4 = (unsigned)c * 4u;
                    float w0[38];
#pragma unroll
                    for (int jj = 0; jj < 38; ++jj) {
                        const int tr = t0 - 30 + jj;
                        float a = 0.f;
                        if (tr >= 0) a = bf2f(*(const bf16*)((const char*)(U + (size_t)(seq0 + tr) * 1024) + cb2));
                        else if (samp) a = *(const float*)((const char*)(hist + (30 + tr) * 1024) + cb4);
                        w0[jj] = a;
                    }
                    float a0[8];
                    { const float bb = *(const float*)((const char*)b_dw + cb4);
#pragma unroll
                      for (int t = 0; t < 8; ++t) a0[t] = bb; }
#pragma unroll
                    for (int j = 0; j < 31; ++j) { const float wv = *(const float*)((const char*)(w_dw + j * 1024) + cb4);
#pragma unroll
                        for (int t = 0; t < 8; ++t) a0[t] += wv * w0[t + j]; }
#pragma unroll
                    for (int t = 0; t < 8; ++t) { hbuf[t * 1024 + c] = a0[t]; s1[t] += a0[t]; s2[t] += a0[t] * a0[t]; }
                }
                float st[16];
#pragma unroll
                for (int t = 0; t < 8; ++t) { st[t] = wave_sum(s1[t]); st[8 + t] = wave_sum(s2[t]); }
                if (lane == 0) {
#pragma unroll
                    for (int i = 0; i < 16; ++i) redc[wave * 16 + i] = st[i];
                }
                __syncthreads();
                if (tid < 16) { float s = 0.f;
#pragma unroll
                    for (int w = 0; w < 8; ++w) s += redc[w * 16 + tid];
                    tot[tid] = s; }
                __syncthreads();
                const int c = 2 * tid;
                const f32x2 gg = *(const f32x2*)(cn_g + c), bb2 = *(const f32x2*)(cn_b + c);
#pragma unroll
                for (int t = 0; t < 8; ++t) {
                    const float mu = tot[t] * (1.f / 1024.f); float var = tot[8 + t] * (1.f / 1024.f) - mu * mu; var = var > 0.f ? var : 0.f;
                    const float rstd = 1.f / sqrtf(var + LN_EPS);
                    const f32x2 hv = *(const LAS f32x2*)(hbuf + t * 1024 + c);
                    float y0 = (hv.x - mu) * rstd * gg.x + bb2.x, y1 = (hv.y - mu) * rstd * gg.y + bb2.y;
                    y0 = y0 * sigm(y0); y1 = y1 * sigm(y1);
                    *(unsigned*)(MIX + (size_t)(m0 + t) * 2048 + c) = pk2(y0, y1);
                }
            }
        }
        for (int i = gt; i < 4 * 30 * 1024; i += NT) { const int b = i / 30720, j = (i >> 10) % 30, c = i & 1023;
            out[O_NCP + i] = bf2f(U[(size_t)(b * 2048 + 2018 + j) * 1024 + c]); }
        for (int i = gt; i < 32 * 30 * 1024; i += NT) { const int sb = i / 30720, j = (i >> 10) % 30, c = i & 1023;
            out[O_NCS + i] = j < 14 ? cache_conv[(size_t)sb * 30720 + (16 + j) * 1024 + c] : bf2f(U[(size_t)(MP + sb * 16 + j - 14) * 1024 + c]); }
    }
    SEAM(2);

    if (IN(3)) {
        for (int e = gt; e < 32 * 4096; e += NT) {
            const int bh = e >> 12, r = e & 4095, k = r >> 5, v4 = r & 31;
            f32x4 S = (f32x4){0.f, 0.f, 0.f, 0.f};
#pragma unroll 8
            for (int c = 0; c < 32; ++c) {
                f32x4* p = (f32x4*)(ST + ((size_t)(bh * 32 + c) * 128 + k) * 128 + v4 * 4);
                const f32x4 A = *p; const float d = DC[(bh * 32 + c) * 128 + k];
                *p = S; S = S * d + A;
            }
            *(f32x4*)(out + O_NHP + ((size_t)bh * 128 + k) * 128 + v4 * 4) = S;
        }
    }
    SEAM(3);

    if (IN(4)) for (int rep_ = 0; rep_ < NREP(4); ++rep_) { if (rep_) xcd_barrier(xbar);
        LAS float* vl = (LAS float*)lds; LAS float* red = (LAS float*)(lds + 8192);
        for (int it = bx; it < 1024 + 256; it += G) {
            int row0, h, nsb; const float* sinit; float* sfin = nullptr;
            if (it < 1024) { const int bh = it >> 5, c = it & 31; h = bh & 7; row0 = (bh >> 3) * 2048 + c * 64; nsb = 4; sinit = ST + (size_t)it * 16384; }
            else { const int j = it - 1024; h = j & 7; row0 = MP + (j >> 3) * 16; nsb = 1; sinit = state_hgrn + (size_t)j * 16384; sfin = out + O_NHS + (size_t)j * 16384; }
            f32x2 Sa[8], Sb[8];
            { const float* sp = sinit + (size_t)(wave * 16) * 128 + lane;
#pragma unroll
              for (int i = 0; i < 8; ++i) { Sa[i] = (f32x2){sp[(2 * i) * 128], sp[(2 * i + 1) * 128]}; Sb[i] = (f32x2){sp[(2 * i) * 128 + 64], sp[(2 * i + 1) * 128 + 64]}; } }
            for (int sb = 0; sb < nsb; ++sb) {
                __syncthreads();
#pragma unroll
                for (int e4 = 0; e4 < 4; ++e4) { const int e = tid + e4 * 512, t = e >> 7, k = e & 127; const size_t gi = (size_t)(row0 + sb * 16 + t) * 1024 + h * 128 + k;
                    vl[e] = bf2f(I[gi]); }
                __syncthreads();
                const CAS float* fbase = (const CAS float*)(F + (size_t)(row0 + sb * 16) * 1024 + h * 128 + wave * 16);
                const CAS unsigned* qbase = (const CAS unsigned*)(Q + (size_t)(row0 + sb * 16) * 1024 + h * 128 + wave * 16);
#pragma unroll 2
                for (int t = 0; t < 16; ++t) {
                    const f32x16 f = *(const CAS f32x16*)(fbase + t * 1024);
                    const u32x8 qp = *(const CAS u32x8*)(qbase + t * 512);
                    const float va = vl[t * 128 + lane], vb = vl[t * 128 + 64 + lane];
                    const f32x2 va2 = (f32x2){va, va}, vb2 = (f32x2){vb, vb};
                    f32x2 oa = (f32x2){0.f, 0.f}, ob = (f32x2){0.f, 0.f};
#pragma unroll
                    for (int i = 0; i < 8; ++i) { const f32x2 f2 = (f32x2){f[2 * i], f[2 * i + 1]};
                        const f32x2 q2 = (f32x2){__uint_as_float(qp[i] << 16), __uint_as_float(qp[i] & 0xffff0000u)};
                        Sa[i] = f2 * (Sa[i] - va2) + va2; Sb[i] = f2 * (Sb[i] - vb2) + vb2;
                        oa += q2 * Sa[i]; ob += q2 * Sb[i]; }
                    red[(wave * 16 + t) * 128 + lane] = oa.x + oa.y; red[(wave * 16 + t) * 128 + 64 + lane] = ob.x + ob.y;
                }
                __syncthreads();
#pragma unroll
                for (int tt = 0; tt < 2; ++tt) {
                    const int t = wave * 2 + tt;
                    float o0 = 0.f, o1 = 0.f;
#pragma unroll
                    for (int q8 = 0; q8 < 8; ++q8) { o0 += red[(q8 * 16 + t) * 128 + lane]; o1 += red[(q8 * 16 + t) * 128 + 64 + lane]; }
                    const float ss = wave_sum(o0 * o0 + o1 * o1);
                    const float r = 1.f / sqrtf(ss * (1.f / 128.f) + LN_EPS);
                    const size_t m = (size_t)(row0 + sb * 16 + t);
                    const float g0 = bf2f(Gt[m * 1024 + h * 128 + lane]), g1 = bf2f(Gt[m * 1024 + h * 128 + 64 + lane]);
                    MIX[m * 2048 + 1024 + h * 128 + lane] = (bf16)f2bf(o0 * r * hg_ng[lane] * g0);
                    MIX[m * 2048 + 1024 + h * 128 + 64 + lane] = (bf16)f2bf(o1 * r * hg_ng[64 + lane] * g1);
                }
            }
            if (sfin) { float* sp = sfin + (size_t)(wave * 16) * 128 + lane;
#pragma unroll
                for (int i = 0; i < 8; ++i) { sp[(2 * i) * 128] = Sa[i].x; sp[(2 * i + 1) * 128] = Sa[i].y; sp[(2 * i) * 128 + 64] = Sb[i].x; sp[(2 * i + 1) * 128 + 64] = Sb[i].y; } }
        }
        __syncthreads();
    }
    SEAM(4);

    if (IN(5)) for (int rep_ = 0; rep_ < NREP(5); ++rep_) { if (rep_) xcd_barrier(xbar);
        pg8::Gemm g{MIX, WOUT, M, D, D}; pg8::StaticOrder S; S.init(M, D, D, G, bx, MP, SPLIT5);
        pg8::EpiRes E{x_prompt, x_sample, out, MP, ALPHA, (float*)(ws + WS_PB5)};
        pg8::gemm_phase<pg8::EpiRes, pg8::StaticOrder, true, true>(lds, g, S, E);
    }
    SEAM(5);

    if (IN(6)) {
        for (int m = gw; m < M; m += NGW) {
            if (m < MP) ln_row(out + (size_t)m * D, nullptr, 0, 0, 1.f, out + (size_t)m * D, XB + (size_t)m * D, ln1_g, ln1_b, lane);
            else ln_row(x_sample + (size_t)(m - MP) * D, (const float*)(ws + WS_PB5) + (size_t)(m - MP) * D, SPLIT5, (size_t)MS * D, ALPHA, out + (size_t)m * D, XB + (size_t)m * D, ln1_g, ln1_b, lane);
        }
    }
    SEAM(6);

    if (IN(7)) for (int rep_ = 0; rep_ < NREP(7); ++rep_) { if (rep_) xcd_barrier(xbar);
        pg8::Gemm g{XB, WGU, M, 2 * FF, D}; pg8::StaticOrder S; S.init(M, 2 * FF, D, G, bx);
        pg8::EpiGateUp E{ACT, FF};
        pg8::gemm_phase<pg8::EpiGateUp, pg8::StaticOrder, true, true>(lds, g, S, E);
    }
    SEAM(7);

    if (IN(8)) {
        pg8::Gemm g{ACT, WDN, M, D, FF}; pg8::StaticOrder S; S.init(M, D, FF, G, bx, MP, SPLIT8);
        pg8::EpiRes E{out, out + (size_t)MP * D, out, MP, ALPHA, (float*)(ws + WS_PB8)};
        pg8::gemm_phase<pg8::EpiRes, pg8::StaticOrder, true, true>(lds, g, S, E);
    }
    SEAM(8);

    if (IN(9)) {
        for (int m = gw; m < M; m += NGW) {
            if (m < MP) ln_row(out + (size_t)m * D, nullptr, 0, 0, 1.f, out + (size_t)m * D, nullptr, ln2_g, ln2_b, lane);
            else ln_row(out + (size_t)m * D, (const float*)(ws + WS_PB8) + (size_t)(m - MP) * D, SPLIT8, (size_t)MS * D, ALPHA, out + (size_t)m * D, nullptr, ln2_g, ln2_b, lane);
        }
    }
#undef IN
#undef SEAM
}

#undef x_prompt
#undef x_sample
#undef cache_conv
#undef state_hgrn
#undef w_in
#undef b_in
#undef w_dw
#undef b_dw
#undef cn_g
#undef cn_b
#undef hlb
#undef hg_ng
#undef w_out
#undef ln1_g
#undef ln1_b
#undef w_gate
#undef w_up
#undef w_down
#undef ln2_g
#undef ln2_b
#undef out
#undef ws
#undef LB
#undef BIASP
#undef WIN
#undef WOUT
#undef WGU
#undef WDN
#undef XB
#undef MIX
#undef U
#undef Q
#undef F
#undef I
#undef Gt
#undef ACT
#undef ST
#undef DC

extern "C" void kernel_launch(void* const* d_in, const int* in_sizes, int n_in, void* d_out, int out_size, void* d_ws, size_t ws_size, hipStream_t stream) {
    static int grid = 0;
    if (grid == 0) {
        int dev = 0, cus = 0, per_cu = 0;
        if (n_in != 20 || ws_size < WS_END) { fprintf(stderr, "kernel_launch: unexpected n_in %d / ws_size %zu\n", n_in, ws_size); grid = -1; return; }
        if (hipGetDevice(&dev) != hipSuccess || hipDeviceGetAttribute(&cus, hipDeviceAttributeMultiprocessorCount, dev) != hipSuccess) { grid = -1; return; }
        if (hipFuncSetAttribute((const void*)fwd_kernel, hipFuncAttributeMaxDynamicSharedMemorySize, LDS_BYTES) != hipSuccess) { fprintf(stderr, "kernel_launch: hipFuncSetAttribute failed\n"); grid = -1; return; }
        if (hipOccupancyMaxActiveBlocksPerMultiprocessor(&per_cu, (const void*)fwd_kernel, NWAVES * 64, LDS_BYTES) != hipSuccess || per_cu < 1) { fprintf(stderr, "kernel_launch: occupancy query says %d\n", per_cu); }
        (void)hipGetLastError();
        grid = cus;
    }
    if (grid < 0) return;
    if (hipMemsetAsync(d_ws, 0, 16384, stream) != hipSuccess) { fprintf(stderr, "kernel_launch: memset failed\n"); return; }
    Args a{};
    for (int i = 0; i < 20; ++i) a.in[i] = (const float*)d_in[i];
    a.out = (float*)d_out; a.ws = (unsigned char*)d_ws;
#if MK_ONE_LAUNCH
    a.ph_lo = 0; a.ph_hi = N_PHASES;
    void* kargs[] = {&a};
    hipError_t e = hipLaunchCooperativeKernel((const void*)fwd_kernel, dim3(grid), dim3(NWAVES * 64), kargs, LDS_BYTES, stream);
    if (e != hipSuccess) fprintf(stderr, "cooperative launch failed: %s (grid %d)\n", hipGetErrorString(e), grid);
#else
    for (int p = 0; p < N_PHASES; ++p) {
        a.ph_lo = p; a.ph_hi = p + 1;
        hipLaunchKernelGGL(fwd_kernel, dim3(grid), dim3(NWAVES * 64), LDS_BYTES, stream, a);
    }
#endif
}
```

```cpp
#include <hip/hip_runtime.h>
#include <hip/hip_cooperative_groups.h>
#include <cstdio>
#include <cstdint>
namespace cg = cooperative_groups;

#ifndef MK_ONE_LAUNCH
#define MK_ONE_LAUNCH 1
#endif

namespace pg8 {
#define PG8_LAS __attribute__((address_space(3)))
typedef unsigned short bf16_t;
typedef short bf16x8 __attribute__((ext_vector_type(8)));
typedef float f32x4 __attribute__((ext_vector_type(4)));
typedef unsigned u32x4 __attribute__((ext_vector_type(4)));
typedef unsigned u32x2 __attribute__((ext_vector_type(2)));
constexpr int BM = 256, BK = 64, HALF = 128, HTB = HALF * BK * 2, STAGE_BYTES = 8 * HTB, NXCD = 8, WGM = 8;

__host__ __device__ __forceinline__ int lds_byte(int r, int c) { const int st = (r >> 4) * 2 + (c >> 5), rr = r & 15, cc = c & 31, ob = rr * 64 + cc * 2; return st * 1024 + (ob ^ (((ob >> 9) & 1) << 5)); }
__host__ __device__ __forceinline__ void stage_rc(int b, int& R, int& C) { const int st = b / 1024, sb = b % 1024, swz = sb ^ (((sb >> 9) & 1) << 5); R = (st >> 1) * 16 + swz / 64; C = (st & 1) * 32 + (swz % 64) / 2; }
__host__ __device__ __forceinline__ int perm32(int rho) { const int n = rho >> 4, i = rho & 15; return 8 * (i >> 2) + 4 * n + (i & 3); }

struct Unit { int pm, pn, kt0, nkt, ks; };
struct Gemm { const bf16_t* A; const bf16_t* Bt; int M, N, K; };

struct StaticOrder {
    int nM, nMf, nN, nfull, nitems, G, c, nt, nsplit;
    __host__ __device__ void init(int M, int N, int K, int G_, int c_, int Mfull = -1, int nsplit_ = 1) {
        nM = M / BM; nMf = Mfull < 0 ? nM : Mfull / BM; nN = N / BM; nt = K / BK; nsplit = nsplit_; nfull = nMf * nN; nitems = nfull + (nM - nMf) * nN * nsplit; G = G_; c = c_; }
    __host__ __device__ bool next(int i, Unit& u) const {
        const long L = (long)i * G + c; if (L >= nitems) return false;
        if (L >= nfull) { const int sidx = (int)L - nfull, un = sidx / nsplit, ks = sidx % nsplit, per = nt / nsplit;
            u.pm = nMf + un / nN; u.pn = un % nN; u.kt0 = ks * per; u.nkt = per; u.ks = ks; return true; }
        int wgid = (int)L; { const int q = nfull / NXCD, r = nfull % NXCD, xcd = wgid % NXCD, off = wgid / NXCD; wgid = (xcd < r ? xcd * (q + 1) : r * (q + 1) + (xcd - r) * q) + off; }
        const int nig = WGM * nN, gid = wgid / nig, fm = gid * WGM, gsz = (nMf - fm) < WGM ? (nMf - fm) : WGM;
        u.pm = fm + ((wgid % nig) % gsz); u.pn = (wgid % nig) / gsz; u.kt0 = 0; u.nkt = nt; u.ks = -1; return true;
    }
    __device__ __forceinline__ void a_ready(const Unit&) const {}
    __device__ __forceinline__ void done(const Unit&) const {}
};

__device__ __forceinline__ unsigned cvt_pk_bf16(float lo, float hi) { unsigned r; asm volatile("v_cvt_pk_bf16_f32 %0, %1, %2" : "=v"(r) : "v"(lo), "v"(hi)); return r; }
__device__ __forceinline__ float sigm(float x) { return __builtin_amdgcn_rcpf(1.0f + __expf(-x)); }

struct EpiProj {
    static constexpr bool PERM = true, AFTER_DRAIN = false;
    bf16_t *U, *QIG; float* F; const float* bias; const float* lb;
    __device__ __forceinline__ void operator()(const f32x4 (&acc)[2][2][4][2], const Unit& u, int wr, int wc, int fr, int fq) const {
        const int row0 = u.pm * BM + wr * 64 + fr;
        const int cl = wc * 32 + 8 * fq;
        const int bcol = u.pn * BM + cl;
        f32x4 bv[2][2];
#pragma unroll
        for (int bj = 0; bj < 2; ++bj)
#pragma unroll
            for (int n = 0; n < 2; ++n) bv[bj][n] = *(const f32x4*)(bias + bcol + bj * HALF + 4 * n);
        if (u.pn < 8) {
#pragma unroll
            for (int ai = 0; ai < 2; ++ai)
#pragma unroll
                for (int m = 0; m < 4; ++m) {
                    const size_t row = (size_t)(row0 + ai * HALF + m * 16);
                    float o[8];
#pragma unroll
                    for (int n = 0; n < 2; ++n) { const f32x4 a = acc[ai][0][m][n] + bv[0][n], g = acc[ai][1][m][n] + bv[1][n];
#pragma unroll
                        for (int e = 0; e < 4; ++e) o[n * 4 + e] = a[e] * sigm(g[e]); }
                    u32x4 w; w.x = cvt_pk_bf16(o[0], o[1]); w.y = cvt_pk_bf16(o[2], o[3]); w.z = cvt_pk_bf16(o[4], o[5]); w.w = cvt_pk_bf16(o[6], o[7]);
                    *(u32x4*)(U + row * 1024 + u.pn * HALF + cl) = w;
                }
        } else {
            const int grp = (u.pn - 8) >> 2;
            const int cbase = ((u.pn - 8) & 3) * BM + cl;
            if (grp == 1) {
                f32x4 lv[2][2];
#pragma unroll
                for (int bj = 0; bj < 2; ++bj)
#pragma unroll
                    for (int n = 0; n < 2; ++n) lv[bj][n] = *(const f32x4*)(lb + cbase + bj * HALF + 4 * n);
#pragma unroll
                for (int ai = 0; ai < 2; ++ai)
#pragma unroll
                    for (int m = 0; m < 4; ++m) {
                        const size_t row = (size_t)(row0 + ai * HALF + m * 16);
#pragma unroll
                        for (int bj = 0; bj < 2; ++bj)
#pragma unroll
                            for (int n = 0; n < 2; ++n) { const f32x4 x = acc[ai][bj][m][n] + bv[bj][n]; const f32x4 l = lv[bj][n]; f32x4 o;
#pragma unroll
                                for (int e = 0; e < 4; ++e) o[e] = l[e] + (1.0f - l[e]) * sigm(x[e]);
                                *(f32x4*)(F + row * 1024 + cbase + bj * HALF + 4 * n) = o; }
                    }
            } else {
                bf16_t* O = QIG + (size_t)(grp - (grp > 0 ? 1 : 0)) * ((size_t)8704 * 1024);
                const bool act = grp != 2;
#pragma unroll
                for (int ai = 0; ai < 2; ++ai)
#pragma unroll
                    for (int m = 0; m < 4; ++m) {
                        const size_t row = (size_t)(row0 + ai * HALF + m * 16);
#pragma unroll
                        for (int bj = 0; bj < 2; ++bj) { float o[8];
#pragma unroll
                            for (int n = 0; n < 2; ++n) { const f32x4 x = acc[ai][bj][m][n] + bv[bj][n];
#pragma unroll
                                for (int e = 0; e < 4; ++e) o[n * 4 + e] = act ? x[e] * sigm(x[e]) : x[e]; }
                            u32x4 w; w.x = cvt_pk_bf16(o[0], o[1]); w.y = cvt_pk_bf16(o[2], o[3]); w.z = cvt_pk_bf16(o[4], o[5]); w.w = cvt_pk_bf16(o[6], o[7]);
                            *(u32x4*)(O + row * 1024 + cbase + bj * HALF) = w; }
                    }
            }
        }
    }
};
struct EpiRes {
    static constexpr bool PERM = false, AFTER_DRAIN = false;
    const float* baseP; const float* baseS; float* out; int split; float alpha; float* part;
    __device__ __forceinline__ void operator()(const f32x4 (&acc)[2][2][4][2], const Unit& u, int wr, int wc, int fr, int fq) const {
        const int row0 = u.pm * BM + wr * 64 + fr;
        const int col0 = u.pn * BM + wc * 32 + 4 * fq;
        if (u.ks >= 0) {
            float* pb = part + (size_t)u.ks * 512 * 2048;
#pragma unroll
            for (int ai = 0; ai < 2; ++ai)
#pragma unroll
                for (int m = 0; m < 4; ++m) { float* op = pb + (size_t)(row0 + ai * HALF + m * 16 - split) * 2048;
#pragma unroll
                    for (int bj = 0; bj < 2; ++bj)
#pragma unroll
                        for (int n = 0; n < 2; ++n) *(f32x4*)(op + col0 + bj * HALF + n * 16) = acc[ai][bj][m][n]; }
            return;
        }
#pragma unroll
        for (int ai = 0; ai < 2; ++ai)
#pragma unroll
            for (int m = 0; m < 4; ++m) {
                const int row = row0 + ai * HALF + m * 16;
                const float* bp = row < split ? baseP + (size_t)row * 2048 : baseS + (size_t)(row - split) * 2048;
                float* op = out + (size_t)row * 2048;
#pragma unroll
                for (int bj = 0; bj < 2; ++bj)
#pragma unroll
                    for (int n = 0; n < 2; ++n) { const int c = col0 + bj * HALF + n * 16; const f32x4 b = *(const f32x4*)(bp + c); *(f32x4*)(op + c) = b * alpha + acc[ai][bj][m][n]; }
            }
    }
};
struct EpiGateUp {
    static constexpr bool PERM = true, AFTER_DRAIN = false;
    bf16_t* O; int ldc;
    __device__ __forceinline__ void operator()(const f32x4 (&acc)[2][2][4][2], const Unit& u, int wr, int wc, int fr, int fq) const {
        const int row0 = u.pm * BM + wr * 64 + fr;
        const int cl = wc * 32 + 8 * fq;
#pragma unroll
        for (int ai = 0; ai < 2; ++ai)
#pragma unroll
            for (int m = 0; m < 4; ++m) {
                const size_t row = (size_t)(row0 + ai * HALF + m * 16);
                float o[8];
#pragma unroll
                for (int n = 0; n < 2; ++n) { const f32x4 g = acc[ai][0][m][n], up = acc[ai][1][m][n];
#pragma unroll
                    for (int e = 0; e < 4; ++e) o[n * 4 + e] = g[e] * sigm(g[e]) * up[e]; }
                u32x4 w; w.x = cvt_pk_bf16(o[0], o[1]); w.y = cvt_pk_bf16(o[2], o[3]); w.z = cvt_pk_bf16(o[4], o[5]); w.w = cvt_pk_bf16(o[6], o[7]);
                *(u32x4*)(O + row * ldc + u.pn * HALF + cl) = w;
            }
    }
};

template <class Epi, class Sched, bool ALIGN_EPI = false, bool SP2 = false>
__device__ __forceinline__ void gemm_phase(PG8_LAS unsigned char* lds, const Gemm g, const Sched& S, const Epi& E) {
    int tid_ = threadIdx.x; asm volatile("" : "+v"(tid_));
    const int tid = tid_, wid = __builtin_amdgcn_readfirstlane(tid >> 6), lane = tid & 63, wr = wid >> 2, wc = wid & 3, fr = lane & 15, fq = lane >> 4;
    const int K = g.K;
    unsigned voffA[2], voffB[2];
#pragma unroll
    for (int i = 0; i < 2; ++i) { int R, C; stage_rc(tid * 16 + i * 8192, R, C); const int Rb = Epi::PERM ? ((R & ~31) + perm32(R & 31)) : R;
        voffA[i] = (unsigned)(R * K + C) * 2u; voffB[i] = (unsigned)(Rb * K + C) * 2u; }
    const size_t kstep = (size_t)(BK * 2);
    const size_t hstep = (size_t)HALF * K * 2;
    const size_t tstep = 2 * hstep;
    const unsigned ldsw = (unsigned)wid * 1024u;
    const int aoff = lds_byte(wr * 64 + fr, fq * 8), boff = lds_byte(wc * 32 + fr, fq * 8);
#define PG8_SA(b, h) (((b) * 2 + (h)) * HTB)
#define PG8_SB(b, h) ((4 + (b) * 2 + (h)) * HTB)
#define PG8_STAGE(bufoff, gbase, voff) do { _Pragma("unroll") for (int _i = 0; _i < 2; ++_i) \
        __builtin_amdgcn_global_load_lds((const unsigned*)((const char*)(gbase) + (voff)[_i]), (PG8_LAS unsigned*)(lds + (bufoff) + ldsw + _i * 8192), 16, 0, 0); } while (0)
#define PG8_LDA(dst, b, h) do { _Pragma("unroll") for (int m = 0; m < 4; ++m) _Pragma("unroll") for (int k = 0; k < 2; ++k) dst[m][k] = *(const PG8_LAS bf16x8*)(lds + PG8_SA(b, h) + aoff + m * 2048 + k * 1024); } while (0)
#define PG8_LDB(dst, b, h) do { _Pragma("unroll") for (int n = 0; n < 2; ++n) _Pragma("unroll") for (int k = 0; k < 2; ++k) dst[n][k] = *(const PG8_LAS bf16x8*)(lds + PG8_SB(b, h) + boff + n * 2048 + k * 1024); } while (0)
#define PG8_MMA(ai, bj, At, Bt) do { __builtin_amdgcn_s_setprio(1); _Pragma("unroll") for (int m = 0; m < 4; ++m) _Pragma("unroll") for (int n = 0; n < 2; ++n) _Pragma("unroll") for (int k = 0; k < 2; ++k) \
        acc[ai][bj][m][n] = __builtin_amdgcn_mfma_f32_16x16x32_bf16(Bt[n][k], At[m][k], acc[ai][bj][m][n], 0, 0, 0); __builtin_amdgcn_s_setprio(0); } while (0)
#define PG8_WAIT_V(n) asm volatile("s_waitcnt vmcnt(" #n ")" ::: "memory")
#define PG8_WAIT_L(n) asm volatile("s_waitcnt lgkmcnt(" #n ")" ::: "memory")
#define PG8_BAR __builtin_amdgcn_s_barrier()
#define PG8_SCHED __builtin_amdgcn_sched_barrier(0)
    Unit cur, nxt; int ui = 0;
    if (!S.next(0, cur)) return;
    f32x4 acc[2][2][4][2];
#pragma unroll
    for (int a = 0; a < 2; ++a)
#pragma unroll
        for (int b = 0; b < 2; ++b)
#pragma unroll
            for (int m = 0; m < 4; ++m)
#pragma unroll
                for (int n = 0; n < 2; ++n) acc[a][b][m][n] = (f32x4){0.f, 0.f, 0.f, 0.f};
    bf16x8 At[4][2], B0[2][2], B1[2][2];
    const char* cA = (const char*)g.A + (size_t)cur.pm * tstep + (size_t)cur.kt0 * kstep; const char* cB = (const char*)g.Bt + (size_t)cur.pn * tstep + (size_t)cur.kt0 * kstep;
    S.a_ready(cur);
    if constexpr (SP2) {
        PG8_STAGE(PG8_SB(0, 0), cB, voffB); PG8_STAGE(PG8_SB(0, 1), cB + hstep, voffB); PG8_STAGE(PG8_SA(0, 0), cA, voffA); PG8_STAGE(PG8_SA(0, 1), cA + hstep, voffA);
        if (wr == 1) PG8_BAR;
        PG8_WAIT_V(2); PG8_BAR;
        PG8_STAGE(PG8_SB(1, 0), cB + kstep, voffB); PG8_STAGE(PG8_SA(1, 0), cA + kstep, voffA); PG8_STAGE(PG8_SB(1, 1), cB + hstep + kstep, voffB);
        PG8_WAIT_V(6); PG8_BAR;
    } else {
        PG8_STAGE(PG8_SB(0, 0), cB, voffB); PG8_STAGE(PG8_SA(0, 0), cA, voffA); PG8_STAGE(PG8_SB(0, 1), cB + hstep, voffB); PG8_STAGE(PG8_SA(0, 1), cA + hstep, voffA);
        if (wr == 1) PG8_BAR;
        PG8_WAIT_V(4); PG8_BAR;
        PG8_STAGE(PG8_SB(1, 0), cB + kstep, voffB); PG8_STAGE(PG8_SA(1, 0), cA + kstep, voffA); PG8_STAGE(PG8_SB(1, 1), cB + hstep + kstep, voffB);
        PG8_WAIT_V(6); PG8_BAR;
    }
    for (;;) {
        const bool has_next = S.next(ui + 1, nxt);
        const char* nA = has_next ? (const char*)g.A + (size_t)nxt.pm * tstep + (size_t)nxt.kt0 * kstep : cA; const char* nB = has_next ? (const char*)g.Bt + (size_t)nxt.pn * tstep + (size_t)nxt.kt0 * kstep : cB;
        const int nt = cur.nkt;
        for (int t = 0; t < nt; t += 2) {
            const bool last = (t == nt - 2);
            const char* a1 = cA + (size_t)(t + 1) * kstep;
            const char* a2 = last ? nA : cA + (size_t)(t + 2) * kstep; const char* b2 = last ? nB : cB + (size_t)(t + 2) * kstep;
            const char* a3 = a2 + kstep; const char* b3 = b2 + kstep;
            if (last && has_next) S.a_ready(nxt);
            if constexpr (SP2) {
            PG8_LDB(B0, 0, 0); PG8_LDB(B1, 0, 1); PG8_SCHED; PG8_LDA(At, 0, 0); PG8_STAGE(PG8_SA(1, 1), a1 + hstep, voffA);
            PG8_WAIT_V(8); PG8_WAIT_L(0); PG8_BAR; PG8_MMA(0, 0, At, B0); PG8_MMA(0, 1, At, B1); PG8_BAR; PG8_SCHED;
            PG8_LDA(At, 0, 1); PG8_STAGE(PG8_SB(0, 0), b2, voffB); PG8_STAGE(PG8_SB(0, 1), b2 + hstep, voffB); PG8_STAGE(PG8_SA(0, 0), a2, voffA);
            PG8_WAIT_V(8); PG8_WAIT_L(0); PG8_BAR; PG8_MMA(1, 0, At, B0); PG8_MMA(1, 1, At, B1); PG8_BAR; PG8_SCHED;
            PG8_LDB(B0, 1, 0); PG8_LDB(B1, 1, 1); PG8_SCHED; PG8_LDA(At, 1, 0); PG8_STAGE(PG8_SA(0, 1), a2 + hstep, voffA);
            PG8_WAIT_V(8); PG8_WAIT_L(0); PG8_BAR; PG8_MMA(0, 0, At, B0); PG8_MMA(0, 1, At, B1); PG8_BAR; PG8_SCHED;
            PG8_LDA(At, 1, 1); PG8_STAGE(PG8_SB(1, 0), b3, voffB); PG8_STAGE(PG8_SB(1, 1), b3 + hstep, voffB); PG8_STAGE(PG8_SA(1, 0), a3, voffA);
            PG8_WAIT_V(8); PG8_WAIT_L(0); PG8_BAR; PG8_MMA(1, 0, At, B0); PG8_MMA(1, 1, At, B1); PG8_BAR; PG8_SCHED;
            } else {
            PG8_LDB(B0, 0, 0); PG8_SCHED; PG8_LDA(At, 0, 0); PG8_STAGE(PG8_SA(1, 1), a1 + hstep, voffA);
            PG8_WAIT_L(8); PG8_BAR; PG8_WAIT_L(0); PG8_MMA(0, 0, At, B0); PG8_BAR; PG8_SCHED;
            PG8_LDB(B1, 0, 1); PG8_STAGE(PG8_SB(0, 0), b2, voffB);
            PG8_BAR; PG8_WAIT_L(0); PG8_MMA(0, 1, At, B1); PG8_BAR;
            PG8_LDA(At, 0, 1); PG8_STAGE(PG8_SA(0, 0), a2, voffA);
            PG8_BAR; PG8_WAIT_L(0); PG8_MMA(1, 0, At, B0); PG8_BAR; PG8_SCHED;
            PG8_STAGE(PG8_SB(0, 1), b2 + hstep, voffB);
            PG8_WAIT_V(6); PG8_BAR; PG8_MMA(1, 1, At, B1); PG8_BAR;
            PG8_LDB(B0, 1, 0); PG8_SCHED; PG8_LDA(At, 1, 0); PG8_STAGE(PG8_SA(0, 1), a2 + hstep, voffA);
            PG8_WAIT_L(8); PG8_BAR; PG8_WAIT_L(0); PG8_MMA(0, 0, At, B0); PG8_BAR; PG8_SCHED;
            PG8_LDB(B1, 1, 1); PG8_STAGE(PG8_SB(1, 0), b3, voffB);
            PG8_BAR; PG8_WAIT_L(0); PG8_MMA(0, 1, At, B1); PG8_BAR;
            PG8_LDA(At, 1, 1); PG8_STAGE(PG8_SA(1, 0), a3, voffA);
            PG8_BAR; PG8_WAIT_L(0); PG8_MMA(1, 0, At, B0); PG8_BAR; PG8_SCHED;
            PG8_STAGE(PG8_SB(1, 1), b3 + hstep, voffB);
            PG8_WAIT_V(6); PG8_BAR; PG8_MMA(1, 1, At, B1); PG8_BAR;
            }
        }
        if constexpr (ALIGN_EPI) { if (wr == 0) PG8_BAR; }
        if constexpr (!Epi::AFTER_DRAIN) { E(acc, cur, wr, wc, fr, fq); S.done(cur); }
        if (!has_next) break;
#pragma unroll
        for (int a = 0; a < 2; ++a)
#pragma unroll
            for (int b = 0; b < 2; ++b)
#pragma unroll
                for (int m = 0; m < 4; ++m)
#pragma unroll
                    for (int n = 0; n < 2; ++n) acc[a][b][m][n] = (f32x4){0.f, 0.f, 0.f, 0.f};
        cur = nxt; cA = nA; cB = nB; ++ui;
        if constexpr (ALIGN_EPI) { if (wr == 1) PG8_BAR; }
    }
    PG8_WAIT_V(0);
    if constexpr (!ALIGN_EPI) { if (wr == 0) PG8_BAR; }
    PG8_BAR;
#undef PG8_SA
#undef PG8_SB
#undef PG8_STAGE
#undef PG8_LDA
#undef PG8_LDB
#undef PG8_MMA
#undef PG8_WAIT_V
#undef PG8_WAIT_L
#undef PG8_BAR
#undef PG8_SCHED
}
}

constexpr int D = 2048, MP = 8192, MS = 512, M = MP + MS, CW = 1024, NH = 8, HD = 128, FF = 5632, NIN = 6144;
constexpr float LN_EPS = 1e-5f;
constexpr float ALPHA = 1.189207115002721f;
constexpr int NWAVES = 8;
constexpr int LDS_BYTES = 147456;
constexpr int N_PHASES = 10;

constexpr size_t MiB = 1u << 20;
constexpr size_t WS_LB = 64 * 1024, WS_BIASP = 128 * 1024;
constexpr size_t WS_WIN = 1 * MiB, WS_WOUT = 25 * MiB, WS_WGU = 33 * MiB, WS_WDN = 77 * MiB;
constexpr size_t WS_XB = 99 * MiB, WS_MIX = 133 * MiB;
constexpr size_t WS_U = 167 * MiB, WS_Q = 184 * MiB, WS_I = 201 * MiB, WS_G = 218 * MiB, WS_F = 235 * MiB, WS_END = 269 * MiB;
constexpr size_t WS_ACT = 167 * MiB;
constexpr int SPLIT5 = 8, SPLIT8 = 11;
constexpr size_t WS_PB5 = 167 * MiB;
constexpr size_t WS_PB8 = 99 * MiB;
static_assert(WS_PB8 + (size_t)SPLIT8 * 512 * 2048 * 4 <= 167 * MiB && (32 % SPLIT5) == 0 && (88 % SPLIT8) == 0 && (32 / SPLIT5) % 2 == 0 && (88 / SPLIT8) % 2 == 0 && 32 / SPLIT5 >= 4 && 88 / SPLIT8 >= 4, "split-K layout");
static_assert(WS_ACT + (size_t)M * FF * 2 <= WS_END, "act overlay");
constexpr size_t O_Y = 0, O_NCP = (size_t)M * D, O_NHP = O_NCP + 4 * 30 * 1024, O_NCS = O_NHP + 4 * 8 * 128 * 128, O_NHS = O_NCS + 32 * 30 * 1024;
constexpr size_t O_ST = 0, O_DC = (size_t)1024 * 16384;

#define LAS __attribute__((address_space(3)))
typedef unsigned short bf16;
typedef float f32x4 __attribute__((ext_vector_type(4)));
typedef float f32x2 __attribute__((ext_vector_type(2)));
typedef unsigned v4u __attribute__((ext_vector_type(4)));
typedef unsigned v2u __attribute__((ext_vector_type(2)));
typedef float f32x16 __attribute__((ext_vector_type(16)));
typedef unsigned u32x8 __attribute__((ext_vector_type(8)));
#define CAS __attribute__((address_space(4)))
#define LDS_WAIT() asm volatile("s_waitcnt lgkmcnt(0)" ::: "memory")

__device__ __forceinline__ unsigned f2bf(float f) { unsigned u = __builtin_bit_cast(unsigned, f); return (u + 0x7fffu + ((u >> 16) & 1u)) >> 16; }
__device__ __forceinline__ unsigned pk2(float lo, float hi) { return f2bf(lo) | (f2bf(hi) << 16); }
__device__ __forceinline__ float bf2f(unsigned short b) { return __uint_as_float((unsigned)b << 16); }
__device__ __forceinline__ float sigm(float x) { return __builtin_amdgcn_rcpf(1.0f + __expf(-x)); }
__device__ __forceinline__ float wave_sum(float v) {
#pragma unroll
    for (int o = 1; o < 64; o <<= 1) v += __shfl_xor(v, o);
    return v;
}

__device__ __forceinline__ void transpose_item(const float* W, int K, int N, bf16* WT, int k0, int n0, int dst_row0, LAS float* scr, int lane) {
#pragma unroll 8
    for (int i = 0; i < 32; ++i) { const int kk = 2 * i + (lane >> 5); scr[kk * 33 + (lane & 31)] = W[(size_t)(k0 + kk) * N + n0 + (lane & 31)]; }
    LDS_WAIT(); asm volatile("" ::: "memory");
    const int c = lane & 7;
#pragma unroll
    for (int j = 0; j < 4; ++j) { const int n = (lane >> 3) + 8 * j; const LAS float* s = scr + (8 * c) * 33 + n;
        v4u o; o.x = pk2(s[0 * 33], s[1 * 33]); o.y = pk2(s[2 * 33], s[3 * 33]); o.z = pk2(s[4 * 33], s[5 * 33]); o.w = pk2(s[6 * 33], s[7 * 33]);
        *(v4u*)(WT + (size_t)(dst_row0 + n) * K + k0 + 8 * c) = o; }
    LDS_WAIT(); asm volatile("" ::: "memory");
}

__device__ __forceinline__ void ln_row(const float* src, const float* part, int npart, size_t pstride, float alpha, float* dstf, bf16* dstb, const float* g, const float* b, int lane) {
    const f32x4* xr = (const f32x4*)src + lane;
    f32x4 v[8]; float s = 0.f;
#pragma unroll
    for (int j = 0; j < 8; ++j) v[j] = xr[64 * j];
    if (npart > 0) {
#pragma unroll
        for (int j = 0; j < 8; ++j) v[j] = v[j] * alpha;
        for (int p = 0; p < npart; ++p) { const f32x4* pr = (const f32x4*)(part + (size_t)p * pstride) + lane;
#pragma unroll
            for (int j = 0; j < 8; ++j) v[j] += pr[64 * j]; }
    }
#pragma unroll
    for (int j = 0; j < 8; ++j) s += (v[j].x + v[j].y) + (v[j].z + v[j].w);
    const float mean = wave_sum(s) * (1.f / D); float s2 = 0.f;
#pragma unroll
    for (int j = 0; j < 8; ++j) { v[j] = v[j] - mean; s2 += (v[j].x * v[j].x + v[j].y * v[j].y) + (v[j].z * v[j].z + v[j].w * v[j].w); }
    const float rstd = 1.f / sqrtf(wave_sum(s2) * (1.f / D) + LN_EPS);
#pragma unroll
    for (int j = 0; j < 8; ++j) {
        const f32x4 gg = ((const f32x4*)g)[lane + 64 * j], bb = ((const f32x4*)b)[lane + 64 * j];
        const f32x4 o = v[j] * rstd * gg + bb;
        if (dstf) ((f32x4*)dstf)[lane + 64 * j] = o;
        if (dstb) { v2u w; w.x = pk2(o.x, o.y); w.y = pk2(o.z, o.w); ((v2u*)dstb)[lane + 64 * j] = w; }
    }
}

#define XB_TMO      128
#define XB_XCNT(j)  (256  + 64 * (j))
#define XB_XSUB(j)  (1280 + 64 * (j))
#define XB_XGEN(j)  (2304 + 64 * (j))
#define XB_TOP      3328
#define XB_TOPGEN   3392
#define XCD_BAR_WORDS 3456
#define XB_SPIN_CAP (1u << 18)
__device__ __forceinline__ unsigned xb_ld(unsigned* p)              { return __hip_atomic_load(p, __ATOMIC_RELAXED, __HIP_MEMORY_SCOPE_AGENT); }
__device__ __forceinline__ unsigned xb_add(unsigned* p, unsigned v) { return __hip_atomic_fetch_add(p, v, __ATOMIC_RELAXED, __HIP_MEMORY_SCOPE_AGENT); }
__device__ __forceinline__ unsigned xb_xcc_id() { return (unsigned)__builtin_amdgcn_s_getreg((3 << 11) | 20) & 0xFu; }
#define XB_SPIN(cond, bar) do { unsigned _sp = 0; while (cond) { __builtin_amdgcn_s_sleep(1); \
    if ((++_sp & 255u) == 0u) { if (xb_ld(&(bar)[XB_TMO])) break; if (_sp > XB_SPIN_CAP) { atomicAdd(&(bar)[XB_TMO], 1u); break; } } } } while (0)
struct XcdBarrier { unsigned* bar; unsigned x; volatile LAS unsigned* st; };
__device__ __forceinline__ XcdBarrier xcd_barrier_post(unsigned* bar, volatile LAS unsigned* st) {
    XcdBarrier b; b.bar = bar; b.x = xb_xcc_id(); b.st = st;
    if (threadIdx.x == 0) (void)xb_add(&bar[XB_XCNT(b.x)], 1u);
    return b;
}
__device__ __forceinline__ void xcd_barrier_complete(unsigned* bar, unsigned x, unsigned& nloc, unsigned& nx) {
    const unsigned G = gridDim.x * gridDim.y * gridDim.z;
    unsigned sum, cnt, mine, sp = 0u;
    for (;;) {
        sum = 0u; cnt = 0u; mine = 0u;
#pragma unroll
        for (unsigned j = 0; j < 16; ++j) { const unsigned c = xb_ld(&bar[XB_XCNT(j)]); sum += c; cnt += (c > 0u) ? 1u : 0u; mine = (j == x) ? c : mine; }
        if (sum == G) break;
        __builtin_amdgcn_s_sleep(1);
        if ((++sp & 255u) == 0u) { if (xb_ld(&bar[XB_TMO])) break; if (sp > XB_SPIN_CAP) { atomicAdd(&bar[XB_TMO], 1u); break; } }
    }
    nloc = mine > 0u ? mine : 1u; nx = cnt > 0u ? cnt : 1u;
}
__device__ __forceinline__ void xcd_barrier(const XcdBarrier& b) {
    asm volatile("s_waitcnt vmcnt(0)" ::: "memory");
    __syncthreads();
    if (threadIdx.x == 0) {
        unsigned* bar = b.bar;
        __builtin_amdgcn_s_waitcnt(0);
        unsigned nloc = b.st[0], nx = b.st[1];
        if (nloc == 0u) { xcd_barrier_complete(bar, b.x, nloc, nx); b.st[0] = nloc; b.st[1] = nx; }
        const unsigned old = xb_add(&bar[XB_XSUB(b.x)], 1u);
        const unsigned gen = old / nloc;
        if (old + 1u == (gen + 1u) * nloc) {
            __builtin_amdgcn_fence(__ATOMIC_RELEASE, "agent");
            asm volatile("s_waitcnt vmcnt(0)" ::: "memory");
            const unsigned og = xb_add(&bar[XB_TOP], 1u);
            const unsigned tg = og / nx;
            if (og + 1u == (tg + 1u) * nx) xb_add(&bar[XB_TOPGEN], 1u);
            else XB_SPIN(xb_ld(&bar[XB_TOPGEN]) == tg, bar);
            __builtin_amdgcn_fence(__ATOMIC_ACQUIRE, "agent");
            xb_add(&bar[XB_XGEN(b.x)], 1u);
            asm volatile("s_waitcnt vmcnt(0)" ::: "memory");
        } else {
            XB_SPIN(xb_ld(&bar[XB_XGEN(b.x)]) == gen, bar);
            __builtin_amdgcn_fence(__ATOMIC_ACQUIRE, "agent");
            asm volatile("s_waitcnt vmcnt(0)" ::: "memory");
        }
    }
    __syncthreads();
}

struct Args { const float* in[20]; float* out; unsigned char* ws; int ph_lo, ph_hi; };

__global__ void __launch_bounds__(NWAVES * 64, 2) fwd_kernel(Args args) {
    extern __shared__ __attribute__((aligned(16))) unsigned char lds_raw[];
    LAS unsigned char* lds = (LAS unsigned char*)lds_raw;
    const int tid = threadIdx.x, lane = tid & 63, wave = __builtin_amdgcn_readfirstlane(tid >> 6);
    const int G = gridDim.x, bx = blockIdx.x;
    const int gt = bx * 512 + tid, NT = G * 512;
    const int gw = bx * NWAVES + wave, NGW = G * NWAVES;

#define x_prompt (args.in[0])
#define x_sample (args.in[1])
#define cache_conv (args.in[2])
#define state_hgrn (args.in[3])
#define w_in (args.in[4])
#define b_in (args.in[5])
#define w_dw (args.in[6])
#define b_dw (args.in[7])
#define cn_g (args.in[8])
#define cn_b (args.in[9])
#define hlb (args.in[10])
#define hg_ng (args.in[11])
#define w_out (args.in[12])
#define ln1_g (args.in[13])
#define ln1_b (args.in[14])
#define w_gate (args.in[15])
#define w_up (args.in[16])
#define w_down (args.in[17])
#define ln2_g (args.in[18])
#define ln2_b (args.in[19])
#define out (args.out)
#define ws (args.ws)
#define LB ((float*)(ws + WS_LB))
#define BIASP ((float*)(ws + WS_BIASP))
#define WIN ((bf16*)(ws + WS_WIN))
#define WOUT ((bf16*)(ws + WS_WOUT))
#define WGU ((bf16*)(ws + WS_WGU))
#define WDN ((bf16*)(ws + WS_WDN))
#define XB ((bf16*)(ws + WS_XB))
#define MIX ((bf16*)(ws + WS_MIX))
#define U ((bf16*)(ws + WS_U))
#define Q ((bf16*)(ws + WS_Q))
#define F ((float*)(ws + WS_F))
#define I ((bf16*)(ws + WS_I))
#define Gt ((bf16*)(ws + WS_G))
#define ACT ((bf16*)(ws + WS_ACT))
#define ST (out + O_ST)
#define DC (out + O_DC)

    const int lo = args.ph_lo, hi = args.ph_hi;
    volatile LAS unsigned* MISC = (volatile LAS unsigned*)(lds + LDS_BYTES - 64);
    if (tid < 16) MISC[tid] = 0u;
    __syncthreads();
    XcdBarrier xbar = xcd_barrier_post((unsigned*)ws, MISC + 8);
#ifndef PH_MASK
#define PH_MASK 0x3ff
#endif
#define IN(k) (((PH_MASK >> (k)) & 1) && lo <= (k) && (k) < hi)
#ifndef REP_MASK
#define REP_MASK 0
#endif
#define NREP(k) (1 + ((REP_MASK >> (k)) & 1))
#define SEAM(k) do { if (IN(k) && IN((k) + 1)) { xcd_barrier(xbar); } } while (0)
    if (hi > 1000) cg::this_grid().sync();

    if (IN(0)) for (int rep_ = 0; rep_ < NREP(0); ++rep_) { if (rep_) xcd_barrier(xbar);
        LAS float* scr = (LAS float*)(lds + wave * 16384);
        constexpr int I_IN = 32 * 192, I_OUT = 32 * 64, I_G = 32 * 176, I_DN = 88 * 64;
        constexpr int NITEMS = I_IN + I_OUT + 2 * I_G + I_DN;
        for (int it = gw; it < NITEMS; it += NGW) {
            int r = it; const float* W; int K, N; bf16* WT; int kind;
            if (r < I_IN) { kind = 0; W = w_in; K = D; N = NIN; WT = WIN; }
            else if ((r -= I_IN) < I_OUT) { kind = 1; W = w_out; K = D; N = D; WT = WOUT; }
            else if ((r -= I_OUT) < I_G) { kind = 2; W = w_gate; K = D; N = FF; WT = WGU; }
            else if ((r -= I_G) < I_G) { kind = 3; W = w_up; K = D; N = FF; WT = WGU; }
            else { r -= I_G; kind = 4; W = w_down; K = FF; N = D; WT = WDN; }
            const int nblk = N / 32, kb = r / nblk, nb = r % nblk, k0 = 64 * kb, n0 = 32 * nb;
            int dst;
            if (kind == 0) dst = n0 < 2048 ? ((n0 & 1023) >> 7) * 256 + (n0 >> 10) * 128 + (n0 & 127) : n0;
            else if (kind == 2) dst = (n0 >> 7) * 256 + (n0 & 127);
            else if (kind == 3) dst = (n0 >> 7) * 256 + 128 + (n0 & 127);
            else dst = n0;
            transpose_item(W, K, N, WT, k0, n0, dst, scr, lane);
        }
        constexpr int NV = M * D / 8, NVP = MP * D / 8;
        for (int i = gt; i < NV; i += NT) {
            const float* src = i < NVP ? x_prompt + (size_t)i * 8 : x_sample + (size_t)(i - NVP) * 8;
            const f32x4 a = *(const f32x4*)src, b = *(const f32x4*)(src + 4);
            v4u o; o.x = pk2(a.x, a.y); o.y = pk2(a.z, a.w); o.z = pk2(b.x, b.y); o.w = pk2(b.z, b.w);
            *(v4u*)(XB + (size_t)i * 8) = o;
        }
        for (int i = gt; i < 1024; i += NT) LB[i] = sigm(hlb[i] - hlb[1024 + i]);
        for (int i = gt; i < NIN; i += NT) { const int orig = i < 2048 ? ((i & 255) >> 7) * 1024 + (i >> 8) * 128 + (i & 127) : i; BIASP[i] = b_in[orig]; }
    }
    SEAM(0);
#ifdef EXTRA_SYNCS
    for (int i_ = 0; i_ < EXTRA_SYNCS; ++i_) cg::this_grid().sync();
#endif

    if (IN(1)) for (int rep_ = 0; rep_ < NREP(1); ++rep_) { if (rep_) xcd_barrier(xbar);
        pg8::Gemm g{XB, WIN, M, NIN, D}; pg8::StaticOrder S; S.init(M, NIN, D, G, bx);
        pg8::EpiProj E{U, Q, F, BIASP, LB};
        pg8::gemm_phase<pg8::EpiProj, pg8::StaticOrder, true, true>(lds, g, S, E);
    }
    SEAM(1);

    if (IN(2)) for (int rep_ = 0; rep_ < NREP(2); ++rep_) { if (rep_) xcd_barrier(xbar);
        LAS float* redc = (LAS float*)(lds + 60000 / 16 * 16); LAS float* tot = redc + 128;
        for (int it = bx; it < 1024 + 1088; it += G) {
            __syncthreads();
            if (it < 1024) {
                const int bh = it >> 5, c = it & 31, b = bh >> 3, h = bh & 7;
                const int row0 = b * 2048 + c * 64;
                LAS bf16* KEt = (LAS bf16*)lds;
                LAS bf16* Vt = (LAS bf16*)(lds + 18432);
                LAS float* Tq = (LAS float*)(lds + 36864);
                const int k = tid & 127, qtr = __builtin_amdgcn_readfirstlane(tid >> 7);
                float lf[16], kk[16]; unsigned short iv[16];
#pragma unroll
                for (int s_ = 0; s_ < 16; ++s_) { const size_t gi = (size_t)(row0 + qtr * 16 + s_) * 1024 + h * 128 + k; const float f = F[gi]; lf[s_] = __log2f(f); kk[s_] = 1.0f - f; iv[s_] = I[gi]; }
                float run = 0.f; float suf[16];
#pragma unroll
                for (int s_ = 15; s_ >= 0; --s_) { suf[s_] = run; run += lf[s_]; }
                Tq[qtr * 128 + k] = run;
                { v4u w0, w1;
                  w0.x = iv[0] | ((unsigned)iv[1] << 16); w0.y = iv[2] | ((unsigned)iv[3] << 16); w0.z = iv[4] | ((unsigned)iv[5] << 16); w0.w = iv[6] | ((unsigned)iv[7] << 16);
                  w1.x = iv[8] | ((unsigned)iv[9] << 16); w1.y = iv[10] | ((unsigned)iv[11] << 16); w1.z = iv[12] | ((unsigned)iv[13] << 16); w1.w = iv[14] | ((unsigned)iv[15] << 16);
                  *(LAS v4u*)(Vt + k * 72 + qtr * 16) = w0; *(LAS v4u*)(Vt + k * 72 + qtr * 16 + 8) = w1; }
                __syncthreads();
                float later = 0.f, total = 0.f;
#pragma unroll
                for (int q2 = 0; q2 < 4; ++q2) { const float tq = Tq[q2 * 128 + k]; total += tq; later += q2 > qtr ? tq : 0.f; }
                { float ke[16];
#pragma unroll
                  for (int s_ = 0; s_ < 16; ++s_) ke[s_] = kk[s_] * exp2f(suf[s_] + later);
                  v4u w0, w1;
                  w0.x = pk2(ke[0], ke[1]); w0.y = pk2(ke[2], ke[3]); w0.z = pk2(ke[4], ke[5]); w0.w = pk2(ke[6], ke[7]);
                  w1.x = pk2(ke[8], ke[9]); w1.y = pk2(ke[10], ke[11]); w1.z = pk2(ke[12], ke[13]); w1.w = pk2(ke[14], ke[15]);
                  *(LAS v4u*)(KEt + k * 72 + qtr * 16) = w0; *(LAS v4u*)(KEt + k * 72 + qtr * 16 + 8) = w1; }
                if (qtr == 0) DC[it * 128 + k] = exp2f(total);
                __syncthreads();
                { const int r = lane & 15, q = lane >> 4;
                  const pg8::bf16x8 a0 = *(const LAS pg8::bf16x8*)(Vt + (16 * wave + r) * 72 + 8 * q), a1 = *(const LAS pg8::bf16x8*)(Vt + (16 * wave + r) * 72 + 8 * q + 32);
                  float* sp = ST + (size_t)it * 16384 + (size_t)(16 * wave + 4 * q) * 128 + r;
#pragma unroll
                  for (int kt = 0; kt < 8; ++kt) {
                      const pg8::bf16x8 b0 = *(const LAS pg8::bf16x8*)(KEt + (16 * kt + r) * 72 + 8 * q), b1 = *(const LAS pg8::bf16x8*)(KEt + (16 * kt + r) * 72 + 8 * q + 32);
                      f32x4 acc = (f32x4){0.f, 0.f, 0.f, 0.f};
                      acc = __builtin_amdgcn_mfma_f32_16x16x32_bf16(a0, b0, acc, 0, 0, 0);
                      acc = __builtin_amdgcn_mfma_f32_16x16x32_bf16(a1, b1, acc, 0, 0, 0);
#pragma unroll
                      for (int j = 0; j < 4; ++j) sp[j * 128 + 16 * kt] = acc[j];
                  } }
            } else {
                const int m0 = (it - 1024) * 8;
                const bool samp = m0 >= MP;
                int t0, seq0; const float* hist = cache_conv;
                if (!samp) { t0 = m0 & 2047; seq0 = m0 - t0; }
                else { const int sbi = (m0 - MP) >> 4; t0 = (m0 - MP) & 15; seq0 = MP + sbi * 16; hist = cache_conv + (size_t)sbi * 30 * 1024; }
                LAS float* hbuf = (LAS float*)(lds + 16384);
                float s1[8], s2[8];
#pragma unroll
                for (int t = 0; t < 8; ++t) { s1[t] = 0.f; s2[t] = 0.f; }
#pragma unroll 1
                for (int p = 0; p < 2; ++p) {
                    const int c = tid + p * 512;
                    const unsigned cb2 = (unsigned)c * 2u, cb4 = (unsigned)c * 4u;
                    float w0[38];
#pragma unroll
                    for (int jj = 0; jj < 38; ++jj) {
                        const int tr = t0 - 30 + jj;
                        float a = 0.f;
                        if (tr >= 0) a = bf2f(*(const bf16*)((const char*)(U + (size_t)(seq0 + tr) * 1024) + cb2));
                        else if (samp) a = *(const float*)((const char*)(hist + (30 + tr) * 1024) + cb4);
                        w0[jj] = a;
                    }
                    float a0[8];
                    { const float bb = *(const float*)((const char*)b_dw + cb4);
#pragma unroll
                      for (int t = 0; t < 8; ++t) a0[t] = bb; }
#pragma unroll
                    for (int j = 0; j < 31; ++j) { const float wv = *(const float*)((const char*)(w_dw + j * 1024) + cb4);
#pragma unroll
                        for (int t = 0; t < 8; ++t) a0[t] += wv * w0[t + j]; }
#pragma unroll
                    for (int t = 0; t < 8; ++t) { hbuf[t * 1024 + c] = a0[t]; s1[t] += a0[t]; s2[t] += a0[t] * a0[t]; }
                }
                float st[16];
#pragma unroll
                for (int t = 0; t < 8; ++t) { st[t] = wave_sum(s1[t]); st[8 + t] = wave_sum(s2[t]); }
                if (lane == 0) {
#pragma unroll
                    for (int i = 0; i < 16; ++i) redc[wave * 16 + i] = st[i];
                }
                __syncthreads();
                if (tid < 16) { float s = 0.f;
#pragma unroll
                    for (int w = 0; w < 8; ++w) s += redc[w * 16 + tid];
                    tot[tid] = s; }
                __syncthreads();
                const int c = 2 * tid;
                const f32x2 gg = *(const f32x2*)(cn_g + c), bb2 = *(const f32x2*)(cn_b + c);
#pragma unroll
                for (int t = 0; t < 8; ++t) {
                    const float mu = tot[t] * (1.f / 1024.f); float var = tot[8 + t] * (1.f / 1024.f) - mu * mu; var = var > 0.f ? var : 0.f;
                    const float rstd = 1.f / sqrtf(var + LN_EPS);
                    const f32x2 hv = *(const LAS f32x2*)(hbuf + t * 1024 + c);
                    float y0 = (hv.x - mu) * rstd * gg.x + bb2.x, y1 = (hv.y - mu) * rstd * gg.y + bb2.y;
                    y0 = y0 * sigm(y0); y1 = y1 * sigm(y1);
                    *(unsigned*)(MIX + (size_t)(m0 + t) * 2048 + c) = pk2(y0, y1);
                }
            }
        }
        for (int i = gt; i < 4 * 30 * 1024; i += NT) { const int b = i / 30720, j = (i >> 10) % 30, c = i & 1023;
            out[O_NCP + i] = bf2f(U[(size_t)(b * 2048 + 2018 + j) * 1024 + c]); }
        for (int i = gt; i < 32 * 30 * 1024; i += NT) { const int sb = i / 30720, j = (i >> 10) % 30, c = i & 1023;
            out[O_NCS + i] = j < 14 ? cache_conv[(size_t)sb * 30720 + (16 + j) * 1024 + c] : bf2f(U[(size_t)(MP + sb * 16 + j - 14) * 1024 + c]); }
    }
    SEAM(2);

    if (IN(3)) {
        for (int e = gt; e < 32 * 4096; e += NT) {
            const int bh = e >> 12, r = e & 4095, v = r >> 5, k4 = r & 31;
            f32x4 S = (f32x4){0.f, 0.f, 0.f, 0.f};
#pragma unroll 8
            for (int c = 0; c < 32; ++c) {
                f32x4* p = (f32x4*)(ST + ((size_t)(bh * 32 + c) * 128 + v) * 128 + k4 * 4);
                const f32x4 A = *p; const f32x4 d = *(const f32x4*)(DC + (bh * 32 + c) * 128 + k4 * 4);
                *p = S; S = S * d + A;
            }
            float* o = out + O_NHP + (size_t)bh * 16384 + (size_t)(k4 * 4) * 128 + v;
            o[0] = S.x; o[128] = S.y; o[256] = S.z; o[384] = S.w;
        }
    }
    SEAM(3);

    if (IN(4)) for (int rep_ = 0; rep_ < NREP(4); ++rep_) { if (rep_) xcd_barrier(xbar);
        LAS float* vl = (LAS float*)lds; LAS float* red = (LAS float*)(lds + 8192);
        for (int it = bx; it < 1024 + 256; it += G) {
          if (it < 1024) {
            const int bh = it >> 5, c = it & 31, h = bh & 7, row0 = (bh >> 3) * 2048 + c * 64;
            LAS bf16* St = (LAS bf16*)lds;
            LAS bf16* QD = (LAS bf16*)(lds + 34816);
            LAS bf16* Vt = (LAS bf16*)(lds + 52224);
            LAS bf16* Pm = (LAS bf16*)(lds + 70656);
            LAS bf16* QDI = (LAS bf16*)(lds + 79872);
            LAS bf16* KD = (LAS bf16*)(lds + 97280);
            LAS float* Tq = (LAS float*)(lds + 140800);
            LAS float* Ob = (LAS float*)(lds + 79872);
            __syncthreads();
            const int k = tid & 127, qtr = __builtin_amdgcn_readfirstlane(tid >> 7);
            float pre[16], kk[16], qq[16]; unsigned short iv[16];
#pragma unroll
            for (int s_ = 0; s_ < 16; ++s_) { const size_t gi = (size_t)(row0 + qtr * 16 + s_) * 1024 + h * 128 + k; const float f = F[gi]; pre[s_] = __log2f(f); kk[s_] = 1.0f - f; qq[s_] = bf2f(Q[gi]); iv[s_] = I[gi]; }
            { const float* sp = ST + (size_t)it * 16384;
#pragma unroll
              for (int j = 0; j < 8; ++j) { const int e = tid + 512 * j, v = e >> 5, k4 = e & 31; const f32x4 x = *(const f32x4*)(sp + (size_t)e * 4);
                  v2u w; w.x = pk2(x.x, x.y); w.y = pk2(x.z, x.w); *(LAS v2u*)(St + v * 136 + k4 * 4) = w; } }
#pragma unroll
            for (int s_ = 1; s_ < 16; ++s_) pre[s_] += pre[s_ - 1];
            const float tot = pre[15];
            Tq[qtr * 128 + k] = tot;
            { v4u w0, w1;
              w0.x = iv[0] | ((unsigned)iv[1] << 16); w0.y = iv[2] | ((unsigned)iv[3] << 16); w0.z = iv[4] | ((unsigned)iv[5] << 16); w0.w = iv[6] | ((unsigned)iv[7] << 16);
              w1.x = iv[8] | ((unsigned)iv[9] << 16); w1.y = iv[10] | ((unsigned)iv[11] << 16); w1.z = iv[12] | ((unsigned)iv[13] << 16); w1.w = iv[14] | ((unsigned)iv[15] << 16);
              *(LAS v4u*)(Vt + k * 72 + qtr * 16) = w0; *(LAS v4u*)(Vt + k * 72 + qtr * 16 + 8) = w1; }
            const int kdoff = qtr == 0 ? 0 : (qtr == 1 ? 16 : (qtr == 2 ? 48 : 96));
#pragma unroll
            for (int s_ = 0; s_ < 16; ++s_) {
                QDI[(16 * qtr + s_) * 136 + k] = (bf16)f2bf(qq[s_] * exp2f(pre[s_]));
                KD[(kdoff + 16 * qtr + s_) * 136 + k] = (bf16)f2bf(kk[s_] * exp2f(-pre[s_]));
            }
            __syncthreads();
            { float lb_ = 0.f;
#pragma unroll
              for (int q2 = 0; q2 < 4; ++q2) lb_ += q2 < qtr ? Tq[q2 * 128 + k] : 0.f;
#pragma unroll
              for (int s_ = 0; s_ < 16; ++s_) QD[(16 * qtr + s_) * 136 + k] = (bf16)f2bf(qq[s_] * exp2f(pre[s_] + lb_));
              float gap = 0.f;
              for (int i = qtr + 1; i < 4; ++i) {
                  const int off = i == 1 ? 16 : (i == 2 ? 48 : 96);
#pragma unroll
                  for (int s_ = 0; s_ < 16; ++s_) KD[(off + 16 * qtr + s_) * 136 + k] = (bf16)f2bf(kk[s_] * exp2f((tot - pre[s_]) + gap));
                  gap += Tq[i * 128 + k];
              } }
            __syncthreads();
            const int r = lane & 15, q = lane >> 4;
            for (int n = wave; n < 10; n += 8) {
                const int i = n == 0 ? 0 : (n < 3 ? 1 : (n < 6 ? 2 : 3)), j = n - (i == 0 ? 0 : (i == 1 ? 1 : (i == 2 ? 3 : 6)));
                const int off = i == 0 ? 0 : (i == 1 ? 16 : (i == 2 ? 48 : 96));
                f32x4 acc = (f32x4){0.f, 0.f, 0.f, 0.f};
#pragma unroll
                for (int ks = 0; ks < 4; ++ks) {
                    const pg8::bf16x8 a = *(const LAS pg8::bf16x8*)(QDI + (16 * i + r) * 136 + 8 * q + 32 * ks);
                    const pg8::bf16x8 bq = *(const LAS pg8::bf16x8*)(KD + (off + 16 * j + r) * 136 + 8 * q + 32 * ks);
                    acc = __builtin_amdgcn_mfma_f32_16x16x32_bf16(a, bq, acc, 0, 0, 0);
                }
#pragma unroll
                for (int jj = 0; jj < 4; ++jj) { const float x = (i != j || r <= 4 * q + jj) ? acc[jj] : 0.f; Pm[(16 * i + 4 * q + jj) * 72 + 16 * j + r] = (bf16)f2bf(x); }
            }
            if (wave == 2 || wave == 3) { const int i = wave == 2 ? 0 : 2, j = i + 1;
#pragma unroll
                for (int jj = 0; jj < 4; ++jj) Pm[(16 * i + 4 * q + jj) * 72 + 16 * j + r] = (bf16)0; }
            __syncthreads();
            { const int i = wave >> 1, vt0 = 4 * (wave & 1);
              pg8::bf16x8 pa[2], qa[4];
#pragma unroll
              for (int ks = 0; ks < 2; ++ks) pa[ks] = *(const LAS pg8::bf16x8*)(Pm + (16 * i + r) * 72 + 8 * q + 32 * ks);
#pragma unroll
              for (int ks = 0; ks < 4; ++ks) qa[ks] = *(const LAS pg8::bf16x8*)(QD + (16 * i + r) * 136 + 8 * q + 32 * ks);
#pragma unroll
              for (int vv = 0; vv < 4; ++vv) { const int vt = vt0 + vv;
                  f32x4 acc = (f32x4){0.f, 0.f, 0.f, 0.f};
                  acc = __builtin_amdgcn_mfma_f32_16x16x32_bf16(pa[0], *(const LAS pg8::bf16x8*)(Vt + (16 * vt + r) * 72 + 8 * q), acc, 0, 0, 0);
                  if (i >= 2) acc = __builtin_amdgcn_mfma_f32_16x16x32_bf16(pa[1], *(const LAS pg8::bf16x8*)(Vt + (16 * vt + r) * 72 + 8 * q + 32), acc, 0, 0, 0);
#pragma unroll
                  for (int ks = 0; ks < 4; ++ks) acc = __builtin_amdgcn_mfma_f32_16x16x32_bf16(qa[ks], *(const LAS pg8::bf16x8*)(St + (16 * vt + r) * 136 + 8 * q + 32 * ks), acc, 0, 0, 0);
#pragma unroll
                  for (int jj = 0; jj < 4; ++jj) Ob[(16 * i + 4 * q + jj) * 132 + 16 * vt + r] = acc[jj];
              } }
            __syncthreads();
#pragma unroll 2
            for (int tt = 0; tt < 8; ++tt) {
                const int t = wave * 8 + tt;
                const float o0 = Ob[t * 132 + lane], o1 = Ob[t * 132 + 64 + lane];
                const float ss = wave_sum(o0 * o0 + o1 * o1);
                const float rr = 1.f / sqrtf(ss * (1.f / 128.f) + LN_EPS);
                const size_t m = (size_t)(row0 + t);
                const float g0 = bf2f(Gt[m * 1024 + h * 128 + lane]), g1 = bf2f(Gt[m * 1024 + h * 128 + 64 + lane]);
                MIX[m * 2048 + 1024 + h * 128 + lane] = (bf16)f2bf(o0 * rr * hg_ng[lane] * g0);
                MIX[m * 2048 + 1024 + h * 128 + 64 + lane] = (bf16)f2bf(o1 * rr * hg_ng[64 + lane] * g1);
            }
          } else {
            int row0, h, nsb; const float* sinit; float* sfin = nullptr;
            if (it < 1024) { const int bh = it >> 5, c = it & 31; h = bh & 7; row0 = (bh >> 3) * 2048 + c * 64; nsb = 4; sinit = ST + (size_t)it * 16384; }
            else { const int j = it - 1024; h = j & 7; row0 = MP + (j >> 3) * 16; nsb = 1; sinit = state_hgrn + (size_t)j * 16384; sfin = out + O_NHS + (size_t)j * 16384; }
            f32x2 Sa[8], Sb[8];
            { const float* sp = sinit + (size_t)(wave * 16) * 128 + lane;
#pragma unroll
              for (int i = 0; i < 8; ++i) { Sa[i] = (f32x2){sp[(2 * i) * 128], sp[(2 * i + 1) * 128]}; Sb[i] = (f32x2){sp[(2 * i) * 128 + 64], sp[(2 * i + 1) * 128 + 64]}; } }
            for (int sb = 0; sb < nsb; ++sb) {
                __syncthreads();
#pragma unroll
                for (int e4 = 0; e4 < 4; ++e4) { const int e = tid + e4 * 512, t = e >> 7, k = e & 127; const size_t gi = (size_t)(row0 + sb * 16 + t) * 1024 + h * 128 + k;
                    vl[e] = bf2f(I[gi]); }
                __syncthreads();
                const CAS float* fbase = (const CAS float*)(F + (size_t)(row0 + sb * 16) * 1024 + h * 128 + wave * 16);
                const CAS unsigned* qbase = (const CAS unsigned*)(Q + (size_t)(row0 + sb * 16) * 1024 + h * 128 + wave * 16);
#pragma unroll 2
                for (int t = 0; t < 16; ++t) {
                    const f32x16 f = *(const CAS f32x16*)(fbase + t * 1024);
                    const u32x8 qp = *(const CAS u32x8*)(qbase + t * 512);
                    const float va = vl[t * 128 + lane], vb = vl[t * 128 + 64 + lane];
                    const f32x2 va2 = (f32x2){va, va}, vb2 = (f32x2){vb, vb};
                    f32x2 oa = (f32x2){0.f, 0.f}, ob = (f32x2){0.f, 0.f};
#pragma unroll
                    for (int i = 0; i < 8; ++i) { const f32x2 f2 = (f32x2){f[2 * i], f[2 * i + 1]};
                        const f32x2 q2 = (f32x2){__uint_as_float(qp[i] << 16), __uint_as_float(qp[i] & 0xffff0000u)};
                        Sa[i] = f2 * (Sa[i] - va2) + va2; Sb[i] = f2 * (Sb[i] - vb2) + vb2;
                        oa += q2 * Sa[i]; ob += q2 * Sb[i]; }
                    red[(wave * 16 + t) * 128 + lane] = oa.x + oa.y; red[(wave * 16 + t) * 128 + 64 + lane] = ob.x + ob.y;
                }
                __syncthreads();
#pragma unroll
                for (int tt = 0; tt < 2; ++tt) {
                    const int t = wave * 2 + tt;
                    float o0 = 0.f, o1 = 0.f;
#pragma unroll
                    for (int q8 = 0; q8 < 8; ++q8) { o0 += red[(q8 * 16 + t) * 128 + lane]; o1 += red[(q8 * 16 + t) * 128 + 64 + lane]; }
                    const float ss = wave_sum(o0 * o0 + o1 * o1);
                    const float r = 1.f / sqrtf(ss * (1.f / 128.f) + LN_EPS);
                    const size_t m = (size_t)(row0 + sb * 16 + t);
                    const float g0 = bf2f(Gt[m * 1024 + h * 128 + lane]), g1 = bf2f(Gt[m * 1024 + h * 128 + 64 + lane]);
                    MIX[m * 2048 + 1024 + h * 128 + lane] = (bf16)f2bf(o0 * r * hg_ng[lane] * g0);
                    MIX[m * 2048 + 1024 + h * 128 + 64 + lane] = (bf16)f2bf(o1 * r * hg_ng[64 + lane] * g1);
                }
            }
            if (sfin) { float* sp = sfin + (size_t)(wave * 16) * 128 + lane;
#pragma unroll
                for (int i = 0; i < 8; ++i) { sp[(2 * i) * 128] = Sa[i].x; sp[(2 * i + 1) * 128] = Sa[i].y; sp[(2 * i) * 128 + 64] = Sb[i].x; sp[(2 * i + 1) * 128 + 64] = Sb[i].y; } }
          }
        }
        __syncthreads();
    }
    SEAM(4);

    if (IN(5)) for (int rep_ = 0; rep_ < NREP(5); ++rep_) { if (rep_) xcd_barrier(xbar);
        pg8::Gemm g{MIX, WOUT, M, D, D}; pg8::StaticOrder S; S.init(M, D, D, G, bx, MP, SPLIT5);
        pg8::EpiRes E{x_prompt, x_sample, out, MP, ALPHA, (float*)(ws + WS_PB5)};
        pg8::gemm_phase<pg8::EpiRes, pg8::StaticOrder, true, true>(lds, g, S, E);
    }
    SEAM(5);

    if (IN(6)) {
        for (int m = gw; m < M; m += NGW) {
            if (m < MP) ln_row(out + (size_t)m * D, nullptr, 0, 0, 1.f, out + (size_t)m * D, XB + (size_t)m * D, ln1_g, ln1_b, lane);
            else ln_row(x_sample + (size_t)(m - MP) * D, (const float*)(ws + WS_PB5) + (size_t)(m - MP) * D, SPLIT5, (size_t)MS * D, ALPHA, out + (size_t)m * D, XB + (size_t)m * D, ln1_g, ln1_b, lane);
        }
    }
    SEAM(6);

    if (IN(7)) for (int rep_ = 0; rep_ < NREP(7); ++rep_) { if (rep_) xcd_barrier(xbar);
        pg8::Gemm g{XB, WGU, M, 2 * FF, D}; pg8::StaticOrder S; S.init(M, 2 * FF, D, G, bx);
        pg8::EpiGateUp E{ACT, FF};
        pg8::gemm_phase<pg8::EpiGateUp, pg8::StaticOrder, true, true>(lds, g, S, E);
    }
    SEAM(7);

    if (IN(8)) {
        pg8::Gemm g{ACT, WDN, M, D, FF}; pg8::StaticOrder S; S.init(M, D, FF, G, bx, MP, SPLIT8);
        pg8::EpiRes E{out, out + (size_t)MP * D, out, MP, ALPHA, (float*)(ws + WS_PB8)};
        pg8::gemm_phase<pg8::EpiRes, pg8::StaticOrder, true, true>(lds, g, S, E);
    }
    SEAM(8);

    if (IN(9)) {
        for (int m = gw; m < M; m += NGW) {
            if (m < MP) ln_row(out + (size_t)m * D, nullptr, 0, 0, 1.f, out + (size_t)m * D, nullptr, ln2_g, ln2_b, lane);
            else ln_row(out + (size_t)m * D, (const float*)(ws + WS_PB8) + (size_t)(m - MP) * D, SPLIT8, (size_t)MS * D, ALPHA, out + (size_t)m * D, nullptr, ln2_g, ln2_b, lane);
        }
    }
#undef IN
#undef SEAM
}

#undef x_prompt
#undef x_sample
#undef cache_conv
#undef state_hgrn
#undef w_in
#undef b_in
#undef w_dw
#undef b_dw
#undef cn_g
#undef cn_b
#undef hlb
#undef hg_ng
#undef w_out
#undef ln1_g
#undef ln1_b
#undef w_gate
#undef w_up
#undef w_down
#undef ln2_g
#undef ln2_b
#undef out
#undef ws
#undef LB
#undef BIASP
#undef WIN
#undef WOUT
#undef WGU
#undef WDN
#undef XB
#undef MIX
#undef U
#undef Q
#undef F
#undef I
#undef Gt
#undef ACT
#undef ST
#undef DC

extern "C" void kernel_launch(void* const* d_in, const int* in_sizes, int n_in, void* d_out, int out_size, void* d_ws, size_t ws_size, hipStream_t stream) {
    static int grid = 0;
    if (grid == 0) {
        int dev = 0, cus = 0, per_cu = 0;
        if (n_in != 20 || ws_size < WS_END) { fprintf(stderr, "kernel_launch: unexpected n_in %d / ws_size %zu\n", n_in, ws_size); grid = -1; return; }
        if (hipGetDevice(&dev) != hipSuccess || hipDeviceGetAttribute(&cus, hipDeviceAttributeMultiprocessorCount, dev) != hipSuccess) { grid = -1; return; }
        if (hipFuncSetAttribute((const void*)fwd_kernel, hipFuncAttributeMaxDynamicSharedMemorySize, LDS_BYTES) != hipSuccess) { fprintf(stderr, "kernel_launch: hipFuncSetAttribute failed\n"); grid = -1; return; }
        if (hipOccupancyMaxActiveBlocksPerMultiprocessor(&per_cu, (const void*)fwd_kernel, NWAVES * 64, LDS_BYTES) != hipSuccess || per_cu < 1) { fprintf(stderr, "kernel_launch: occupancy query says %d\n", per_cu); }
        (void)hipGetLastError();
        grid = cus;
    }
    if (grid < 0) return;
    if (hipMemsetAsync(d_ws, 0, 16384, stream) != hipSuccess) { fprintf(stderr, "kernel_launch: memset failed\n"); return; }
    Args a{};
    for (int i = 0; i < 20; ++i) a.in[i] = (const float*)d_in[i];
    a.out = (float*)d_out; a.ws = (unsigned char*)d_ws;
#if MK_ONE_LAUNCH
    a.ph_lo = 0; a.ph_hi = N_PHASES;
    void* kargs[] = {&a};
    hipError_t e = hipLaunchCooperativeKernel((const void*)fwd_kernel, dim3(grid), dim3(NWAVES * 64), kargs, LDS_BYTES, stream);
    if (e != hipSuccess) fprintf(stderr, "cooperative launch failed: %s (grid %d)\n", hipGetErrorString(e), grid);
#else
    for (int p = 0; p < N_PHASES; ++p) {
        a.ph_lo = p; a.ph_hi = p + 1;
        hipLaunchKernelGGL(fwd_kernel, dim3(grid), dim3(NWAVES * 64), LDS_BYTES, stream, a);
    }
#endif
}
```

```cpp
#include <hip/hip_runtime.h>
#include <hip/hip_cooperative_groups.h>
#include <cstdio>
#include <cstdint>
namespace cg = cooperative_groups;

#ifndef MK_ONE_LAUNCH
#define MK_ONE_LAUNCH 1
#endif

namespace pg8 {
#define PG8_LAS __attribute__((address_space(3)))
typedef unsigned short bf16_t;
typedef short bf16x8 __attribute__((ext_vector_type(8)));
typedef float f32x4 __attribute__((ext_vector_type(4)));
typedef unsigned u32x4 __attribute__((ext_vector_type(4)));
typedef unsigned u32x2 __attribute__((ext_vector_type(2)));
constexpr int BM = 256, BK = 64, HALF = 128, HTB = HALF * BK * 2, STAGE_BYTES = 8 * HTB, NXCD = 8, WGM = 8;

__host__ __device__ __forceinline__ int lds_byte(int r, int c) { const int st = (r >> 4) * 2 + (c >> 5), rr = r & 15, cc = c & 31, ob = rr * 64 + cc * 2; return st * 1024 + (ob ^ (((ob >> 9) & 1) << 5)); }
__host__ __device__ __forceinline__ void stage_rc(int b, int& R, int& C) { const int st = b / 1024, sb = b % 1024, swz = sb ^ (((sb >> 9) & 1) << 5); R = (st >> 1) * 16 + swz / 64; C = (st & 1) * 32 + (swz % 64) / 2; }
__host__ __device__ __forceinline__ int perm32(int rho) { const int n = rho >> 4, i = rho & 15; return 8 * (i >> 2) + 4 * n + (i & 3); }

struct Unit { int pm, pn, kt0, nkt, ks; };
struct Gemm { const bf16_t* A; const bf16_t* Bt; int M, N, K; };

struct StaticOrder {
    int nM, nMf, nN, nfull, nitems, G, c, nt, nsplit;
    __host__ __device__ void init(int M, int N, int K, int G_, int c_, int Mfull = -1, int nsplit_ = 1) {
        nM = M / BM; nMf = Mfull < 0 ? nM : Mfull / BM; nN = N / BM; nt = K / BK; nsplit = nsplit_; nfull = nMf * nN; nitems = nfull + (nM - nMf) * nN * nsplit; G = G_; c = c_; }
    __host__ __device__ bool next(int i, Unit& u) const {
        const long L = (long)i * G + c; if (L >= nitems) return false;
        if (L >= nfull) { const int sidx = (int)L - nfull, un = sidx / nsplit, ks = sidx % nsplit, per = nt / nsplit;
            u.pm = nMf + un / nN; u.pn = un % nN; u.kt0 = ks * per; u.nkt = per; u.ks = ks; return true; }
        int wgid = (int)L; { const int q = nfull / NXCD, r = nfull % NXCD, xcd = wgid % NXCD, off = wgid / NXCD; wgid = (xcd < r ? xcd * (q + 1) : r * (q + 1) + (xcd - r) * q) + off; }
        const int nig = WGM * nN, gid = wgid / nig, fm = gid * WGM, gsz = (nMf - fm) < WGM ? (nMf - fm) : WGM;
        u.pm = fm + ((wgid % nig) % gsz); u.pn = (wgid % nig) / gsz; u.kt0 = 0; u.nkt = nt; u.ks = -1; return true;
    }
    __device__ __forceinline__ void a_ready(const Unit&) const {}
    __device__ __forceinline__ void done(const Unit&) const {}
};

__device__ __forceinline__ unsigned cvt_pk_bf16(float lo, float hi) { unsigned r; asm volatile("v_cvt_pk_bf16_f32 %0, %1, %2" : "=v"(r) : "v"(lo), "v"(hi)); return r; }
__device__ __forceinline__ float sigm(float x) { return __builtin_amdgcn_rcpf(1.0f + __expf(-x)); }

struct EpiProj {
    static constexpr bool PERM = true, AFTER_DRAIN = false;
    bf16_t *U, *QIG; float* F; const float* bias; const float* lb;
    __device__ __forceinline__ void operator()(const f32x4 (&acc)[2][2][4][2], const Unit& u, int wr, int wc, int fr, int fq) const {
        const int row0 = u.pm * BM + wr * 64 + fr;
        const int cl = wc * 32 + 8 * fq;
        const int bcol = u.pn * BM + cl;
        f32x4 bv[2][2];
#pragma unroll
        for (int bj = 0; bj < 2; ++bj)
#pragma unroll
            for (int n = 0; n < 2; ++n) bv[bj][n] = *(const f32x4*)(bias + bcol + bj * HALF + 4 * n);
        if (u.pn < 8) {
#pragma unroll
            for (int ai = 0; ai < 2; ++ai)
#pragma unroll
                for (int m = 0; m < 4; ++m) {
                    const size_t row = (size_t)(row0 + ai * HALF + m * 16);
                    float o[8];
#pragma unroll
                    for (int n = 0; n < 2; ++n) { const f32x4 a = acc[ai][0][m][n] + bv[0][n], g = acc[ai][1][m][n] + bv[1][n];
#pragma unroll
                        for (int e = 0; e < 4; ++e) o[n * 4 + e] = a[e] * sigm(g[e]); }
                    u32x4 w; w.x = cvt_pk_bf16(o[0], o[1]); w.y = cvt_pk_bf16(o[2], o[3]); w.z = cvt_pk_bf16(o[4], o[5]); w.w = cvt_pk_bf16(o[6], o[7]);
                    *(u32x4*)(U + row * 1024 + u.pn * HALF + cl) = w;
                }
        } else {
            const int grp = (u.pn - 8) >> 2;
            const int cbase = ((u.pn - 8) & 3) * BM + cl;
            if (grp == 1) {
                f32x4 lv[2][2];
#pragma unroll
                for (int bj = 0; bj < 2; ++bj)
#pragma unroll
                    for (int n = 0; n < 2; ++n) lv[bj][n] = *(const f32x4*)(lb + cbase + bj * HALF + 4 * n);
#pragma unroll
                for (int ai = 0; ai < 2; ++ai)
#pragma unroll
                    for (int m = 0; m < 4; ++m) {
                        const size_t row = (size_t)(row0 + ai * HALF + m * 16);
#pragma unroll
                        for (int bj = 0; bj < 2; ++bj)
#pragma unroll
                            for (int n = 0; n < 2; ++n) { const f32x4 x = acc[ai][bj][m][n] + bv[bj][n]; const f32x4 l = lv[bj][n]; f32x4 o;
#pragma unroll
                                for (int e = 0; e < 4; ++e) o[e] = l[e] + (1.0f - l[e]) * sigm(x[e]);
                                *(f32x4*)(F + row * 1024 + cbase + bj * HALF + 4 * n) = o; }
                    }
            } else {
                bf16_t* O = QIG + (size_t)(grp - (grp > 0 ? 1 : 0)) * ((size_t)8704 * 1024);
                const bool act = grp != 2;
#pragma unroll
                for (int ai = 0; ai < 2; ++ai)
#pragma unroll
                    for (int m = 0; m < 4; ++m) {
                        const size_t row = (size_t)(row0 + ai * HALF + m * 16);
#pragma unroll
                        for (int bj = 0; bj < 2; ++bj) { float o[8];
#pragma unroll
                            for (int n = 0; n < 2; ++n) { const f32x4 x = acc[ai][bj][m][n] + bv[bj][n];
#pragma unroll
                                for (int e = 0; e < 4; ++e) o[n * 4 + e] = act ? x[e] * sigm(x[e]) : x[e]; }
                            u32x4 w; w.x = cvt_pk_bf16(o[0], o[1]); w.y = cvt_pk_bf16(o[2], o[3]); w.z = cvt_pk_bf16(o[4], o[5]); w.w = cvt_pk_bf16(o[6], o[7]);
                            *(u32x4*)(O + row * 1024 + cbase + bj * HALF) = w; }
                    }
            }
        }
    }
};
struct EpiRes {
    static constexpr bool PERM = false, AFTER_DRAIN = false;
    const float* baseP; const float* baseS; float* out; int split; float alpha; float* part;
    __device__ __forceinline__ void operator()(const f32x4 (&acc)[2][2][4][2], const Unit& u, int wr, int wc, int fr, int fq) const {
        const int row0 = u.pm * BM + wr * 64 + fr;
        const int col0 = u.pn * BM + wc * 32 + 4 * fq;
        if (u.ks >= 0) {
            float* pb = part + (size_t)u.ks * 512 * 2048;
#pragma unroll
            for (int ai = 0; ai < 2; ++ai)
#pragma unroll
                for (int m = 0; m < 4; ++m) { float* op = pb + (size_t)(row0 + ai * HALF + m * 16 - split) * 2048;
#pragma unroll
                    for (int bj = 0; bj < 2; ++bj)
#pragma unroll
                        for (int n = 0; n < 2; ++n) *(f32x4*)(op + col0 + bj * HALF + n * 16) = acc[ai][bj][m][n]; }
            return;
        }
#pragma unroll
        for (int ai = 0; ai < 2; ++ai)
#pragma unroll
            for (int m = 0; m < 4; ++m) {
                const int row = row0 + ai * HALF + m * 16;
                const float* bp = row < split ? baseP + (size_t)row * 2048 : baseS + (size_t)(row - split) * 2048;
                float* op = out + (size_t)row * 2048;
#pragma unroll
                for (int bj = 0; bj < 2; ++bj)
#pragma unroll
                    for (int n = 0; n < 2; ++n) { const int c = col0 + bj * HALF + n * 16; const f32x4 b = *(const f32x4*)(bp + c); *(f32x4*)(op + c) = b * alpha + acc[ai][bj][m][n]; }
            }
    }
};
struct EpiGateUp {
    static constexpr bool PERM = true, AFTER_DRAIN = false;
    bf16_t* O; int ldc;
    __device__ __forceinline__ void operator()(const f32x4 (&acc)[2][2][4][2], const Unit& u, int wr, int wc, int fr, int fq) const {
        const int row0 = u.pm * BM + wr * 64 + fr;
        const int cl = wc * 32 + 8 * fq;
#pragma unroll
        for (int ai = 0; ai < 2; ++ai)
#pragma unroll
            for (int m = 0; m < 4; ++m) {
                const size_t row = (size_t)(row0 + ai * HALF + m * 16);
                float o[8];
#pragma unroll
                for (int n = 0; n < 2; ++n) { const f32x4 g = acc[ai][0][m][n], up = acc[ai][1][m][n];
#pragma unroll
                    for (int e = 0; e < 4; ++e) o[n * 4 + e] = g[e] * sigm(g[e]) * up[e]; }
                u32x4 w; w.x = cvt_pk_bf16(o[0], o[1]); w.y = cvt_pk_bf16(o[2], o[3]); w.z = cvt_pk_bf16(o[4], o[5]); w.w = cvt_pk_bf16(o[6], o[7]);
                *(u32x4*)(O + row * ldc + u.pn * HALF + cl) = w;
            }
    }
};

template <class Epi, class Sched, bool ALIGN_EPI = false, bool SP2 = false>
__device__ __forceinline__ void gemm_phase(PG8_LAS unsigned char* lds, const Gemm g, const Sched& S, const Epi& E) {
    int tid_ = threadIdx.x; asm volatile("" : "+v"(tid_));
    const int tid = tid_, wid = __builtin_amdgcn_readfirstlane(tid >> 6), lane = tid & 63, wr = wid >> 2, wc = wid & 3, fr = lane & 15, fq = lane >> 4;
    const int K = g.K;
    unsigned voffA[2], voffB[2];
#pragma unroll
    for (int i = 0; i < 2; ++i) { int R, C; stage_rc(tid * 16 + i * 8192, R, C); const int Rb = Epi::PERM ? ((R & ~31) + perm32(R & 31)) : R;
        voffA[i] = (unsigned)(R * K + C) * 2u; voffB[i] = (unsigned)(Rb * K + C) * 2u; }
    const size_t kstep = (size_t)(BK * 2);
    const size_t hstep = (size_t)HALF * K * 2;
    const size_t tstep = 2 * hstep;
    const unsigned ldsw = (unsigned)wid * 1024u;
    const int aoff = lds_byte(wr * 64 + fr, fq * 8), boff = lds_byte(wc * 32 + fr, fq * 8);
#define PG8_SA(b, h) (((b) * 2 + (h)) * HTB)
#define PG8_SB(b, h) ((4 + (b) * 2 + (h)) * HTB)
#define PG8_STAGE(bufoff, gbase, voff) do { _Pragma("unroll") for (int _i = 0; _i < 2; ++_i) \
        __builtin_amdgcn_global_load_lds((const unsigned*)((const char*)(gbase) + (voff)[_i]), (PG8_LAS unsigned*)(lds + (bufoff) + ldsw + _i * 8192), 16, 0, 0); } while (0)
#define PG8_LDA(dst, b, h) do { _Pragma("unroll") for (int m = 0; m < 4; ++m) _Pragma("unroll") for (int k = 0; k < 2; ++k) dst[m][k] = *(const PG8_LAS bf16x8*)(lds + PG8_SA(b, h) + aoff + m * 2048 + k * 1024); } while (0)
#define PG8_LDB(dst, b, h) do { _Pragma("unroll") for (int n = 0; n < 2; ++n) _Pragma("unroll") for (int k = 0; k < 2; ++k) dst[n][k] = *(const PG8_LAS bf16x8*)(lds + PG8_SB(b, h) + boff + n * 2048 + k * 1024); } while (0)
#define PG8_MMA(ai, bj, At, Bt) do { __builtin_amdgcn_s_setprio(1); _Pragma("unroll") for (int m = 0; m < 4; ++m) _Pragma("unroll") for (int n = 0; n < 2; ++n) _Pragma("unroll") for (int k = 0; k < 2; ++k) \
        acc[ai][bj][m][n] = __builtin_amdgcn_mfma_f32_16x16x32_bf16(Bt[n][k], At[m][k], acc[ai][bj][m][n], 0, 0, 0); __builtin_amdgcn_s_setprio(0); } while (0)
#define PG8_WAIT_V(n) asm volatile("s_waitcnt vmcnt(" #n ")" ::: "memory")
#define PG8_WAIT_L(n) asm volatile("s_waitcnt lgkmcnt(" #n ")" ::: "memory")
#define PG8_BAR __builtin_amdgcn_s_barrier()
#define PG8_SCHED __builtin_amdgcn_sched_barrier(0)
    Unit cur, nxt; int ui = 0;
    if (!S.next(0, cur)) return;
    f32x4 acc[2][2][4][2];
#pragma unroll
    for (int a = 0; a < 2; ++a)
#pragma unroll
        for (int b = 0; b < 2; ++b)
#pragma unroll
            for (int m = 0; m < 4; ++m)
#pragma unroll
                for (int n = 0; n < 2; ++n) acc[a][b][m][n] = (f32x4){0.f, 0.f, 0.f, 0.f};
    bf16x8 At[4][2], B0[2][2], B1[2][2];
    const char* cA = (const char*)g.A + (size_t)cur.pm * tstep + (size_t)cur.kt0 * kstep; const char* cB = (const char*)g.Bt + (size_t)cur.pn * tstep + (size_t)cur.kt0 * kstep;
    S.a_ready(cur);
    if constexpr (SP2) {
        PG8_STAGE(PG8_SB(0, 0), cB, voffB); PG8_STAGE(PG8_SB(0, 1), cB + hstep, voffB); PG8_STAGE(PG8_SA(0, 0), cA, voffA); PG8_STAGE(PG8_SA(0, 1), cA + hstep, voffA);
        if (wr == 1) PG8_BAR;
        PG8_WAIT_V(2); PG8_BAR;
        PG8_STAGE(PG8_SB(1, 0), cB + kstep, voffB); PG8_STAGE(PG8_SA(1, 0), cA + kstep, voffA); PG8_STAGE(PG8_SB(1, 1), cB + hstep + kstep, voffB);
        PG8_WAIT_V(6); PG8_BAR;
    } else {
        PG8_STAGE(PG8_SB(0, 0), cB, voffB); PG8_STAGE(PG8_SA(0, 0), cA, voffA); PG8_STAGE(PG8_SB(0, 1), cB + hstep, voffB); PG8_STAGE(PG8_SA(0, 1), cA + hstep, voffA);
        if (wr == 1) PG8_BAR;
        PG8_WAIT_V(4); PG8_BAR;
        PG8_STAGE(PG8_SB(1, 0), cB + kstep, voffB); PG8_STAGE(PG8_SA(1, 0), cA + kstep, voffA); PG8_STAGE(PG8_SB(1, 1), cB + hstep + kstep, voffB);
        PG8_WAIT_V(6); PG8_BAR;
    }
    for (;;) {
        const bool has_next = S.next(ui + 1, nxt);
        const char* nA = has_next ? (const char*)g.A + (size_t)nxt.pm * tstep + (size_t)nxt.kt0 * kstep : cA; const char* nB = has_next ? (const char*)g.Bt + (size_t)nxt.pn * tstep + (size_t)nxt.kt0 * kstep : cB;
        const int nt = cur.nkt;
        for (int t = 0; t < nt; t += 2) {
            const bool last = (t == nt - 2);
            const char* a1 = cA + (size_t)(t + 1) * kstep;
            const char* a2 = last ? nA : cA + (size_t)(t + 2) * kstep; const char* b2 = last ? nB : cB + (size_t)(t + 2) * kstep;
            const char* a3 = a2 + kstep; const char* b3 = b2 + kstep;
            if (last && has_next) S.a_ready(nxt);
            if constexpr (SP2) {
            PG8_LDB(B0, 0, 0); PG8_LDB(B1, 0, 1); PG8_SCHED; PG8_LDA(At, 0, 0); PG8_STAGE(PG8_SA(1, 1), a1 + hstep, voffA);
            PG8_WAIT_V(8); PG8_WAIT_L(0); PG8_BAR; PG8_MMA(0, 0, At, B0); PG8_MMA(0, 1, At, B1); PG8_BAR; PG8_SCHED;
            PG8_LDA(At, 0, 1); PG8_STAGE(PG8_SB(0, 0), b2, voffB); PG8_STAGE(PG8_SB(0, 1), b2 + hstep, voffB); PG8_STAGE(PG8_SA(0, 0), a2, voffA);
            PG8_WAIT_V(8); PG8_WAIT_L(0); PG8_BAR; PG8_MMA(1, 0, At, B0); PG8_MMA(1, 1, At, B1); PG8_BAR; PG8_SCHED;
            PG8_LDB(B0, 1, 0); PG8_LDB(B1, 1, 1); PG8_SCHED; PG8_LDA(At, 1, 0); PG8_STAGE(PG8_SA(0, 1), a2 + hstep, voffA);
            PG8_WAIT_V(8); PG8_WAIT_L(0); PG8_BAR; PG8_MMA(0, 0, At, B0); PG8_MMA(0, 1, At, B1); PG8_BAR; PG8_SCHED;
            PG8_LDA(At, 1, 1); PG8_STAGE(PG8_SB(1, 0), b3, voffB); PG8_STAGE(PG8_SB(1, 1), b3 + hstep, voffB); PG8_STAGE(PG8_SA(1, 0), a3, voffA);
            PG8_WAIT_V(8); PG8_WAIT_L(0); PG8_BAR; PG8_MMA(1, 0, At, B0); PG8_MMA(1, 1, At, B1); PG8_BAR; PG8_SCHED;
            } else {
            PG8_LDB(B0, 0, 0); PG8_SCHED; PG8_LDA(At, 0, 0); PG8_STAGE(PG8_SA(1, 1), a1 + hstep, voffA);
            PG8_WAIT_L(8); PG8_BAR; PG8_WAIT_L(0); PG8_MMA(0, 0, At, B0); PG8_BAR; PG8_SCHED;
            PG8_LDB(B1, 0, 1); PG8_STAGE(PG8_SB(0, 0), b2, voffB);
            PG8_BAR; PG8_WAIT_L(0); PG8_MMA(0, 1, At, B1); PG8_BAR;
            PG8_LDA(At, 0, 1); PG8_STAGE(PG8_SA(0, 0), a2, voffA);
            PG8_BAR; PG8_WAIT_L(0); PG8_MMA(1, 0, At, B0); PG8_BAR; PG8_SCHED;
            PG8_STAGE(PG8_SB(0, 1), b2 + hstep, voffB);
            PG8_WAIT_V(6); PG8_BAR; PG8_MMA(1, 1, At, B1); PG8_BAR;
            PG8_LDB(B0, 1, 0); PG8_SCHED; PG8_LDA(At, 1, 0); PG8_STAGE(PG8_SA(0, 1), a2 + hstep, voffA);
            PG8_WAIT_L(8); PG8_BAR; PG8_WAIT_L(0); PG8_MMA(0, 0, At, B0); PG8_BAR; PG8_SCHED;
            PG8_LDB(B1, 1, 1); PG8_STAGE(PG8_SB(1, 0), b3, voffB);
            PG8_BAR; PG8_WAIT_L(0); PG8_MMA(0, 1, At, B1); PG8_BAR;
            PG8_LDA(At, 1, 1); PG8_STAGE(PG8_SA(1, 0), a3, voffA);
            PG8_BAR; PG8_WAIT_L(0); PG8_MMA(1, 0, At, B0); PG8_BAR; PG8_SCHED;
            PG8_STAGE(PG8_SB(1, 1), b3 + hstep, voffB);
            PG8_WAIT_V(6); PG8_BAR; PG8_MMA(1, 1, At, B1); PG8_BAR;
            }
        }
        if constexpr (ALIGN_EPI) { if (wr == 0) PG8_BAR; }
        if constexpr (!Epi::AFTER_DRAIN) { E(acc, cur, wr, wc, fr, fq); S.done(cur); }
        if (!has_next) break;
#pragma unroll
        for (int a = 0; a < 2; ++a)
#pragma unroll
            for (int b = 0; b < 2; ++b)
#pragma unroll
                for (int m = 0; m < 4; ++m)
#pragma unroll
                    for (int n = 0; n < 2; ++n) acc[a][b][m][n] = (f32x4){0.f, 0.f, 0.f, 0.f};
        cur = nxt; cA = nA; cB = nB; ++ui;
        if constexpr (ALIGN_EPI) { if (wr == 1) PG8_BAR; }
    }
    PG8_WAIT_V(0);
    if constexpr (!ALIGN_EPI) { if (wr == 0) PG8_BAR; }
    PG8_BAR;
#undef PG8_SA
#undef PG8_SB
#undef PG8_STAGE
#undef PG8_LDA
#undef PG8_LDB
#undef PG8_MMA
#undef PG8_WAIT_V
#undef PG8_WAIT_L
#undef PG8_BAR
#undef PG8_SCHED
}
}

constexpr int D = 2048, MP = 8192, MS = 512, M = MP + MS, CW = 1024, NH = 8, HD = 128, FF = 5632, NIN = 6144;
constexpr float LN_EPS = 1e-5f;
constexpr float ALPHA = 1.189207115002721f;
constexpr int NWAVES = 8;
constexpr int LDS_BYTES = 147456;
constexpr int N_PHASES = 10;

constexpr size_t MiB = 1u << 20;
constexpr size_t WS_LB = 64 * 1024, WS_BIASP = 128 * 1024;
constexpr size_t WS_WIN = 1 * MiB, WS_WOUT = 25 * MiB, WS_WGU = 33 * MiB, WS_WDN = 77 * MiB;
constexpr size_t WS_XB = 99 * MiB, WS_MIX = 133 * MiB;
constexpr size_t WS_U = 167 * MiB, WS_Q = 184 * MiB, WS_I = 201 * MiB, WS_G = 218 * MiB, WS_F = 235 * MiB, WS_END = 269 * MiB;
constexpr size_t WS_ACT = 167 * MiB;
constexpr int SPLIT5 = 8, SPLIT8 = 11;
constexpr size_t WS_PB5 = 167 * MiB;
constexpr size_t WS_PB8 = 99 * MiB;
static_assert(WS_PB8 + (size_t)SPLIT8 * 512 * 2048 * 4 <= 167 * MiB && (32 % SPLIT5) == 0 && (88 % SPLIT8) == 0 && (32 / SPLIT5) % 2 == 0 && (88 / SPLIT8) % 2 == 0 && 32 / SPLIT5 >= 4 && 88 / SPLIT8 >= 4, "split-K layout");
static_assert(WS_ACT + (size_t)M * FF * 2 <= WS_END, "act overlay");
constexpr size_t O_Y = 0, O_NCP = (size_t)M * D, O_NHP = O_NCP + 4 * 30 * 1024, O_NCS = O_NHP + 4 * 8 * 128 * 128, O_NHS = O_NCS + 32 * 30 * 1024;
constexpr size_t O_ST = 0, O_DC = (size_t)1024 * 16384;

#define LAS __attribute__((address_space(3)))
typedef unsigned short bf16;
typedef float f32x4 __attribute__((ext_vector_type(4)));
typedef float f32x2 __attribute__((ext_vector_type(2)));
typedef unsigned v4u __attribute__((ext_vector_type(4)));
typedef unsigned v2u __attribute__((ext_vector_type(2)));
typedef float f32x16 __attribute__((ext_vector_type(16)));
typedef unsigned u32x8 __attribute__((ext_vector_type(8)));
#define CAS __attribute__((address_space(4)))
#define LDS_WAIT() asm volatile("s_waitcnt lgkmcnt(0)" ::: "memory")

__device__ __forceinline__ unsigned f2bf(float f) { unsigned u = __builtin_bit_cast(unsigned, f); return (u + 0x7fffu + ((u >> 16) & 1u)) >> 16; }
__device__ __forceinline__ unsigned pk2(float lo, float hi) { return f2bf(lo) | (f2bf(hi) << 16); }
__device__ __forceinline__ float bf2f(unsigned short b) { return __uint_as_float((unsigned)b << 16); }
__device__ __forceinline__ float sigm(float x) { return __builtin_amdgcn_rcpf(1.0f + __expf(-x)); }
__device__ __forceinline__ float wave_sum(float v) {
#pragma unroll
    for (int o = 1; o < 64; o <<= 1) v += __shfl_xor(v, o);
    return v;
}

__device__ __forceinline__ void transpose_item(const float* W, int K, int N, bf16* WT, int k0, int n0, int dst_row0, LAS float* scr, int lane) {
    { f32x4 v[8];
      const int kq = lane >> 3, n4 = (lane & 7) * 4;
#pragma unroll
      for (int i = 0; i < 8; ++i) v[i] = *(const f32x4*)(W + (size_t)(k0 + 8 * i + kq) * N + n0 + n4);
#pragma unroll
      for (int i = 0; i < 8; ++i) { LAS float* d = scr + (8 * i + kq) * 33 + n4; d[0] = v[i].x; d[1] = v[i].y; d[2] = v[i].z; d[3] = v[i].w; } }
    LDS_WAIT(); asm volatile("" ::: "memory");
    const int c = lane & 7;
#pragma unroll
    for (int j = 0; j < 4; ++j) { const int n = (lane >> 3) + 8 * j; const LAS float* s = scr + (8 * c) * 33 + n;
        v4u o; o.x = pk2(s[0 * 33], s[1 * 33]); o.y = pk2(s[2 * 33], s[3 * 33]); o.z = pk2(s[4 * 33], s[5 * 33]); o.w = pk2(s[6 * 33], s[7 * 33]);
        *(v4u*)(WT + (size_t)(dst_row0 + n) * K + k0 + 8 * c) = o; }
    LDS_WAIT(); asm volatile("" ::: "memory");
}

__device__ __forceinline__ void ln_row(const float* src, const float* part, int npart, size_t pstride, float alpha, float* dstf, bf16* dstb, const float* g, const float* b, int lane) {
    const f32x4* xr = (const f32x4*)src + lane;
    f32x4 v[8]; float s = 0.f;
#pragma unroll
    for (int j = 0; j < 8; ++j) v[j] = xr[64 * j];
    if (npart > 0) {
#pragma unroll
        for (int j = 0; j < 8; ++j) v[j] = v[j] * alpha;
        for (int p = 0; p < npart; ++p) { const f32x4* pr = (const f32x4*)(part + (size_t)p * pstride) + lane;
#pragma unroll
            for (int j = 0; j < 8; ++j) v[j] += pr[64 * j]; }
    }
#pragma unroll
    for (int j = 0; j < 8; ++j) s += (v[j].x + v[j].y) + (v[j].z + v[j].w);
    const float mean = wave_sum(s) * (1.f / D); float s2 = 0.f;
#pragma unroll
    for (int j = 0; j < 8; ++j) { v[j] = v[j] - mean; s2 += (v[j].x * v[j].x + v[j].y * v[j].y) + (v[j].z * v[j].z + v[j].w * v[j].w); }
    const float rstd = 1.f / sqrtf(wave_sum(s2) * (1.f / D) + LN_EPS);
#pragma unroll
    for (int j = 0; j < 8; ++j) {
        const f32x4 gg = ((const f32x4*)g)[lane + 64 * j], bb = ((const f32x4*)b)[lane + 64 * j];
        const f32x4 o = v[j] * rstd * gg + bb;
        if (dstf) ((f32x4*)dstf)[lane + 64 * j] = o;
        if (dstb) { v2u w; w.x = pk2(o.x, o.y); w.y = pk2(o.z, o.w); ((v2u*)dstb)[lane + 64 * j] = w; }
    }
}

#define XB_TMO      128
#define XB_XCNT(j)  (256  + 64 * (j))
#define XB_XSUB(j)  (1280 + 64 * (j))
#define XB_XGEN(j)  (2304 + 64 * (j))
#define XB_TOP      3328
#define XB_TOPGEN   3392
#define XCD_BAR_WORDS 3456
#define XB_SPIN_CAP (1u << 18)
__device__ __forceinline__ unsigned xb_ld(unsigned* p)              { return __hip_atomic_load(p, __ATOMIC_RELAXED, __HIP_MEMORY_SCOPE_AGENT); }
__device__ __forceinline__ unsigned xb_add(unsigned* p, unsigned v) { return __hip_atomic_fetch_add(p, v, __ATOMIC_RELAXED, __HIP_MEMORY_SCOPE_AGENT); }
__device__ __forceinline__ unsigned xb_xcc_id() { return (unsigned)__builtin_amdgcn_s_getreg((3 << 11) | 20) & 0xFu; }
#define XB_SPIN(cond, bar) do { unsigned _sp = 0; while (cond) { __builtin_amdgcn_s_sleep(1); \
    if ((++_sp & 255u) == 0u) { if (xb_ld(&(bar)[XB_TMO])) break; if (_sp > XB_SPIN_CAP) { atomicAdd(&(bar)[XB_TMO], 1u); break; } } } } while (0)
struct XcdBarrier { unsigned* bar; unsigned x; volatile LAS unsigned* st; };
__device__ __forceinline__ XcdBarrier xcd_barrier_post(unsigned* bar, volatile LAS unsigned* st) {
    XcdBarrier b; b.bar = bar; b.x = xb_xcc_id(); b.st = st;
    if (threadIdx.x == 0) (void)xb_add(&bar[XB_XCNT(b.x)], 1u);
    return b;
}
__device__ __forceinline__ void xcd_barrier_complete(unsigned* bar, unsigned x, unsigned& nloc, unsigned& nx) {
    const unsigned G = gridDim.x * gridDim.y * gridDim.z;
    unsigned sum, cnt, mine, sp = 0u;
    for (;;) {
        sum = 0u; cnt = 0u; mine = 0u;
#pragma unroll
        for (unsigned j = 0; j < 16; ++j) { const unsigned c = xb_ld(&bar[XB_XCNT(j)]); sum += c; cnt += (c > 0u) ? 1u : 0u; mine = (j == x) ? c : mine; }
        if (sum == G) break;
        __builtin_amdgcn_s_sleep(1);
        if ((++sp & 255u) == 0u) { if (xb_ld(&bar[XB_TMO])) break; if (sp > XB_SPIN_CAP) { atomicAdd(&bar[XB_TMO], 1u); break; } }
    }
    nloc = mine > 0u ? mine : 1u; nx = cnt > 0u ? cnt : 1u;
}
__device__ __forceinline__ void xcd_barrier(const XcdBarrier& b) {
    asm volatile("s_waitcnt vmcnt(0)" ::: "memory");
    __syncthreads();
    if (threadIdx.x == 0) {
        unsigned* bar = b.bar;
        __builtin_amdgcn_s_waitcnt(0);
        unsigned nloc = b.st[0], nx = b.st[1];
        if (nloc == 0u) { xcd_barrier_complete(bar, b.x, nloc, nx); b.st[0] = nloc; b.st[1] = nx; }
        const unsigned old = xb_add(&bar[XB_XSUB(b.x)], 1u);
        const unsigned gen = old / nloc;
        if (old + 1u == (gen + 1u) * nloc) {
            __builtin_amdgcn_fence(__ATOMIC_RELEASE, "agent");
            asm volatile("s_waitcnt vmcnt(0)" ::: "memory");
            const unsigned og = xb_add(&bar[XB_TOP], 1u);
            const unsigned tg = og / nx;
            if (og + 1u == (tg + 1u) * nx) xb_add(&bar[XB_TOPGEN], 1u);
            else XB_SPIN(xb_ld(&bar[XB_TOPGEN]) == tg, bar);
            __builtin_amdgcn_fence(__ATOMIC_ACQUIRE, "agent");
            xb_add(&bar[XB_XGEN(b.x)], 1u);
            asm volatile("s_waitcnt vmcnt(0)" ::: "memory");
        } else {
            XB_SPIN(xb_ld(&bar[XB_XGEN(b.x)]) == gen, bar);
            __builtin_amdgcn_fence(__ATOMIC_ACQUIRE, "agent");
            asm volatile("s_waitcnt vmcnt(0)" ::: "memory");
        }
    }
    __syncthreads();
}

struct Args { const float* in[20]; float* out; unsigned char* ws; int ph_lo, ph_hi; };

__global__ void __launch_bounds__(NWAVES * 64, 2) fwd_kernel(Args args) {
    extern __shared__ __attribute__((aligned(16))) unsigned char lds_raw[];
    LAS unsigned char* lds = (LAS unsigned char*)lds_raw;
    const int tid = threadIdx.x, lane = tid & 63, wave = __builtin_amdgcn_readfirstlane(tid >> 6);
    const int G = gridDim.x, bx = blockIdx.x;
    const int gt = bx * 512 + tid, NT = G * 512;
    const int gw = bx * NWAVES + wave, NGW = G * NWAVES;

#define x_prompt (args.in[0])
#define x_sample (args.in[1])
#define cache_conv (args.in[2])
#define state_hgrn (args.in[3])
#define w_in (args.in[4])
#define b_in (args.in[5])
#define w_dw (args.in[6])
#define b_dw (args.in[7])
#define cn_g (args.in[8])
#define cn_b (args.in[9])
#define hlb (args.in[10])
#define hg_ng (args.in[11])
#define w_out (args.in[12])
#define ln1_g (args.in[13])
#define ln1_b (args.in[14])
#define w_gate (args.in[15])
#define w_up (args.in[16])
#define w_down (args.in[17])
#define ln2_g (args.in[18])
#define ln2_b (args.in[19])
#define out (args.out)
#define ws (args.ws)
#define LB ((float*)(ws + WS_LB))
#define BIASP ((float*)(ws + WS_BIASP))
#define WIN ((bf16*)(ws + WS_WIN))
#define WOUT ((bf16*)(ws + WS_WOUT))
#define WGU ((bf16*)(ws + WS_WGU))
#define WDN ((bf16*)(ws + WS_WDN))
#define XB ((bf16*)(ws + WS_XB))
#define MIX ((bf16*)(ws + WS_MIX))
#define U ((bf16*)(ws + WS_U))
#define Q ((bf16*)(ws + WS_Q))
#define F ((float*)(ws + WS_F))
#define I ((bf16*)(ws + WS_I))
#define Gt ((bf16*)(ws + WS_G))
#define ACT ((bf16*)(ws + WS_ACT))
#define ST (out + O_ST)
#define DC (out + O_DC)

    const int lo = args.ph_lo, hi = args.ph_hi;
    volatile LAS unsigned* MISC = (volatile LAS unsigned*)(lds + LDS_BYTES - 64);
    if (tid < 16) MISC[tid] = 0u;
    __syncthreads();
    XcdBarrier xbar = xcd_barrier_post((unsigned*)ws, MISC + 8);
#ifndef PH_MASK
#define PH_MASK 0x3ff
#endif
#define IN(k) (((PH_MASK >> (k)) & 1) && lo <= (k) && (k) < hi)
#ifndef REP_MASK
#define REP_MASK 0
#endif
#define NREP(k) (1 + ((REP_MASK >> (k)) & 1))
#define SEAM(k) do { if (IN(k) && IN((k) + 1)) { xcd_barrier(xbar); } } while (0)
    if (hi > 1000) cg::this_grid().sync();

    if (IN(0)) for (int rep_ = 0; rep_ < NREP(0); ++rep_) { if (rep_) xcd_barrier(xbar);
        LAS float* scr = (LAS float*)(lds + wave * 16384);
        constexpr int I_IN = 32 * 192;
        for (int it = gw; it < I_IN; it += NGW) {
            const int nblk = NIN / 32, kb = it / nblk, nb = it % nblk, k0 = 64 * kb, n0 = 32 * nb;
            const int dst = n0 < 2048 ? ((n0 & 1023) >> 7) * 256 + (n0 >> 10) * 128 + (n0 & 127) : n0;
            transpose_item(w_in, D, NIN, WIN, k0, n0, dst, scr, lane);
        }
        constexpr int NV = M * D / 8, NVP = MP * D / 8;
#pragma unroll 4
        for (int i = gt; i < NV; i += NT) {
            const float* src = i < NVP ? x_prompt + (size_t)i * 8 : x_sample + (size_t)(i - NVP) * 8;
            const f32x4 a = *(const f32x4*)src, b = *(const f32x4*)(src + 4);
            v4u o; o.x = pk2(a.x, a.y); o.y = pk2(a.z, a.w); o.z = pk2(b.x, b.y); o.w = pk2(b.z, b.w);
            *(v4u*)(XB + (size_t)i * 8) = o;
        }
        for (int i = gt; i < 1024; i += NT) LB[i] = sigm(hlb[i] - hlb[1024 + i]);
        for (int i = gt; i < NIN; i += NT) { const int orig = i < 2048 ? ((i & 255) >> 7) * 1024 + (i >> 8) * 128 + (i & 127) : i; BIASP[i] = b_in[orig]; }
    }
    SEAM(0);
#ifdef EXTRA_SYNCS
    for (int i_ = 0; i_ < EXTRA_SYNCS; ++i_) cg::this_grid().sync();
#endif

    if (IN(1)) for (int rep_ = 0; rep_ < NREP(1); ++rep_) { if (rep_) xcd_barrier(xbar);
        pg8::Gemm g{XB, WIN, M, NIN, D}; pg8::StaticOrder S; S.init(M, NIN, D, G, bx);
        pg8::EpiProj E{U, Q, F, BIASP, LB};
        pg8::gemm_phase<pg8::EpiProj, pg8::StaticOrder, true, true>(lds, g, S, E);
        const int nlast = S.nitems % G;
        if (nlast > 0 && bx >= nlast) {
            LAS float* scr = (LAS float*)(lds + wave * 16384);
            constexpr int I_OUT = 32 * 64, I_G = 32 * 176, I_DN = 88 * 64;
            const int gw2 = (bx - nlast) * NWAVES + wave, NGW2 = (G - nlast) * NWAVES;
            for (int it = gw2; it < I_OUT + 2 * I_G + I_DN; it += NGW2) {
                int r = it; const float* W; int K, N; bf16* WT; int kind;
                if (r < I_OUT) { kind = 1; W = w_out; K = D; N = D; WT = WOUT; }
                else if ((r -= I_OUT) < I_G) { kind = 2; W = w_gate; K = D; N = FF; WT = WGU; }
                else if ((r -= I_G) < I_G) { kind = 3; W = w_up; K = D; N = FF; WT = WGU; }
                else { r -= I_G; kind = 4; W = w_down; K = FF; N = D; WT = WDN; }
                const int nblk = N / 32, kb = r / nblk, nb = r % nblk, k0 = 64 * kb, n0 = 32 * nb;
                int dst;
                if (kind == 2) dst = (n0 >> 7) * 256 + (n0 & 127);
                else if (kind == 3) dst = (n0 >> 7) * 256 + 128 + (n0 & 127);
                else dst = n0;
                transpose_item(W, K, N, WT, k0, n0, dst, scr, lane);
            }
        }
    }
    SEAM(1);

    if (IN(2)) for (int rep_ = 0; rep_ < NREP(2); ++rep_) { if (rep_) xcd_barrier(xbar);
        for (int it = bx; it < 1024 + 544; it += G) {
#ifdef P2_PROBE
            if (rep_ == 1 && ((P2_PROBE == 1) == (it >= 1024))) continue;
#endif
            __syncthreads();
            if (it < 1024) {
                const int bh = it >> 5, c = it & 31, b = bh >> 3, h = bh & 7;
                const int row0 = b * 2048 + c * 64;
                LAS bf16* KEt = (LAS bf16*)lds;
                LAS bf16* Vt = (LAS bf16*)(lds + 18432);
                LAS float* Tq = (LAS float*)(lds + 36864);
                const int k = tid & 127, qtr = __builtin_amdgcn_readfirstlane(tid >> 7);
                float lf[16], kk[16]; unsigned short iv[16];
#pragma unroll
                for (int s_ = 0; s_ < 16; ++s_) { const size_t gi = (size_t)(row0 + qtr * 16 + s_) * 1024 + h * 128 + k; const float f = F[gi]; lf[s_] = __log2f(f); kk[s_] = 1.0f - f; iv[s_] = I[gi]; }
                float run = 0.f; float suf[16];
#pragma unroll
                for (int s_ = 15; s_ >= 0; --s_) { suf[s_] = run; run += lf[s_]; }
                Tq[qtr * 128 + k] = run;
                { v4u w0, w1;
                  w0.x = iv[0] | ((unsigned)iv[1] << 16); w0.y = iv[2] | ((unsigned)iv[3] << 16); w0.z = iv[4] | ((unsigned)iv[5] << 16); w0.w = iv[6] | ((unsigned)iv[7] << 16);
                  w1.x = iv[8] | ((unsigned)iv[9] << 16); w1.y = iv[10] | ((unsigned)iv[11] << 16); w1.z = iv[12] | ((unsigned)iv[13] << 16); w1.w = iv[14] | ((unsigned)iv[15] << 16);
                  *(LAS v4u*)(Vt + k * 72 + qtr * 16) = w0; *(LAS v4u*)(Vt + k * 72 + qtr * 16 + 8) = w1; }
                __syncthreads();
                float later = 0.f, total = 0.f;
#pragma unroll
                for (int q2 = 0; q2 < 4; ++q2) { const float tq = Tq[q2 * 128 + k]; total += tq; later += q2 > qtr ? tq : 0.f; }
                { float ke[16];
#pragma unroll
                  for (int s_ = 0; s_ < 16; ++s_) ke[s_] = kk[s_] * exp2f(suf[s_] + later);
                  v4u w0, w1;
                  w0.x = pk2(ke[0], ke[1]); w0.y = pk2(ke[2], ke[3]); w0.z = pk2(ke[4], ke[5]); w0.w = pk2(ke[6], ke[7]);
                  w1.x = pk2(ke[8], ke[9]); w1.y = pk2(ke[10], ke[11]); w1.z = pk2(ke[12], ke[13]); w1.w = pk2(ke[14], ke[15]);
                  *(LAS v4u*)(KEt + k * 72 + qtr * 16) = w0; *(LAS v4u*)(KEt + k * 72 + qtr * 16 + 8) = w1; }
                if (qtr == 0) DC[it * 128 + k] = exp2f(total);
                __syncthreads();
                { const int r = lane & 15, q = lane >> 4;
                  const pg8::bf16x8 a0 = *(const LAS pg8::bf16x8*)(Vt + (16 * wave + r) * 72 + 8 * q), a1 = *(const LAS pg8::bf16x8*)(Vt + (16 * wave + r) * 72 + 8 * q + 32);
                  float* sp = ST + (size_t)it * 16384 + (size_t)(16 * wave + 4 * q) * 128 + r;
#pragma unroll
                  for (int kt = 0; kt < 8; ++kt) {
                      const pg8::bf16x8 b0 = *(const LAS pg8::bf16x8*)(KEt + (16 * kt + r) * 72 + 8 * q), b1 = *(const LAS pg8::bf16x8*)(KEt + (16 * kt + r) * 72 + 8 * q + 32);
                      f32x4 acc = (f32x4){0.f, 0.f, 0.f, 0.f};
                      acc = __builtin_amdgcn_mfma_f32_16x16x32_bf16(a0, b0, acc, 0, 0, 0);
                      acc = __builtin_amdgcn_mfma_f32_16x16x32_bf16(a1, b1, acc, 0, 0, 0);
#pragma unroll
                      for (int j = 0; j < 4; ++j) sp[j * 128 + 16 * kt] = acc[j];
                  } }
            } else {
                const int m0 = (it - 1024) * 16;
                const bool samp = m0 >= MP;
                int t0, seq0; const float* hist = cache_conv;
                if (!samp) { t0 = m0 & 2047; seq0 = m0 - t0; }
                else { t0 = 0; seq0 = m0; hist = cache_conv + (size_t)((m0 - MP) >> 4) * 30 * 1024; }
                const int hrow0 = samp ? ((m0 - MP) >> 4) * 30 : 0;
                const __amdgpu_buffer_rsrc_t rU = __builtin_amdgcn_make_buffer_rsrc((void*)U, 0, M * 1024 * 2, 0x00020000);
                const __amdgpu_buffer_rsrc_t rH = __builtin_amdgcn_make_buffer_rsrc((void*)cache_conv, 0, 32 * 30 * 1024 * 4, 0x00020000);
                const __amdgpu_buffer_rsrc_t rW = __builtin_amdgcn_make_buffer_rsrc((void*)w_dw, 0, 31 * 1024 * 4, 0x00020000);
                const bool interior = t0 >= 30;
                LAS float* hbuf = (LAS float*)(lds + 16384);
                LAS f32x2* stat = (LAS f32x2*)(lds + 16384 + 65536);
                const int c = 2 * tid;
                f32x2 acc[16];
                { const f32x2 bb = *(const f32x2*)(b_dw + c);
#pragma unroll
                  for (int t = 0; t < 16; ++t) acc[t] = bb; }
#pragma unroll
                for (int ch = 0; ch < 2; ++ch) {
                    const int j0 = ch * 16, nj = ch ? 15 : 16;
                    f32x2 win[31];
                    if (interior) {
                        const int rb = (seq0 + t0 - 30 + j0) * 2048;
#pragma unroll
                        for (int xi = 0; xi < 31; ++xi) if (xi < nj + 15) { const unsigned pw = __builtin_amdgcn_raw_buffer_load_b32(rU, 4 * tid, rb + xi * 2048, 0); win[xi] = (f32x2){__uint_as_float(pw << 16), __uint_as_float(pw & 0xffff0000u)}; }
                    } else {
#pragma unroll
                        for (int xi = 0; xi < 31; ++xi) if (xi < nj + 15) {
                            const int tr = t0 - 30 + j0 + xi;
                            f32x2 wv = (f32x2){0.f, 0.f};
                            if (tr >= 0) { const unsigned pw = __builtin_amdgcn_raw_buffer_load_b32(rU, 4 * tid, (seq0 + tr) * 2048, 0); wv = (f32x2){__uint_as_float(pw << 16), __uint_as_float(pw & 0xffff0000u)}; }
                            else if (samp) { const v2u hv = __builtin_amdgcn_raw_buffer_load_b64(rH, 8 * tid, (hrow0 + 30 + tr) * 4096, 0); wv = (f32x2){__uint_as_float(hv.x), __uint_as_float(hv.y)}; }
                            win[xi] = wv;
                        }
                    }
#pragma unroll
                    for (int jj = 0; jj < 16; ++jj) if (jj < nj) { const v2u wu = __builtin_amdgcn_raw_buffer_load_b64(rW, 8 * tid, (j0 + jj) * 4096, 0); const f32x2 w2 = (f32x2){__uint_as_float(wu.x), __uint_as_float(wu.y)};
#pragma unroll
                        for (int t = 0; t < 16; ++t) acc[t] += w2 * win[t + jj]; }
                    asm volatile("" ::: "memory");
                }
#pragma unroll
                for (int t = 0; t < 16; ++t) *(LAS f32x2*)(hbuf + t * 1024 + c) = acc[t];
                __syncthreads();
#pragma unroll
                for (int tt = 0; tt < 2; ++tt) { const int t = 2 * wave + tt; float s1 = 0.f, s2 = 0.f;
#pragma unroll
                    for (int i = 0; i < 4; ++i) { const f32x4 x = *(const LAS f32x4*)(hbuf + t * 1024 + 4 * lane + 256 * i); s1 += (x.x + x.y) + (x.z + x.w); s2 += (x.x * x.x + x.y * x.y) + (x.z * x.z + x.w * x.w); }
                    s1 = wave_sum(s1); s2 = wave_sum(s2);
                    const float mu = s1 * (1.f / 1024.f); float var = s2 * (1.f / 1024.f) - mu * mu; var = var > 0.f ? var : 0.f;
                    if (lane == 0) stat[t] = (f32x2){mu, 1.f / sqrtf(var + LN_EPS)}; }
                __syncthreads();
                const f32x2 gg = *(const f32x2*)(cn_g + c), bb2 = *(const f32x2*)(cn_b + c);
#pragma unroll
                for (int t = 0; t < 16; ++t) {
                    const f32x2 st2 = stat[t];
                    float y0 = (acc[t].x - st2.x) * st2.y * gg.x + bb2.x, y1 = (acc[t].y - st2.x) * st2.y * gg.y + bb2.y;
                    y0 = y0 * sigm(y0); y1 = y1 * sigm(y1);
                    *(unsigned*)(MIX + (size_t)(m0 + t) * 2048 + c) = pk2(y0, y1);
                }
            }
        }
        for (int i = gt; i < 4 * 30 * 1024; i += NT) { const int b = i / 30720, j = (i >> 10) % 30, c = i & 1023;
            out[O_NCP + i] = bf2f(U[(size_t)(b * 2048 + 2018 + j) * 1024 + c]); }
        for (int i = gt; i < 32 * 30 * 1024; i += NT) { const int sb = i / 30720, j = (i >> 10) % 30, c = i & 1023;
            out[O_NCS + i] = j < 14 ? cache_conv[(size_t)sb * 30720 + (16 + j) * 1024 + c] : bf2f(U[(size_t)(MP + sb * 16 + j - 14) * 1024 + c]); }
    }
    SEAM(2);

    if (IN(3)) {
        for (int e = gt; e < 32 * 4096; e += NT) {
            const int bh = e >> 12, r = e & 4095, v = r >> 5, k4 = r & 31;
            f32x4 S = (f32x4){0.f, 0.f, 0.f, 0.f};
#pragma unroll 8
            for (int c = 0; c < 32; ++c) {
                f32x4* p = (f32x4*)(ST + ((size_t)(bh * 32 + c) * 128 + v) * 128 + k4 * 4);
                const f32x4 A = *p; const f32x4 d = *(const f32x4*)(DC + (bh * 32 + c) * 128 + k4 * 4);
                *p = S; S = S * d + A;
            }
            float* o = out + O_NHP + (size_t)bh * 16384 + (size_t)(k4 * 4) * 128 + v;
            o[0] = S.x; o[128] = S.y; o[256] = S.z; o[384] = S.w;
        }
    }
    SEAM(3);

    if (IN(4)) for (int rep_ = 0; rep_ < NREP(4); ++rep_) { if (rep_) xcd_barrier(xbar);
        LAS float* vl = (LAS float*)lds; LAS float* red = (LAS float*)(lds + 8192);
        for (int it = bx; it < 1024 + 256; it += G) {
          if (it < 1024) {
            const int bh = it >> 5, c = it & 31, h = bh & 7, row0 = (bh >> 3) * 2048 + c * 64;
            LAS bf16* St = (LAS bf16*)lds;
            LAS bf16* QD = (LAS bf16*)(lds + 34816);
            LAS bf16* Vt = (LAS bf16*)(lds + 52224);
            LAS bf16* Pm = (LAS bf16*)(lds + 70656);
            LAS bf16* QDI = (LAS bf16*)(lds + 79872);
            LAS bf16* KD = (LAS bf16*)(lds + 97280);
            LAS float* Tq = (LAS float*)(lds + 140800);
            LAS float* Ob = (LAS float*)(lds + 79872);
            __syncthreads();
            const int k = tid & 127, qtr = __builtin_amdgcn_readfirstlane(tid >> 7);
            float pre[16], kk[16], qq[16]; unsigned short iv[16];
#pragma unroll
            for (int s_ = 0; s_ < 16; ++s_) { const size_t gi = (size_t)(row0 + qtr * 16 + s_) * 1024 + h * 128 + k; const float f = F[gi]; pre[s_] = __log2f(f); kk[s_] = 1.0f - f; qq[s_] = bf2f(Q[gi]); iv[s_] = I[gi]; }
            { const float* sp = ST + (size_t)it * 16384;
#pragma unroll
              for (int j = 0; j < 8; ++j) { const int e = tid + 512 * j, v = e >> 5, k4 = e & 31; const f32x4 x = *(const f32x4*)(sp + (size_t)e * 4);
                  v2u w; w.x = pk2(x.x, x.y); w.y = pk2(x.z, x.w); *(LAS v2u*)(St + v * 136 + k4 * 4) = w; } }
#pragma unroll
            for (int s_ = 1; s_ < 16; ++s_) pre[s_] += pre[s_ - 1];
            const float tot = pre[15];
            Tq[qtr * 128 + k] = tot;
            { v4u w0, w1;
              w0.x = iv[0] | ((unsigned)iv[1] << 16); w0.y = iv[2] | ((unsigned)iv[3] << 16); w0.z = iv[4] | ((unsigned)iv[5] << 16); w0.w = iv[6] | ((unsigned)iv[7] << 16);
              w1.x = iv[8] | ((unsigned)iv[9] << 16); w1.y = iv[10] | ((unsigned)iv[11] << 16); w1.z = iv[12] | ((unsigned)iv[13] << 16); w1.w = iv[14] | ((unsigned)iv[15] << 16);
              *(LAS v4u*)(Vt + k * 72 + qtr * 16) = w0; *(LAS v4u*)(Vt + k * 72 + qtr * 16 + 8) = w1; }
            const int kdoff = qtr == 0 ? 0 : (qtr == 1 ? 16 : (qtr == 2 ? 48 : 96));
#pragma unroll
            for (int s_ = 0; s_ < 16; ++s_) {
                QDI[(16 * qtr + s_) * 136 + k] = (bf16)f2bf(qq[s_] * exp2f(pre[s_]));
                KD[(kdoff + 16 * qtr + s_) * 136 + k] = (bf16)f2bf(kk[s_] * exp2f(-pre[s_]));
            }
            __syncthreads();
            { float lb_ = 0.f;
#pragma unroll
              for (int q2 = 0; q2 < 4; ++q2) lb_ += q2 < qtr ? Tq[q2 * 128 + k] : 0.f;
#pragma unroll
              for (int s_ = 0; s_ < 16; ++s_) QD[(16 * qtr + s_) * 136 + k] = (bf16)f2bf(qq[s_] * exp2f(pre[s_] + lb_));
              float gap = 0.f;
              for (int i = qtr + 1; i < 4; ++i) {
                  const int off = i == 1 ? 16 : (i == 2 ? 48 : 96);
#pragma unroll
                  for (int s_ = 0; s_ < 16; ++s_) KD[(off + 16 * qtr + s_) * 136 + k] = (bf16)f2bf(kk[s_] * exp2f((tot - pre[s_]) + gap));
                  gap += Tq[i * 128 + k];
              } }
            __syncthreads();
            const int r = lane & 15, q = lane >> 4;
            for (int n = wave; n < 10; n += 8) {
                const int i = n == 0 ? 0 : (n < 3 ? 1 : (n < 6 ? 2 : 3)), j = n - (i == 0 ? 0 : (i == 1 ? 1 : (i == 2 ? 3 : 6)));
                const int off = i == 0 ? 0 : (i == 1 ? 16 : (i == 2 ? 48 : 96));
                f32x4 acc = (f32x4){0.f, 0.f, 0.f, 0.f};
#pragma unroll
                for (int ks = 0; ks < 4; ++ks) {
                    const pg8::bf16x8 a = *(const LAS pg8::bf16x8*)(QDI + (16 * i + r) * 136 + 8 * q + 32 * ks);
                    const pg8::bf16x8 bq = *(const LAS pg8::bf16x8*)(KD + (off + 16 * j + r) * 136 + 8 * q + 32 * ks);
                    acc = __builtin_amdgcn_mfma_f32_16x16x32_bf16(a, bq, acc, 0, 0, 0);
                }
#pragma unroll
                for (int jj = 0; jj < 4; ++jj) { const float x = (i != j || r <= 4 * q + jj) ? acc[jj] : 0.f; Pm[(16 * i + 4 * q + jj) * 72 + 16 * j + r] = (bf16)f2bf(x); }
            }
            if (wave == 2 || wave == 3) { const int i = wave == 2 ? 0 : 2, j = i + 1;
#pragma unroll
                for (int jj = 0; jj < 4; ++jj) Pm[(16 * i + 4 * q + jj) * 72 + 16 * j + r] = (bf16)0; }
            __syncthreads();
            { const int i = wave >> 1, vt0 = 4 * (wave & 1);
              pg8::bf16x8 pa[2], qa[4];
#pragma unroll
              for (int ks = 0; ks < 2; ++ks) pa[ks] = *(const LAS pg8::bf16x8*)(Pm + (16 * i + r) * 72 + 8 * q + 32 * ks);
#pragma unroll
              for (int ks = 0; ks < 4; ++ks) qa[ks] = *(const LAS pg8::bf16x8*)(QD + (16 * i + r) * 136 + 8 * q + 32 * ks);
#pragma unroll
              for (int vv = 0; vv < 4; ++vv) { const int vt = vt0 + vv;
                  f32x4 acc = (f32x4){0.f, 0.f, 0.f, 0.f};
                  acc = __builtin_amdgcn_mfma_f32_16x16x32_bf16(pa[0], *(const LAS pg8::bf16x8*)(Vt + (16 * vt + r) * 72 + 8 * q), acc, 0, 0, 0);
                  if (i >= 2) acc = __builtin_amdgcn_mfma_f32_16x16x32_bf16(pa[1], *(const LAS pg8::bf16x8*)(Vt + (16 * vt + r) * 72 + 8 * q + 32), acc, 0, 0, 0);
#pragma unroll
                  for (int ks = 0; ks < 4; ++ks) acc = __builtin_amdgcn_mfma_f32_16x16x32_bf16(qa[ks], *(const LAS pg8::bf16x8*)(St + (16 * vt + r) * 136 + 8 * q + 32 * ks), acc, 0, 0, 0);
#pragma unroll
                  for (int jj = 0; jj < 4; ++jj) Ob[(16 * i + 4 * q + jj) * 132 + 16 * vt + r] = acc[jj];
              } }
            __syncthreads();
#pragma unroll 2
            for (int tt = 0; tt < 8; ++tt) {
                const int t = wave * 8 + tt;
                const float o0 = Ob[t * 132 + lane], o1 = Ob[t * 132 + 64 + lane];
                const float ss = wave_sum(o0 * o0 + o1 * o1);
                const float rr = 1.f / sqrtf(ss * (1.f / 128.f) + LN_EPS);
                const size_t m = (size_t)(row0 + t);
                const float g0 = bf2f(Gt[m * 1024 + h * 128 + lane]), g1 = bf2f(Gt[m * 1024 + h * 128 + 64 + lane]);
                MIX[m * 2048 + 1024 + h * 128 + lane] = (bf16)f2bf(o0 * rr * hg_ng[lane] * g0);
                MIX[m * 2048 + 1024 + h * 128 + 64 + lane] = (bf16)f2bf(o1 * rr * hg_ng[64 + lane] * g1);
            }
          } else {
            int row0, h, nsb; const float* sinit; float* sfin = nullptr;
            if (it < 1024) { const int bh = it >> 5, c = it & 31; h = bh & 7; row0 = (bh >> 3) * 2048 + c * 64; nsb = 4; sinit = ST + (size_t)it * 16384; }
            else { const int j = it - 1024; h = j & 7; row0 = MP + (j >> 3) * 16; nsb = 1; sinit = state_hgrn + (size_t)j * 16384; sfin = out + O_NHS + (size_t)j * 16384; }
            f32x2 Sa[8], Sb[8];
            { const float* sp = sinit + (size_t)(wave * 16) * 128 + lane;
#pragma unroll
              for (int i = 0; i < 8; ++i) { Sa[i] = (f32x2){sp[(2 * i) * 128], sp[(2 * i + 1) * 128]}; Sb[i] = (f32x2){sp[(2 * i) * 128 + 64], sp[(2 * i + 1) * 128 + 64]}; } }
            for (int sb = 0; sb < nsb; ++sb) {
                __syncthreads();
#pragma unroll
                for (int e4 = 0; e4 < 4; ++e4) { const int e = tid + e4 * 512, t = e >> 7, k = e & 127; const size_t gi = (size_t)(row0 + sb * 16 + t) * 1024 + h * 128 + k;
                    vl[e] = bf2f(I[gi]); }
                __syncthreads();
                const CAS float* fbase = (const CAS float*)(F + (size_t)(row0 + sb * 16) * 1024 + h * 128 + wave * 16);
                const CAS unsigned* qbase = (const CAS unsigned*)(Q + (size_t)(row0 + sb * 16) * 1024 + h * 128 + wave * 16);
#pragma unroll 2
                for (int t = 0; t < 16; ++t) {
                    const f32x16 f = *(const CAS f32x16*)(fbase + t * 1024);
                    const u32x8 qp = *(const CAS u32x8*)(qbase + t * 512);
                    const float va = vl[t * 128 + lane], vb = vl[t * 128 + 64 + lane];
                    const f32x2 va2 = (f32x2){va, va}, vb2 = (f32x2){vb, vb};
                    f32x2 oa = (f32x2){0.f, 0.f}, ob = (f32x2){0.f, 0.f};
#pragma unroll
                    for (int i = 0; i < 8; ++i) { const f32x2 f2 = (f32x2){f[2 * i], f[2 * i + 1]};
                        const f32x2 q2 = (f32x2){__uint_as_float(qp[i] << 16), __uint_as_float(qp[i] & 0xffff0000u)};
                        Sa[i] = f2 * (Sa[i] - va2) + va2; Sb[i] = f2 * (Sb[i] - vb2) + vb2;
                        oa += q2 * Sa[i]; ob += q2 * Sb[i]; }
                    red[(wave * 16 + t) * 128 + lane] = oa.x + oa.y; red[(wave * 16 + t) * 128 + 64 + lane] = ob.x + ob.y;
                }
                __syncthreads();
#pragma unroll
                for (int tt = 0; tt < 2; ++tt) {
                    const int t = wave * 2 + tt;
                    float o0 = 0.f, o1 = 0.f;
#pragma unroll
                    for (int q8 = 0; q8 < 8; ++q8) { o0 += red[(q8 * 16 + t) * 128 + lane]; o1 += red[(q8 * 16 + t) * 128 + 64 + lane]; }
                    const float ss = wave_sum(o0 * o0 + o1 * o1);
                    const float r = 1.f / sqrtf(ss * (1.f / 128.f) + LN_EPS);
                    const size_t m = (size_t)(row0 + sb * 16 + t);
                    const float g0 = bf2f(Gt[m * 1024 + h * 128 + lane]), g1 = bf2f(Gt[m * 1024 + h * 128 + 64 + lane]);
                    MIX[m * 2048 + 1024 + h * 128 + lane] = (bf16)f2bf(o0 * r * hg_ng[lane] * g0);
                    MIX[m * 2048 + 1024 + h * 128 + 64 + lane] = (bf16)f2bf(o1 * r * hg_ng[64 + lane] * g1);
                }
            }
            if (sfin) { float* sp = sfin + (size_t)(wave * 16) * 128 + lane;
#pragma unroll
                for (int i = 0; i < 8; ++i) { sp[(2 * i) * 128] = Sa[i].x; sp[(2 * i + 1) * 128] = Sa[i].y; sp[(2 * i) * 128 + 64] = Sb[i].x; sp[(2 * i + 1) * 128 + 64] = Sb[i].y; } }
          }
        }
        __syncthreads();
    }
    SEAM(4);

    if (IN(5)) for (int rep_ = 0; rep_ < NREP(5); ++rep_) { if (rep_) xcd_barrier(xbar);
        pg8::Gemm g{MIX, WOUT, M, D, D}; pg8::StaticOrder S; S.init(M, D, D, G, bx, MP, SPLIT5);
        pg8::EpiRes E{x_prompt, x_sample, out, MP, ALPHA, (float*)(ws + WS_PB5)};
        pg8::gemm_phase<pg8::EpiRes, pg8::StaticOrder, true, true>(lds, g, S, E);
    }
    SEAM(5);

    if (IN(6)) {
        for (int m = gw; m < M; m += NGW) {
            if (m < MP) ln_row(out + (size_t)m * D, nullptr, 0, 0, 1.f, out + (size_t)m * D, XB + (size_t)m * D, ln1_g, ln1_b, lane);
            else ln_row(x_sample + (size_t)(m - MP) * D, (const float*)(ws + WS_PB5) + (size_t)(m - MP) * D, SPLIT5, (size_t)MS * D, ALPHA, out + (size_t)m * D, XB + (size_t)m * D, ln1_g, ln1_b, lane);
        }
    }
    SEAM(6);

    if (IN(7)) for (int rep_ = 0; rep_ < NREP(7); ++rep_) { if (rep_) xcd_barrier(xbar);
        pg8::Gemm g{XB, WGU, M, 2 * FF, D}; pg8::StaticOrder S; S.init(M, 2 * FF, D, G, bx);
        pg8::EpiGateUp E{ACT, FF};
        pg8::gemm_phase<pg8::EpiGateUp, pg8::StaticOrder, true, true>(lds, g, S, E);
    }
    SEAM(7);

    if (IN(8)) {
        pg8::Gemm g{ACT, WDN, M, D, FF}; pg8::StaticOrder S; S.init(M, D, FF, G, bx, MP, SPLIT8);
        pg8::EpiRes E{out, out + (size_t)MP * D, out, MP, ALPHA, (float*)(ws + WS_PB8)};
        pg8::gemm_phase<pg8::EpiRes, pg8::StaticOrder, true, true>(lds, g, S, E);
    }
    SEAM(8);

    if (IN(9)) {
        for (int m = gw; m < M; m += NGW) {
            if (m < MP) ln_row(out + (size_t)m * D, nullptr, 0, 0, 1.f, out + (size_t)m * D, nullptr, ln2_g, ln2_b, lane);
            else ln_row(out + (size_t)m * D, (const float*)(ws + WS_PB8) + (size_t)(m - MP) * D, SPLIT8, (size_t)MS * D, ALPHA, out + (size_t)m * D, nullptr, ln2_g, ln2_b, lane);
        }
    }
#undef IN
#undef SEAM
}

#undef x_prompt
#undef x_sample
#undef cache_conv
#undef state_hgrn
#undef w_in
#undef b_in
#undef w_dw
#undef b_dw
#undef cn_g
#undef cn_b
#undef hlb
#undef hg_ng
#undef w_out
#undef ln1_g
#undef ln1_b
#undef w_gate
#undef w_up
#undef w_down
#undef ln2_g
#undef ln2_b
#undef out
#undef ws
#undef LB
#undef BIASP
#undef WIN
#undef WOUT
#undef WGU
#undef WDN
#undef XB
#undef MIX
#undef U
#undef Q
#undef F
#undef I
#undef Gt
#undef ACT
#undef ST
#undef DC

extern "C" void kernel_launch(void* const* d_in, const int* in_sizes, int n_in, void* d_out, int out_size, void* d_ws, size_t ws_size, hipStream_t stream) {
    static int grid = 0;
    if (grid == 0) {
        int dev = 0, cus = 0, per_cu = 0;
        if (n_in != 20 || ws_size < WS_END) { fprintf(stderr, "kernel_launch: unexpected n_in %d / ws_size %zu\n", n_in, ws_size); grid = -1; return; }
        if (hipGetDevice(&dev) != hipSuccess || hipDeviceGetAttribute(&cus, hipDeviceAttributeMultiprocessorCount, dev) != hipSuccess) { grid = -1; return; }
        if (hipFuncSetAttribute((const void*)fwd_kernel, hipFuncAttributeMaxDynamicSharedMemorySize, LDS_BYTES) != hipSuccess) { fprintf(stderr, "kernel_launch: hipFuncSetAttribute failed\n"); grid = -1; return; }
        if (hipOccupancyMaxActiveBlocksPerMultiprocessor(&per_cu, (const void*)fwd_kernel, NWAVES * 64, LDS_BYTES) != hipSuccess || per_cu < 1) { fprintf(stderr, "kernel_launch: occupancy query says %d\n", per_cu); }
        (void)hipGetLastError();
        grid = cus;
    }
    if (grid < 0) return;
    if (hipMemsetAsync(d_ws, 0, 16384, stream) != hipSuccess) { fprintf(stderr, "kernel_launch: memset failed\n"); return; }
    Args a{};
    for (int i = 0; i < 20; ++i) a.in[i] = (const float*)d_in[i];
    a.out = (float*)d_out; a.ws = (unsigned char*)d_ws;
#if MK_ONE_LAUNCH
    a.ph_lo = 0; a.ph_hi = N_PHASES;
    void* kargs[] = {&a};
    hipError_t e = hipLaunchCooperativeKernel((const void*)fwd_kernel, dim3(grid), dim3(NWAVES * 64), kargs, LDS_BYTES, stream);
    if (e != hipSuccess) fprintf(stderr, "cooperative launch failed: %s (grid %d)\n", hipGetErrorString(e), grid);
#else
    for (int p = 0; p < N_PHASES; ++p) {
        a.ph_lo = p; a.ph_hi = p + 1;
        hipLaunchKernelGGL(fwd_kernel, dim3(grid), dim3(NWAVES * 64), LDS_BYTES, stream, a);
    }
#endif
}
```

```cpp
#include <hip/hip_runtime.h>
#include <hip/hip_cooperative_groups.h>
#include <cstdio>
#include <cstdint>
namespace cg = cooperative_groups;

#ifndef MK_ONE_LAUNCH
#define MK_ONE_LAUNCH 1
#endif

namespace pg8 {
#define PG8_LAS __attribute__((address_space(3)))
typedef unsigned short bf16_t;
typedef short bf16x8 __attribute__((ext_vector_type(8)));
typedef float f32x4 __attribute__((ext_vector_type(4)));
typedef unsigned u32x4 __attribute__((ext_vector_type(4)));
typedef unsigned u32x2 __attribute__((ext_vector_type(2)));
constexpr int BM = 256, BK = 64, HALF = 128, HTB = HALF * BK * 2, STAGE_BYTES = 8 * HTB, NXCD = 8, WGM = 8;

__host__ __device__ __forceinline__ int lds_byte(int r, int c) { const int st = (r >> 4) * 2 + (c >> 5), rr = r & 15, cc = c & 31, ob = rr * 64 + cc * 2; return st * 1024 + (ob ^ (((ob >> 9) & 1) << 5)); }
__host__ __device__ __forceinline__ void stage_rc(int b, int& R, int& C) { const int st = b / 1024, sb = b % 1024, swz = sb ^ (((sb >> 9) & 1) << 5); R = (st >> 1) * 16 + swz / 64; C = (st & 1) * 32 + (swz % 64) / 2; }
__host__ __device__ __forceinline__ int perm32(int rho) { const int n = rho >> 4, i = rho & 15; return 8 * (i >> 2) + 4 * n + (i & 3); }

struct Unit { int pm, pn, kt0, nkt, ks; };
struct Gemm { const bf16_t* A; const bf16_t* Bt; int M, N, K; };

struct StaticOrder {
    int nM, nMf, nN, nfull, nitems, G, c, nt, nsplit;
    __host__ __device__ void init(int M, int N, int K, int G_, int c_, int Mfull = -1, int nsplit_ = 1) {
        nM = M / BM; nMf = Mfull < 0 ? nM : Mfull / BM; nN = N / BM; nt = K / BK; nsplit = nsplit_; nfull = nMf * nN; nitems = nfull + (nM - nMf) * nN * nsplit; G = G_; c = c_; }
    __host__ __device__ bool next(int i, Unit& u) const {
        const long L = (long)i * G + c; if (L >= nitems) return false;
        if (L >= nfull) { const int sidx = (int)L - nfull, un = sidx / nsplit, ks = sidx % nsplit, per = nt / nsplit;
            u.pm = nMf + un / nN; u.pn = un % nN; u.kt0 = ks * per; u.nkt = per; u.ks = ks; return true; }
        int wgid = (int)L; { const int q = nfull / NXCD, r = nfull % NXCD, xcd = wgid % NXCD, off = wgid / NXCD; wgid = (xcd < r ? xcd * (q + 1) : r * (q + 1) + (xcd - r) * q) + off; }
        const int nig = WGM * nN, gid = wgid / nig, fm = gid * WGM, gsz = (nMf - fm) < WGM ? (nMf - fm) : WGM;
        u.pm = fm + ((wgid % nig) % gsz); u.pn = (wgid % nig) / gsz; u.kt0 = 0; u.nkt = nt; u.ks = -1; return true;
    }
    __device__ __forceinline__ void a_ready(const Unit&) const {}
    __device__ __forceinline__ void done(const Unit&) const {}
};

__device__ __forceinline__ unsigned cvt_pk_bf16(float lo, float hi) { unsigned r; asm volatile("v_cvt_pk_bf16_f32 %0, %1, %2" : "=v"(r) : "v"(lo), "v"(hi)); return r; }
__device__ __forceinline__ float sigm(float x) { return __builtin_amdgcn_rcpf(1.0f + __expf(-x)); }

struct EpiProj {
    static constexpr bool PERM = true, AFTER_DRAIN = false;
    bf16_t *U, *QIG; float* F; const float* bias; const float* lb;
    __device__ __forceinline__ void operator()(const f32x4 (&acc)[2][2][4][2], const Unit& u, int wr, int wc, int fr, int fq) const {
        const int row0 = u.pm * BM + wr * 64 + fr;
        const int cl = wc * 32 + 8 * fq;
        const int bcol = u.pn * BM + cl;
        f32x4 bv[2][2];
#pragma unroll
        for (int bj = 0; bj < 2; ++bj)
#pragma unroll
            for (int n = 0; n < 2; ++n) bv[bj][n] = *(const f32x4*)(bias + bcol + bj * HALF + 4 * n);
        if (u.pn < 8) {
#pragma unroll
            for (int ai = 0; ai < 2; ++ai)
#pragma unroll
                for (int m = 0; m < 4; ++m) {
                    const size_t row = (size_t)(row0 + ai * HALF + m * 16);
                    float o[8];
#pragma unroll
                    for (int n = 0; n < 2; ++n) { const f32x4 a = acc[ai][0][m][n] + bv[0][n], g = acc[ai][1][m][n] + bv[1][n];
#pragma unroll
                        for (int e = 0; e < 4; ++e) o[n * 4 + e] = a[e] * sigm(g[e]); }
                    u32x4 w; w.x = cvt_pk_bf16(o[0], o[1]); w.y = cvt_pk_bf16(o[2], o[3]); w.z = cvt_pk_bf16(o[4], o[5]); w.w = cvt_pk_bf16(o[6], o[7]);
                    *(u32x4*)(U + row * 1024 + u.pn * HALF + cl) = w;
                }
        } else {
            const int grp = (u.pn - 8) >> 2;
            const int cbase = ((u.pn - 8) & 3) * BM + cl;
            if (grp == 1) {
                f32x4 lv[2][2];
#pragma unroll
                for (int bj = 0; bj < 2; ++bj)
#pragma unroll
                    for (int n = 0; n < 2; ++n) lv[bj][n] = *(const f32x4*)(lb + cbase + bj * HALF + 4 * n);
#pragma unroll
                for (int ai = 0; ai < 2; ++ai)
#pragma unroll
                    for (int m = 0; m < 4; ++m) {
                        const size_t row = (size_t)(row0 + ai * HALF + m * 16);
#pragma unroll
                        for (int bj = 0; bj < 2; ++bj)
#pragma unroll
                            for (int n = 0; n < 2; ++n) { const f32x4 x = acc[ai][bj][m][n] + bv[bj][n]; const f32x4 l = lv[bj][n]; f32x4 o;
#pragma unroll
                                for (int e = 0; e < 4; ++e) o[e] = l[e] + (1.0f - l[e]) * sigm(x[e]);
                                *(f32x4*)(F + row * 1024 + cbase + bj * HALF + 4 * n) = o; }
                    }
            } else {
                bf16_t* O = QIG + (size_t)(grp - (grp > 0 ? 1 : 0)) * ((size_t)8704 * 1024);
                const bool act = grp != 2;
#pragma unroll
                for (int ai = 0; ai < 2; ++ai)
#pragma unroll
                    for (int m = 0; m < 4; ++m) {
                        const size_t row = (size_t)(row0 + ai * HALF + m * 16);
#pragma unroll
                        for (int bj = 0; bj < 2; ++bj) { float o[8];
#pragma unroll
                            for (int n = 0; n < 2; ++n) { const f32x4 x = acc[ai][bj][m][n] + bv[bj][n];
#pragma unroll
                                for (int e = 0; e < 4; ++e) o[n * 4 + e] = act ? x[e] * sigm(x[e]) : x[e]; }
                            u32x4 w; w.x = cvt_pk_bf16(o[0], o[1]); w.y = cvt_pk_bf16(o[2], o[3]); w.z = cvt_pk_bf16(o[4], o[5]); w.w = cvt_pk_bf16(o[6], o[7]);
                            *(u32x4*)(O + row * 1024 + cbase + bj * HALF) = w; }
                    }
            }
        }
    }
};
struct EpiRes {
    static constexpr bool PERM = false, AFTER_DRAIN = false;
    const float* baseP; const float* baseS; float* out; int split; float alpha; float* part;
    __device__ __forceinline__ void operator()(const f32x4 (&acc)[2][2][4][2], const Unit& u, int wr, int wc, int fr, int fq) const {
        const int row0 = u.pm * BM + wr * 64 + fr;
        const int col0 = u.pn * BM + wc * 32 + 4 * fq;
        if (u.ks >= 0) {
            float* pb = part + (size_t)u.ks * 512 * 2048;
#pragma unroll
            for (int ai = 0; ai < 2; ++ai)
#pragma unroll
                for (int m = 0; m < 4; ++m) { float* op = pb + (size_t)(row0 + ai * HALF + m * 16 - split) * 2048;
#pragma unroll
                    for (int bj = 0; bj < 2; ++bj)
#pragma unroll
                        for (int n = 0; n < 2; ++n) *(f32x4*)(op + col0 + bj * HALF + n * 16) = acc[ai][bj][m][n]; }
            return;
        }
#pragma unroll
        for (int ai = 0; ai < 2; ++ai)
#pragma unroll
            for (int m = 0; m < 4; ++m) {
                const int row = row0 + ai * HALF + m * 16;
                const float* bp = row < split ? baseP + (size_t)row * 2048 : baseS + (size_t)(row - split) * 2048;
                float* op = out + (size_t)row * 2048;
#pragma unroll
                for (int bj = 0; bj < 2; ++bj)
#pragma unroll
                    for (int n = 0; n < 2; ++n) { const int c = col0 + bj * HALF + n * 16; const f32x4 b = *(const f32x4*)(bp + c); *(f32x4*)(op + c) = b * alpha + acc[ai][bj][m][n]; }
            }
    }
};
template <bool BASE_BF16> struct EpiResB {
    static constexpr bool PERM = true, AFTER_DRAIN = false;
    const void* base; bf16_t* out; int split; float alpha; bf16_t* part;
    __device__ __forceinline__ void operator()(const f32x4 (&acc)[2][2][4][2], const Unit& u, int wr, int wc, int fr, int fq) const {
        const int row0 = u.pm * BM + wr * 64 + fr;
        const int col0 = u.pn * BM + wc * 32 + 8 * fq;
        if (u.ks >= 0) {
            bf16_t* pb = part + (size_t)u.ks * 512 * 2048;
#pragma unroll
            for (int ai = 0; ai < 2; ++ai)
#pragma unroll
                for (int m = 0; m < 4; ++m) { bf16_t* op = pb + (size_t)(row0 + ai * HALF + m * 16 - split) * 2048;
#pragma unroll
                    for (int bj = 0; bj < 2; ++bj) { const f32x4 v0 = acc[ai][bj][m][0], v1 = acc[ai][bj][m][1];
                        u32x4 w; w.x = cvt_pk_bf16(v0[0], v0[1]); w.y = cvt_pk_bf16(v0[2], v0[3]); w.z = cvt_pk_bf16(v1[0], v1[1]); w.w = cvt_pk_bf16(v1[2], v1[3]);
                        *(u32x4*)(op + col0 + bj * HALF) = w; } }
            return;
        }
#pragma unroll
        for (int ai = 0; ai < 2; ++ai)
#pragma unroll
            for (int m = 0; m < 4; ++m) {
                const size_t row = (size_t)(row0 + ai * HALF + m * 16);
#pragma unroll
                for (int bj = 0; bj < 2; ++bj) { const int c = col0 + bj * HALF; f32x4 b0, b1;
                    if constexpr (BASE_BF16) { const u32x4 w = *(const u32x4*)((const bf16_t*)base + row * 2048 + c);
                        b0 = (f32x4){__uint_as_float(w.x << 16), __uint_as_float(w.x & 0xffff0000u), __uint_as_float(w.y << 16), __uint_as_float(w.y & 0xffff0000u)};
                        b1 = (f32x4){__uint_as_float(w.z << 16), __uint_as_float(w.z & 0xffff0000u), __uint_as_float(w.w << 16), __uint_as_float(w.w & 0xffff0000u)}; }
                    else { const float* bp = (const float*)base + row * 2048 + c; b0 = *(const f32x4*)bp; b1 = *(const f32x4*)(bp + 4); }
                    const f32x4 v0 = b0 * alpha + acc[ai][bj][m][0], v1 = b1 * alpha + acc[ai][bj][m][1];
                    u32x4 w; w.x = cvt_pk_bf16(v0[0], v0[1]); w.y = cvt_pk_bf16(v0[2], v0[3]); w.z = cvt_pk_bf16(v1[0], v1[1]); w.w = cvt_pk_bf16(v1[2], v1[3]);
                    *(u32x4*)(out + row * 2048 + c) = w; }
            }
    }
};
struct EpiGateUp {
    static constexpr bool PERM = true, AFTER_DRAIN = false;
    bf16_t* O; int ldc;
    __device__ __forceinline__ void operator()(const f32x4 (&acc)[2][2][4][2], const Unit& u, int wr, int wc, int fr, int fq) const {
        const int row0 = u.pm * BM + wr * 64 + fr;
        const int cl = wc * 32 + 8 * fq;
#pragma unroll
        for (int ai = 0; ai < 2; ++ai)
#pragma unroll
            for (int m = 0; m < 4; ++m) {
                const size_t row = (size_t)(row0 + ai * HALF + m * 16);
                float o[8];
#pragma unroll
                for (int n = 0; n < 2; ++n) { const f32x4 g = acc[ai][0][m][n], up = acc[ai][1][m][n];
#pragma unroll
                    for (int e = 0; e < 4; ++e) o[n * 4 + e] = g[e] * sigm(g[e]) * up[e]; }
                u32x4 w; w.x = cvt_pk_bf16(o[0], o[1]); w.y = cvt_pk_bf16(o[2], o[3]); w.z = cvt_pk_bf16(o[4], o[5]); w.w = cvt_pk_bf16(o[6], o[7]);
                *(u32x4*)(O + row * ldc + u.pn * HALF + cl) = w;
            }
    }
};

template <class Epi, class Sched, bool ALIGN_EPI = false, bool SP2 = false>
__device__ __forceinline__ void gemm_phase(PG8_LAS unsigned char* lds, const Gemm g, const Sched& S, const Epi& E) {
    int tid_ = threadIdx.x; asm volatile("" : "+v"(tid_));
    const int tid = tid_, wid = __builtin_amdgcn_readfirstlane(tid >> 6), lane = tid & 63, wr = wid >> 2, wc = wid & 3, fr = lane & 15, fq = lane >> 4;
    const int K = g.K;
    unsigned voffA[2], voffB[2];
#pragma unroll
    for (int i = 0; i < 2; ++i) { int R, C; stage_rc(tid * 16 + i * 8192, R, C); const int Rb = Epi::PERM ? ((R & ~31) + perm32(R & 31)) : R;
        voffA[i] = (unsigned)(R * K + C) * 2u; voffB[i] = (unsigned)(Rb * K + C) * 2u; }
    const size_t kstep = (size_t)(BK * 2);
    const size_t hstep = (size_t)HALF * K * 2;
    const size_t tstep = 2 * hstep;
    const unsigned ldsw = (unsigned)wid * 1024u;
    const int aoff = lds_byte(wr * 64 + fr, fq * 8), boff = lds_byte(wc * 32 + fr, fq * 8);
#define PG8_SA(b, h) (((b) * 2 + (h)) * HTB)
#define PG8_SB(b, h) ((4 + (b) * 2 + (h)) * HTB)
#define PG8_STAGE(bufoff, gbase, voff) do { _Pragma("unroll") for (int _i = 0; _i < 2; ++_i) \
        __builtin_amdgcn_global_load_lds((const unsigned*)((const char*)(gbase) + (voff)[_i]), (PG8_LAS unsigned*)(lds + (bufoff) + ldsw + _i * 8192), 16, 0, 0); } while (0)
#define PG8_LDA(dst, b, h) do { _Pragma("unroll") for (int m = 0; m < 4; ++m) _Pragma("unroll") for (int k = 0; k < 2; ++k) dst[m][k] = *(const PG8_LAS bf16x8*)(lds + PG8_SA(b, h) + aoff + m * 2048 + k * 1024); } while (0)
#define PG8_LDB(dst, b, h) do { _Pragma("unroll") for (int n = 0; n < 2; ++n) _Pragma("unroll") for (int k = 0; k < 2; ++k) dst[n][k] = *(const PG8_LAS bf16x8*)(lds + PG8_SB(b, h) + boff + n * 2048 + k * 1024); } while (0)
#define PG8_MMA(ai, bj, At, Bt) do { __builtin_amdgcn_s_setprio(1); _Pragma("unroll") for (int m = 0; m < 4; ++m) _Pragma("unroll") for (int n = 0; n < 2; ++n) _Pragma("unroll") for (int k = 0; k < 2; ++k) \
        acc[ai][bj][m][n] = __builtin_amdgcn_mfma_f32_16x16x32_bf16(Bt[n][k], At[m][k], acc[ai][bj][m][n], 0, 0, 0); __builtin_amdgcn_s_setprio(0); } while (0)
#define PG8_WAIT_V(n) asm volatile("s_waitcnt vmcnt(" #n ")" ::: "memory")
#define PG8_WAIT_L(n) asm volatile("s_waitcnt lgkmcnt(" #n ")" ::: "memory")
#define PG8_BAR __builtin_amdgcn_s_barrier()
#define PG8_SCHED __builtin_amdgcn_sched_barrier(0)
    Unit cur, nxt; int ui = 0;
    if (!S.next(0, cur)) return;
    f32x4 acc[2][2][4][2];
#pragma unroll
    for (int a = 0; a < 2; ++a)
#pragma unroll
        for (int b = 0; b < 2; ++b)
#pragma unroll
            for (int m = 0; m < 4; ++m)
#pragma unroll
                for (int n = 0; n < 2; ++n) acc[a][b][m][n] = (f32x4){0.f, 0.f, 0.f, 0.f};
    bf16x8 At[4][2], B0[2][2], B1[2][2];
    const char* cA = (const char*)g.A + (size_t)cur.pm * tstep + (size_t)cur.kt0 * kstep; const char* cB = (const char*)g.Bt + (size_t)cur.pn * tstep + (size_t)cur.kt0 * kstep;
    S.a_ready(cur);
    if constexpr (SP2) {
        PG8_STAGE(PG8_SB(0, 0), cB, voffB); PG8_STAGE(PG8_SB(0, 1), cB + hstep, voffB); PG8_STAGE(PG8_SA(0, 0), cA, voffA); PG8_STAGE(PG8_SA(0, 1), cA + hstep, voffA);
        if (wr == 1) PG8_BAR;
        PG8_WAIT_V(2); PG8_BAR;
        PG8_STAGE(PG8_SB(1, 0), cB + kstep, voffB); PG8_STAGE(PG8_SA(1, 0), cA + kstep, voffA); PG8_STAGE(PG8_SB(1, 1), cB + hstep + kstep, voffB);
        PG8_WAIT_V(6); PG8_BAR;
    } else {
        PG8_STAGE(PG8_SB(0, 0), cB, voffB); PG8_STAGE(PG8_SA(0, 0), cA, voffA); PG8_STAGE(PG8_SB(0, 1), cB + hstep, voffB); PG8_STAGE(PG8_SA(0, 1), cA + hstep, voffA);
        if (wr == 1) PG8_BAR;
        PG8_WAIT_V(4); PG8_BAR;
        PG8_STAGE(PG8_SB(1, 0), cB + kstep, voffB); PG8_STAGE(PG8_SA(1, 0), cA + kstep, voffA); PG8_STAGE(PG8_SB(1, 1), cB + hstep + kstep, voffB);
        PG8_WAIT_V(6); PG8_BAR;
    }
    for (;;) {
        const bool has_next = S.next(ui + 1, nxt);
        const char* nA = has_next ? (const char*)g.A + (size_t)nxt.pm * tstep + (size_t)nxt.kt0 * kstep : cA; const char* nB = has_next ? (const char*)g.Bt + (size_t)nxt.pn * tstep + (size_t)nxt.kt0 * kstep : cB;
        const int nt = cur.nkt;
        for (int t = 0; t < nt; t += 2) {
            const bool last = (t == nt - 2);
            const char* a1 = cA + (size_t)(t + 1) * kstep;
            const char* a2 = last ? nA : cA + (size_t)(t + 2) * kstep; const char* b2 = last ? nB : cB + (size_t)(t + 2) * kstep;
            const char* a3 = a2 + kstep; const char* b3 = b2 + kstep;
            if (last && has_next) S.a_ready(nxt);
            if constexpr (SP2) {
            PG8_LDB(B0, 0, 0); PG8_LDB(B1, 0, 1); PG8_SCHED; PG8_LDA(At, 0, 0); PG8_STAGE(PG8_SA(1, 1), a1 + hstep, voffA);
            PG8_WAIT_V(8); PG8_WAIT_L(0); PG8_BAR; PG8_MMA(0, 0, At, B0); PG8_MMA(0, 1, At, B1); PG8_BAR; PG8_SCHED;
            PG8_LDA(At, 0, 1); PG8_STAGE(PG8_SB(0, 0), b2, voffB); PG8_STAGE(PG8_SB(0, 1), b2 + hstep, voffB); PG8_STAGE(PG8_SA(0, 0), a2, voffA);
            PG8_WAIT_V(8); PG8_WAIT_L(0); PG8_BAR; PG8_MMA(1, 0, At, B0); PG8_MMA(1, 1, At, B1); PG8_BAR; PG8_SCHED;
            PG8_LDB(B0, 1, 0); PG8_LDB(B1, 1, 1); PG8_SCHED; PG8_LDA(At, 1, 0); PG8_STAGE(PG8_SA(0, 1), a2 + hstep, voffA);
            PG8_WAIT_V(8); PG8_WAIT_L(0); PG8_BAR; PG8_MMA(0, 0, At, B0); PG8_MMA(0, 1, At, B1); PG8_BAR; PG8_SCHED;
            PG8_LDA(At, 1, 1); PG8_STAGE(PG8_SB(1, 0), b3, voffB); PG8_STAGE(PG8_SB(1, 1), b3 + hstep, voffB); PG8_STAGE(PG8_SA(1, 0), a3, voffA);
            PG8_WAIT_V(8); PG8_WAIT_L(0); PG8_BAR; PG8_MMA(1, 0, At, B0); PG8_MMA(1, 1, At, B1); PG8_BAR; PG8_SCHED;
            } else {
            PG8_LDB(B0, 0, 0); PG8_SCHED; PG8_LDA(At, 0, 0); PG8_STAGE(PG8_SA(1, 1), a1 + hstep, voffA);
            PG8_WAIT_L(8); PG8_BAR; PG8_WAIT_L(0); PG8_MMA(0, 0, At, B0); PG8_BAR; PG8_SCHED;
            PG8_LDB(B1, 0, 1); PG8_STAGE(PG8_SB(0, 0), b2, voffB);
            PG8_BAR; PG8_WAIT_L(0); PG8_MMA(0, 1, At, B1); PG8_BAR;
            PG8_LDA(At, 0, 1); PG8_STAGE(PG8_SA(0, 0), a2, voffA);
            PG8_BAR; PG8_WAIT_L(0); PG8_MMA(1, 0, At, B0); PG8_BAR; PG8_SCHED;
            PG8_STAGE(PG8_SB(0, 1), b2 + hstep, voffB);
            PG8_WAIT_V(6); PG8_BAR; PG8_MMA(1, 1, At, B1); PG8_BAR;
            PG8_LDB(B0, 1, 0); PG8_SCHED; PG8_LDA(At, 1, 0); PG8_STAGE(PG8_SA(0, 1), a2 + hstep, voffA);
            PG8_WAIT_L(8); PG8_BAR; PG8_WAIT_L(0); PG8_MMA(0, 0, At, B0); PG8_BAR; PG8_SCHED;
            PG8_LDB(B1, 1, 1); PG8_STAGE(PG8_SB(1, 0), b3, voffB);
            PG8_BAR; PG8_WAIT_L(0); PG8_MMA(0, 1, At, B1); PG8_BAR;
            PG8_LDA(At, 1, 1); PG8_STAGE(PG8_SA(1, 0), a3, voffA);
            PG8_BAR; PG8_WAIT_L(0); PG8_MMA(1, 0, At, B0); PG8_BAR; PG8_SCHED;
            PG8_STAGE(PG8_SB(1, 1), b3 + hstep, voffB);
            PG8_WAIT_V(6); PG8_BAR; PG8_MMA(1, 1, At, B1); PG8_BAR;
            }
        }
        if constexpr (ALIGN_EPI) { if (wr == 0) PG8_BAR; }
        if constexpr (!Epi::AFTER_DRAIN) { E(acc, cur, wr, wc, fr, fq); S.done(cur); }
        if (!has_next) break;
#pragma unroll
        for (int a = 0; a < 2; ++a)
#pragma unroll
            for (int b = 0; b < 2; ++b)
#pragma unroll
                for (int m = 0; m < 4; ++m)
#pragma unroll
                    for (int n = 0; n < 2; ++n) acc[a][b][m][n] = (f32x4){0.f, 0.f, 0.f, 0.f};
        cur = nxt; cA = nA; cB = nB; ++ui;
        if constexpr (ALIGN_EPI) { if (wr == 1) PG8_BAR; }
    }
    PG8_WAIT_V(0);
    if constexpr (!ALIGN_EPI) { if (wr == 0) PG8_BAR; }
    PG8_BAR;
#undef PG8_SA
#undef PG8_SB
#undef PG8_STAGE
#undef PG8_LDA
#undef PG8_LDB
#undef PG8_MMA
#undef PG8_WAIT_V
#undef PG8_WAIT_L
#undef PG8_BAR
#undef PG8_SCHED
}
}

constexpr int D = 2048, MP = 8192, MS = 512, M = MP + MS, CW = 1024, NH = 8, HD = 128, FF = 5632, NIN = 6144;
constexpr float LN_EPS = 1e-5f;
constexpr float ALPHA = 1.189207115002721f;
constexpr int NWAVES = 8;
constexpr int LDS_BYTES = 147456;
constexpr int N_PHASES = 10;

constexpr size_t MiB = 1u << 20;
constexpr size_t WS_LB = 64 * 1024, WS_BIASP = 128 * 1024;
constexpr size_t WS_WIN = 1 * MiB, WS_WOUT = 25 * MiB, WS_WGU = 33 * MiB, WS_WDN = 77 * MiB;
constexpr size_t WS_XB = 99 * MiB, WS_MIX = 133 * MiB;
constexpr size_t WS_U = 167 * MiB, WS_Q = 184 * MiB, WS_I = 201 * MiB, WS_G = 218 * MiB, WS_F = 235 * MiB, WS_END = 269 * MiB;
constexpr size_t WS_ACT = 167 * MiB;
constexpr int SPLIT5 = 4, SPLIT8 = 11;
constexpr int W_DN_SPLIT = 44 * 64;
constexpr size_t WS_PB5 = 167 * MiB;
constexpr size_t WS_PB8 = 33 * MiB;
static_assert(WS_PB8 + (size_t)SPLIT8 * 512 * 2048 * 4 <= 77 * MiB && (32 % SPLIT5) == 0 && (88 % SPLIT8) == 0 && (32 / SPLIT5) % 2 == 0 && (88 / SPLIT8) % 2 == 0 && 32 / SPLIT5 >= 4 && 88 / SPLIT8 >= 4, "split-K layout");
static_assert(WS_ACT + (size_t)M * FF * 2 <= WS_END, "act overlay");
constexpr size_t O_Y = 0, O_NCP = (size_t)M * D, O_NHP = O_NCP + 4 * 30 * 1024, O_NCS = O_NHP + 4 * 8 * 128 * 128, O_NHS = O_NCS + 32 * 30 * 1024;
constexpr size_t O_ST = 0, O_DC = (size_t)1024 * 16384;

#define LAS __attribute__((address_space(3)))
typedef unsigned short bf16;
typedef float f32x4 __attribute__((ext_vector_type(4)));
typedef float f32x2 __attribute__((ext_vector_type(2)));
typedef unsigned v4u __attribute__((ext_vector_type(4)));
typedef unsigned v2u __attribute__((ext_vector_type(2)));
typedef float f32x16 __attribute__((ext_vector_type(16)));
typedef unsigned u32x8 __attribute__((ext_vector_type(8)));
#define CAS __attribute__((address_space(4)))
#define LDS_WAIT() asm volatile("s_waitcnt lgkmcnt(0)" ::: "memory")

__device__ __forceinline__ unsigned f2bf(float f) { unsigned u = __builtin_bit_cast(unsigned, f); return (u + 0x7fffu + ((u >> 16) & 1u)) >> 16; }
__device__ __forceinline__ unsigned pk2(float lo, float hi) { return f2bf(lo) | (f2bf(hi) << 16); }
__device__ __forceinline__ bf16 bfr(float x) { return (bf16)(pg8::cvt_pk_bf16(x, 0.f) & 0xffffu); }
__device__ __forceinline__ float bf2f(unsigned short b) { return __uint_as_float((unsigned)b << 16); }
__device__ __forceinline__ float sigm(float x) { return __builtin_amdgcn_rcpf(1.0f + __expf(-x)); }
__device__ __forceinline__ float wave_sum(float v) {
#pragma unroll
    for (int o = 1; o < 64; o <<= 1) v += __shfl_xor(v, o);
    return v;
}

__device__ __forceinline__ void transpose_item(const float* W, int K, int N, bf16* WT, int k0, int n0, int dst_row0, LAS float* scr, int lane) {
    { f32x4 v[8];
      const int kq = lane >> 3, n4 = (lane & 7) * 4;
#pragma unroll
      for (int i = 0; i < 8; ++i) v[i] = *(const f32x4*)(W + (size_t)(k0 + 8 * i + kq) * N + n0 + n4);
#pragma unroll
      for (int i = 0; i < 8; ++i) { LAS float* d = scr + (8 * i + kq) * 33 + n4; d[0] = v[i].x; d[1] = v[i].y; d[2] = v[i].z; d[3] = v[i].w; } }
    LDS_WAIT(); asm volatile("" ::: "memory");
    const int c = lane & 7;
#pragma unroll
    for (int j = 0; j < 4; ++j) { const int n = (lane >> 3) + 8 * j; const LAS float* s = scr + (8 * c) * 33 + n;
        v4u o; o.x = pk2(s[0 * 33], s[1 * 33]); o.y = pk2(s[2 * 33], s[3 * 33]); o.z = pk2(s[4 * 33], s[5 * 33]); o.w = pk2(s[6 * 33], s[7 * 33]);
        *(v4u*)(WT + (size_t)(dst_row0 + n) * K + k0 + 8 * c) = o; }
    LDS_WAIT(); asm volatile("" ::: "memory");
}

template <int KIND> __device__ __forceinline__ void transpose_stream(const float* W, int K, int N, bf16* WT, int first, int end, int stride, LAS float* scr, int lane) {
    const int nblk = N / 32, kq = lane >> 3, n4 = (lane & 7) * 4, c = lane & 7;
    f32x4 v[8];
    if (first < end) { const int kb = first / nblk, nb = first % nblk;
#pragma unroll
        for (int i = 0; i < 8; ++i) v[i] = *(const f32x4*)(W + (size_t)(64 * kb + 8 * i + kq) * N + 32 * nb + n4); }
    for (int it = first; it < end; it += stride) {
        const int kb = it / nblk, nb = it % nblk, k0 = 64 * kb, n0 = 32 * nb;
        int dst;
        if (KIND == 1) dst = n0 < 2048 ? ((n0 & 1023) >> 7) * 256 + (n0 >> 10) * 128 + (n0 & 127) : n0;
        else if (KIND == 2) dst = (n0 >> 7) * 256 + (n0 & 127);
        else if (KIND == 3) dst = (n0 >> 7) * 256 + 128 + (n0 & 127);
        else dst = n0;
#pragma unroll
        for (int i = 0; i < 8; ++i) { LAS float* d = scr + (8 * i + kq) * 33 + n4; d[0] = v[i].x; d[1] = v[i].y; d[2] = v[i].z; d[3] = v[i].w; }
        { const int nx = it + stride;
          if (nx < end) { const int kb2 = nx / nblk, nb2 = nx % nblk;
#pragma unroll
              for (int i = 0; i < 8; ++i) v[i] = *(const f32x4*)(W + (size_t)(64 * kb2 + 8 * i + kq) * N + 32 * nb2 + n4); } }
        LDS_WAIT(); asm volatile("" ::: "memory");
#pragma unroll
        for (int j = 0; j < 4; ++j) { const int n = (lane >> 3) + 8 * j; const LAS float* sp = scr + (8 * c) * 33 + n;
            v4u o; o.x = pg8::cvt_pk_bf16(sp[0 * 33], sp[1 * 33]); o.y = pg8::cvt_pk_bf16(sp[2 * 33], sp[3 * 33]); o.z = pg8::cvt_pk_bf16(sp[4 * 33], sp[5 * 33]); o.w = pg8::cvt_pk_bf16(sp[6 * 33], sp[7 * 33]);
            *(v4u*)(WT + (size_t)(dst + n) * K + k0 + 8 * c) = o; }
        LDS_WAIT(); asm volatile("" ::: "memory");
    }
}

template <bool SRC_BF16, int NP> __device__ __forceinline__ void ln_row(const void* src, const bf16* part, size_t pstride, float alpha, float* dstf, bf16* dstb, const float* g, const float* b, int lane) {
    f32x4 v[8]; float s = 0.f;
    if constexpr (SRC_BF16) {
#pragma unroll
        for (int j = 0; j < 8; ++j) { const v2u w = ((const v2u*)src)[lane + 64 * j]; v[j] = (f32x4){__uint_as_float(w.x << 16), __uint_as_float(w.x & 0xffff0000u), __uint_as_float(w.y << 16), __uint_as_float(w.y & 0xffff0000u)}; }
    } else {
#pragma unroll
        for (int j = 0; j < 8; ++j) v[j] = ((const f32x4*)src)[lane + 64 * j];
    }
    if constexpr (NP > 0) {
#pragma unroll
        for (int j = 0; j < 8; ++j) v[j] = v[j] * alpha;
#pragma unroll
        for (int p0 = 0; p0 < NP; p0 += 4) {
            v2u w[4][8];
#pragma unroll
            for (int pp = 0; pp < 4; ++pp) if (p0 + pp < NP) { const v2u* pr = (const v2u*)(part + (size_t)(p0 + pp) * pstride) + lane;
#pragma unroll
                for (int j = 0; j < 8; ++j) w[pp][j] = pr[64 * j]; }
#pragma unroll
            for (int pp = 0; pp < 4; ++pp) if (p0 + pp < NP) {
#pragma unroll
                for (int j = 0; j < 8; ++j) v[j] += (f32x4){__uint_as_float(w[pp][j].x << 16), __uint_as_float(w[pp][j].x & 0xffff0000u), __uint_as_float(w[pp][j].y << 16), __uint_as_float(w[pp][j].y & 0xffff0000u)}; }
        }
    }
#pragma unroll
    for (int j = 0; j < 8; ++j) s += (v[j].x + v[j].y) + (v[j].z + v[j].w);
    const float mean = wave_sum(s) * (1.f / D); float s2 = 0.f;
#pragma unroll
    for (int j = 0; j < 8; ++j) { v[j] = v[j] - mean; s2 += (v[j].x * v[j].x + v[j].y * v[j].y) + (v[j].z * v[j].z + v[j].w * v[j].w); }
    const float rstd = 1.f / sqrtf(wave_sum(s2) * (1.f / D) + LN_EPS);
#pragma unroll
    for (int j = 0; j < 8; ++j) {
        const f32x4 gg = ((const f32x4*)g)[lane + 64 * j], bb = ((const f32x4*)b)[lane + 64 * j];
        const f32x4 o = v[j] * rstd * gg + bb;
        if (dstf) ((f32x4*)dstf)[lane + 64 * j] = o;
        if (dstb) { v2u w; w.x = pk2(o.x, o.y); w.y = pk2(o.z, o.w); ((v2u*)dstb)[lane + 64 * j] = w; }
    }
}

__device__ __forceinline__ void ln_core(f32x4 (&v)[8], const f32x4 (&gg)[8], const f32x4 (&bb)[8], float* dstf, bf16* dstb, int lane) {
    float s = 0.f;
#pragma unroll
    for (int j = 0; j < 8; ++j) s += (v[j].x + v[j].y) + (v[j].z + v[j].w);
    const float mean = wave_sum(s) * (1.f / D); float s2 = 0.f;
#pragma unroll
    for (int j = 0; j < 8; ++j) { v[j] = v[j] - mean; s2 += (v[j].x * v[j].x + v[j].y * v[j].y) + (v[j].z * v[j].z + v[j].w * v[j].w); }
    const float rstd = 1.f / sqrtf(wave_sum(s2) * (1.f / D) + LN_EPS);
#pragma unroll
    for (int j = 0; j < 8; ++j) {
        const f32x4 o = v[j] * rstd * gg[j] + bb[j];
        if (dstf) ((f32x4*)dstf)[lane + 64 * j] = o;
        if (dstb) { v2u w; w.x = pk2(o.x, o.y); w.y = pk2(o.z, o.w); ((v2u*)dstb)[lane + 64 * j] = w; }
    }
}
__device__ __forceinline__ void ln_rows_bf16(const bf16* src, float* dstf, bf16* dstb, const float* g, const float* b, int gw, int NGW, int nrows, int lane) {
    f32x4 gg[8], bb[8];
#pragma unroll
    for (int j = 0; j < 8; ++j) { gg[j] = ((const f32x4*)g)[lane + 64 * j]; bb[j] = ((const f32x4*)b)[lane + 64 * j]; }
    v2u cur[8];
    if (gw < nrows) {
#pragma unroll
        for (int j = 0; j < 8; ++j) cur[j] = ((const v2u*)(src + (size_t)gw * D))[lane + 64 * j];
    }
    for (int m = gw; m < nrows; m += NGW) {
        v2u nxt[8];
        const bool hn = m + NGW < nrows;
        if (hn) {
#pragma unroll
            for (int j = 0; j < 8; ++j) nxt[j] = ((const v2u*)(src + (size_t)(m + NGW) * D))[lane + 64 * j];
        }
        f32x4 v[8];
#pragma unroll
        for (int j = 0; j < 8; ++j) v[j] = (f32x4){__uint_as_float(cur[j].x << 16), __uint_as_float(cur[j].x & 0xffff0000u), __uint_as_float(cur[j].y << 16), __uint_as_float(cur[j].y & 0xffff0000u)};
        ln_core(v, gg, bb, dstf ? dstf + (size_t)m * D : nullptr, dstb ? dstb + (size_t)m * D : nullptr, lane);
        if (hn) {
#pragma unroll
            for (int j = 0; j < 8; ++j) cur[j] = nxt[j];
        }
    }
}

#define XB_TMO      128
#define XB_XCNT(j)  (256  + 64 * (j))
#define XB_XSUB(j)  (1280 + 64 * (j))
#define XB_XGEN(j)  (2304 + 64 * (j))
#define XB_TOP      3328
#define XB_TOPGEN   3392
#define XCD_BAR_WORDS 3456
#define XB_SPIN_CAP (1u << 18)
__device__ __forceinline__ unsigned xb_ld(unsigned* p)              { return __hip_atomic_load(p, __ATOMIC_RELAXED, __HIP_MEMORY_SCOPE_AGENT); }
__device__ __forceinline__ unsigned xb_add(unsigned* p, unsigned v) { return __hip_atomic_fetch_add(p, v, __ATOMIC_RELAXED, __HIP_MEMORY_SCOPE_AGENT); }
__device__ __forceinline__ unsigned xb_xcc_id() { return (unsigned)__builtin_amdgcn_s_getreg((3 << 11) | 20) & 0xFu; }
#define XB_SPIN(cond, bar) do { unsigned _sp = 0; while (cond) { __builtin_amdgcn_s_sleep(1); \
    if ((++_sp & 255u) == 0u) { if (xb_ld(&(bar)[XB_TMO])) break; if (_sp > XB_SPIN_CAP) { atomicAdd(&(bar)[XB_TMO], 1u); break; } } } } while (0)
struct XcdBarrier { unsigned* bar; unsigned x; volatile LAS unsigned* st; };
__device__ __forceinline__ XcdBarrier xcd_barrier_post(unsigned* bar, volatile LAS unsigned* st) {
    XcdBarrier b; b.bar = bar; b.x = xb_xcc_id(); b.st = st;
    if (threadIdx.x == 0) (void)xb_add(&bar[XB_XCNT(b.x)], 1u);
    return b;
}
__device__ __forceinline__ void xcd_barrier_complete(unsigned* bar, unsigned x, unsigned& nloc, unsigned& nx) {
    const unsigned G = gridDim.x * gridDim.y * gridDim.z;
    unsigned sum, cnt, mine, sp = 0u;
    for (;;) {
        sum = 0u; cnt = 0u; mine = 0u;
#pragma unroll
        for (unsigned j = 0; j < 16; ++j) { const unsigned c = xb_ld(&bar[XB_XCNT(j)]); sum += c; cnt += (c > 0u) ? 1u : 0u; mine = (j == x) ? c : mine; }
        if (sum == G) break;
        __builtin_amdgcn_s_sleep(1);
        if ((++sp & 255u) == 0u) { if (xb_ld(&bar[XB_TMO])) break; if (sp > XB_SPIN_CAP) { atomicAdd(&bar[XB_TMO], 1u); break; } }
    }
    nloc = mine > 0u ? mine : 1u; nx = cnt > 0u ? cnt : 1u;
}
__device__ __forceinline__ void xcd_barrier(const XcdBarrier& b) {
    asm volatile("s_waitcnt vmcnt(0)" ::: "memory");
    __syncthreads();
    if (threadIdx.x == 0) {
        unsigned* bar = b.bar;
        __builtin_amdgcn_s_waitcnt(0);
        unsigned nloc = b.st[0], nx = b.st[1];
        if (nloc == 0u) { xcd_barrier_complete(bar, b.x, nloc, nx); b.st[0] = nloc; b.st[1] = nx; }
        const unsigned old = xb_add(&bar[XB_XSUB(b.x)], 1u);
        const unsigned gen = old / nloc;
        if (old + 1u == (gen + 1u) * nloc) {
            __builtin_amdgcn_fence(__ATOMIC_RELEASE, "agent");
            asm volatile("s_waitcnt vmcnt(0)" ::: "memory");
            const unsigned og = xb_add(&bar[XB_TOP], 1u);
            const unsigned tg = og / nx;
            if (og + 1u == (tg + 1u) * nx) xb_add(&bar[XB_TOPGEN], 1u);
            else XB_SPIN(xb_ld(&bar[XB_TOPGEN]) == tg, bar);
            __builtin_amdgcn_fence(__ATOMIC_ACQUIRE, "agent");
            xb_add(&bar[XB_XGEN(b.x)], 1u);
            asm volatile("s_waitcnt vmcnt(0)" ::: "memory");
        } else {
            XB_SPIN(xb_ld(&bar[XB_XGEN(b.x)]) == gen, bar);
            __builtin_amdgcn_fence(__ATOMIC_ACQUIRE, "agent");
            asm volatile("s_waitcnt vmcnt(0)" ::: "memory");
        }
    }
    __syncthreads();
}

struct Args { const float* in[20]; float* out; unsigned char* ws; int ph_lo, ph_hi; };

__global__ void __launch_bounds__(NWAVES * 64, 2) fwd_kernel(Args args) {
    extern __shared__ __attribute__((aligned(16))) unsigned char lds_raw[];
    LAS unsigned char* lds = (LAS unsigned char*)lds_raw;
    const int tid = threadIdx.x, lane = tid & 63, wave = __builtin_amdgcn_readfirstlane(tid >> 6);
    const int G = gridDim.x, bx = blockIdx.x;
    const int gt = bx * 512 + tid, NT = G * 512;
    const int gw = bx * NWAVES + wave, NGW = G * NWAVES;

#define x_prompt (args.in[0])
#define x_sample (args.in[1])
#define cache_conv (args.in[2])
#define state_hgrn (args.in[3])
#define w_in (args.in[4])
#define b_in (args.in[5])
#define w_dw (args.in[6])
#define b_dw (args.in[7])
#define cn_g (args.in[8])
#define cn_b (args.in[9])
#define hlb (args.in[10])
#define hg_ng (args.in[11])
#define w_out (args.in[12])
#define ln1_g (args.in[13])
#define ln1_b (args.in[14])
#define w_gate (args.in[15])
#define w_up (args.in[16])
#define w_down (args.in[17])
#define ln2_g (args.in[18])
#define ln2_b (args.in[19])
#define out (args.out)
#define ws (args.ws)
#define LB ((float*)(ws + WS_LB))
#define BIASP ((float*)(ws + WS_BIASP))
#define WIN ((bf16*)(ws + WS_WIN))
#define WOUT ((bf16*)(ws + WS_WOUT))
#define WGU ((bf16*)(ws + WS_WGU))
#define WDN ((bf16*)(ws + WS_WDN))
#define XB ((bf16*)(ws + WS_XB))
#define MIX ((bf16*)(ws + WS_MIX))
#define U ((bf16*)(ws + WS_U))
#define Q ((bf16*)(ws + WS_Q))
#define F ((float*)(ws + WS_F))
#define I ((bf16*)(ws + WS_I))
#define Gt ((bf16*)(ws + WS_G))
#define ACT ((bf16*)(ws + WS_ACT))
#define ST (out + O_ST)
#define DC (out + O_DC)

    const int lo = args.ph_lo, hi = args.ph_hi;
    volatile LAS unsigned* MISC = (volatile LAS unsigned*)(lds + LDS_BYTES - 64);
    if (tid < 16) MISC[tid] = 0u;
    __syncthreads();
    XcdBarrier xbar = xcd_barrier_post((unsigned*)ws, MISC + 8);
#ifndef PH_MASK
#define PH_MASK 0x3ff
#endif
#define IN(k) (((PH_MASK >> (k)) & 1) && lo <= (k) && (k) < hi)
#ifndef REP_MASK
#define REP_MASK 0
#endif
#define NREP(k) (1 + ((REP_MASK >> (k)) & 1))
#ifdef TS_A
    unsigned long long ts_a = 0, ts_b = 0;
#define STAMP(k) do { if ((k) == TS_A) ts_a = __builtin_amdgcn_s_memrealtime(); if ((k) == TS_B) ts_b = __builtin_amdgcn_s_memrealtime(); } while (0)
#else
#define STAMP(k) do { } while (0)
#endif
#define SEAM(k) do { if (IN(k) && IN((k) + 1)) { xcd_barrier(xbar); } STAMP((k) + 1); } while (0)
    STAMP(0);
    if (hi > 1000) cg::this_grid().sync();

    if (IN(0)) for (int rep_ = 0; rep_ < NREP(0); ++rep_) { if (rep_) xcd_barrier(xbar);
        LAS float* scr = (LAS float*)(lds + wave * 16384);
        constexpr int I_IN = 32 * 192;
        transpose_stream<1>(w_in, D, NIN, WIN, gw, I_IN, NGW, scr, lane);
        constexpr int NV = M * D / 8, NVP = MP * D / 8;
#pragma unroll 4
        for (int i = gt; i < NV; i += NT) {
            const float* src = i < NVP ? x_prompt + (size_t)i * 8 : x_sample + (size_t)(i - NVP) * 8;
            const f32x4 a = *(const f32x4*)src, b = *(const f32x4*)(src + 4);
            v4u o; o.x = pk2(a.x, a.y); o.y = pk2(a.z, a.w); o.z = pk2(b.x, b.y); o.w = pk2(b.z, b.w);
            *(v4u*)(XB + (size_t)i * 8) = o;
        }
        for (int i = gt; i < 1024; i += NT) LB[i] = sigm(hlb[i] - hlb[1024 + i]);
        for (int i = gt; i < NIN; i += NT) { const int orig = i < 2048 ? ((i & 255) >> 7) * 1024 + (i >> 8) * 128 + (i & 127) : i; BIASP[i] = b_in[orig]; }
    }
    SEAM(0);
#ifdef EXTRA_SYNCS
    for (int i_ = 0; i_ < EXTRA_SYNCS; ++i_) cg::this_grid().sync();
#endif

    if (IN(1)) for (int rep_ = 0; rep_ < NREP(1); ++rep_) { if (rep_) xcd_barrier(xbar);
        pg8::Gemm g{XB, WIN, M, NIN, D}; pg8::StaticOrder S; S.init(M, NIN, D, G, bx);
        pg8::EpiProj E{U, Q, F, BIASP, LB};
        pg8::gemm_phase<pg8::EpiProj, pg8::StaticOrder, true, true>(lds, g, S, E);
        const int nlast = S.nitems % G;
        if (nlast > 0 && bx >= nlast) {
            LAS float* scr = (LAS float*)(lds + wave * 16384);
            constexpr int I_OUT = 32 * 64, I_G = 32 * 176, I_DN = 88 * 64;
            const int gw2 = (bx - nlast) * NWAVES + wave, NGW2 = (G - nlast) * NWAVES;
            transpose_stream<0>(w_out, D, D, WOUT, gw2, I_OUT, NGW2, scr, lane);
            transpose_stream<2>(w_gate, D, FF, WGU, gw2, I_G, NGW2, scr, lane);
            transpose_stream<3>(w_up, D, FF, WGU, gw2, I_G, NGW2, scr, lane);
        }
    }
    SEAM(1);

    if (IN(2)) for (int rep_ = 0; rep_ < NREP(2); ++rep_) { if (rep_) xcd_barrier(xbar);
#define LBAR2() do { asm volatile("s_waitcnt lgkmcnt(0)" ::: "memory"); __builtin_amdgcn_s_barrier(); asm volatile("" ::: "memory"); } while (0)
        float pf[16]; unsigned short pi[16];
#define P2_LOAD(IT) do { const int bh_ = (IT) >> 5, c_ = (IT) & 31, h_ = bh_ & 7, row0_ = (bh_ >> 3) * 2048 + c_ * 64; const int k_ = tid & 127, qtr_ = __builtin_amdgcn_readfirstlane(tid >> 7); \
            _Pragma("unroll") for (int s_ = 0; s_ < 16; ++s_) { const size_t gi = (size_t)(row0_ + qtr_ * 16 + s_) * 1024 + h_ * 128 + k_; pf[s_] = F[gi]; pi[s_] = I[gi]; } } while (0)
        if (bx < 1024) P2_LOAD(bx);
        for (int it = bx; it < 1024 + 544; it += G) {
#ifdef P2_PROBE
            if (rep_ == 1 && ((P2_PROBE == 1) == (it >= 1024))) continue;
#endif
            LBAR2();
            if (it == 1024 + bx) STAMP(20);
            if (it < 1024) {
                const int bh = it >> 5, c = it & 31, b = bh >> 3, h = bh & 7;
                const int row0 = b * 2048 + c * 64;
                LAS bf16* KEt = (LAS bf16*)lds;
                LAS bf16* Vt = (LAS bf16*)(lds + 18432);
                LAS float* Tq = (LAS float*)(lds + 36864);
                const int k = tid & 127, qtr = __builtin_amdgcn_readfirstlane(tid >> 7);
                float lf[16], kk[16]; unsigned short iv[16];
#pragma unroll
                for (int s_ = 0; s_ < 16; ++s_) { const float f = pf[s_]; lf[s_] = __builtin_amdgcn_logf(f); kk[s_] = 1.0f - f; iv[s_] = pi[s_]; }
                if (it + G < 1024) P2_LOAD(it + G);
                float run = 0.f; float suf[16];
#pragma unroll
                for (int s_ = 15; s_ >= 0; --s_) { suf[s_] = run; run += lf[s_]; }
                Tq[qtr * 128 + k] = run;
                { v4u w0, w1;
                  w0.x = iv[0] | ((unsigned)iv[1] << 16); w0.y = iv[2] | ((unsigned)iv[3] << 16); w0.z = iv[4] | ((unsigned)iv[5] << 16); w0.w = iv[6] | ((unsigned)iv[7] << 16);
                  w1.x = iv[8] | ((unsigned)iv[9] << 16); w1.y = iv[10] | ((unsigned)iv[11] << 16); w1.z = iv[12] | ((unsigned)iv[13] << 16); w1.w = iv[14] | ((unsigned)iv[15] << 16);
                  *(LAS v4u*)(Vt + k * 72 + qtr * 16) = w0; *(LAS v4u*)(Vt + k * 72 + qtr * 16 + 8) = w1; }
                LBAR2();
                float later = 0.f, total = 0.f;
#pragma unroll
                for (int q2 = 0; q2 < 4; ++q2) { const float tq = Tq[q2 * 128 + k]; total += tq; later += q2 > qtr ? tq : 0.f; }
                { float ke[16];
#pragma unroll
                  for (int s_ = 0; s_ < 16; ++s_) ke[s_] = kk[s_] * __builtin_amdgcn_exp2f(suf[s_] + later);
                  v4u w0, w1;
                  w0.x = pg8::cvt_pk_bf16(ke[0], ke[1]); w0.y = pg8::cvt_pk_bf16(ke[2], ke[3]); w0.z = pg8::cvt_pk_bf16(ke[4], ke[5]); w0.w = pg8::cvt_pk_bf16(ke[6], ke[7]);
                  w1.x = pg8::cvt_pk_bf16(ke[8], ke[9]); w1.y = pg8::cvt_pk_bf16(ke[10], ke[11]); w1.z = pg8::cvt_pk_bf16(ke[12], ke[13]); w1.w = pg8::cvt_pk_bf16(ke[14], ke[15]);
                  *(LAS v4u*)(KEt + k * 72 + qtr * 16) = w0; *(LAS v4u*)(KEt + k * 72 + qtr * 16 + 8) = w1; }
                if (qtr == 0) DC[it * 128 + k] = exp2f(total);
                LBAR2();
                { const int r = lane & 15, q = lane >> 4;
                  const pg8::bf16x8 a0 = *(const LAS pg8::bf16x8*)(Vt + (16 * wave + r) * 72 + 8 * q), a1 = *(const LAS pg8::bf16x8*)(Vt + (16 * wave + r) * 72 + 8 * q + 32);
                  float* sp = ST + (size_t)it * 16384 + (size_t)(16 * wave + 4 * q) * 128 + r;
#pragma unroll
                  for (int kt = 0; kt < 8; ++kt) {
                      const pg8::bf16x8 b0 = *(const LAS pg8::bf16x8*)(KEt + (16 * kt + r) * 72 + 8 * q), b1 = *(const LAS pg8::bf16x8*)(KEt + (16 * kt + r) * 72 + 8 * q + 32);
                      f32x4 acc = (f32x4){0.f, 0.f, 0.f, 0.f};
                      acc = __builtin_amdgcn_mfma_f32_16x16x32_bf16(a0, b0, acc, 0, 0, 0);
                      acc = __builtin_amdgcn_mfma_f32_16x16x32_bf16(a1, b1, acc, 0, 0, 0);
#pragma unroll
                      for (int j = 0; j < 4; ++j) sp[j * 128 + 16 * kt] = acc[j];
                  } }
            } else {
                const int m0 = (it - 1024) * 16;
                const bool samp = m0 >= MP;
                int t0, seq0; const float* hist = cache_conv;
                if (!samp) { t0 = m0 & 2047; seq0 = m0 - t0; }
                else { t0 = 0; seq0 = m0; hist = cache_conv + (size_t)((m0 - MP) >> 4) * 30 * 1024; }
                const int hrow0 = samp ? ((m0 - MP) >> 4) * 30 : 0;
                const __amdgpu_buffer_rsrc_t rU = __builtin_amdgcn_make_buffer_rsrc((void*)U, 0, M * 1024 * 2, 0x00020000);
                const __amdgpu_buffer_rsrc_t rH = __builtin_amdgcn_make_buffer_rsrc((void*)cache_conv, 0, 32 * 30 * 1024 * 4, 0x00020000);
                const __amdgpu_buffer_rsrc_t rW = __builtin_amdgcn_make_buffer_rsrc((void*)w_dw, 0, 31 * 1024 * 4, 0x00020000);
                const bool interior = t0 >= 30;
                LAS float* hbuf = (LAS float*)(lds + 16384);
                LAS f32x2* stat = (LAS f32x2*)(lds + 16384 + 65536);
                const int c = 2 * tid;
                f32x2 acc[16];
                { const f32x2 bb = *(const f32x2*)(b_dw + c);
#pragma unroll
                  for (int t = 0; t < 16; ++t) acc[t] = bb; }
#pragma unroll
                for (int ch = 0; ch < 2; ++ch) {
                    const int j0 = ch * 16, nj = ch ? 15 : 16;
                    f32x2 win[31];
                    if (interior) {
                        const int rb = (seq0 + t0 - 30 + j0) * 2048;
#pragma unroll
                        for (int xi = 0; xi < 31; ++xi) if (xi < nj + 15) { const unsigned pw = __builtin_amdgcn_raw_buffer_load_b32(rU, 4 * tid, rb + xi * 2048, 0); win[xi] = (f32x2){__uint_as_float(pw << 16), __uint_as_float(pw & 0xffff0000u)}; }
                    } else {
#pragma unroll
                        for (int xi = 0; xi < 31; ++xi) if (xi < nj + 15) {
                            const int tr = t0 - 30 + j0 + xi;
                            f32x2 wv = (f32x2){0.f, 0.f};
                            if (tr >= 0) { const unsigned pw = __builtin_amdgcn_raw_buffer_load_b32(rU, 4 * tid, (seq0 + tr) * 2048, 0); wv = (f32x2){__uint_as_float(pw << 16), __uint_as_float(pw & 0xffff0000u)}; }
                            else if (samp) { const v2u hv = __builtin_amdgcn_raw_buffer_load_b64(rH, 8 * tid, (hrow0 + 30 + tr) * 4096, 0); wv = (f32x2){__uint_as_float(hv.x), __uint_as_float(hv.y)}; }
                            win[xi] = wv;
                        }
                    }
#pragma unroll
                    for (int jj = 0; jj < 16; ++jj) if (jj < nj) { const v2u wu = __builtin_amdgcn_raw_buffer_load_b64(rW, 8 * tid, (j0 + jj) * 4096, 0); const f32x2 w2 = (f32x2){__uint_as_float(wu.x), __uint_as_float(wu.y)};
#pragma unroll
                        for (int t = 0; t < 16; ++t) acc[t] += w2 * win[t + jj]; }
                    asm volatile("" ::: "memory");
                }
#pragma unroll
                for (int t = 0; t < 16; ++t) *(LAS f32x2*)(hbuf + t * 1024 + c) = acc[t];
                __syncthreads();
#pragma unroll
                for (int tt = 0; tt < 2; ++tt) { const int t = 2 * wave + tt; float s1 = 0.f, s2 = 0.f;
#pragma unroll
                    for (int i = 0; i < 4; ++i) { const f32x4 x = *(const LAS f32x4*)(hbuf + t * 1024 + 4 * lane + 256 * i); s1 += (x.x + x.y) + (x.z + x.w); s2 += (x.x * x.x + x.y * x.y) + (x.z * x.z + x.w * x.w); }
                    s1 = wave_sum(s1); s2 = wave_sum(s2);
                    const float mu = s1 * (1.f / 1024.f); float var = s2 * (1.f / 1024.f) - mu * mu; var = var > 0.f ? var : 0.f;
                    if (lane == 0) stat[t] = (f32x2){mu, 1.f / sqrtf(var + LN_EPS)}; }
                __syncthreads();
                const f32x2 gg = *(const f32x2*)(cn_g + c), bb2 = *(const f32x2*)(cn_b + c);
#pragma unroll
                for (int t = 0; t < 16; ++t) {
                    const f32x2 st2 = stat[t];
                    float y0 = (acc[t].x - st2.x) * st2.y * gg.x + bb2.x, y1 = (acc[t].y - st2.x) * st2.y * gg.y + bb2.y;
                    y0 = y0 * sigm(y0); y1 = y1 * sigm(y1);
                    *(unsigned*)(MIX + (size_t)(m0 + t) * 2048 + c) = pk2(y0, y1);
                }
            }
        }
        STAMP(21);
        { const int nx = (1024 + 544) % G;
          const int first = (nx > 0 && nx < G) ? nx : 0, nwg = G - first;
          if (bx >= first) {
              const int gt2 = (bx - first) * 512 + tid, NT2 = nwg * 512;
              for (int i = gt2; i < 4 * 30 * 1024; i += NT2) { const int b = i / 30720, j = (i >> 10) % 30, c = i & 1023;
                  out[O_NCP + i] = bf2f(U[(size_t)(b * 2048 + 2018 + j) * 1024 + c]); }
              for (int i = gt2; i < 32 * 30 * 1024; i += NT2) { const int sb = i / 30720, j = (i >> 10) % 30, c = i & 1023;
                  out[O_NCS + i] = j < 14 ? cache_conv[(size_t)sb * 30720 + (16 + j) * 1024 + c] : bf2f(U[(size_t)(MP + sb * 16 + j - 14) * 1024 + c]); }
          } }
    }
    SEAM(2);

    if (IN(3)) {
        for (int e = gt; e < 32 * 4096; e += NT) {
            const int bh = e >> 12, r = e & 4095, v = r >> 5, k4 = r & 31;
            f32x4 S = (f32x4){0.f, 0.f, 0.f, 0.f};
#pragma unroll 8
            for (int c = 0; c < 32; ++c) {
                f32x4* p = (f32x4*)(ST + ((size_t)(bh * 32 + c) * 128 + v) * 128 + k4 * 4);
                const f32x4 A = *p; const f32x4 d = *(const f32x4*)(DC + (bh * 32 + c) * 128 + k4 * 4);
                *p = S; S = S * d + A;
            }
            float* o = out + O_NHP + (size_t)bh * 16384 + (size_t)(k4 * 4) * 128 + v;
            o[0] = S.x; o[128] = S.y; o[256] = S.z; o[384] = S.w;
        }
    }
    SEAM(3);

    if (IN(4)) for (int rep_ = 0; rep_ < NREP(4); ++rep_) { if (rep_) xcd_barrier(xbar);
        LAS float* vl = (LAS float*)lds; LAS float* red = (LAS float*)(lds + 8192);
        LAS float* fl2 = (LAS float*)(lds + 73728); LAS float* ql2 = (LAS float*)(lds + 81920);
#define LBAR() do { asm volatile("s_waitcnt lgkmcnt(0)" ::: "memory"); __builtin_amdgcn_s_barrier(); asm volatile("" ::: "memory"); } while (0)
        float fr[16]; unsigned short qh[16], ih[16]; unsigned gq[8]; f32x4 sv[8];
#define P4_LOAD(IT) do { const int bh_ = (IT) >> 5, c_ = (IT) & 31, h_ = bh_ & 7, row0_ = (bh_ >> 3) * 2048 + c_ * 64; const int k_ = tid & 127, qtr_ = __builtin_amdgcn_readfirstlane(tid >> 7); \
            _Pragma("unroll") for (int s_ = 0; s_ < 16; ++s_) { const size_t gi = (size_t)(row0_ + qtr_ * 16 + s_) * 1024 + h_ * 128 + k_; fr[s_] = F[gi]; qh[s_] = Q[gi]; ih[s_] = I[gi]; } \
            _Pragma("unroll") for (int j = 0; j < 8; ++j) sv[j] = *(const f32x4*)(ST + (size_t)(IT) * 16384 + (size_t)(tid + 512 * j) * 4); \
            _Pragma("unroll") for (int tt = 0; tt < 8; ++tt) { const size_t m = (size_t)(row0_ + wave * 8 + tt); gq[tt] = *(const unsigned*)(Gt + m * 1024 + h_ * 128 + 2 * lane); } } while (0)
        if (bx < 1024) P4_LOAD(bx);
        float ng0 = hg_ng[2 * lane], ng1 = hg_ng[2 * lane + 1];
        asm volatile("" : "+v"(ng0), "+v"(ng1));
        for (int it = bx; it < 1024; it += G) {
          {
            const int bh = it >> 5, c = it & 31, h = bh & 7, row0 = (bh >> 3) * 2048 + c * 64;
            LAS bf16* St = (LAS bf16*)lds;
            LAS bf16* QD = (LAS bf16*)(lds + 34816);
            LAS bf16* Vt = (LAS bf16*)(lds + 52224);
            LAS bf16* Pm = (LAS bf16*)(lds + 70656);
            LAS bf16* QDI = (LAS bf16*)(lds + 79872);
            LAS bf16* KD = (LAS bf16*)(lds + 97280);
            LAS float* Tq = (LAS float*)(lds + 140800);
            LAS float* Ob = (LAS float*)(lds + 79872);
            LBAR();
            const int k = tid & 127, qtr = __builtin_amdgcn_readfirstlane(tid >> 7);
            float pre[16], kk[16], qq[16]; unsigned short iv[16];
#pragma unroll
            for (int s_ = 0; s_ < 16; ++s_) { const float f = fr[s_]; pre[s_] = __builtin_amdgcn_logf(f); kk[s_] = 1.0f - f; qq[s_] = bf2f(qh[s_]); iv[s_] = ih[s_]; }
#pragma unroll
            for (int j = 0; j < 8; ++j) { const int e = tid + 512 * j, v = e >> 5, k4 = e & 31; const f32x4 x = sv[j];
                v2u w; w.x = pk2(x.x, x.y); w.y = pk2(x.z, x.w); *(LAS v2u*)(St + v * 136 + k4 * 4) = w; }
#pragma unroll
            for (int s_ = 1; s_ < 16; ++s_) pre[s_] += pre[s_ - 1];
            const float tot = pre[15];
            Tq[qtr * 128 + k] = tot;
            { v4u w0, w1;
              w0.x = iv[0] | ((unsigned)iv[1] << 16); w0.y = iv[2] | ((unsigned)iv[3] << 16); w0.z = iv[4] | ((unsigned)iv[5] << 16); w0.w = iv[6] | ((unsigned)iv[7] << 16);
              w1.x = iv[8] | ((unsigned)iv[9] << 16); w1.y = iv[10] | ((unsigned)iv[11] << 16); w1.z = iv[12] | ((unsigned)iv[13] << 16); w1.w = iv[14] | ((unsigned)iv[15] << 16);
              *(LAS v4u*)(Vt + k * 72 + qtr * 16) = w0; *(LAS v4u*)(Vt + k * 72 + qtr * 16 + 8) = w1; }
            const int kdoff = qtr == 0 ? 0 : (qtr == 1 ? 16 : (qtr == 2 ? 48 : 96));
#pragma unroll
            for (int s_ = 0; s_ < 16; ++s_) {
                QDI[(16 * qtr + s_) * 136 + k] = bfr(qq[s_] * __builtin_amdgcn_exp2f(pre[s_]));
                KD[(kdoff + 16 * qtr + s_) * 136 + k] = bfr(kk[s_] * __builtin_amdgcn_exp2f(fminf(-pre[s_], 120.f)));
            }
            LBAR();
            { float lb_ = 0.f;
#pragma unroll
              for (int q2 = 0; q2 < 4; ++q2) lb_ += q2 < qtr ? Tq[q2 * 128 + k] : 0.f;
#pragma unroll
              for (int s_ = 0; s_ < 16; ++s_) QD[(16 * qtr + s_) * 136 + k] = bfr(qq[s_] * __builtin_amdgcn_exp2f(pre[s_] + lb_));
              float gap = 0.f;
              for (int i = qtr + 1; i < 4; ++i) {
                  const int off = i == 1 ? 16 : (i == 2 ? 48 : 96);
#pragma unroll
                  for (int s_ = 0; s_ < 16; ++s_) KD[(off + 16 * qtr + s_) * 136 + k] = bfr(kk[s_] * __builtin_amdgcn_exp2f((tot - pre[s_]) + gap));
                  gap += Tq[i * 128 + k];
              } }
            unsigned gpre[8];
#pragma unroll
            for (int i = 0; i < 8; ++i) gpre[i] = gq[i];
            if (it + G < 1024) P4_LOAD(it + G);
            LBAR();
            const int r = lane & 15, q = lane >> 4;
            for (int n = wave; n < 10; n += 8) {
                const int i = n == 0 ? 0 : (n < 3 ? 1 : (n < 6 ? 2 : 3)), j = n - (i == 0 ? 0 : (i == 1 ? 1 : (i == 2 ? 3 : 6)));
                const int off = i == 0 ? 0 : (i == 1 ? 16 : (i == 2 ? 48 : 96));
                f32x4 acc = (f32x4){0.f, 0.f, 0.f, 0.f};
#pragma unroll
                for (int ks = 0; ks < 4; ++ks) {
                    const pg8::bf16x8 a = *(const LAS pg8::bf16x8*)(QDI + (16 * i + r) * 136 + 8 * q + 32 * ks);
                    const pg8::bf16x8 bq = *(const LAS pg8::bf16x8*)(KD + (off + 16 * j + r) * 136 + 8 * q + 32 * ks);
                    acc = __builtin_amdgcn_mfma_f32_16x16x32_bf16(a, bq, acc, 0, 0, 0);
                }
#pragma unroll
                for (int jj = 0; jj < 4; ++jj) { const float x = (i != j || r <= 4 * q + jj) ? acc[jj] : 0.f; Pm[(16 * i + 4 * q + jj) * 72 + 16 * j + r] = bfr(x); }
            }
            if (wave == 2 || wave == 3) { const int i = wave == 2 ? 0 : 2, j = i + 1;
#pragma unroll
                for (int jj = 0; jj < 4; ++jj) Pm[(16 * i + 4 * q + jj) * 72 + 16 * j + r] = (bf16)0; }
            LBAR();
            { const int i = wave >> 1, vt0 = 4 * (wave & 1);
              pg8::bf16x8 pa[2], qa[4];
#pragma unroll
              for (int ks = 0; ks < 2; ++ks) pa[ks] = *(const LAS pg8::bf16x8*)(Pm + (16 * i + r) * 72 + 8 * q + 32 * ks);
#pragma unroll
              for (int ks = 0; ks < 4; ++ks) qa[ks] = *(const LAS pg8::bf16x8*)(QD + (16 * i + r) * 136 + 8 * q + 32 * ks);
#pragma unroll
              for (int vv = 0; vv < 4; ++vv) { const int vt = vt0 + vv;
                  f32x4 acc = (f32x4){0.f, 0.f, 0.f, 0.f};
                  acc = __builtin_amdgcn_mfma_f32_16x16x32_bf16(pa[0], *(const LAS pg8::bf16x8*)(Vt + (16 * vt + r) * 72 + 8 * q), acc, 0, 0, 0);
                  if (i >= 2) acc = __builtin_amdgcn_mfma_f32_16x16x32_bf16(pa[1], *(const LAS pg8::bf16x8*)(Vt + (16 * vt + r) * 72 + 8 * q + 32), acc, 0, 0, 0);
#pragma unroll
                  for (int ks = 0; ks < 4; ++ks) acc = __builtin_amdgcn_mfma_f32_16x16x32_bf16(qa[ks], *(const LAS pg8::bf16x8*)(St + (16 * vt + r) * 136 + 8 * q + 32 * ks), acc, 0, 0, 0);
#pragma unroll
                  for (int jj = 0; jj < 4; ++jj) Ob[(16 * i + 4 * q + jj) * 132 + 16 * vt + r] = acc[jj];
              } }
            LBAR();
            { float o0[8], o1[8], ss[8];
#pragma unroll
              for (int tt = 0; tt < 8; ++tt) { const int t = wave * 8 + tt; const f32x2 ov = *(const LAS f32x2*)(Ob + t * 132 + 2 * lane); o0[tt] = ov.x; o1[tt] = ov.y; ss[tt] = o0[tt] * o0[tt] + o1[tt] * o1[tt]; }
#pragma unroll
              for (int o = 1; o < 64; o <<= 1) {
#pragma unroll
                  for (int tt = 0; tt < 8; ++tt) ss[tt] += __shfl_xor(ss[tt], o); }
#pragma unroll
              for (int tt = 0; tt < 8; ++tt) {
                  const float rr = __builtin_amdgcn_rsqf(ss[tt] * (1.f / 128.f) + LN_EPS);
                  const size_t m = (size_t)(row0 + wave * 8 + tt);
                  const float g0 = __uint_as_float(gpre[tt] << 16), g1 = __uint_as_float(gpre[tt] & 0xffff0000u);
                  *(unsigned*)(MIX + m * 2048 + 1024 + h * 128 + 2 * lane) = pg8::cvt_pk_bf16(o0[tt] * rr * ng0 * g0, o1[tt] * rr * ng1 * g1);
              } }
          }
        }
#undef P4_LOAD
#undef LBAR
        __syncthreads();
        STAMP(22);
        for (int it = 1024 + bx; it < 1024 + 256; it += G) {
          {
            int row0, h, nsb; const float* sinit; float* sfin = nullptr;
            if (it < 1024) { const int bh = it >> 5, c = it & 31; h = bh & 7; row0 = (bh >> 3) * 2048 + c * 64; nsb = 4; sinit = ST + (size_t)it * 16384; }
            else { const int j = it - 1024; h = j & 7; row0 = MP + (j >> 3) * 16; nsb = 1; sinit = state_hgrn + (size_t)j * 16384; sfin = out + O_NHS + (size_t)j * 16384; }
            f32x2 Sa[8], Sb[8];
            { const float* sp = sinit + (size_t)(wave * 16) * 128 + lane;
#pragma unroll
              for (int i = 0; i < 8; ++i) { Sa[i] = (f32x2){sp[(2 * i) * 128], sp[(2 * i + 1) * 128]}; Sb[i] = (f32x2){sp[(2 * i) * 128 + 64], sp[(2 * i + 1) * 128 + 64]}; } }
            for (int sb = 0; sb < nsb; ++sb) {
                __syncthreads();
#pragma unroll
                for (int e4 = 0; e4 < 4; ++e4) { const int e = tid + e4 * 512, t = e >> 7, k = e & 127; const size_t gi = (size_t)(row0 + sb * 16 + t) * 1024 + h * 128 + k;
                    vl[e] = bf2f(I[gi]); fl2[e] = F[gi]; ql2[e] = bf2f(Q[gi]); }
                __syncthreads();
#pragma unroll 2
                for (int t = 0; t < 16; ++t) {
                    f32x4 f4[4], q4[4];
#pragma unroll
                    for (int i = 0; i < 4; ++i) { f4[i] = *(const LAS f32x4*)(fl2 + t * 128 + wave * 16 + 4 * i); q4[i] = *(const LAS f32x4*)(ql2 + t * 128 + wave * 16 + 4 * i); }
                    const float va = vl[t * 128 + lane], vb = vl[t * 128 + 64 + lane];
                    const f32x2 va2 = (f32x2){va, va}, vb2 = (f32x2){vb, vb};
                    f32x2 oa = (f32x2){0.f, 0.f}, ob = (f32x2){0.f, 0.f};
#pragma unroll
                    for (int i = 0; i < 8; ++i) { const f32x2 f2 = (f32x2){f4[i >> 1][2 * (i & 1)], f4[i >> 1][2 * (i & 1) + 1]};
                        const f32x2 q2 = (f32x2){q4[i >> 1][2 * (i & 1)], q4[i >> 1][2 * (i & 1) + 1]};
                        Sa[i] = f2 * (Sa[i] - va2) + va2; Sb[i] = f2 * (Sb[i] - vb2) + vb2;
                        oa += q2 * Sa[i]; ob += q2 * Sb[i]; }
                    red[(wave * 16 + t) * 128 + lane] = oa.x + oa.y; red[(wave * 16 + t) * 128 + 64 + lane] = ob.x + ob.y;
                }
                __syncthreads();
#pragma unroll
                for (int tt = 0; tt < 2; ++tt) {
                    const int t = wave * 2 + tt;
                    float o0 = 0.f, o1 = 0.f;
#pragma unroll
                    for (int q8 = 0; q8 < 8; ++q8) { o0 += red[(q8 * 16 + t) * 128 + lane]; o1 += red[(q8 * 16 + t) * 128 + 64 + lane]; }
                    const float ss = wave_sum(o0 * o0 + o1 * o1);
                    const float r = 1.f / sqrtf(ss * (1.f / 128.f) + LN_EPS);
                    const size_t m = (size_t)(row0 + sb * 16 + t);
                    const float g0 = bf2f(Gt[m * 1024 + h * 128 + lane]), g1 = bf2f(Gt[m * 1024 + h * 128 + 64 + lane]);
                    MIX[m * 2048 + 1024 + h * 128 + lane] = (bf16)f2bf(o0 * r * hg_ng[lane] * g0);
                    MIX[m * 2048 + 1024 + h * 128 + 64 + lane] = (bf16)f2bf(o1 * r * hg_ng[64 + lane] * g1);
                }
            }
            if (sfin) { float* sp = sfin + (size_t)(wave * 16) * 128 + lane;
#pragma unroll
                for (int i = 0; i < 8; ++i) { sp[(2 * i) * 128] = Sa[i].x; sp[(2 * i + 1) * 128] = Sa[i].y; sp[(2 * i) * 128 + 64] = Sb[i].x; sp[(2 * i + 1) * 128 + 64] = Sb[i].y; } }
          }
        }
        __syncthreads();
    }
    SEAM(4);

    if (IN(5)) for (int rep_ = 0; rep_ < NREP(5); ++rep_) { if (rep_) xcd_barrier(xbar);
        pg8::Gemm g{MIX, WOUT, M, D, D}; pg8::StaticOrder S; S.init(M, D, D, G, bx, MP, SPLIT5);
        pg8::EpiResB<true> E{XB, XB, MP, ALPHA, (pg8::bf16_t*)(ws + WS_PB5)};
        pg8::gemm_phase<pg8::EpiResB<true>, pg8::StaticOrder, true, true>(lds, g, S, E);
        { const int nlast = S.nitems % G, first = nlast > 0 ? nlast : 0, nwg = G - first;
          if (bx >= first) {
              LAS float* scr = (LAS float*)(lds + wave * 16384);
              constexpr int I_G = 32 * 176;
              const int gw2 = (bx - first) * NWAVES + wave, NGW2 = nwg * NWAVES;
              transpose_stream<0>(w_down, FF, D, WDN, gw2, W_DN_SPLIT, NGW2, scr, lane);
          } }
    }
    SEAM(5);

    if (IN(6)) {
        ln_rows_bf16(XB, nullptr, XB, ln1_g, ln1_b, gw, NGW, MP, lane);
        if ((gw & 3) == 0) for (int m = MP + (gw >> 2); m < M; m += (NGW + 3) >> 2)
            ln_row<false, SPLIT5>(x_sample + (size_t)(m - MP) * D, (const bf16*)(ws + WS_PB5) + (size_t)(m - MP) * D, (size_t)MS * D, ALPHA, nullptr, XB + (size_t)m * D, ln1_g, ln1_b, lane);
    }
    SEAM(6);

    if (IN(7)) for (int rep_ = 0; rep_ < NREP(7); ++rep_) { if (rep_) xcd_barrier(xbar);
        pg8::Gemm g{XB, WGU, M, 2 * FF, D}; pg8::StaticOrder S; S.init(M, 2 * FF, D, G, bx);
        pg8::EpiGateUp E{ACT, FF};
        pg8::gemm_phase<pg8::EpiGateUp, pg8::StaticOrder, true, true>(lds, g, S, E);
        const int nlast = S.nitems % G;
        {
            const int first = nlast > 0 ? nlast : 0, nwg = G - first;
            if (bx >= first) {
                LAS float* scr = (LAS float*)(lds + wave * 16384);
                constexpr int I_DN = 88 * 64;
                const int gw2 = (bx - first) * NWAVES + wave, NGW2 = nwg * NWAVES;
                transpose_stream<0>(w_down, FF, D, WDN, W_DN_SPLIT + gw2, I_DN, NGW2, scr, lane);
            }
        }
    }
    SEAM(7);

    if (IN(8)) {
        pg8::Gemm g{ACT, WDN, M, D, FF}; pg8::StaticOrder S; S.init(M, D, FF, G, bx, MP, SPLIT8);
        pg8::EpiResB<true> E{XB, MIX, MP, ALPHA, (pg8::bf16_t*)(ws + WS_PB8)};
        pg8::gemm_phase<pg8::EpiResB<true>, pg8::StaticOrder, true, true>(lds, g, S, E);
    }
    SEAM(8);

    if (IN(9)) {
        ln_rows_bf16(MIX, out, nullptr, ln2_g, ln2_b, gw, NGW, MP, lane);
        if ((gw & 3) == 0) for (int m = MP + (gw >> 2); m < M; m += (NGW + 3) >> 2)
            ln_row<true, SPLIT8>(XB + (size_t)m * D, (const bf16*)(ws + WS_PB8) + (size_t)(m - MP) * D, (size_t)MS * D, ALPHA, out + (size_t)m * D, nullptr, ln2_g, ln2_b, lane);
    }
    STAMP(10);
#ifdef TS_A
    __syncthreads();
    if (bx == 0 && tid == 0) { asm volatile("s_waitcnt vmcnt(0)" ::: "memory"); out[0] = out[0] + (float)(ts_b - ts_a) * 1e-4f; }
#endif
#undef IN
#undef SEAM
}

#undef x_prompt
#undef x_sample
#undef cache_conv
#undef state_hgrn
#undef w_in
#undef b_in
#undef w_dw
#undef b_dw
#undef cn_g
#undef cn_b
#undef hlb
#undef hg_ng
#undef w_out
#undef ln1_g
#undef ln1_b
#undef w_gate
#undef w_up
#undef w_down
#undef ln2_g
#undef ln2_b
#undef out
#undef ws
#undef LB
#undef BIASP
#undef WIN
#undef WOUT
#undef WGU
#undef WDN
#undef XB
#undef MIX
#undef U
#undef Q
#undef F
#undef I
#undef Gt
#undef ACT
#undef ST
#undef DC

extern "C" void kernel_launch(void* const* d_in, const int* in_sizes, int n_in, void* d_out, int out_size, void* d_ws, size_t ws_size, hipStream_t stream) {
    static int grid = 0;
    if (grid == 0) {
        int dev = 0, cus = 0, per_cu = 0;
        if (n_in != 20 || ws_size < WS_END) { fprintf(stderr, "kernel_launch: unexpected n_in %d / ws_size %zu\n", n_in, ws_size); grid = -1; return; }
        if (hipGetDevice(&dev) != hipSuccess || hipDeviceGetAttribute(&cus, hipDeviceAttributeMultiprocessorCount, dev) != hipSuccess) { grid = -1; return; }
        if (hipFuncSetAttribute((const void*)fwd_kernel, hipFuncAttributeMaxDynamicSharedMemorySize, LDS_BYTES) != hipSuccess) { fprintf(stderr, "kernel_launch: hipFuncSetAttribute failed\n"); grid = -1; return; }
        if (hipOccupancyMaxActiveBlocksPerMultiprocessor(&per_cu, (const void*)fwd_kernel, NWAVES * 64, LDS_BYTES) != hipSuccess || per_cu < 1) { fprintf(stderr, "kernel_launch: occupancy query says %d\n", per_cu); }
        (void)hipGetLastError();
        grid = cus;
    }
    if (grid < 0) return;
    if (hipMemsetAsync(d_ws, 0, 16384, stream) != hipSuccess) { fprintf(stderr, "kernel_launch: memset failed\n"); return; }
    Args a{};
    for (int i = 0; i < 20; ++i) a.in[i] = (const float*)d_in[i];
    a.out = (float*)d_out; a.ws = (unsigned char*)d_ws;
#if MK_ONE_LAUNCH
    a.ph_lo = 0; a.ph_hi = N_PHASES;
    void* kargs[] = {&a};
    hipError_t e = hipLaunchCooperativeKernel((const void*)fwd_kernel, dim3(grid), dim3(NWAVES * 64), kargs, LDS_BYTES, stream);
    if (e != hipSuccess) fprintf(stderr, "cooperative launch failed: %s (grid %d)\n", hipGetErrorString(e), grid);
#else
    for (int p = 0; p < N_PHASES; ++p) {
        a.ph_lo = p; a.ph_hi = p + 1;
        hipLaunchKernelGGL(fwd_kernel, dim3(grid), dim3(NWAVES * 64), LDS_BYTES, stream, a);
    }
#endif
}
```

```cpp
#include <hip/hip_runtime.h>
#include <hip/hip_cooperative_groups.h>
#include <cstdio>
#include <cstdint>
namespace cg = cooperative_groups;

#ifndef MK_ONE_LAUNCH
#define MK_ONE_LAUNCH 1
#endif

namespace pg8 {
#define PG8_LAS __attribute__((address_space(3)))
typedef unsigned short bf16_t;
typedef short bf16x8 __attribute__((ext_vector_type(8)));
typedef float f32x4 __attribute__((ext_vector_type(4)));
typedef unsigned u32x4 __attribute__((ext_vector_type(4)));
typedef unsigned u32x2 __attribute__((ext_vector_type(2)));
constexpr int BM = 256, BK = 64, HALF = 128, HTB = HALF * BK * 2, STAGE_BYTES = 8 * HTB, NXCD = 8, WGM = 8;

__host__ __device__ __forceinline__ int lds_byte(int r, int c) { const int st = (r >> 4) * 2 + (c >> 5), rr = r & 15, cc = c & 31, ob = rr * 64 + cc * 2; return st * 1024 + (ob ^ (((ob >> 9) & 1) << 5)); }
__host__ __device__ __forceinline__ void stage_rc(int b, int& R, int& C) { const int st = b / 1024, sb = b % 1024, swz = sb ^ (((sb >> 9) & 1) << 5); R = (st >> 1) * 16 + swz / 64; C = (st & 1) * 32 + (swz % 64) / 2; }
__host__ __device__ __forceinline__ int perm32(int rho) { const int n = rho >> 4, i = rho & 15; return 8 * (i >> 2) + 4 * n + (i & 3); }

struct Unit { int pm, pn, kt0, nkt, ks; };
struct Gemm { const bf16_t* A; const bf16_t* Bt; int M, N, K; };

struct StaticOrder {
    int nM, nMf, nN, nfull, nitems, G, c, nt, nsplit;
    __host__ __device__ void init(int M, int N, int K, int G_, int c_, int Mfull = -1, int nsplit_ = 1) {
        nM = M / BM; nMf = Mfull < 0 ? nM : Mfull / BM; nN = N / BM; nt = K / BK; nsplit = nsplit_; nfull = nMf * nN; nitems = nfull + (nM - nMf) * nN * nsplit; G = G_; c = c_; }
    __host__ __device__ bool next(int i, Unit& u) const {
        const long L = (long)i * G + c; if (L >= nitems) return false;
        if (L >= nfull) { const int sidx = (int)L - nfull, un = sidx / nsplit, ks = sidx % nsplit, per = nt / nsplit;
            u.pm = nMf + un / nN; u.pn = un % nN; u.kt0 = ks * per; u.nkt = per; u.ks = ks; return true; }
        int wgid = (int)L; { const int q = nfull / NXCD, r = nfull % NXCD, xcd = wgid % NXCD, off = wgid / NXCD; wgid = (xcd < r ? xcd * (q + 1) : r * (q + 1) + (xcd - r) * q) + off; }
        const int nig = WGM * nN, gid = wgid / nig, fm = gid * WGM, gsz = (nMf - fm) < WGM ? (nMf - fm) : WGM;
        u.pm = fm + ((wgid % nig) % gsz); u.pn = (wgid % nig) / gsz; u.kt0 = 0; u.nkt = nt; u.ks = -1; return true;
    }
    __device__ __forceinline__ void a_ready(const Unit&) const {}
    __device__ __forceinline__ void done(const Unit&) const {}
};

__device__ __forceinline__ unsigned cvt_pk_bf16(float lo, float hi) { unsigned r; asm volatile("v_cvt_pk_bf16_f32 %0, %1, %2" : "=v"(r) : "v"(lo), "v"(hi)); return r; }
__device__ __forceinline__ float sigm(float x) { return __builtin_amdgcn_rcpf(1.0f + __expf(-x)); }

struct EpiProj {
    static constexpr bool PERM = true, AFTER_DRAIN = false;
    bf16_t *U, *QIG; float* F; const float* bias; const float* lb;
    __device__ __forceinline__ void operator()(const f32x4 (&acc)[2][2][4][2], const Unit& u, int wr, int wc, int fr, int fq) const {
        const int row0 = u.pm * BM + wr * 64 + fr;
        const int cl = wc * 32 + 8 * fq;
        const int bcol = u.pn * BM + cl;
        f32x4 bv[2][2];
#pragma unroll
        for (int bj = 0; bj < 2; ++bj)
#pragma unroll
            for (int n = 0; n < 2; ++n) bv[bj][n] = *(const f32x4*)(bias + bcol + bj * HALF + 4 * n);
        if (u.pn < 8) {
#pragma unroll
            for (int ai = 0; ai < 2; ++ai)
#pragma unroll
                for (int m = 0; m < 4; ++m) {
                    const size_t row = (size_t)(row0 + ai * HALF + m * 16);
                    float o[8];
#pragma unroll
                    for (int n = 0; n < 2; ++n) { const f32x4 a = acc[ai][0][m][n] + bv[0][n], g = acc[ai][1][m][n] + bv[1][n];
#pragma unroll
                        for (int e = 0; e < 4; ++e) o[n * 4 + e] = a[e] * sigm(g[e]); }
                    u32x4 w; w.x = cvt_pk_bf16(o[0], o[1]); w.y = cvt_pk_bf16(o[2], o[3]); w.z = cvt_pk_bf16(o[4], o[5]); w.w = cvt_pk_bf16(o[6], o[7]);
                    *(u32x4*)(U + row * 1024 + u.pn * HALF + cl) = w;
                }
        } else {
            const int grp = (u.pn - 8) >> 2;
            const int cbase = ((u.pn - 8) & 3) * BM + cl;
            if (grp == 1) {
                f32x4 lv[2][2];
#pragma unroll
                for (int bj = 0; bj < 2; ++bj)
#pragma unroll
                    for (int n = 0; n < 2; ++n) lv[bj][n] = *(const f32x4*)(lb + cbase + bj * HALF + 4 * n);
#pragma unroll
                for (int ai = 0; ai < 2; ++ai)
#pragma unroll
                    for (int m = 0; m < 4; ++m) {
                        const size_t row = (size_t)(row0 + ai * HALF + m * 16);
#pragma unroll
                        for (int bj = 0; bj < 2; ++bj)
#pragma unroll
                            for (int n = 0; n < 2; ++n) { const f32x4 x = acc[ai][bj][m][n] + bv[bj][n]; const f32x4 l = lv[bj][n]; f32x4 o;
#pragma unroll
                                for (int e = 0; e < 4; ++e) o[e] = l[e] + (1.0f - l[e]) * sigm(x[e]);
                                *(f32x4*)(F + row * 1024 + cbase + bj * HALF + 4 * n) = o; }
                    }
            } else {
                bf16_t* O = QIG + (size_t)(grp - (grp > 0 ? 1 : 0)) * ((size_t)8704 * 1024);
                const bool act = grp != 2;
#pragma unroll
                for (int ai = 0; ai < 2; ++ai)
#pragma unroll
                    for (int m = 0; m < 4; ++m) {
                        const size_t row = (size_t)(row0 + ai * HALF + m * 16);
#pragma unroll
                        for (int bj = 0; bj < 2; ++bj) { float o[8];
#pragma unroll
                            for (int n = 0; n < 2; ++n) { const f32x4 x = acc[ai][bj][m][n] + bv[bj][n];
#pragma unroll
                                for (int e = 0; e < 4; ++e) o[n * 4 + e] = act ? x[e] * sigm(x[e]) : x[e]; }
                            u32x4 w; w.x = cvt_pk_bf16(o[0], o[1]); w.y = cvt_pk_bf16(o[2], o[3]); w.z = cvt_pk_bf16(o[4], o[5]); w.w = cvt_pk_bf16(o[6], o[7]);
                            *(u32x4*)(O + row * 1024 + cbase + bj * HALF) = w; }
                    }
            }
        }
    }
};
struct EpiRes {
    static constexpr bool PERM = false, AFTER_DRAIN = false;
    const float* baseP; const float* baseS; float* out; int split; float alpha; float* part;
    __device__ __forceinline__ void operator()(const f32x4 (&acc)[2][2][4][2], const Unit& u, int wr, int wc, int fr, int fq) const {
        const int row0 = u.pm * BM + wr * 64 + fr;
        const int col0 = u.pn * BM + wc * 32 + 4 * fq;
        if (u.ks >= 0) {
            float* pb = part + (size_t)u.ks * 512 * 2048;
#pragma unroll
            for (int ai = 0; ai < 2; ++ai)
#pragma unroll
                for (int m = 0; m < 4; ++m) { float* op = pb + (size_t)(row0 + ai * HALF + m * 16 - split) * 2048;
#pragma unroll
                    for (int bj = 0; bj < 2; ++bj)
#pragma unroll
                        for (int n = 0; n < 2; ++n) *(f32x4*)(op + col0 + bj * HALF + n * 16) = acc[ai][bj][m][n]; }
            return;
        }
#pragma unroll
        for (int ai = 0; ai < 2; ++ai)
#pragma unroll
            for (int m = 0; m < 4; ++m) {
                const int row = row0 + ai * HALF + m * 16;
                const float* bp = row < split ? baseP + (size_t)row * 2048 : baseS + (size_t)(row - split) * 2048;
                float* op = out + (size_t)row * 2048;
#pragma unroll
                for (int bj = 0; bj < 2; ++bj)
#pragma unroll
                    for (int n = 0; n < 2; ++n) { const int c = col0 + bj * HALF + n * 16; const f32x4 b = *(const f32x4*)(bp + c); *(f32x4*)(op + c) = b * alpha + acc[ai][bj][m][n]; }
            }
    }
};
template <bool BASE_BF16> struct EpiResB {
    static constexpr bool PERM = true, AFTER_DRAIN = false;
    const void* base; bf16_t* out; int split; float alpha; bf16_t* part;
    __device__ __forceinline__ void operator()(const f32x4 (&acc)[2][2][4][2], const Unit& u, int wr, int wc, int fr, int fq) const {
        const int row0 = u.pm * BM + wr * 64 + fr;
        const int col0 = u.pn * BM + wc * 32 + 8 * fq;
        if (u.ks >= 0) {
            bf16_t* pb = part + (size_t)u.ks * 512 * 2048;
#pragma unroll
            for (int ai = 0; ai < 2; ++ai)
#pragma unroll
                for (int m = 0; m < 4; ++m) { bf16_t* op = pb + (size_t)(row0 + ai * HALF + m * 16 - split) * 2048;
#pragma unroll
                    for (int bj = 0; bj < 2; ++bj) { const f32x4 v0 = acc[ai][bj][m][0], v1 = acc[ai][bj][m][1];
                        u32x4 w; w.x = cvt_pk_bf16(v0[0], v0[1]); w.y = cvt_pk_bf16(v0[2], v0[3]); w.z = cvt_pk_bf16(v1[0], v1[1]); w.w = cvt_pk_bf16(v1[2], v1[3]);
                        *(u32x4*)(op + col0 + bj * HALF) = w; } }
            return;
        }
#pragma unroll
        for (int ai = 0; ai < 2; ++ai)
#pragma unroll
            for (int m = 0; m < 4; ++m) {
                const size_t row = (size_t)(row0 + ai * HALF + m * 16);
#pragma unroll
                for (int bj = 0; bj < 2; ++bj) { const int c = col0 + bj * HALF; f32x4 b0, b1;
                    if constexpr (BASE_BF16) { const u32x4 w = *(const u32x4*)((const bf16_t*)base + row * 2048 + c);
                        b0 = (f32x4){__uint_as_float(w.x << 16), __uint_as_float(w.x & 0xffff0000u), __uint_as_float(w.y << 16), __uint_as_float(w.y & 0xffff0000u)};
                        b1 = (f32x4){__uint_as_float(w.z << 16), __uint_as_float(w.z & 0xffff0000u), __uint_as_float(w.w << 16), __uint_as_float(w.w & 0xffff0000u)}; }
                    else { const float* bp = (const float*)base + row * 2048 + c; b0 = *(const f32x4*)bp; b1 = *(const f32x4*)(bp + 4); }
                    const f32x4 v0 = b0 * alpha + acc[ai][bj][m][0], v1 = b1 * alpha + acc[ai][bj][m][1];
                    u32x4 w; w.x = cvt_pk_bf16(v0[0], v0[1]); w.y = cvt_pk_bf16(v0[2], v0[3]); w.z = cvt_pk_bf16(v1[0], v1[1]); w.w = cvt_pk_bf16(v1[2], v1[3]);
                    *(u32x4*)(out + row * 2048 + c) = w; }
            }
    }
};
struct EpiGateUp {
    static constexpr bool PERM = true, AFTER_DRAIN = false;
    bf16_t* O; int ldc;
    __device__ __forceinline__ void operator()(const f32x4 (&acc)[2][2][4][2], const Unit& u, int wr, int wc, int fr, int fq) const {
        const int row0 = u.pm * BM + wr * 64 + fr;
        const int cl = wc * 32 + 8 * fq;
#pragma unroll
        for (int ai = 0; ai < 2; ++ai)
#pragma unroll
            for (int m = 0; m < 4; ++m) {
                const size_t row = (size_t)(row0 + ai * HALF + m * 16);
                float o[8];
#pragma unroll
                for (int n = 0; n < 2; ++n) { const f32x4 g = acc[ai][0][m][n], up = acc[ai][1][m][n];
#pragma unroll
                    for (int e = 0; e < 4; ++e) o[n * 4 + e] = g[e] * sigm(g[e]) * up[e]; }
                u32x4 w; w.x = cvt_pk_bf16(o[0], o[1]); w.y = cvt_pk_bf16(o[2], o[3]); w.z = cvt_pk_bf16(o[4], o[5]); w.w = cvt_pk_bf16(o[6], o[7]);
                *(u32x4*)(O + row * ldc + u.pn * HALF + cl) = w;
            }
    }
};

template <class Epi, class Sched, bool ALIGN_EPI = false, bool SP2 = false>
__device__ __forceinline__ void gemm_phase(PG8_LAS unsigned char* lds, const Gemm g, const Sched& S, const Epi& E) {
    int tid_ = threadIdx.x; asm volatile("" : "+v"(tid_));
    const int tid = tid_, wid = __builtin_amdgcn_readfirstlane(tid >> 6), lane = tid & 63, wr = wid >> 2, wc = wid & 3, fr = lane & 15, fq = lane >> 4;
    const int K = g.K;
    unsigned voffA[2], voffB[2];
#pragma unroll
    for (int i = 0; i < 2; ++i) { int R, C; stage_rc(tid * 16 + i * 8192, R, C); const int Rb = Epi::PERM ? ((R & ~31) + perm32(R & 31)) : R;
        voffA[i] = (unsigned)(R * K + C) * 2u; voffB[i] = (unsigned)(Rb * K + C) * 2u; }
    const size_t kstep = (size_t)(BK * 2);
    const size_t hstep = (size_t)HALF * K * 2;
    const size_t tstep = 2 * hstep;
    const unsigned ldsw = (unsigned)wid * 1024u;
    const int aoff = lds_byte(wr * 64 + fr, fq * 8), boff = lds_byte(wc * 32 + fr, fq * 8);
#define PG8_SA(b, h) (((b) * 2 + (h)) * HTB)
#define PG8_SB(b, h) ((4 + (b) * 2 + (h)) * HTB)
#define PG8_STAGE(bufoff, gbase, voff) do { _Pragma("unroll") for (int _i = 0; _i < 2; ++_i) \
        __builtin_amdgcn_global_load_lds((const unsigned*)((const char*)(gbase) + (voff)[_i]), (PG8_LAS unsigned*)(lds + (bufoff) + ldsw + _i * 8192), 16, 0, 0); } while (0)
#define PG8_LDA(dst, b, h) do { _Pragma("unroll") for (int m = 0; m < 4; ++m) _Pragma("unroll") for (int k = 0; k < 2; ++k) dst[m][k] = *(const PG8_LAS bf16x8*)(lds + PG8_SA(b, h) + aoff + m * 2048 + k * 1024); } while (0)
#define PG8_LDB(dst, b, h) do { _Pragma("unroll") for (int n = 0; n < 2; ++n) _Pragma("unroll") for (int k = 0; k < 2; ++k) dst[n][k] = *(const PG8_LAS bf16x8*)(lds + PG8_SB(b, h) + boff + n * 2048 + k * 1024); } while (0)
#define PG8_MMA(ai, bj, At, Bt) do { __builtin_amdgcn_s_setprio(1); _Pragma("unroll") for (int m = 0; m < 4; ++m) _Pragma("unroll") for (int n = 0; n < 2; ++n) _Pragma("unroll") for (int k = 0; k < 2; ++k) \
        acc[ai][bj][m][n] = __builtin_amdgcn_mfma_f32_16x16x32_bf16(Bt[n][k], At[m][k], acc[ai][bj][m][n], 0, 0, 0); __builtin_amdgcn_s_setprio(0); } while (0)
#define PG8_WAIT_V(n) asm volatile("s_waitcnt vmcnt(" #n ")" ::: "memory")
#define PG8_WAIT_L(n) asm volatile("s_waitcnt lgkmcnt(" #n ")" ::: "memory")
#define PG8_BAR __builtin_amdgcn_s_barrier()
#define PG8_SCHED __builtin_amdgcn_sched_barrier(0)
    Unit cur, nxt; int ui = 0;
    if (!S.next(0, cur)) return;
    f32x4 acc[2][2][4][2];
#pragma unroll
    for (int a = 0; a < 2; ++a)
#pragma unroll
        for (int b = 0; b < 2; ++b)
#pragma unroll
            for (int m = 0; m < 4; ++m)
#pragma unroll
                for (int n = 0; n < 2; ++n) acc[a][b][m][n] = (f32x4){0.f, 0.f, 0.f, 0.f};
    bf16x8 At[4][2], B0[2][2], B1[2][2];
    const char* cA = (const char*)g.A + (size_t)cur.pm * tstep + (size_t)cur.kt0 * kstep; const char* cB = (const char*)g.Bt + (size_t)cur.pn * tstep + (size_t)cur.kt0 * kstep;
    S.a_ready(cur);
    if constexpr (SP2) {
        PG8_STAGE(PG8_SB(0, 0), cB, voffB); PG8_STAGE(PG8_SB(0, 1), cB + hstep, voffB); PG8_STAGE(PG8_SA(0, 0), cA, voffA); PG8_STAGE(PG8_SA(0, 1), cA + hstep, voffA);
        if (wr == 1) PG8_BAR;
        PG8_WAIT_V(2); PG8_BAR;
        PG8_STAGE(PG8_SB(1, 0), cB + kstep, voffB); PG8_STAGE(PG8_SA(1, 0), cA + kstep, voffA); PG8_STAGE(PG8_SB(1, 1), cB + hstep + kstep, voffB);
        PG8_WAIT_V(6); PG8_BAR;
    } else {
        PG8_STAGE(PG8_SB(0, 0), cB, voffB); PG8_STAGE(PG8_SA(0, 0), cA, voffA); PG8_STAGE(PG8_SB(0, 1), cB + hstep, voffB); PG8_STAGE(PG8_SA(0, 1), cA + hstep, voffA);
        if (wr == 1) PG8_BAR;
        PG8_WAIT_V(4); PG8_BAR;
        PG8_STAGE(PG8_SB(1, 0), cB + kstep, voffB); PG8_STAGE(PG8_SA(1, 0), cA + kstep, voffA); PG8_STAGE(PG8_SB(1, 1), cB + hstep + kstep, voffB);
        PG8_WAIT_V(6); PG8_BAR;
    }
    for (;;) {
        const bool has_next = S.next(ui + 1, nxt);
        const char* nA = has_next ? (const char*)g.A + (size_t)nxt.pm * tstep + (size_t)nxt.kt0 * kstep : cA; const char* nB = has_next ? (const char*)g.Bt + (size_t)nxt.pn * tstep + (size_t)nxt.kt0 * kstep : cB;
        const int nt = cur.nkt;
        for (int t = 0; t < nt; t += 2) {
            const bool last = (t == nt - 2);
            const char* a1 = cA + (size_t)(t + 1) * kstep;
            const char* a2 = last ? nA : cA + (size_t)(t + 2) * kstep; const char* b2 = last ? nB : cB + (size_t)(t + 2) * kstep;
            const char* a3 = a2 + kstep; const char* b3 = b2 + kstep;
            if (last && has_next) S.a_ready(nxt);
            if constexpr (SP2) {
            PG8_LDB(B0, 0, 0); PG8_LDB(B1, 0, 1); PG8_SCHED; PG8_LDA(At, 0, 0); PG8_STAGE(PG8_SA(1, 1), a1 + hstep, voffA);
            PG8_WAIT_V(8); PG8_WAIT_L(0); PG8_BAR; PG8_MMA(0, 0, At, B0); PG8_MMA(0, 1, At, B1); PG8_BAR; PG8_SCHED;
            PG8_LDA(At, 0, 1); PG8_STAGE(PG8_SB(0, 0), b2, voffB); PG8_STAGE(PG8_SB(0, 1), b2 + hstep, voffB); PG8_STAGE(PG8_SA(0, 0), a2, voffA);
            PG8_WAIT_V(8); PG8_WAIT_L(0); PG8_BAR; PG8_MMA(1, 0, At, B0); PG8_MMA(1, 1, At, B1); PG8_BAR; PG8_SCHED;
            PG8_LDB(B0, 1, 0); PG8_LDB(B1, 1, 1); PG8_SCHED; PG8_LDA(At, 1, 0); PG8_STAGE(PG8_SA(0, 1), a2 + hstep, voffA);
            PG8_WAIT_V(8); PG8_WAIT_L(0); PG8_BAR; PG8_MMA(0, 0, At, B0); PG8_MMA(0, 1, At, B1); PG8_BAR; PG8_SCHED;
            PG8_LDA(At, 1, 1); PG8_STAGE(PG8_SB(1, 0), b3, voffB); PG8_STAGE(PG8_SB(1, 1), b3 + hstep, voffB); PG8_STAGE(PG8_SA(1, 0), a3, voffA);
            PG8_WAIT_V(8); PG8_WAIT_L(0); PG8_BAR; PG8_MMA(1, 0, At, B0); PG8_MMA(1, 1, At, B1); PG8_BAR; PG8_SCHED;
            } else {
            PG8_LDB(B0, 0, 0); PG8_SCHED; PG8_LDA(At, 0, 0); PG8_STAGE(PG8_SA(1, 1), a1 + hstep, voffA);
            PG8_WAIT_L(8); PG8_BAR; PG8_WAIT_L(0); PG8_MMA(0, 0, At, B0); PG8_BAR; PG8_SCHED;
            PG8_LDB(B1, 0, 1); PG8_STAGE(PG8_SB(0, 0), b2, voffB);
            PG8_BAR; PG8_WAIT_L(0); PG8_MMA(0, 1, At, B1); PG8_BAR;
            PG8_LDA(At, 0, 1); PG8_STAGE(PG8_SA(0, 0), a2, voffA);
            PG8_BAR; PG8_WAIT_L(0); PG8_MMA(1, 0, At, B0); PG8_BAR; PG8_SCHED;
            PG8_STAGE(PG8_SB(0, 1), b2 + hstep, voffB);
            PG8_WAIT_V(6); PG8_BAR; PG8_MMA(1, 1, At, B1); PG8_BAR;
            PG8_LDB(B0, 1, 0); PG8_SCHED; PG8_LDA(At, 1, 0); PG8_STAGE(PG8_SA(0, 1), a2 + hstep, voffA);
            PG8_WAIT_L(8); PG8_BAR; PG8_WAIT_L(0); PG8_MMA(0, 0, At, B0); PG8_BAR; PG8_SCHED;
            PG8_LDB(B1, 1, 1); PG8_STAGE(PG8_SB(1, 0), b3, voffB);
            PG8_BAR; PG8_WAIT_L(0); PG8_MMA(0, 1, At, B1); PG8_BAR;
            PG8_LDA(At, 1, 1); PG8_STAGE(PG8_SA(1, 0), a3, voffA);
            PG8_BAR; PG8_WAIT_L(0); PG8_MMA(1, 0, At, B0); PG8_BAR; PG8_SCHED;
            PG8_STAGE(PG8_SB(1, 1), b3 + hstep, voffB);
            PG8_WAIT_V(6); PG8_BAR; PG8_MMA(1, 1, At, B1); PG8_BAR;
            }
        }
        if constexpr (ALIGN_EPI) { if (wr == 0) PG8_BAR; }
        if constexpr (!Epi::AFTER_DRAIN) { E(acc, cur, wr, wc, fr, fq); S.done(cur); }
        if (!has_next) break;
#pragma unroll
        for (int a = 0; a < 2; ++a)
#pragma unroll
            for (int b = 0; b < 2; ++b)
#pragma unroll
                for (int m = 0; m < 4; ++m)
#pragma unroll
                    for (int n = 0; n < 2; ++n) acc[a][b][m][n] = (f32x4){0.f, 0.f, 0.f, 0.f};
        cur = nxt; cA = nA; cB = nB; ++ui;
        if constexpr (ALIGN_EPI) { if (wr == 1) PG8_BAR; }
    }
    PG8_WAIT_V(0);
    if constexpr (!ALIGN_EPI) { if (wr == 0) PG8_BAR; }
    PG8_BAR;
#undef PG8_SA
#undef PG8_SB
#undef PG8_STAGE
#undef PG8_LDA
#undef PG8_LDB
#undef PG8_MMA
#undef PG8_WAIT_V
#undef PG8_WAIT_L
#undef PG8_BAR
#undef PG8_SCHED
}
}

constexpr int D = 2048, MP = 8192, MS = 512, M = MP + MS, CW = 1024, NH = 8, HD = 128, FF = 5632, NIN = 6144;
constexpr float LN_EPS = 1e-5f;
constexpr float ALPHA = 1.189207115002721f;
constexpr int NWAVES = 8;
constexpr int LDS_BYTES = 147456;
constexpr int N_PHASES = 10;

constexpr size_t MiB = 1u << 20;
constexpr size_t WS_LB = 64 * 1024, WS_BIASP = 128 * 1024;
constexpr size_t WS_WIN = 1 * MiB, WS_WOUT = 25 * MiB, WS_WGU = 33 * MiB, WS_WDN = 77 * MiB;
constexpr size_t WS_XB = 99 * MiB, WS_MIX = 133 * MiB;
constexpr size_t WS_U = 167 * MiB, WS_Q = 184 * MiB, WS_I = 201 * MiB, WS_G = 218 * MiB, WS_F = 235 * MiB, WS_END = 269 * MiB;
constexpr size_t WS_ACT = 167 * MiB;
constexpr int SPLIT5 = 4, SPLIT8 = 11;
constexpr int W_DN_SPLIT = 44 * 64;
constexpr size_t WS_PB5 = 167 * MiB;
constexpr size_t WS_PB8 = 33 * MiB;
static_assert(WS_PB8 + (size_t)SPLIT8 * 512 * 2048 * 4 <= 77 * MiB && (32 % SPLIT5) == 0 && (88 % SPLIT8) == 0 && (32 / SPLIT5) % 2 == 0 && (88 / SPLIT8) % 2 == 0 && 32 / SPLIT5 >= 4 && 88 / SPLIT8 >= 4, "split-K layout");
static_assert(WS_ACT + (size_t)M * FF * 2 <= WS_END, "act overlay");
constexpr size_t O_Y = 0, O_NCP = (size_t)M * D, O_NHP = O_NCP + 4 * 30 * 1024, O_NCS = O_NHP + 4 * 8 * 128 * 128, O_NHS = O_NCS + 32 * 30 * 1024;
constexpr size_t O_ST = 0, O_DC = (size_t)1024 * 16384;

#define LAS __attribute__((address_space(3)))
typedef unsigned short bf16;
typedef float f32x4 __attribute__((ext_vector_type(4)));
typedef float f32x2 __attribute__((ext_vector_type(2)));
typedef unsigned v4u __attribute__((ext_vector_type(4)));
typedef unsigned v2u __attribute__((ext_vector_type(2)));
typedef float f32x16 __attribute__((ext_vector_type(16)));
typedef unsigned u32x8 __attribute__((ext_vector_type(8)));
#define CAS __attribute__((address_space(4)))
#define LDS_WAIT() asm volatile("s_waitcnt lgkmcnt(0)" ::: "memory")

__device__ __forceinline__ unsigned f2bf(float f) { unsigned u = __builtin_bit_cast(unsigned, f); return (u + 0x7fffu + ((u >> 16) & 1u)) >> 16; }
__device__ __forceinline__ unsigned pk2(float lo, float hi) { return f2bf(lo) | (f2bf(hi) << 16); }
__device__ __forceinline__ bf16 bfr(float x) { return (bf16)(pg8::cvt_pk_bf16(x, 0.f) & 0xffffu); }
__device__ __forceinline__ float bf2f(unsigned short b) { return __uint_as_float((unsigned)b << 16); }
__device__ __forceinline__ float sigm(float x) { return __builtin_amdgcn_rcpf(1.0f + __expf(-x)); }
__device__ __forceinline__ float wave_sum(float v) {
#pragma unroll
    for (int o = 1; o < 64; o <<= 1) v += __shfl_xor(v, o);
    return v;
}

__device__ __forceinline__ void transpose_item(const float* W, int K, int N, bf16* WT, int k0, int n0, int dst_row0, LAS float* scr, int lane) {
    { f32x4 v[8];
      const int kq = lane >> 3, n4 = (lane & 7) * 4;
#pragma unroll
      for (int i = 0; i < 8; ++i) v[i] = *(const f32x4*)(W + (size_t)(k0 + 8 * i + kq) * N + n0 + n4);
#pragma unroll
      for (int i = 0; i < 8; ++i) { LAS float* d = scr + (8 * i + kq) * 33 + n4; d[0] = v[i].x; d[1] = v[i].y; d[2] = v[i].z; d[3] = v[i].w; } }
    LDS_WAIT(); asm volatile("" ::: "memory");
    const int c = lane & 7;
#pragma unroll
    for (int j = 0; j < 4; ++j) { const int n = (lane >> 3) + 8 * j; const LAS float* s = scr + (8 * c) * 33 + n;
        v4u o; o.x = pk2(s[0 * 33], s[1 * 33]); o.y = pk2(s[2 * 33], s[3 * 33]); o.z = pk2(s[4 * 33], s[5 * 33]); o.w = pk2(s[6 * 33], s[7 * 33]);
        *(v4u*)(WT + (size_t)(dst_row0 + n) * K + k0 + 8 * c) = o; }
    LDS_WAIT(); asm volatile("" ::: "memory");
}

template <int KIND> __device__ __forceinline__ void transpose_stream(const float* W, int K, int N, bf16* WT, int first, int end, int stride, LAS float* scr, int lane) {
    const int nblk = N / 32, kq = lane >> 3, n4 = (lane & 7) * 4, c = lane & 7;
    f32x4 v[8];
    if (first < end) { const int kb = first / nblk, nb = first % nblk;
#pragma unroll
        for (int i = 0; i < 8; ++i) v[i] = *(const f32x4*)(W + (size_t)(64 * kb + 8 * i + kq) * N + 32 * nb + n4); }
    for (int it = first; it < end; it += stride) {
        const int kb = it / nblk, nb = it % nblk, k0 = 64 * kb, n0 = 32 * nb;
        int dst;
        if (KIND == 1) dst = n0 < 2048 ? ((n0 & 1023) >> 7) * 256 + (n0 >> 10) * 128 + (n0 & 127) : n0;
        else if (KIND == 2) dst = (n0 >> 7) * 256 + (n0 & 127);
        else if (KIND == 3) dst = (n0 >> 7) * 256 + 128 + (n0 & 127);
        else dst = n0;
#pragma unroll
        for (int i = 0; i < 8; ++i) { LAS float* d = scr + (8 * i + kq) * 33 + n4; d[0] = v[i].x; d[1] = v[i].y; d[2] = v[i].z; d[3] = v[i].w; }
        { const int nx = it + stride;
          if (nx < end) { const int kb2 = nx / nblk, nb2 = nx % nblk;
#pragma unroll
              for (int i = 0; i < 8; ++i) v[i] = *(const f32x4*)(W + (size_t)(64 * kb2 + 8 * i + kq) * N + 32 * nb2 + n4); } }
        LDS_WAIT(); asm volatile("" ::: "memory");
#pragma unroll
        for (int j = 0; j < 4; ++j) { const int n = (lane >> 3) + 8 * j; const LAS float* sp = scr + (8 * c) * 33 + n;
            v4u o; o.x = pg8::cvt_pk_bf16(sp[0 * 33], sp[1 * 33]); o.y = pg8::cvt_pk_bf16(sp[2 * 33], sp[3 * 33]); o.z = pg8::cvt_pk_bf16(sp[4 * 33], sp[5 * 33]); o.w = pg8::cvt_pk_bf16(sp[6 * 33], sp[7 * 33]);
            *(v4u*)(WT + (size_t)(dst + n) * K + k0 + 8 * c) = o; }
        LDS_WAIT(); asm volatile("" ::: "memory");
    }
}

template <bool SRC_BF16, int NP> __device__ __forceinline__ void ln_row(const void* src, const bf16* part, size_t pstride, float alpha, float* dstf, bf16* dstb, const float* g, const float* b, int lane) {
    f32x4 v[8]; float s = 0.f;
    if constexpr (SRC_BF16) {
#pragma unroll
        for (int j = 0; j < 8; ++j) { const v2u w = ((const v2u*)src)[lane + 64 * j]; v[j] = (f32x4){__uint_as_float(w.x << 16), __uint_as_float(w.x & 0xffff0000u), __uint_as_float(w.y << 16), __uint_as_float(w.y & 0xffff0000u)}; }
    } else {
#pragma unroll
        for (int j = 0; j < 8; ++j) v[j] = ((const f32x4*)src)[lane + 64 * j];
    }
    if constexpr (NP > 0) {
#pragma unroll
        for (int j = 0; j < 8; ++j) v[j] = v[j] * alpha;
#pragma unroll
        for (int p0 = 0; p0 < NP; p0 += 4) {
            v2u w[4][8];
#pragma unroll
            for (int pp = 0; pp < 4; ++pp) if (p0 + pp < NP) { const v2u* pr = (const v2u*)(part + (size_t)(p0 + pp) * pstride) + lane;
#pragma unroll
                for (int j = 0; j < 8; ++j) w[pp][j] = pr[64 * j]; }
#pragma unroll
            for (int pp = 0; pp < 4; ++pp) if (p0 + pp < NP) {
#pragma unroll
                for (int j = 0; j < 8; ++j) v[j] += (f32x4){__uint_as_float(w[pp][j].x << 16), __uint_as_float(w[pp][j].x & 0xffff0000u), __uint_as_float(w[pp][j].y << 16), __uint_as_float(w[pp][j].y & 0xffff0000u)}; }
        }
    }
#pragma unroll
    for (int j = 0; j < 8; ++j) s += (v[j].x + v[j].y) + (v[j].z + v[j].w);
    const float mean = wave_sum(s) * (1.f / D); float s2 = 0.f;
#pragma unroll
    for (int j = 0; j < 8; ++j) { v[j] = v[j] - mean; s2 += (v[j].x * v[j].x + v[j].y * v[j].y) + (v[j].z * v[j].z + v[j].w * v[j].w); }
    const float rstd = 1.f / sqrtf(wave_sum(s2) * (1.f / D) + LN_EPS);
#pragma unroll
    for (int j = 0; j < 8; ++j) {
        const f32x4 gg = ((const f32x4*)g)[lane + 64 * j], bb = ((const f32x4*)b)[lane + 64 * j];
        const f32x4 o = v[j] * rstd * gg + bb;
        if (dstf) ((f32x4*)dstf)[lane + 64 * j] = o;
        if (dstb) { v2u w; w.x = pk2(o.x, o.y); w.y = pk2(o.z, o.w); ((v2u*)dstb)[lane + 64 * j] = w; }
    }
}

__device__ __forceinline__ void ln_core(f32x4 (&v)[8], const f32x4 (&gg)[8], const f32x4 (&bb)[8], float* dstf, bf16* dstb, int lane) {
    float s = 0.f;
#pragma unroll
    for (int j = 0; j < 8; ++j) s += (v[j].x + v[j].y) + (v[j].z + v[j].w);
    const float mean = wave_sum(s) * (1.f / D); float s2 = 0.f;
#pragma unroll
    for (int j = 0; j < 8; ++j) { v[j] = v[j] - mean; s2 += (v[j].x * v[j].x + v[j].y * v[j].y) + (v[j].z * v[j].z + v[j].w * v[j].w); }
    const float rstd = 1.f / sqrtf(wave_sum(s2) * (1.f / D) + LN_EPS);
#pragma unroll
    for (int j = 0; j < 8; ++j) {
        const f32x4 o = v[j] * rstd * gg[j] + bb[j];
        if (dstf) ((f32x4*)dstf)[lane + 64 * j] = o;
        if (dstb) { v2u w; w.x = pk2(o.x, o.y); w.y = pk2(o.z, o.w); ((v2u*)dstb)[lane + 64 * j] = w; }
    }
}
__device__ __forceinline__ void ln_rows_bf16(const bf16* src, float* dstf, bf16* dstb, const float* g, const float* b, int gw, int NGW, int nrows, int lane) {
    f32x4 gg[8], bb[8];
#pragma unroll
    for (int j = 0; j < 8; ++j) { gg[j] = ((const f32x4*)g)[lane + 64 * j]; bb[j] = ((const f32x4*)b)[lane + 64 * j]; }
    v2u cur[8];
    if (gw < nrows) {
#pragma unroll
        for (int j = 0; j < 8; ++j) cur[j] = ((const v2u*)(src + (size_t)gw * D))[lane + 64 * j];
    }
    for (int m = gw; m < nrows; m += NGW) {
        v2u nxt[8];
        const bool hn = m + NGW < nrows;
        if (hn) {
#pragma unroll
            for (int j = 0; j < 8; ++j) nxt[j] = ((const v2u*)(src + (size_t)(m + NGW) * D))[lane + 64 * j];
        }
        f32x4 v[8];
#pragma unroll
        for (int j = 0; j < 8; ++j) v[j] = (f32x4){__uint_as_float(cur[j].x << 16), __uint_as_float(cur[j].x & 0xffff0000u), __uint_as_float(cur[j].y << 16), __uint_as_float(cur[j].y & 0xffff0000u)};
        ln_core(v, gg, bb, dstf ? dstf + (size_t)m * D : nullptr, dstb ? dstb + (size_t)m * D : nullptr, lane);
        if (hn) {
#pragma unroll
            for (int j = 0; j < 8; ++j) cur[j] = nxt[j];
        }
    }
}

#define XB_TMO      128
#define XB_XCNT(j)  (256  + 64 * (j))
#define XB_XSUB(j)  (1280 + 64 * (j))
#define XB_XGEN(j)  (2304 + 64 * (j))
#define XB_TOP      3328
#define XB_TOPGEN   3392
#define XCD_BAR_WORDS 3456
#define XB_SPIN_CAP (1u << 18)
__device__ __forceinline__ unsigned xb_ld(unsigned* p)              { return __hip_atomic_load(p, __ATOMIC_RELAXED, __HIP_MEMORY_SCOPE_AGENT); }
__device__ __forceinline__ unsigned xb_add(unsigned* p, unsigned v) { return __hip_atomic_fetch_add(p, v, __ATOMIC_RELAXED, __HIP_MEMORY_SCOPE_AGENT); }
__device__ __forceinline__ unsigned xb_xcc_id() { return (unsigned)__builtin_amdgcn_s_getreg((3 << 11) | 20) & 0xFu; }
#define XB_SPIN(cond, bar) do { unsigned _sp = 0; while (cond) { __builtin_amdgcn_s_sleep(1); \
    if ((++_sp & 255u) == 0u) { if (xb_ld(&(bar)[XB_TMO])) break; if (_sp > XB_SPIN_CAP) { atomicAdd(&(bar)[XB_TMO], 1u); break; } } } } while (0)
struct XcdBarrier { unsigned* bar; unsigned x; volatile LAS unsigned* st; };
__device__ __forceinline__ XcdBarrier xcd_barrier_post(unsigned* bar, volatile LAS unsigned* st) {
    XcdBarrier b; b.bar = bar; b.x = xb_xcc_id(); b.st = st;
    if (threadIdx.x == 0) (void)xb_add(&bar[XB_XCNT(b.x)], 1u);
    return b;
}
__device__ __forceinline__ void xcd_barrier_complete(unsigned* bar, unsigned x, unsigned& nloc, unsigned& nx) {
    const unsigned G = gridDim.x * gridDim.y * gridDim.z;
    unsigned sum, cnt, mine, sp = 0u;
    for (;;) {
        sum = 0u; cnt = 0u; mine = 0u;
#pragma unroll
        for (unsigned j = 0; j < 16; ++j) { const unsigned c = xb_ld(&bar[XB_XCNT(j)]); sum += c; cnt += (c > 0u) ? 1u : 0u; mine = (j == x) ? c : mine; }
        if (sum == G) break;
        __builtin_amdgcn_s_sleep(1);
        if ((++sp & 255u) == 0u) { if (xb_ld(&bar[XB_TMO])) break; if (sp > XB_SPIN_CAP) { atomicAdd(&bar[XB_TMO], 1u); break; } }
    }
    nloc = mine > 0u ? mine : 1u; nx = cnt > 0u ? cnt : 1u;
}
__device__ __forceinline__ void xcd_barrier(const XcdBarrier& b) {
    asm volatile("s_waitcnt vmcnt(0)" ::: "memory");
    __syncthreads();
    if (threadIdx.x == 0) {
        unsigned* bar = b.bar;
        __builtin_amdgcn_s_waitcnt(0);
        unsigned nloc = b.st[0], nx = b.st[1];
        if (nloc == 0u) { xcd_barrier_complete(bar, b.x, nloc, nx); b.st[0] = nloc; b.st[1] = nx; }
        const unsigned old = xb_add(&bar[XB_XSUB(b.x)], 1u);
        const unsigned gen = old / nloc;
        if (old + 1u == (gen + 1u) * nloc) {
            __builtin_amdgcn_fence(__ATOMIC_RELEASE, "agent");
            asm volatile("s_waitcnt vmcnt(0)" ::: "memory");
            const unsigned og = xb_add(&bar[XB_TOP], 1u);
            const unsigned tg = og / nx;
            if (og + 1u == (tg + 1u) * nx) xb_add(&bar[XB_TOPGEN], 1u);
            else XB_SPIN(xb_ld(&bar[XB_TOPGEN]) == tg, bar);
            __builtin_amdgcn_fence(__ATOMIC_ACQUIRE, "agent");
            xb_add(&bar[XB_XGEN(b.x)], 1u);
            asm volatile("s_waitcnt vmcnt(0)" ::: "memory");
        } else {
            XB_SPIN(xb_ld(&bar[XB_XGEN(b.x)]) == gen, bar);
            __builtin_amdgcn_fence(__ATOMIC_ACQUIRE, "agent");
            asm volatile("s_waitcnt vmcnt(0)" ::: "memory");
        }
    }
    __syncthreads();
}

__device__ __forceinline__ int p2_chunk_item(int bx, int s, int G) {
    if (G != 256) { const int it = bx + s * G; return it < 1024 ? it : -1; }
    if (s < 2) return bx + 256 * s;
    if (bx < 32) return -1;
    const int j = (bx - 32) + 224 * (s - 2);
    return j < 512 ? 512 + j : -1;
}

struct Args { const float* in[20]; float* out; unsigned char* ws; int ph_lo, ph_hi; };

__global__ void __launch_bounds__(NWAVES * 64, 2) fwd_kernel(Args args) {
    extern __shared__ __attribute__((aligned(16))) unsigned char lds_raw[];
    LAS unsigned char* lds = (LAS unsigned char*)lds_raw;
    const int tid = threadIdx.x, lane = tid & 63, wave = __builtin_amdgcn_readfirstlane(tid >> 6);
    const int G = gridDim.x, bx = blockIdx.x;
    const int gt = bx * 512 + tid, NT = G * 512;
    const int gw = bx * NWAVES + wave, NGW = G * NWAVES;

#define x_prompt (args.in[0])
#define x_sample (args.in[1])
#define cache_conv (args.in[2])
#define state_hgrn (args.in[3])
#define w_in (args.in[4])
#define b_in (args.in[5])
#define w_dw (args.in[6])
#define b_dw (args.in[7])
#define cn_g (args.in[8])
#define cn_b (args.in[9])
#define hlb (args.in[10])
#define hg_ng (args.in[11])
#define w_out (args.in[12])
#define ln1_g (args.in[13])
#define ln1_b (args.in[14])
#define w_gate (args.in[15])
#define w_up (args.in[16])
#define w_down (args.in[17])
#define ln2_g (args.in[18])
#define ln2_b (args.in[19])
#define out (args.out)
#define ws (args.ws)
#define LB ((float*)(ws + WS_LB))
#define BIASP ((float*)(ws + WS_BIASP))
#define WIN ((bf16*)(ws + WS_WIN))
#define WOUT ((bf16*)(ws + WS_WOUT))
#define WGU ((bf16*)(ws + WS_WGU))
#define WDN ((bf16*)(ws + WS_WDN))
#define XB ((bf16*)(ws + WS_XB))
#define MIX ((bf16*)(ws + WS_MIX))
#define U ((bf16*)(ws + WS_U))
#define Q ((bf16*)(ws + WS_Q))
#define F ((float*)(ws + WS_F))
#define I ((bf16*)(ws + WS_I))
#define Gt ((bf16*)(ws + WS_G))
#define ACT ((bf16*)(ws + WS_ACT))
#define ST (out + O_ST)
#define DC (out + O_DC)

    const int lo = args.ph_lo, hi = args.ph_hi;
    volatile LAS unsigned* MISC = (volatile LAS unsigned*)(lds + LDS_BYTES - 64);
    if (tid < 16) MISC[tid] = 0u;
    __syncthreads();
    XcdBarrier xbar = xcd_barrier_post((unsigned*)ws, MISC + 8);
#ifndef PH_MASK
#define PH_MASK 0x3ff
#endif
#define IN(k) (((PH_MASK >> (k)) & 1) && lo <= (k) && (k) < hi)
#ifndef REP_MASK
#define REP_MASK 0
#endif
#define NREP(k) (1 + ((REP_MASK >> (k)) & 1))
#ifdef TS_A
    unsigned long long ts_a = 0, ts_b = 0;
#define STAMP(k) do { if ((k) == TS_A) ts_a = __builtin_amdgcn_s_memrealtime(); if ((k) == TS_B) ts_b = __builtin_amdgcn_s_memrealtime(); } while (0)
#else
#define STAMP(k) do { } while (0)
#endif
#define SEAM(k) do { if (IN(k) && IN((k) + 1)) { xcd_barrier(xbar); } STAMP((k) + 1); } while (0)
    STAMP(0);
    if (hi > 1000) cg::this_grid().sync();

    if (IN(0)) for (int rep_ = 0; rep_ < NREP(0); ++rep_) { if (rep_) xcd_barrier(xbar);
        LAS float* scr = (LAS float*)(lds + wave * 16384);
        constexpr int I_IN = 32 * 192;
        transpose_stream<1>(w_in, D, NIN, WIN, gw, I_IN, NGW, scr, lane);
        constexpr int NV = M * D / 8, NVP = MP * D / 8;
#pragma unroll 4
        for (int i = gt; i < NV; i += NT) {
            const float* src = i < NVP ? x_prompt + (size_t)i * 8 : x_sample + (size_t)(i - NVP) * 8;
            const f32x4 a = *(const f32x4*)src, b = *(const f32x4*)(src + 4);
            v4u o; o.x = pk2(a.x, a.y); o.y = pk2(a.z, a.w); o.z = pk2(b.x, b.y); o.w = pk2(b.z, b.w);
            *(v4u*)(XB + (size_t)i * 8) = o;
        }
        for (int i = gt; i < 1024; i += NT) LB[i] = sigm(hlb[i] - hlb[1024 + i]);
        for (int i = gt; i < NIN; i += NT) { const int orig = i < 2048 ? ((i & 255) >> 7) * 1024 + (i >> 8) * 128 + (i & 127) : i; BIASP[i] = b_in[orig]; }
    }
    SEAM(0);
#ifdef EXTRA_SYNCS
    for (int i_ = 0; i_ < EXTRA_SYNCS; ++i_) cg::this_grid().sync();
#endif

    if (IN(1)) for (int rep_ = 0; rep_ < NREP(1); ++rep_) { if (rep_) xcd_barrier(xbar);
        pg8::Gemm g{XB, WIN, M, NIN, D}; pg8::StaticOrder S; S.init(M, NIN, D, G, bx);
        pg8::EpiProj E{U, Q, F, BIASP, LB};
        pg8::gemm_phase<pg8::EpiProj, pg8::StaticOrder, true, true>(lds, g, S, E);
        const int nlast = S.nitems % G;
        if (nlast > 0 && bx >= nlast) {
            LAS float* scr = (LAS float*)(lds + wave * 16384);
            constexpr int I_OUT = 32 * 64, I_G = 32 * 176, I_DN = 88 * 64;
            const int gw2 = (bx - nlast) * NWAVES + wave, NGW2 = (G - nlast) * NWAVES;
            transpose_stream<0>(w_out, D, D, WOUT, gw2, I_OUT, NGW2, scr, lane);
            transpose_stream<2>(w_gate, D, FF, WGU, gw2, I_G, NGW2, scr, lane);
            transpose_stream<3>(w_up, D, FF, WGU, gw2, I_G, NGW2, scr, lane);
        }
    }
    SEAM(1);

    if (IN(2)) for (int rep_ = 0; rep_ < NREP(2); ++rep_) { if (rep_) xcd_barrier(xbar);
#define LBAR2() do { asm volatile("s_waitcnt lgkmcnt(0)" ::: "memory"); __builtin_amdgcn_s_barrier(); asm volatile("" ::: "memory"); } while (0)
        float pf[16]; unsigned short pi[16];
#define P2_LOAD(IT) do { const int bh_ = (IT) >> 5, c_ = (IT) & 31, h_ = bh_ & 7, row0_ = (bh_ >> 3) * 2048 + c_ * 64; const int k_ = tid & 127, qtr_ = __builtin_amdgcn_readfirstlane(tid >> 7); \
            _Pragma("unroll") for (int s_ = 0; s_ < 16; ++s_) { const size_t gi = (size_t)(row0_ + qtr_ * 16 + s_) * 1024 + h_ * 128 + k_; pf[s_] = F[gi]; pi[s_] = I[gi]; } } while (0)
        int ait = p2_chunk_item(bx, 0, G), aslot = 0;
        if (ait >= 0) P2_LOAD(ait);
        while (ait >= 0) {
            const int it = ait;
            const int anext = p2_chunk_item(bx, aslot + 1, G);
            LBAR2();
            {
                const int bh = it >> 5, c = it & 31, b = bh >> 3, h = bh & 7;
                const int row0 = b * 2048 + c * 64;
                LAS bf16* KEt = (LAS bf16*)lds;
                LAS bf16* Vt = (LAS bf16*)(lds + 18432);
                LAS float* Tq = (LAS float*)(lds + 36864);
                const int k = tid & 127, qtr = __builtin_amdgcn_readfirstlane(tid >> 7);
                float lf[16], kk[16]; unsigned short iv[16];
#pragma unroll
                for (int s_ = 0; s_ < 16; ++s_) { const float f = pf[s_]; lf[s_] = __builtin_amdgcn_logf(f); kk[s_] = 1.0f - f; iv[s_] = pi[s_]; }
                if (anext >= 0) P2_LOAD(anext);
                float run = 0.f; float suf[16];
#pragma unroll
                for (int s_ = 15; s_ >= 0; --s_) { suf[s_] = run; run += lf[s_]; }
                Tq[qtr * 128 + k] = run;
                { v4u w0, w1;
                  w0.x = iv[0] | ((unsigned)iv[1] << 16); w0.y = iv[2] | ((unsigned)iv[3] << 16); w0.z = iv[4] | ((unsigned)iv[5] << 16); w0.w = iv[6] | ((unsigned)iv[7] << 16);
                  w1.x = iv[8] | ((unsigned)iv[9] << 16); w1.y = iv[10] | ((unsigned)iv[11] << 16); w1.z = iv[12] | ((unsigned)iv[13] << 16); w1.w = iv[14] | ((unsigned)iv[15] << 16);
                  *(LAS v4u*)(Vt + k * 72 + qtr * 16) = w0; *(LAS v4u*)(Vt + k * 72 + qtr * 16 + 8) = w1; }
                LBAR2();
                float later = 0.f, total = 0.f;
#pragma unroll
                for (int q2 = 0; q2 < 4; ++q2) { const float tq = Tq[q2 * 128 + k]; total += tq; later += q2 > qtr ? tq : 0.f; }
                { float ke[16];
#pragma unroll
                  for (int s_ = 0; s_ < 16; ++s_) ke[s_] = kk[s_] * __builtin_amdgcn_exp2f(suf[s_] + later);
                  v4u w0, w1;
                  w0.x = pg8::cvt_pk_bf16(ke[0], ke[1]); w0.y = pg8::cvt_pk_bf16(ke[2], ke[3]); w0.z = pg8::cvt_pk_bf16(ke[4], ke[5]); w0.w = pg8::cvt_pk_bf16(ke[6], ke[7]);
                  w1.x = pg8::cvt_pk_bf16(ke[8], ke[9]); w1.y = pg8::cvt_pk_bf16(ke[10], ke[11]); w1.z = pg8::cvt_pk_bf16(ke[12], ke[13]); w1.w = pg8::cvt_pk_bf16(ke[14], ke[15]);
                  *(LAS v4u*)(KEt + k * 72 + qtr * 16) = w0; *(LAS v4u*)(KEt + k * 72 + qtr * 16 + 8) = w1; }
                if (qtr == 0) DC[it * 128 + k] = exp2f(total);
                LBAR2();
                { const int r = lane & 15, q = lane >> 4;
                  const pg8::bf16x8 a0 = *(const LAS pg8::bf16x8*)(Vt + (16 * wave + r) * 72 + 8 * q), a1 = *(const LAS pg8::bf16x8*)(Vt + (16 * wave + r) * 72 + 8 * q + 32);
                  float* sp = ST + (size_t)it * 16384 + (size_t)(16 * wave + 4 * q) * 128 + r;
#pragma unroll
                  for (int kt = 0; kt < 8; ++kt) {
                      const pg8::bf16x8 b0 = *(const LAS pg8::bf16x8*)(KEt + (16 * kt + r) * 72 + 8 * q), b1 = *(const LAS pg8::bf16x8*)(KEt + (16 * kt + r) * 72 + 8 * q + 32);
                      f32x4 acc = (f32x4){0.f, 0.f, 0.f, 0.f};
                      acc = __builtin_amdgcn_mfma_f32_16x16x32_bf16(a0, b0, acc, 0, 0, 0);
                      acc = __builtin_amdgcn_mfma_f32_16x16x32_bf16(a1, b1, acc, 0, 0, 0);
#pragma unroll
                      for (int j = 0; j < 4; ++j) sp[j * 128 + 16 * kt] = acc[j];
                  } }
            }
            ait = anext; ++aslot;
        }
        STAMP(20);
        for (int it = 1024 + bx; it < 1024 + 544; it += G) {
            LBAR2();
            {
                const int m0 = (it - 1024) * 16;
                const bool samp = m0 >= MP;
                int t0, seq0; const float* hist = cache_conv;
                if (!samp) { t0 = m0 & 2047; seq0 = m0 - t0; }
                else { t0 = 0; seq0 = m0; hist = cache_conv + (size_t)((m0 - MP) >> 4) * 30 * 1024; }
                const int hrow0 = samp ? ((m0 - MP) >> 4) * 30 : 0;
                const __amdgpu_buffer_rsrc_t rU = __builtin_amdgcn_make_buffer_rsrc((void*)U, 0, M * 1024 * 2, 0x00020000);
                const __amdgpu_buffer_rsrc_t rH = __builtin_amdgcn_make_buffer_rsrc((void*)cache_conv, 0, 32 * 30 * 1024 * 4, 0x00020000);
                const __amdgpu_buffer_rsrc_t rW = __builtin_amdgcn_make_buffer_rsrc((void*)w_dw, 0, 31 * 1024 * 4, 0x00020000);
                const bool interior = t0 >= 30;
                LAS float* hbuf = (LAS float*)(lds + 16384);
                LAS f32x2* stat = (LAS f32x2*)(lds + 16384 + 65536);
                const int c = 2 * tid;
                f32x2 acc[16];
                { const f32x2 bb = *(const f32x2*)(b_dw + c);
#pragma unroll
                  for (int t = 0; t < 16; ++t) acc[t] = bb; }
#pragma unroll
                for (int ch = 0; ch < 2; ++ch) {
                    const int j0 = ch * 16, nj = ch ? 15 : 16;
                    f32x2 win[31];
                    if (interior) {
                        const int rb = (seq0 + t0 - 30 + j0) * 2048;
#pragma unroll
                        for (int xi = 0; xi < 31; ++xi) if (xi < nj + 15) { const unsigned pw = __builtin_amdgcn_raw_buffer_load_b32(rU, 4 * tid, rb + xi * 2048, 0); win[xi] = (f32x2){__uint_as_float(pw << 16), __uint_as_float(pw & 0xffff0000u)}; }
                    } else {
#pragma unroll
                        for (int xi = 0; xi < 31; ++xi) if (xi < nj + 15) {
                            const int tr = t0 - 30 + j0 + xi;
                            f32x2 wv = (f32x2){0.f, 0.f};
                            if (tr >= 0) { const unsigned pw = __builtin_amdgcn_raw_buffer_load_b32(rU, 4 * tid, (seq0 + tr) * 2048, 0); wv = (f32x2){__uint_as_float(pw << 16), __uint_as_float(pw & 0xffff0000u)}; }
                            else if (samp) { const v2u hv = __builtin_amdgcn_raw_buffer_load_b64(rH, 8 * tid, (hrow0 + 30 + tr) * 4096, 0); wv = (f32x2){__uint_as_float(hv.x), __uint_as_float(hv.y)}; }
                            win[xi] = wv;
                        }
                    }
#pragma unroll
                    for (int jj = 0; jj < 16; ++jj) if (jj < nj) { const v2u wu = __builtin_amdgcn_raw_buffer_load_b64(rW, 8 * tid, (j0 + jj) * 4096, 0); const f32x2 w2 = (f32x2){__uint_as_float(wu.x), __uint_as_float(wu.y)};
#pragma unroll
                        for (int t = 0; t < 16; ++t) acc[t] += w2 * win[t + jj]; }
                    asm volatile("" ::: "memory");
                }
#pragma unroll
                for (int t = 0; t < 16; ++t) *(LAS f32x2*)(hbuf + t * 1024 + c) = acc[t];
                __syncthreads();
#pragma unroll
                for (int tt = 0; tt < 2; ++tt) { const int t = 2 * wave + tt; float s1 = 0.f, s2 = 0.f;
#pragma unroll
                    for (int i = 0; i < 4; ++i) { const f32x4 x = *(const LAS f32x4*)(hbuf + t * 1024 + 4 * lane + 256 * i); s1 += (x.x + x.y) + (x.z + x.w); s2 += (x.x * x.x + x.y * x.y) + (x.z * x.z + x.w * x.w); }
                    s1 = wave_sum(s1); s2 = wave_sum(s2);
                    const float mu = s1 * (1.f / 1024.f); float var = s2 * (1.f / 1024.f) - mu * mu; var = var > 0.f ? var : 0.f;
                    if (lane == 0) stat[t] = (f32x2){mu, 1.f / sqrtf(var + LN_EPS)}; }
                __syncthreads();
                const f32x2 gg = *(const f32x2*)(cn_g + c), bb2 = *(const f32x2*)(cn_b + c);
#pragma unroll
                for (int t = 0; t < 16; ++t) {
                    const f32x2 st2 = stat[t];
                    float y0 = (acc[t].x - st2.x) * st2.y * gg.x + bb2.x, y1 = (acc[t].y - st2.x) * st2.y * gg.y + bb2.y;
                    y0 = y0 * sigm(y0); y1 = y1 * sigm(y1);
                    *(unsigned*)(MIX + (size_t)(m0 + t) * 2048 + c) = pk2(y0, y1);
                }
            }
        }
        STAMP(21);
        { const int nx = (1024 + 544) % G;
          const int first = (nx > 0 && nx < G) ? nx : 0;
          const bool deal = G == 256;
          const bool mine = deal ? (bx < 32 || bx >= 96) : (bx >= first);
          const int nwg = deal ? 192 : G - first, widx = deal ? (bx < 32 ? bx : bx - 64) : bx - first;
          if (mine) {
              const int gt2 = widx * 512 + tid, NT2 = nwg * 512;
              for (int i = gt2; i < 4 * 30 * 1024; i += NT2) { const int b = i / 30720, j = (i >> 10) % 30, c = i & 1023;
                  out[O_NCP + i] = bf2f(U[(size_t)(b * 2048 + 2018 + j) * 1024 + c]); }
              for (int i = gt2; i < 32 * 30 * 1024; i += NT2) { const int sb = i / 30720, j = (i >> 10) % 30, c = i & 1023;
                  out[O_NCS + i] = j < 14 ? cache_conv[(size_t)sb * 30720 + (16 + j) * 1024 + c] : bf2f(U[(size_t)(MP + sb * 16 + j - 14) * 1024 + c]); }
          } }
    }
    SEAM(2);

    if (IN(3)) {
        for (int e = gt; e < 32 * 4096; e += NT) {
            const int bh = e >> 12, r = e & 4095, v = r >> 5, k4 = r & 31;
            f32x4 S = (f32x4){0.f, 0.f, 0.f, 0.f};
#pragma unroll 8
            for (int c = 0; c < 32; ++c) {
                f32x4* p = (f32x4*)(ST + ((size_t)(bh * 32 + c) * 128 + v) * 128 + k4 * 4);
                const f32x4 A = *p; const f32x4 d = *(const f32x4*)(DC + (bh * 32 + c) * 128 + k4 * 4);
                *p = S; S = S * d + A;
            }
            float* o = out + O_NHP + (size_t)bh * 16384 + (size_t)(k4 * 4) * 128 + v;
            o[0] = S.x; o[128] = S.y; o[256] = S.z; o[384] = S.w;
        }
    }
    SEAM(3);

    if (IN(4)) for (int rep_ = 0; rep_ < NREP(4); ++rep_) { if (rep_) xcd_barrier(xbar);
        LAS float* vl = (LAS float*)lds; LAS float* red = (LAS float*)(lds + 8192);
        LAS float* fl2 = (LAS float*)(lds + 73728); LAS float* ql2 = (LAS float*)(lds + 81920);
#define LBAR() do { asm volatile("s_waitcnt lgkmcnt(0)" ::: "memory"); __builtin_amdgcn_s_barrier(); asm volatile("" ::: "memory"); } while (0)
        float fr[16]; unsigned short qh[16], ih[16]; unsigned gq[8]; f32x4 sv[8];
#define P4_LOAD(IT) do { const int bh_ = (IT) >> 5, c_ = (IT) & 31, h_ = bh_ & 7, row0_ = (bh_ >> 3) * 2048 + c_ * 64; const int k_ = tid & 127, qtr_ = __builtin_amdgcn_readfirstlane(tid >> 7); \
            _Pragma("unroll") for (int s_ = 0; s_ < 16; ++s_) { const size_t gi = (size_t)(row0_ + qtr_ * 16 + s_) * 1024 + h_ * 128 + k_; fr[s_] = F[gi]; qh[s_] = Q[gi]; ih[s_] = I[gi]; } \
            _Pragma("unroll") for (int j = 0; j < 8; ++j) sv[j] = *(const f32x4*)(ST + (size_t)(IT) * 16384 + (size_t)(tid + 512 * j) * 4); \
            _Pragma("unroll") for (int tt = 0; tt < 8; ++tt) { const size_t m = (size_t)(row0_ + wave * 8 + tt); gq[tt] = *(const unsigned*)(Gt + m * 1024 + h_ * 128 + 2 * lane); } } while (0)
        if (bx < 1024) P4_LOAD(bx);
        float ng0 = hg_ng[2 * lane], ng1 = hg_ng[2 * lane + 1];
        asm volatile("" : "+v"(ng0), "+v"(ng1));
        for (int it = bx; it < 1024; it += G) {
          {
            const int bh = it >> 5, c = it & 31, h = bh & 7, row0 = (bh >> 3) * 2048 + c * 64;
            LAS bf16* St = (LAS bf16*)lds;
            LAS bf16* QD = (LAS bf16*)(lds + 34816);
            LAS bf16* Vt = (LAS bf16*)(lds + 52224);
            LAS bf16* Pm = (LAS bf16*)(lds + 70656);
            LAS bf16* QDI = (LAS bf16*)(lds + 79872);
            LAS bf16* KD = (LAS bf16*)(lds + 97280);
            LAS float* Tq = (LAS float*)(lds + 140800);
            LAS float* Ob = (LAS float*)(lds + 79872);
            LBAR();
            const int k = tid & 127, qtr = __builtin_amdgcn_readfirstlane(tid >> 7);
            float pre[16], kk[16], qq[16]; unsigned short iv[16];
#pragma unroll
            for (int s_ = 0; s_ < 16; ++s_) { const float f = fr[s_]; pre[s_] = __builtin_amdgcn_logf(f); kk[s_] = 1.0f - f; qq[s_] = bf2f(qh[s_]); iv[s_] = ih[s_]; }
#pragma unroll
            for (int j = 0; j < 8; ++j) { const int e = tid + 512 * j, v = e >> 5, k4 = e & 31; const f32x4 x = sv[j];
                v2u w; w.x = pk2(x.x, x.y); w.y = pk2(x.z, x.w); *(LAS v2u*)(St + v * 136 + k4 * 4) = w; }
#pragma unroll
            for (int s_ = 1; s_ < 16; ++s_) pre[s_] += pre[s_ - 1];
            const float tot = pre[15];
            Tq[qtr * 128 + k] = tot;
            { v4u w0, w1;
              w0.x = iv[0] | ((unsigned)iv[1] << 16); w0.y = iv[2] | ((unsigned)iv[3] << 16); w0.z = iv[4] | ((unsigned)iv[5] << 16); w0.w = iv[6] | ((unsigned)iv[7] << 16);
              w1.x = iv[8] | ((unsigned)iv[9] << 16); w1.y = iv[10] | ((unsigned)iv[11] << 16); w1.z = iv[12] | ((unsigned)iv[13] << 16); w1.w = iv[14] | ((unsigned)iv[15] << 16);
              *(LAS v4u*)(Vt + k * 72 + qtr * 16) = w0; *(LAS v4u*)(Vt + k * 72 + qtr * 16 + 8) = w1; }
            const int kdoff = qtr == 0 ? 0 : (qtr == 1 ? 16 : (qtr == 2 ? 48 : 96));
#pragma unroll
            for (int s_ = 0; s_ < 16; ++s_) {
                QDI[(16 * qtr + s_) * 136 + k] = bfr(qq[s_] * __builtin_amdgcn_exp2f(pre[s_]));
                KD[(kdoff + 16 * qtr + s_) * 136 + k] = bfr(kk[s_] * __builtin_amdgcn_exp2f(fminf(-pre[s_], 120.f)));
            }
            LBAR();
            { float lb_ = 0.f;
#pragma unroll
              for (int q2 = 0; q2 < 4; ++q2) lb_ += q2 < qtr ? Tq[q2 * 128 + k] : 0.f;
#pragma unroll
              for (int s_ = 0; s_ < 16; ++s_) QD[(16 * qtr + s_) * 136 + k] = bfr(qq[s_] * __builtin_amdgcn_exp2f(pre[s_] + lb_));
              float gap = 0.f;
              for (int i = qtr + 1; i < 4; ++i) {
                  const int off = i == 1 ? 16 : (i == 2 ? 48 : 96);
#pragma unroll
                  for (int s_ = 0; s_ < 16; ++s_) KD[(off + 16 * qtr + s_) * 136 + k] = bfr(kk[s_] * __builtin_amdgcn_exp2f((tot - pre[s_]) + gap));
                  gap += Tq[i * 128 + k];
              } }
            unsigned gpre[8];
#pragma unroll
            for (int i = 0; i < 8; ++i) gpre[i] = gq[i];
            if (it + G < 1024) P4_LOAD(it + G);
            LBAR();
            const int r = lane & 15, q = lane >> 4;
            for (int n = wave; n < 10; n += 8) {
                const int i = n == 0 ? 0 : (n < 3 ? 1 : (n < 6 ? 2 : 3)), j = n - (i == 0 ? 0 : (i == 1 ? 1 : (i == 2 ? 3 : 6)));
                const int off = i == 0 ? 0 : (i == 1 ? 16 : (i == 2 ? 48 : 96));
                f32x4 acc = (f32x4){0.f, 0.f, 0.f, 0.f};
#pragma unroll
                for (int ks = 0; ks < 4; ++ks) {
                    const pg8::bf16x8 a = *(const LAS pg8::bf16x8*)(QDI + (16 * i + r) * 136 + 8 * q + 32 * ks);
                    const pg8::bf16x8 bq = *(const LAS pg8::bf16x8*)(KD + (off + 16 * j + r) * 136 + 8 * q + 32 * ks);
                    acc = __builtin_amdgcn_mfma_f32_16x16x32_bf16(a, bq, acc, 0, 0, 0);
                }
#pragma unroll
                for (int jj = 0; jj < 4; ++jj) { const float x = (i != j || r <= 4 * q + jj) ? acc[jj] : 0.f; Pm[(16 * i + 4 * q + jj) * 72 + 16 * j + r] = bfr(x); }
            }
            if (wave == 2 || wave == 3) { const int i = wave == 2 ? 0 : 2, j = i + 1;
#pragma unroll
                for (int jj = 0; jj < 4; ++jj) Pm[(16 * i + 4 * q + jj) * 72 + 16 * j + r] = (bf16)0; }
            LBAR();
            { const int i = wave >> 1, vt0 = 4 * (wave & 1);
              pg8::bf16x8 pa[2], qa[4];
#pragma unroll
              for (int ks = 0; ks < 2; ++ks) pa[ks] = *(const LAS pg8::bf16x8*)(Pm + (16 * i + r) * 72 + 8 * q + 32 * ks);
#pragma unroll
              for (int ks = 0; ks < 4; ++ks) qa[ks] = *(const LAS pg8::bf16x8*)(QD + (16 * i + r) * 136 + 8 * q + 32 * ks);
#pragma unroll
              for (int vv = 0; vv < 4; ++vv) { const int vt = vt0 + vv;
                  f32x4 acc = (f32x4){0.f, 0.f, 0.f, 0.f};
                  acc = __builtin_amdgcn_mfma_f32_16x16x32_bf16(pa[0], *(const LAS pg8::bf16x8*)(Vt + (16 * vt + r) * 72 + 8 * q), acc, 0, 0, 0);
                  if (i >= 2) acc = __builtin_amdgcn_mfma_f32_16x16x32_bf16(pa[1], *(const LAS pg8::bf16x8*)(Vt + (16 * vt + r) * 72 + 8 * q + 32), acc, 0, 0, 0);
#pragma unroll
                  for (int ks = 0; ks < 4; ++ks) acc = __builtin_amdgcn_mfma_f32_16x16x32_bf16(qa[ks], *(const LAS pg8::bf16x8*)(St + (16 * vt + r) * 136 + 8 * q + 32 * ks), acc, 0, 0, 0);
#pragma unroll
                  for (int jj = 0; jj < 4; ++jj) Ob[(16 * i + 4 * q + jj) * 132 + 16 * vt + r] = acc[jj];
              } }
            LBAR();
            { float o0[8], o1[8], ss[8];
#pragma unroll
              for (int tt = 0; tt < 8; ++tt) { const int t = wave * 8 + tt; const f32x2 ov = *(const LAS f32x2*)(Ob + t * 132 + 2 * lane); o0[tt] = ov.x; o1[tt] = ov.y; ss[tt] = o0[tt] * o0[tt] + o1[tt] * o1[tt]; }
#pragma unroll
              for (int o = 1; o < 64; o <<= 1) {
#pragma unroll
                  for (int tt = 0; tt < 8; ++tt) ss[tt] += __shfl_xor(ss[tt], o); }
#pragma unroll
              for (int tt = 0; tt < 8; ++tt) {
                  const float rr = __builtin_amdgcn_rsqf(ss[tt] * (1.f / 128.f) + LN_EPS);
                  const size_t m = (size_t)(row0 + wave * 8 + tt);
                  const float g0 = __uint_as_float(gpre[tt] << 16), g1 = __uint_as_float(gpre[tt] & 0xffff0000u);
                  *(unsigned*)(MIX + m * 2048 + 1024 + h * 128 + 2 * lane) = pg8::cvt_pk_bf16(o0[tt] * rr * ng0 * g0, o1[tt] * rr * ng1 * g1);
              } }
          }
        }
#undef P4_LOAD
#undef LBAR
        __syncthreads();
        STAMP(22);
        for (int it = 1024 + bx; it < 1024 + 256; it += G) {
          {
            int row0, h, nsb; const float* sinit; float* sfin = nullptr;
            if (it < 1024) { const int bh = it >> 5, c = it & 31; h = bh & 7; row0 = (bh >> 3) * 2048 + c * 64; nsb = 4; sinit = ST + (size_t)it * 16384; }
            else { const int j = it - 1024; h = j & 7; row0 = MP + (j >> 3) * 16; nsb = 1; sinit = state_hgrn + (size_t)j * 16384; sfin = out + O_NHS + (size_t)j * 16384; }
            f32x2 Sa[8], Sb[8];
            { const float* sp = sinit + (size_t)(wave * 16) * 128 + lane;
#pragma unroll
              for (int i = 0; i < 8; ++i) { Sa[i] = (f32x2){sp[(2 * i) * 128], sp[(2 * i + 1) * 128]}; Sb[i] = (f32x2){sp[(2 * i) * 128 + 64], sp[(2 * i + 1) * 128 + 64]}; } }
            for (int sb = 0; sb < nsb; ++sb) {
                __syncthreads();
#pragma unroll
                for (int e4 = 0; e4 < 4; ++e4) { const int e = tid + e4 * 512, t = e >> 7, k = e & 127; const size_t gi = (size_t)(row0 + sb * 16 + t) * 1024 + h * 128 + k;
                    vl[e] = bf2f(I[gi]); fl2[e] = F[gi]; ql2[e] = bf2f(Q[gi]); }
                __syncthreads();
#pragma unroll 2
                for (int t = 0; t < 16; ++t) {
                    f32x4 f4[4], q4[4];
#pragma unroll
                    for (int i = 0; i < 4; ++i) { f4[i] = *(const LAS f32x4*)(fl2 + t * 128 + wave * 16 + 4 * i); q4[i] = *(const LAS f32x4*)(ql2 + t * 128 + wave * 16 + 4 * i); }
                    const float va = vl[t * 128 + lane], vb = vl[t * 128 + 64 + lane];
                    const f32x2 va2 = (f32x2){va, va}, vb2 = (f32x2){vb, vb};
                    f32x2 oa = (f32x2){0.f, 0.f}, ob = (f32x2){0.f, 0.f};
#pragma unroll
                    for (int i = 0; i < 8; ++i) { const f32x2 f2 = (f32x2){f4[i >> 1][2 * (i & 1)], f4[i >> 1][2 * (i & 1) + 1]};
                        const f32x2 q2 = (f32x2){q4[i >> 1][2 * (i & 1)], q4[i >> 1][2 * (i & 1) + 1]};
                        Sa[i] = f2 * (Sa[i] - va2) + va2; Sb[i] = f2 * (Sb[i] - vb2) + vb2;
                        oa += q2 * Sa[i]; ob += q2 * Sb[i]; }
                    red[(wave * 16 + t) * 128 + lane] = oa.x + oa.y; red[(wave * 16 + t) * 128 + 64 + lane] = ob.x + ob.y;
                }
                __syncthreads();
#pragma unroll
                for (int tt = 0; tt < 2; ++tt) {
                    const int t = wave * 2 + tt;
                    float o0 = 0.f, o1 = 0.f;
#pragma unroll
                    for (int q8 = 0; q8 < 8; ++q8) { o0 += red[(q8 * 16 + t) * 128 + lane]; o1 += red[(q8 * 16 + t) * 128 + 64 + lane]; }
                    const float ss = wave_sum(o0 * o0 + o1 * o1);
                    const float r = 1.f / sqrtf(ss * (1.f / 128.f) + LN_EPS);
                    const size_t m = (size_t)(row0 + sb * 16 + t);
                    const float g0 = bf2f(Gt[m * 1024 + h * 128 + lane]), g1 = bf2f(Gt[m * 1024 + h * 128 + 64 + lane]);
                    MIX[m * 2048 + 1024 + h * 128 + lane] = (bf16)f2bf(o0 * r * hg_ng[lane] * g0);
                    MIX[m * 2048 + 1024 + h * 128 + 64 + lane] = (bf16)f2bf(o1 * r * hg_ng[64 + lane] * g1);
                }
            }
            if (sfin) { float* sp = sfin + (size_t)(wave * 16) * 128 + lane;
#pragma unroll
                for (int i = 0; i < 8; ++i) { sp[(2 * i) * 128] = Sa[i].x; sp[(2 * i + 1) * 128] = Sa[i].y; sp[(2 * i) * 128 + 64] = Sb[i].x; sp[(2 * i + 1) * 128 + 64] = Sb[i].y; } }
          }
        }
        __syncthreads();
    }
    SEAM(4);

    if (IN(5)) for (int rep_ = 0; rep_ < NREP(5); ++rep_) { if (rep_) xcd_barrier(xbar);
        pg8::Gemm g{MIX, WOUT, M, D, D}; pg8::StaticOrder S; S.init(M, D, D, G, bx, MP, SPLIT5);
        pg8::EpiResB<true> E{XB, XB, MP, ALPHA, (pg8::bf16_t*)(ws + WS_PB5)};
        pg8::gemm_phase<pg8::EpiResB<true>, pg8::StaticOrder, true, true>(lds, g, S, E);
        { const int nlast = S.nitems % G, first = nlast > 0 ? nlast : 0, nwg = G - first;
          if (bx >= first) {
              LAS float* scr = (LAS float*)(lds + wave * 16384);
              constexpr int I_G = 32 * 176;
              const int gw2 = (bx - first) * NWAVES + wave, NGW2 = nwg * NWAVES;
              transpose_stream<0>(w_down, FF, D, WDN, gw2, W_DN_SPLIT, NGW2, scr, lane);
          } }
    }
    SEAM(5);

    if (IN(6)) {
        ln_rows_bf16(XB, nullptr, XB, ln1_g, ln1_b, gw, NGW, MP, lane);
        if ((gw & 3) == 0) for (int m = MP + (gw >> 2); m < M; m += (NGW + 3) >> 2)
            ln_row<false, SPLIT5>(x_sample + (size_t)(m - MP) * D, (const bf16*)(ws + WS_PB5) + (size_t)(m - MP) * D, (size_t)MS * D, ALPHA, nullptr, XB + (size_t)m * D, ln1_g, ln1_b, lane);
    }
    SEAM(6);

    if (IN(7)) for (int rep_ = 0; rep_ < NREP(7); ++rep_) { if (rep_) xcd_barrier(xbar);
        pg8::Gemm g{XB, WGU, M, 2 * FF, D}; pg8::StaticOrder S; S.init(M, 2 * FF, D, G, bx);
        pg8::EpiGateUp E{ACT, FF};
        pg8::gemm_phase<pg8::EpiGateUp, pg8::StaticOrder, true, true>(lds, g, S, E);
        const int nlast = S.nitems % G;
        {
            const int first = nlast > 0 ? nlast : 0, nwg = G - first;
            if (bx >= first) {
                LAS float* scr = (LAS float*)(lds + wave * 16384);
                constexpr int I_DN = 88 * 64;
                const int gw2 = (bx - first) * NWAVES + wave, NGW2 = nwg * NWAVES;
                transpose_stream<0>(w_down, FF, D, WDN, W_DN_SPLIT + gw2, I_DN, NGW2, scr, lane);
            }
        }
    }
    SEAM(7);

    if (IN(8)) {
        pg8::Gemm g{ACT, WDN, M, D, FF}; pg8::StaticOrder S; S.init(M, D, FF, G, bx, MP, SPLIT8);
        pg8::EpiResB<true> E{XB, MIX, MP, ALPHA, (pg8::bf16_t*)(ws + WS_PB8)};
        pg8::gemm_phase<pg8::EpiResB<true>, pg8::StaticOrder, true, true>(lds, g, S, E);
    }
    SEAM(8);

    if (IN(9)) {
        ln_rows_bf16(MIX, out, nullptr, ln2_g, ln2_b, gw, NGW, MP, lane);
        if ((gw & 3) == 0) for (int m = MP + (gw >> 2); m < M; m += (NGW + 3) >> 2)
            ln_row<true, SPLIT8>(XB + (size_t)m * D, (const bf16*)(ws + WS_PB8) + (size_t)(m - MP) * D, (size_t)MS * D, ALPHA, out + (size_t)m * D, nullptr, ln2_g, ln2_b, lane);
    }
    STAMP(10);
#ifdef TS_A
    __syncthreads();
    if (bx == 0 && tid == 0) { asm volatile("s_waitcnt vmcnt(0)" ::: "memory"); out[0] = out[0] + (float)(ts_b - ts_a) * 1e-4f; }
#endif
#undef IN
#undef SEAM
}

#undef x_prompt
#undef x_sample
#undef cache_conv
#undef state_hgrn
#undef w_in
#undef b_in
#undef w_dw
#undef b_dw
#undef cn_g
#undef cn_b
#undef hlb
#undef hg_ng
#undef w_out
#undef ln1_g
#undef ln1_b
#undef w_gate
#undef w_up
#undef w_down
#undef ln2_g
#undef ln2_b
#undef out
#undef ws
#undef LB
#undef BIASP
#undef WIN
#undef WOUT
#undef WGU
#undef WDN
#undef XB
#undef MIX
#undef U
#undef Q
#undef F
#undef I
#undef Gt
#undef ACT
#undef ST
#undef DC

extern "C" void kernel_launch(void* const* d_in, const int* in_sizes, int n_in, void* d_out, int out_size, void* d_ws, size_t ws_size, hipStream_t stream) {
    static int grid = 0;
    if (grid == 0) {
        int dev = 0, cus = 0, per_cu = 0;
        if (n_in != 20 || ws_size < WS_END) { fprintf(stderr, "kernel_launch: unexpected n_in %d / ws_size %zu\n", n_in, ws_size); grid = -1; return; }
        if (hipGetDevice(&dev) != hipSuccess || hipDeviceGetAttribute(&cus, hipDeviceAttributeMultiprocessorCount, dev) != hipSuccess) { grid = -1; return; }
        if (hipFuncSetAttribute((const void*)fwd_kernel, hipFuncAttributeMaxDynamicSharedMemorySize, LDS_BYTES) != hipSuccess) { fprintf(stderr, "kernel_launch: hipFuncSetAttribute failed\n"); grid = -1; return; }
        if (hipOccupancyMaxActiveBlocksPerMultiprocessor(&per_cu, (const void*)fwd_kernel, NWAVES * 64, LDS_BYTES) != hipSuccess || per_cu < 1) { fprintf(stderr, "kernel_launch: occupancy query says %d\n", per_cu); }
        (void)hipGetLastError();
        grid = cus;
    }
    if (grid < 0) return;
    if (hipMemsetAsync(d_ws, 0, 16384, stream) != hipSuccess) { fprintf(stderr, "kernel_launch: memset failed\n"); return; }
    Args a{};
    for (int i = 0; i < 20; ++i) a.in[i] = (const float*)d_in[i];
    a.out = (float*)d_out; a.ws = (unsigned char*)d_ws;
#if MK_ONE_LAUNCH
    a.ph_lo = 0; a.ph_hi = N_PHASES;
    void* kargs[] = {&a};
    hipError_t e = hipLaunchCooperativeKernel((const void*)fwd_kernel, dim3(grid), dim3(NWAVES * 64), kargs, LDS_BYTES, stream);
    if (e != hipSuccess) fprintf(stderr, "cooperative launch failed: %s (grid %d)\n", hipGetErrorString(e), grid);
#else
    for (int p = 0; p < N_PHASES; ++p) {
        a.ph_lo = p; a.ph_hi = p + 1;
        hipLaunchKernelGGL(fwd_kernel, dim3(grid), dim3(NWAVES * 64), LDS_BYTES, stream, a);
    }
#endif
}
```

```cpp
#include <hip/hip_runtime.h>
#include <hip/hip_cooperative_groups.h>
#include <cstdio>
#include <cstdint>
namespace cg = cooperative_groups;

#ifndef MK_ONE_LAUNCH
#define MK_ONE_LAUNCH 1
#endif

namespace pg8 {
#define PG8_LAS __attribute__((address_space(3)))
typedef unsigned short bf16_t;
typedef short bf16x8 __attribute__((ext_vector_type(8)));
typedef float f32x4 __attribute__((ext_vector_type(4)));
typedef unsigned u32x4 __attribute__((ext_vector_type(4)));
typedef unsigned u32x2 __attribute__((ext_vector_type(2)));
constexpr int BM = 256, BK = 64, HALF = 128, HTB = HALF * BK * 2, STAGE_BYTES = 8 * HTB, NXCD = 8, WGM = 8;

__host__ __device__ __forceinline__ int lds_byte(int r, int c) { const int st = (r >> 4) * 2 + (c >> 5), rr = r & 15, cc = c & 31, ob = rr * 64 + cc * 2; return st * 1024 + (ob ^ (((ob >> 9) & 1) << 5)); }
__host__ __device__ __forceinline__ void stage_rc(int b, int& R, int& C) { const int st = b / 1024, sb = b % 1024, swz = sb ^ (((sb >> 9) & 1) << 5); R = (st >> 1) * 16 + swz / 64; C = (st & 1) * 32 + (swz % 64) / 2; }
__host__ __device__ __forceinline__ int perm32(int rho) { const int n = rho >> 4, i = rho & 15; return 8 * (i >> 2) + 4 * n + (i & 3); }

struct Unit { int pm, pn, kt0, nkt, ks; };
struct Gemm { const bf16_t* A; const bf16_t* Bt; int M, N, K; };

struct StaticOrder {
    int nM, nMf, nN, nfull, nitems, G, c, nt, nsplit;
    __host__ __device__ void init(int M, int N, int K, int G_, int c_, int Mfull = -1, int nsplit_ = 1) {
        nM = M / BM; nMf = Mfull < 0 ? nM : Mfull / BM; nN = N / BM; nt = K / BK; nsplit = nsplit_; nfull = nMf * nN; nitems = nfull + (nM - nMf) * nN * nsplit; G = G_; c = c_; }
    __host__ __device__ bool next(int i, Unit& u) const {
        const long L = (long)i * G + c; if (L >= nitems) return false;
        if (L >= nfull) { const int sidx = (int)L - nfull, un = sidx / nsplit, ks = sidx % nsplit, per = nt / nsplit;
            u.pm = nMf + un / nN; u.pn = un % nN; u.kt0 = ks * per; u.nkt = per; u.ks = ks; return true; }
        int wgid = (int)L; { const int q = nfull / NXCD, r = nfull % NXCD, xcd = wgid % NXCD, off = wgid / NXCD; wgid = (xcd < r ? xcd * (q + 1) : r * (q + 1) + (xcd - r) * q) + off; }
        const int nig = WGM * nN, gid = wgid / nig, fm = gid * WGM, gsz = (nMf - fm) < WGM ? (nMf - fm) : WGM;
        u.pm = fm + ((wgid % nig) % gsz); u.pn = (wgid % nig) / gsz; u.kt0 = 0; u.nkt = nt; u.ks = -1; return true;
    }
    __device__ __forceinline__ void a_ready(const Unit&) const {}
    __device__ __forceinline__ void done(const Unit&) const {}
};

__device__ __forceinline__ unsigned cvt_pk_bf16(float lo, float hi) { unsigned r; asm volatile("v_cvt_pk_bf16_f32 %0, %1, %2" : "=v"(r) : "v"(lo), "v"(hi)); return r; }
__device__ __forceinline__ float sigm(float x) { return __builtin_amdgcn_rcpf(1.0f + __expf(-x)); }

struct EpiProj {
    static constexpr bool PERM = true, AFTER_DRAIN = false;
    bf16_t *U, *QIG; float* F; const float* bias; const float* lb;
    __device__ __forceinline__ void operator()(const f32x4 (&acc)[2][2][4][2], const Unit& u, int wr, int wc, int fr, int fq) const {
        const int row0 = u.pm * BM + wr * 64 + fr;
        const int cl = wc * 32 + 8 * fq;
        const int bcol = u.pn * BM + cl;
        f32x4 bv[2][2];
#pragma unroll
        for (int bj = 0; bj < 2; ++bj)
#pragma unroll
            for (int n = 0; n < 2; ++n) bv[bj][n] = *(const f32x4*)(bias + bcol + bj * HALF + 4 * n);
        if (u.pn < 8) {
#pragma unroll
            for (int ai = 0; ai < 2; ++ai)
#pragma unroll
                for (int m = 0; m < 4; ++m) {
                    const size_t row = (size_t)(row0 + ai * HALF + m * 16);
                    float o[8];
#pragma unroll
                    for (int n = 0; n < 2; ++n) { const f32x4 a = acc[ai][0][m][n] + bv[0][n], g = acc[ai][1][m][n] + bv[1][n];
#pragma unroll
                        for (int e = 0; e < 4; ++e) o[n * 4 + e] = a[e] * sigm(g[e]); }
                    u32x4 w; w.x = cvt_pk_bf16(o[0], o[1]); w.y = cvt_pk_bf16(o[2], o[3]); w.z = cvt_pk_bf16(o[4], o[5]); w.w = cvt_pk_bf16(o[6], o[7]);
                    *(u32x4*)(U + row * 1024 + u.pn * HALF + cl) = w;
                }
        } else {
            const int grp = (u.pn - 8) >> 2;
            const int cbase = ((u.pn - 8) & 3) * BM + cl;
            if (grp == 1) {
                f32x4 lv[2][2];
#pragma unroll
                for (int bj = 0; bj < 2; ++bj)
#pragma unroll
                    for (int n = 0; n < 2; ++n) lv[bj][n] = *(const f32x4*)(lb + cbase + bj * HALF + 4 * n);
#pragma unroll
                for (int ai = 0; ai < 2; ++ai)
#pragma unroll
                    for (int m = 0; m < 4; ++m) {
                        const size_t row = (size_t)(row0 + ai * HALF + m * 16);
#pragma unroll
                        for (int bj = 0; bj < 2; ++bj)
#pragma unroll
                            for (int n = 0; n < 2; ++n) { const f32x4 x = acc[ai][bj][m][n] + bv[bj][n]; const f32x4 l = lv[bj][n]; f32x4 o;
#pragma unroll
                                for (int e = 0; e < 4; ++e) o[e] = l[e] + (1.0f - l[e]) * sigm(x[e]);
                                *(f32x4*)(F + row * 1024 + cbase + bj * HALF + 4 * n) = o; }
                    }
            } else {
                bf16_t* O = QIG + (size_t)(grp - (grp > 0 ? 1 : 0)) * ((size_t)8704 * 1024);
                const bool act = grp != 2;
#pragma unroll
                for (int ai = 0; ai < 2; ++ai)
#pragma unroll
                    for (int m = 0; m < 4; ++m) {
                        const size_t row = (size_t)(row0 + ai * HALF + m * 16);
#pragma unroll
                        for (int bj = 0; bj < 2; ++bj) { float o[8];
#pragma unroll
                            for (int n = 0; n < 2; ++n) { const f32x4 x = acc[ai][bj][m][n] + bv[bj][n];
#pragma unroll
                                for (int e = 0; e < 4; ++e) o[n * 4 + e] = act ? x[e] * sigm(x[e]) : x[e]; }
                            u32x4 w; w.x = cvt_pk_bf16(o[0], o[1]); w.y = cvt_pk_bf16(o[2], o[3]); w.z = cvt_pk_bf16(o[4], o[5]); w.w = cvt_pk_bf16(o[6], o[7]);
                            *(u32x4*)(O + row * 1024 + cbase + bj * HALF) = w; }
                    }
            }
        }
    }
};
struct EpiRes {
    static constexpr bool PERM = false, AFTER_DRAIN = false;
    const float* baseP; const float* baseS; float* out; int split; float alpha; float* part;
    __device__ __forceinline__ void operator()(const f32x4 (&acc)[2][2][4][2], const Unit& u, int wr, int wc, int fr, int fq) const {
        const int row0 = u.pm * BM + wr * 64 + fr;
        const int col0 = u.pn * BM + wc * 32 + 4 * fq;
        if (u.ks >= 0) {
            float* pb = part + (size_t)u.ks * 512 * 2048;
#pragma unroll
            for (int ai = 0; ai < 2; ++ai)
#pragma unroll
                for (int m = 0; m < 4; ++m) { float* op = pb + (size_t)(row0 + ai * HALF + m * 16 - split) * 2048;
#pragma unroll
                    for (int bj = 0; bj < 2; ++bj)
#pragma unroll
                        for (int n = 0; n < 2; ++n) *(f32x4*)(op + col0 + bj * HALF + n * 16) = acc[ai][bj][m][n]; }
            return;
        }
#pragma unroll
        for (int ai = 0; ai < 2; ++ai)
#pragma unroll
            for (int m = 0; m < 4; ++m) {
                const int row = row0 + ai * HALF + m * 16;
                const float* bp = row < split ? baseP + (size_t)row * 2048 : baseS + (size_t)(row - split) * 2048;
                float* op = out + (size_t)row * 2048;
#pragma unroll
                for (int bj = 0; bj < 2; ++bj)
#pragma unroll
                    for (int n = 0; n < 2; ++n) { const int c = col0 + bj * HALF + n * 16; const f32x4 b = *(const f32x4*)(bp + c); *(f32x4*)(op + c) = b * alpha + acc[ai][bj][m][n]; }
            }
    }
};
template <bool BASE_BF16> struct EpiResB {
    static constexpr bool PERM = true, AFTER_DRAIN = false;
    const void* base; bf16_t* out; int split; float alpha; bf16_t* part;
    __device__ __forceinline__ void operator()(const f32x4 (&acc)[2][2][4][2], const Unit& u, int wr, int wc, int fr, int fq) const {
        const int row0 = u.pm * BM + wr * 64 + fr;
        const int col0 = u.pn * BM + wc * 32 + 8 * fq;
        if (u.ks >= 0) {
            bf16_t* pb = part + (size_t)u.ks * 512 * 2048;
#pragma unroll
            for (int ai = 0; ai < 2; ++ai)
#pragma unroll
                for (int m = 0; m < 4; ++m) { bf16_t* op = pb + (size_t)(row0 + ai * HALF + m * 16 - split) * 2048;
#pragma unroll
                    for (int bj = 0; bj < 2; ++bj) { const f32x4 v0 = acc[ai][bj][m][0], v1 = acc[ai][bj][m][1];
                        u32x4 w; w.x = cvt_pk_bf16(v0[0], v0[1]); w.y = cvt_pk_bf16(v0[2], v0[3]); w.z = cvt_pk_bf16(v1[0], v1[1]); w.w = cvt_pk_bf16(v1[2], v1[3]);
                        *(u32x4*)(op + col0 + bj * HALF) = w; } }
            return;
        }
#pragma unroll
        for (int ai = 0; ai < 2; ++ai)
#pragma unroll
            for (int m = 0; m < 4; ++m) {
                const size_t row = (size_t)(row0 + ai * HALF + m * 16);
#pragma unroll
                for (int bj = 0; bj < 2; ++bj) { const int c = col0 + bj * HALF; f32x4 b0, b1;
                    if constexpr (BASE_BF16) { const u32x4 w = *(const u32x4*)((const bf16_t*)base + row * 2048 + c);
                        b0 = (f32x4){__uint_as_float(w.x << 16), __uint_as_float(w.x & 0xffff0000u), __uint_as_float(w.y << 16), __uint_as_float(w.y & 0xffff0000u)};
                        b1 = (f32x4){__uint_as_float(w.z << 16), __uint_as_float(w.z & 0xffff0000u), __uint_as_float(w.w << 16), __uint_as_float(w.w & 0xffff0000u)}; }
                    else { const float* bp = (const float*)base + row * 2048 + c; b0 = *(const f32x4*)bp; b1 = *(const f32x4*)(bp + 4); }
                    const f32x4 v0 = b0 * alpha + acc[ai][bj][m][0], v1 = b1 * alpha + acc[ai][bj][m][1];
                    u32x4 w; w.x = cvt_pk_bf16(v0[0], v0[1]); w.y = cvt_pk_bf16(v0[2], v0[3]); w.z = cvt_pk_bf16(v1[0], v1[1]); w.w = cvt_pk_bf16(v1[2], v1[3]);
                    *(u32x4*)(out + row * 2048 + c) = w; }
            }
    }
};
struct EpiGateUp {
    static constexpr bool PERM = true, AFTER_DRAIN = false;
    bf16_t* O; int ldc;
    __device__ __forceinline__ void operator()(const f32x4 (&acc)[2][2][4][2], const Unit& u, int wr, int wc, int fr, int fq) const {
        const int row0 = u.pm * BM + wr * 64 + fr;
        const int cl = wc * 32 + 8 * fq;
#pragma unroll
        for (int ai = 0; ai < 2; ++ai)
#pragma unroll
            for (int m = 0; m < 4; ++m) {
                const size_t row = (size_t)(row0 + ai * HALF + m * 16);
                float o[8];
#pragma unroll
                for (int n = 0; n < 2; ++n) { const f32x4 g = acc[ai][0][m][n], up = acc[ai][1][m][n];
#pragma unroll
                    for (int e = 0; e < 4; ++e) o[n * 4 + e] = g[e] * sigm(g[e]) * up[e]; }
                u32x4 w; w.x = cvt_pk_bf16(o[0], o[1]); w.y = cvt_pk_bf16(o[2], o[3]); w.z = cvt_pk_bf16(o[4], o[5]); w.w = cvt_pk_bf16(o[6], o[7]);
                *(u32x4*)(O + row * ldc + u.pn * HALF + cl) = w;
            }
    }
};

template <class Epi, class Sched, bool ALIGN_EPI = false, bool SP2 = false>
__device__ __forceinline__ void gemm_phase(PG8_LAS unsigned char* lds, const Gemm g, const Sched& S, const Epi& E) {
    int tid_ = threadIdx.x; asm volatile("" : "+v"(tid_));
    const int tid = tid_, wid = __builtin_amdgcn_readfirstlane(tid >> 6), lane = tid & 63, wr = wid >> 2, wc = wid & 3, fr = lane & 15, fq = lane >> 4;
    const int K = g.K;
    unsigned voffA[2], voffB[2];
#pragma unroll
    for (int i = 0; i < 2; ++i) { int R, C; stage_rc(tid * 16 + i * 8192, R, C); const int Rb = Epi::PERM ? ((R & ~31) + perm32(R & 31)) : R;
        voffA[i] = (unsigned)(R * K + C) * 2u; voffB[i] = (unsigned)(Rb * K + C) * 2u; }
    const size_t kstep = (size_t)(BK * 2);
    const size_t hstep = (size_t)HALF * K * 2;
    const size_t tstep = 2 * hstep;
    const unsigned ldsw = (unsigned)wid * 1024u;
    const int aoff = lds_byte(wr * 64 + fr, fq * 8), boff = lds_byte(wc * 32 + fr, fq * 8);
#define PG8_SA(b, h) (((b) * 2 + (h)) * HTB)
#define PG8_SB(b, h) ((4 + (b) * 2 + (h)) * HTB)
#define PG8_STAGE(bufoff, gbase, voff) do { _Pragma("unroll") for (int _i = 0; _i < 2; ++_i) \
        __builtin_amdgcn_global_load_lds((const unsigned*)((const char*)(gbase) + (voff)[_i]), (PG8_LAS unsigned*)(lds + (bufoff) + ldsw + _i * 8192), 16, 0, 0); } while (0)
#define PG8_LDA(dst, b, h) do { _Pragma("unroll") for (int m = 0; m < 4; ++m) _Pragma("unroll") for (int k = 0; k < 2; ++k) dst[m][k] = *(const PG8_LAS bf16x8*)(lds + PG8_SA(b, h) + aoff + m * 2048 + k * 1024); } while (0)
#define PG8_LDB(dst, b, h) do { _Pragma("unroll") for (int n = 0; n < 2; ++n) _Pragma("unroll") for (int k = 0; k < 2; ++k) dst[n][k] = *(const PG8_LAS bf16x8*)(lds + PG8_SB(b, h) + boff + n * 2048 + k * 1024); } while (0)
#define PG8_MMA(ai, bj, At, Bt) do { __builtin_amdgcn_s_setprio(1); _Pragma("unroll") for (int m = 0; m < 4; ++m) _Pragma("unroll") for (int n = 0; n < 2; ++n) _Pragma("unroll") for (int k = 0; k < 2; ++k) \
        acc[ai][bj][m][n] = __builtin_amdgcn_mfma_f32_16x16x32_bf16(Bt[n][k], At[m][k], acc[ai][bj][m][n], 0, 0, 0); __builtin_amdgcn_s_setprio(0); } while (0)
#define PG8_WAIT_V(n) asm volatile("s_waitcnt vmcnt(" #n ")" ::: "memory")
#define PG8_WAIT_L(n) asm volatile("s_waitcnt lgkmcnt(" #n ")" ::: "memory")
#define PG8_BAR __builtin_amdgcn_s_barrier()
#define PG8_SCHED __builtin_amdgcn_sched_barrier(0)
    Unit cur, nxt; int ui = 0;
    if (!S.next(0, cur)) return;
    f32x4 acc[2][2][4][2];
#pragma unroll
    for (int a = 0; a < 2; ++a)
#pragma unroll
        for (int b = 0; b < 2; ++b)
#pragma unroll
            for (int m = 0; m < 4; ++m)
#pragma unroll
                for (int n = 0; n < 2; ++n) acc[a][b][m][n] = (f32x4){0.f, 0.f, 0.f, 0.f};
    bf16x8 At[4][2], B0[2][2], B1[2][2];
    const char* cA = (const char*)g.A + (size_t)cur.pm * tstep + (size_t)cur.kt0 * kstep; const char* cB = (const char*)g.Bt + (size_t)cur.pn * tstep + (size_t)cur.kt0 * kstep;
    S.a_ready(cur);
    if constexpr (SP2) {
        PG8_STAGE(PG8_SB(0, 0), cB, voffB); PG8_STAGE(PG8_SB(0, 1), cB + hstep, voffB); PG8_STAGE(PG8_SA(0, 0), cA, voffA); PG8_STAGE(PG8_SA(0, 1), cA + hstep, voffA);
        if (wr == 1) PG8_BAR;
        PG8_WAIT_V(2); PG8_BAR;
        PG8_STAGE(PG8_SB(1, 0), cB + kstep, voffB); PG8_STAGE(PG8_SA(1, 0), cA + kstep, voffA); PG8_STAGE(PG8_SB(1, 1), cB + hstep + kstep, voffB);
        PG8_WAIT_V(6); PG8_BAR;
    } else {
        PG8_STAGE(PG8_SB(0, 0), cB, voffB); PG8_STAGE(PG8_SA(0, 0), cA, voffA); PG8_STAGE(PG8_SB(0, 1), cB + hstep, voffB); PG8_STAGE(PG8_SA(0, 1), cA + hstep, voffA);
        if (wr == 1) PG8_BAR;
        PG8_WAIT_V(4); PG8_BAR;
        PG8_STAGE(PG8_SB(1, 0), cB + kstep, voffB); PG8_STAGE(PG8_SA(1, 0), cA + kstep, voffA); PG8_STAGE(PG8_SB(1, 1), cB + hstep + kstep, voffB);
        PG8_WAIT_V(6); PG8_BAR;
    }
    for (;;) {
        const bool has_next = S.next(ui + 1, nxt);
        const char* nA = has_next ? (const char*)g.A + (size_t)nxt.pm * tstep + (size_t)nxt.kt0 * kstep : cA; const char* nB = has_next ? (const char*)g.Bt + (size_t)nxt.pn * tstep + (size_t)nxt.kt0 * kstep : cB;
        const int nt = cur.nkt;
        for (int t = 0; t < nt; t += 2) {
            const bool last = (t == nt - 2);
            const char* a1 = cA + (size_t)(t + 1) * kstep;
            const char* a2 = last ? nA : cA + (size_t)(t + 2) * kstep; const char* b2 = last ? nB : cB + (size_t)(t + 2) * kstep;
            const char* a3 = a2 + kstep; const char* b3 = b2 + kstep;
            if (last && has_next) S.a_ready(nxt);
            if constexpr (SP2) {
            PG8_LDB(B0, 0, 0); PG8_LDB(B1, 0, 1); PG8_SCHED; PG8_LDA(At, 0, 0); PG8_STAGE(PG8_SA(1, 1), a1 + hstep, voffA);
            PG8_WAIT_V(8); PG8_WAIT_L(0); PG8_BAR; PG8_MMA(0, 0, At, B0); PG8_MMA(0, 1, At, B1); PG8_BAR; PG8_SCHED;
            PG8_LDA(At, 0, 1); PG8_STAGE(PG8_SB(0, 0), b2, voffB); PG8_STAGE(PG8_SB(0, 1), b2 + hstep, voffB); PG8_STAGE(PG8_SA(0, 0), a2, voffA);
            PG8_WAIT_V(8); PG8_WAIT_L(0); PG8_BAR; PG8_MMA(1, 0, At, B0); PG8_MMA(1, 1, At, B1); PG8_BAR; PG8_SCHED;
            PG8_LDB(B0, 1, 0); PG8_LDB(B1, 1, 1); PG8_SCHED; PG8_LDA(At, 1, 0); PG8_STAGE(PG8_SA(0, 1), a2 + hstep, voffA);
            PG8_WAIT_V(8); PG8_WAIT_L(0); PG8_BAR; PG8_MMA(0, 0, At, B0); PG8_MMA(0, 1, At, B1); PG8_BAR; PG8_SCHED;
            PG8_LDA(At, 1, 1); PG8_STAGE(PG8_SB(1, 0), b3, voffB); PG8_STAGE(PG8_SB(1, 1), b3 + hstep, voffB); PG8_STAGE(PG8_SA(1, 0), a3, voffA);
            PG8_WAIT_V(8); PG8_WAIT_L(0); PG8_BAR; PG8_MMA(1, 0, At, B0); PG8_MMA(1, 1, At, B1); PG8_BAR; PG8_SCHED;
            } else {
            PG8_LDB(B0, 0, 0); PG8_SCHED; PG8_LDA(At, 0, 0); PG8_STAGE(PG8_SA(1, 1), a1 + hstep, voffA);
            PG8_WAIT_L(8); PG8_BAR; PG8_WAIT_L(0); PG8_MMA(0, 0, At, B0); PG8_BAR; PG8_SCHED;
            PG8_LDB(B1, 0, 1); PG8_STAGE(PG8_SB(0, 0), b2, voffB);
            PG8_BAR; PG8_WAIT_L(0); PG8_MMA(0, 1, At, B1); PG8_BAR;
            PG8_LDA(At, 0, 1); PG8_STAGE(PG8_SA(0, 0), a2, voffA);
            PG8_BAR; PG8_WAIT_L(0); PG8_MMA(1, 0, At, B0); PG8_BAR; PG8_SCHED;
            PG8_STAGE(PG8_SB(0, 1), b2 + hstep, voffB);
            PG8_WAIT_V(6); PG8_BAR; PG8_MMA(1, 1, At, B1); PG8_BAR;
            PG8_LDB(B0, 1, 0); PG8_SCHED; PG8_LDA(At, 1, 0); PG8_STAGE(PG8_SA(0, 1), a2 + hstep, voffA);
            PG8_WAIT_L(8); PG8_BAR; PG8_WAIT_L(0); PG8_MMA(0, 0, At, B0); PG8_BAR; PG8_SCHED;
            PG8_LDB(B1, 1, 1); PG8_STAGE(PG8_SB(1, 0), b3, voffB);
            PG8_BAR; PG8_WAIT_L(0); PG8_MMA(0, 1, At, B1); PG8_BAR;
            PG8_LDA(At, 1, 1); PG8_STAGE(PG8_SA(1, 0), a3, voffA);
            PG8_BAR; PG8_WAIT_L(0); PG8_MMA(1, 0, At, B0); PG8_BAR; PG8_SCHED;
            PG8_STAGE(PG8_SB(1, 1), b3 + hstep, voffB);
            PG8_WAIT_V(6); PG8_BAR; PG8_MMA(1, 1, At, B1); PG8_BAR;
            }
        }
        if constexpr (ALIGN_EPI) { if (wr == 0) PG8_BAR; }
        if constexpr (!Epi::AFTER_DRAIN) { E(acc, cur, wr, wc, fr, fq); S.done(cur); }
        if (!has_next) break;
#pragma unroll
        for (int a = 0; a < 2; ++a)
#pragma unroll
            for (int b = 0; b < 2; ++b)
#pragma unroll
                for (int m = 0; m < 4; ++m)
#pragma unroll
                    for (int n = 0; n < 2; ++n) acc[a][b][m][n] = (f32x4){0.f, 0.f, 0.f, 0.f};
        cur = nxt; cA = nA; cB = nB; ++ui;
        if constexpr (ALIGN_EPI) { if (wr == 1) PG8_BAR; }
    }
    PG8_WAIT_V(0);
    if constexpr (!ALIGN_EPI) { if (wr == 0) PG8_BAR; }
    PG8_BAR;
#undef PG8_SA
#undef PG8_SB
#undef PG8_STAGE
#undef PG8_LDA
#undef PG8_LDB
#undef PG8_MMA
#undef PG8_WAIT_V
#undef PG8_WAIT_L
#undef PG8_BAR
#undef PG8_SCHED
}
}

constexpr int D = 2048, MP = 8192, MS = 512, M = MP + MS, CW = 1024, NH = 8, HD = 128, FF = 5632, NIN = 6144;
constexpr float LN_EPS = 1e-5f;
constexpr float ALPHA = 1.189207115002721f;
constexpr int NWAVES = 8;
constexpr int LDS_BYTES = 147456;
constexpr int N_PHASES = 10;

constexpr size_t MiB = 1u << 20;
constexpr size_t WS_LB = 64 * 1024, WS_BIASP = 128 * 1024;
constexpr size_t WS_WIN = 1 * MiB, WS_WOUT = 25 * MiB, WS_WGU = 33 * MiB, WS_WDN = 77 * MiB;
constexpr size_t WS_XB = 99 * MiB, WS_MIX = 133 * MiB;
constexpr size_t WS_U = 167 * MiB, WS_Q = 184 * MiB, WS_I = 201 * MiB, WS_G = 218 * MiB, WS_F = 235 * MiB, WS_END = 269 * MiB;
constexpr size_t WS_ACT = 167 * MiB;
constexpr int SPLIT5 = 4, SPLIT8 = 11;
constexpr int W_DN_SPLIT = 44 * 64;
constexpr size_t WS_PB5 = 167 * MiB;
constexpr size_t WS_PB8 = 33 * MiB;
static_assert(WS_PB8 + (size_t)SPLIT8 * 512 * 2048 * 4 <= 77 * MiB && (32 % SPLIT5) == 0 && (88 % SPLIT8) == 0 && (32 / SPLIT5) % 2 == 0 && (88 / SPLIT8) % 2 == 0 && 32 / SPLIT5 >= 4 && 88 / SPLIT8 >= 4, "split-K layout");
static_assert(WS_ACT + (size_t)M * FF * 2 <= WS_END, "act overlay");
constexpr size_t O_Y = 0, O_NCP = (size_t)M * D, O_NHP = O_NCP + 4 * 30 * 1024, O_NCS = O_NHP + 4 * 8 * 128 * 128, O_NHS = O_NCS + 32 * 30 * 1024;
constexpr size_t O_ST = 0, O_DC = (size_t)1024 * 16384;

#define LAS __attribute__((address_space(3)))
typedef unsigned short bf16;
typedef float f32x4 __attribute__((ext_vector_type(4)));
typedef float f32x2 __attribute__((ext_vector_type(2)));
typedef unsigned v4u __attribute__((ext_vector_type(4)));
typedef unsigned v2u __attribute__((ext_vector_type(2)));
typedef float f32x16 __attribute__((ext_vector_type(16)));
typedef unsigned u32x8 __attribute__((ext_vector_type(8)));
#define CAS __attribute__((address_space(4)))
#define LDS_WAIT() asm volatile("s_waitcnt lgkmcnt(0)" ::: "memory")

__device__ __forceinline__ unsigned f2bf(float f) { unsigned u = __builtin_bit_cast(unsigned, f); return (u + 0x7fffu + ((u >> 16) & 1u)) >> 16; }
__device__ __forceinline__ unsigned pk2(float lo, float hi) { return f2bf(lo) | (f2bf(hi) << 16); }
__device__ __forceinline__ bf16 bfr(float x) { return (bf16)(pg8::cvt_pk_bf16(x, 0.f) & 0xffffu); }
__device__ __forceinline__ float bf2f(unsigned short b) { return __uint_as_float((unsigned)b << 16); }
__device__ __forceinline__ float sigm(float x) { return __builtin_amdgcn_rcpf(1.0f + __expf(-x)); }
__device__ __forceinline__ float wave_sum(float v) {
#pragma unroll
    for (int o = 1; o < 64; o <<= 1) v += __shfl_xor(v, o);
    return v;
}

__device__ __forceinline__ void transpose_item(const float* W, int K, int N, bf16* WT, int k0, int n0, int dst_row0, LAS float* scr, int lane) {
    { f32x4 v[8];
      const int kq = lane >> 3, n4 = (lane & 7) * 4;
#pragma unroll
      for (int i = 0; i < 8; ++i) v[i] = *(const f32x4*)(W + (size_t)(k0 + 8 * i + kq) * N + n0 + n4);
#pragma unroll
      for (int i = 0; i < 8; ++i) { LAS float* d = scr + (8 * i + kq) * 33 + n4; d[0] = v[i].x; d[1] = v[i].y; d[2] = v[i].z; d[3] = v[i].w; } }
    LDS_WAIT(); asm volatile("" ::: "memory");
    const int c = lane & 7;
#pragma unroll
    for (int j = 0; j < 4; ++j) { const int n = (lane >> 3) + 8 * j; const LAS float* s = scr + (8 * c) * 33 + n;
        v4u o; o.x = pk2(s[0 * 33], s[1 * 33]); o.y = pk2(s[2 * 33], s[3 * 33]); o.z = pk2(s[4 * 33], s[5 * 33]); o.w = pk2(s[6 * 33], s[7 * 33]);
        *(v4u*)(WT + (size_t)(dst_row0 + n) * K + k0 + 8 * c) = o; }
    LDS_WAIT(); asm volatile("" ::: "memory");
}

template <int KIND> __device__ __forceinline__ void transpose_stream(const float* W, int K, int N, bf16* WT, int first, int end, int stride, LAS float* scr, int lane) {
    const int nblk = N / 32, kq = lane >> 3, n4 = (lane & 7) * 4, c = lane & 7;
    f32x4 v[8];
    if (first < end) { const int kb = first / nblk, nb = first % nblk;
#pragma unroll
        for (int i = 0; i < 8; ++i) v[i] = __builtin_nontemporal_load((const f32x4*)(W + (size_t)(64 * kb + 8 * i + kq) * N + 32 * nb + n4)); }
    for (int it = first; it < end; it += stride) {
        const int kb = it / nblk, nb = it % nblk, k0 = 64 * kb, n0 = 32 * nb;
        int dst;
        if (KIND == 1) dst = n0 < 2048 ? ((n0 & 1023) >> 7) * 256 + (n0 >> 10) * 128 + (n0 & 127) : n0;
        else if (KIND == 2) dst = (n0 >> 7) * 256 + (n0 & 127);
        else if (KIND == 3) dst = (n0 >> 7) * 256 + 128 + (n0 & 127);
        else dst = n0;
#pragma unroll
        for (int i = 0; i < 8; ++i) { LAS float* d = scr + (8 * i + kq) * 33 + n4; d[0] = v[i].x; d[1] = v[i].y; d[2] = v[i].z; d[3] = v[i].w; }
        { const int nx = it + stride;
          if (nx < end) { const int kb2 = nx / nblk, nb2 = nx % nblk;
#pragma unroll
              for (int i = 0; i < 8; ++i) v[i] = __builtin_nontemporal_load((const f32x4*)(W + (size_t)(64 * kb2 + 8 * i + kq) * N + 32 * nb2 + n4)); } }
        LDS_WAIT(); asm volatile("" ::: "memory");
#pragma unroll
        for (int j = 0; j < 4; ++j) { const int n = (lane >> 3) + 8 * j; const LAS float* sp = scr + (8 * c) * 33 + n;
            v4u o; o.x = pg8::cvt_pk_bf16(sp[0 * 33], sp[1 * 33]); o.y = pg8::cvt_pk_bf16(sp[2 * 33], sp[3 * 33]); o.z = pg8::cvt_pk_bf16(sp[4 * 33], sp[5 * 33]); o.w = pg8::cvt_pk_bf16(sp[6 * 33], sp[7 * 33]);
            *(v4u*)(WT + (size_t)(dst + n) * K + k0 + 8 * c) = o; }
        LDS_WAIT(); asm volatile("" ::: "memory");
    }
}

template <bool SRC_BF16, int NP> __device__ __forceinline__ void ln_row(const void* src, const bf16* part, size_t pstride, float alpha, float* dstf, bf16* dstb, const float* g, const float* b, int lane) {
    f32x4 v[8]; float s = 0.f;
    if constexpr (SRC_BF16) {
#pragma unroll
        for (int j = 0; j < 8; ++j) { const v2u w = ((const v2u*)src)[lane + 64 * j]; v[j] = (f32x4){__uint_as_float(w.x << 16), __uint_as_float(w.x & 0xffff0000u), __uint_as_float(w.y << 16), __uint_as_float(w.y & 0xffff0000u)}; }
    } else {
#pragma unroll
        for (int j = 0; j < 8; ++j) v[j] = ((const f32x4*)src)[lane + 64 * j];
    }
    if constexpr (NP > 0) {
#pragma unroll
        for (int j = 0; j < 8; ++j) v[j] = v[j] * alpha;
#pragma unroll
        for (int p0 = 0; p0 < NP; p0 += 4) {
            v2u w[4][8];
#pragma unroll
            for (int pp = 0; pp < 4; ++pp) if (p0 + pp < NP) { const v2u* pr = (const v2u*)(part + (size_t)(p0 + pp) * pstride) + lane;
#pragma unroll
                for (int j = 0; j < 8; ++j) w[pp][j] = pr[64 * j]; }
#pragma unroll
            for (int pp = 0; pp < 4; ++pp) if (p0 + pp < NP) {
#pragma unroll
                for (int j = 0; j < 8; ++j) v[j] += (f32x4){__uint_as_float(w[pp][j].x << 16), __uint_as_float(w[pp][j].x & 0xffff0000u), __uint_as_float(w[pp][j].y << 16), __uint_as_float(w[pp][j].y & 0xffff0000u)}; }
        }
    }
#pragma unroll
    for (int j = 0; j < 8; ++j) s += (v[j].x + v[j].y) + (v[j].z + v[j].w);
    const float mean = wave_sum(s) * (1.f / D); float s2 = 0.f;
#pragma unroll
    for (int j = 0; j < 8; ++j) { v[j] = v[j] - mean; s2 += (v[j].x * v[j].x + v[j].y * v[j].y) + (v[j].z * v[j].z + v[j].w * v[j].w); }
    const float rstd = 1.f / sqrtf(wave_sum(s2) * (1.f / D) + LN_EPS);
#pragma unroll
    for (int j = 0; j < 8; ++j) {
        const f32x4 gg = ((const f32x4*)g)[lane + 64 * j], bb = ((const f32x4*)b)[lane + 64 * j];
        const f32x4 o = v[j] * rstd * gg + bb;
        if (dstf) ((f32x4*)dstf)[lane + 64 * j] = o;
        if (dstb) { v2u w; w.x = pk2(o.x, o.y); w.y = pk2(o.z, o.w); ((v2u*)dstb)[lane + 64 * j] = w; }
    }
}

__device__ __forceinline__ void ln_core(f32x4 (&v)[8], const f32x4 (&gg)[8], const f32x4 (&bb)[8], float* dstf, bf16* dstb, int lane) {
    float s = 0.f;
#pragma unroll
    for (int j = 0; j < 8; ++j) s += (v[j].x + v[j].y) + (v[j].z + v[j].w);
    const float mean = wave_sum(s) * (1.f / D); float s2 = 0.f;
#pragma unroll
    for (int j = 0; j < 8; ++j) { v[j] = v[j] - mean; s2 += (v[j].x * v[j].x + v[j].y * v[j].y) + (v[j].z * v[j].z + v[j].w * v[j].w); }
    const float rstd = 1.f / sqrtf(wave_sum(s2) * (1.f / D) + LN_EPS);
#pragma unroll
    for (int j = 0; j < 8; ++j) {
        const f32x4 o = v[j] * rstd * gg[j] + bb[j];
        if (dstf) __builtin_nontemporal_store(o, (f32x4*)dstf + lane + 64 * j);
        if (dstb) { v2u w; w.x = pk2(o.x, o.y); w.y = pk2(o.z, o.w); ((v2u*)dstb)[lane + 64 * j] = w; }
    }
}
__device__ __forceinline__ void ln_rows_bf16(const bf16* src, float* dstf, bf16* dstb, const float* g, const float* b, int gw, int NGW, int nrows, int lane) {
    f32x4 gg[8], bb[8];
#pragma unroll
    for (int j = 0; j < 8; ++j) { gg[j] = ((const f32x4*)g)[lane + 64 * j]; bb[j] = ((const f32x4*)b)[lane + 64 * j]; }
    v2u cur[8];
    if (gw < nrows) {
#pragma unroll
        for (int j = 0; j < 8; ++j) cur[j] = ((const v2u*)(src + (size_t)gw * D))[lane + 64 * j];
    }
    for (int m = gw; m < nrows; m += NGW) {
        v2u nxt[8];
        const bool hn = m + NGW < nrows;
        if (hn) {
#pragma unroll
            for (int j = 0; j < 8; ++j) nxt[j] = ((const v2u*)(src + (size_t)(m + NGW) * D))[lane + 64 * j];
        }
        f32x4 v[8];
#pragma unroll
        for (int j = 0; j < 8; ++j) v[j] = (f32x4){__uint_as_float(cur[j].x << 16), __uint_as_float(cur[j].x & 0xffff0000u), __uint_as_float(cur[j].y << 16), __uint_as_float(cur[j].y & 0xffff0000u)};
        ln_core(v, gg, bb, dstf ? dstf + (size_t)m * D : nullptr, dstb ? dstb + (size_t)m * D : nullptr, lane);
        if (hn) {
#pragma unroll
            for (int j = 0; j < 8; ++j) cur[j] = nxt[j];
        }
    }
}

#define XB_TMO      128
#define XB_XCNT(j)  (256  + 64 * (j))
#define XB_XSUB(j)  (1280 + 64 * (j))
#define XB_XGEN(j)  (2304 + 64 * (j))
#define XB_TOP      3328
#define XB_TOPGEN   3392
#define XCD_BAR_WORDS 3456
#define XB_SPIN_CAP (1u << 18)
__device__ __forceinline__ unsigned xb_ld(unsigned* p)              { return __hip_atomic_load(p, __ATOMIC_RELAXED, __HIP_MEMORY_SCOPE_AGENT); }
__device__ __forceinline__ unsigned xb_add(unsigned* p, unsigned v) { return __hip_atomic_fetch_add(p, v, __ATOMIC_RELAXED, __HIP_MEMORY_SCOPE_AGENT); }
__device__ __forceinline__ unsigned xb_xcc_id() { return (unsigned)__builtin_amdgcn_s_getreg((3 << 11) | 20) & 0xFu; }
#define XB_SPIN(cond, bar) do { unsigned _sp = 0; while (cond) { __builtin_amdgcn_s_sleep(1); \
    if ((++_sp & 255u) == 0u) { if (xb_ld(&(bar)[XB_TMO])) break; if (_sp > XB_SPIN_CAP) { atomicAdd(&(bar)[XB_TMO], 1u); break; } } } } while (0)
struct XcdBarrier { unsigned* bar; unsigned x; volatile LAS unsigned* st; };
__device__ __forceinline__ XcdBarrier xcd_barrier_post(unsigned* bar, volatile LAS unsigned* st) {
    XcdBarrier b; b.bar = bar; b.x = xb_xcc_id(); b.st = st;
    if (threadIdx.x == 0) (void)xb_add(&bar[XB_XCNT(b.x)], 1u);
    return b;
}
__device__ __forceinline__ void xcd_barrier_complete(unsigned* bar, unsigned x, unsigned& nloc, unsigned& nx) {
    const unsigned G = gridDim.x * gridDim.y * gridDim.z;
    unsigned sum, cnt, mine, sp = 0u;
    for (;;) {
        sum = 0u; cnt = 0u; mine = 0u;
#pragma unroll
        for (unsigned j = 0; j < 16; ++j) { const unsigned c = xb_ld(&bar[XB_XCNT(j)]); sum += c; cnt += (c > 0u) ? 1u : 0u; mine = (j == x) ? c : mine; }
        if (sum == G) break;
        __builtin_amdgcn_s_sleep(1);
        if ((++sp & 255u) == 0u) { if (xb_ld(&bar[XB_TMO])) break; if (sp > XB_SPIN_CAP) { atomicAdd(&bar[XB_TMO], 1u); break; } }
    }
    nloc = mine > 0u ? mine : 1u; nx = cnt > 0u ? cnt : 1u;
}
__device__ __forceinline__ void xcd_barrier(const XcdBarrier& b) {
    asm volatile("s_waitcnt vmcnt(0)" ::: "memory");
    __syncthreads();
    if (threadIdx.x == 0) {
        unsigned* bar = b.bar;
        __builtin_amdgcn_s_waitcnt(0);
        unsigned nloc = b.st[0], nx = b.st[1];
        if (nloc == 0u) { xcd_barrier_complete(bar, b.x, nloc, nx); b.st[0] = nloc; b.st[1] = nx; }
        const unsigned old = xb_add(&bar[XB_XSUB(b.x)], 1u);
        const unsigned gen = old / nloc;
        if (old + 1u == (gen + 1u) * nloc) {
            __builtin_amdgcn_fence(__ATOMIC_RELEASE, "agent");
            asm volatile("s_waitcnt vmcnt(0)" ::: "memory");
            const unsigned og = xb_add(&bar[XB_TOP], 1u);
            const unsigned tg = og / nx;
            if (og + 1u == (tg + 1u) * nx) xb_add(&bar[XB_TOPGEN], 1u);
            else XB_SPIN(xb_ld(&bar[XB_TOPGEN]) == tg, bar);
            __builtin_amdgcn_fence(__ATOMIC_ACQUIRE, "agent");
            xb_add(&bar[XB_XGEN(b.x)], 1u);
            asm volatile("s_waitcnt vmcnt(0)" ::: "memory");
        } else {
            XB_SPIN(xb_ld(&bar[XB_XGEN(b.x)]) == gen, bar);
            __builtin_amdgcn_fence(__ATOMIC_ACQUIRE, "agent");
            asm volatile("s_waitcnt vmcnt(0)" ::: "memory");
        }
    }
    __syncthreads();
}

struct Args { const float* in[20]; float* out; unsigned char* ws; int ph_lo, ph_hi; };

__global__ void __launch_bounds__(NWAVES * 64, 2) fwd_kernel(Args args) {
    extern __shared__ __attribute__((aligned(16))) unsigned char lds_raw[];
    LAS unsigned char* lds = (LAS unsigned char*)lds_raw;
    const int tid = threadIdx.x, lane = tid & 63, wave = __builtin_amdgcn_readfirstlane(tid >> 6);
    const int G = gridDim.x, bx = blockIdx.x;
    const int gt = bx * 512 + tid, NT = G * 512;
    const int gw = bx * NWAVES + wave, NGW = G * NWAVES;

#define x_prompt (args.in[0])
#define x_sample (args.in[1])
#define cache_conv (args.in[2])
#define state_hgrn (args.in[3])
#define w_in (args.in[4])
#define b_in (args.in[5])
#define w_dw (args.in[6])
#define b_dw (args.in[7])
#define cn_g (args.in[8])
#define cn_b (args.in[9])
#define hlb (args.in[10])
#define hg_ng (args.in[11])
#define w_out (args.in[12])
#define ln1_g (args.in[13])
#define ln1_b (args.in[14])
#define w_gate (args.in[15])
#define w_up (args.in[16])
#define w_down (args.in[17])
#define ln2_g (args.in[18])
#define ln2_b (args.in[19])
#define out (args.out)
#define ws (args.ws)
#define LB ((float*)(ws + WS_LB))
#define BIASP ((float*)(ws + WS_BIASP))
#define WIN ((bf16*)(ws + WS_WIN))
#define WOUT ((bf16*)(ws + WS_WOUT))
#define WGU ((bf16*)(ws + WS_WGU))
#define WDN ((bf16*)(ws + WS_WDN))
#define XB ((bf16*)(ws + WS_XB))
#define MIX ((bf16*)(ws + WS_MIX))
#define U ((bf16*)(ws + WS_U))
#define Q ((bf16*)(ws + WS_Q))
#define F ((float*)(ws + WS_F))
#define I ((bf16*)(ws + WS_I))
#define Gt ((bf16*)(ws + WS_G))
#define ACT ((bf16*)(ws + WS_ACT))
#define ST (out + O_ST)
#define DC (out + O_DC)

    const int lo = args.ph_lo, hi = args.ph_hi;
    volatile LAS unsigned* MISC = (volatile LAS unsigned*)(lds + LDS_BYTES - 64);
    if (tid < 16) MISC[tid] = 0u;
    __syncthreads();
    XcdBarrier xbar = xcd_barrier_post((unsigned*)ws, MISC + 8);
#ifndef PH_MASK
#define PH_MASK 0x3ff
#endif
#define IN(k) (((PH_MASK >> (k)) & 1) && lo <= (k) && (k) < hi)
#ifndef REP_MASK
#define REP_MASK 0
#endif
#define NREP(k) (1 + ((REP_MASK >> (k)) & 1))
#ifdef TS_A
    unsigned long long ts_a = 0, ts_b = 0;
#define STAMP(k) do { if ((k) == TS_A) ts_a = __builtin_amdgcn_s_memrealtime(); if ((k) == TS_B) ts_b = __builtin_amdgcn_s_memrealtime(); } while (0)
#else
#define STAMP(k) do { } while (0)
#endif
#define SEAM(k) do { if (IN(k) && IN((k) + 1)) { xcd_barrier(xbar); } STAMP((k) + 1); } while (0)
    STAMP(0);
    if (hi > 1000) cg::this_grid().sync();

    if (IN(0)) for (int rep_ = 0; rep_ < NREP(0); ++rep_) { if (rep_) xcd_barrier(xbar);
        LAS float* scr = (LAS float*)(lds + wave * 16384);
        constexpr int I_IN = 32 * 192;
        transpose_stream<1>(w_in, D, NIN, WIN, gw, I_IN, NGW, scr, lane);
        constexpr int NV = M * D / 8, NVP = MP * D / 8;
#pragma unroll 4
        for (int i = gt; i < NV; i += NT) {
            const float* src = i < NVP ? x_prompt + (size_t)i * 8 : x_sample + (size_t)(i - NVP) * 8;
            const f32x4 a = __builtin_nontemporal_load((const f32x4*)src), b = __builtin_nontemporal_load((const f32x4*)(src + 4));
            v4u o; o.x = pk2(a.x, a.y); o.y = pk2(a.z, a.w); o.z = pk2(b.x, b.y); o.w = pk2(b.z, b.w);
            *(v4u*)(XB + (size_t)i * 8) = o;
        }
        for (int i = gt; i < 1024; i += NT) LB[i] = sigm(hlb[i] - hlb[1024 + i]);
        for (int i = gt; i < NIN; i += NT) { const int orig = i < 2048 ? ((i & 255) >> 7) * 1024 + (i >> 8) * 128 + (i & 127) : i; BIASP[i] = b_in[orig]; }
    }
    SEAM(0);
#ifdef EXTRA_SYNCS
    for (int i_ = 0; i_ < EXTRA_SYNCS; ++i_) cg::this_grid().sync();
#endif

    if (IN(1)) for (int rep_ = 0; rep_ < NREP(1); ++rep_) { if (rep_) xcd_barrier(xbar);
        pg8::Gemm g{XB, WIN, M, NIN, D}; pg8::StaticOrder S; S.init(M, NIN, D, G, bx);
        pg8::EpiProj E{U, Q, F, BIASP, LB};
        pg8::gemm_phase<pg8::EpiProj, pg8::StaticOrder, true, true>(lds, g, S, E);
        const int nlast = S.nitems % G;
        if (nlast > 0 && bx >= nlast) {
            LAS float* scr = (LAS float*)(lds + wave * 16384);
            constexpr int I_OUT = 32 * 64, I_G = 32 * 176, I_DN = 88 * 64;
            const int gw2 = (bx - nlast) * NWAVES + wave, NGW2 = (G - nlast) * NWAVES;
            transpose_stream<0>(w_out, D, D, WOUT, gw2, I_OUT, NGW2, scr, lane);
            transpose_stream<2>(w_gate, D, FF, WGU, gw2, I_G, NGW2, scr, lane);
            transpose_stream<3>(w_up, D, FF, WGU, gw2, I_G, NGW2, scr, lane);
        }
    }
    SEAM(1);

    if (IN(2)) for (int rep_ = 0; rep_ < NREP(2); ++rep_) { if (rep_) xcd_barrier(xbar);
#define LBAR2() do { asm volatile("s_waitcnt lgkmcnt(0)" ::: "memory"); __builtin_amdgcn_s_barrier(); asm volatile("" ::: "memory"); } while (0)
        float pf[16]; unsigned short pi[16];
#define P2_LOAD(IT) do { const int bh_ = (IT) >> 5, c_ = (IT) & 31, h_ = bh_ & 7, row0_ = (bh_ >> 3) * 2048 + c_ * 64; const int k_ = tid & 127, qtr_ = __builtin_amdgcn_readfirstlane(tid >> 7); \
            _Pragma("unroll") for (int s_ = 0; s_ < 16; ++s_) { const size_t gi = (size_t)(row0_ + qtr_ * 16 + s_) * 1024 + h_ * 128 + k_; pf[s_] = F[gi]; pi[s_] = I[gi]; } } while (0)
        if (bx < 1024) P2_LOAD(bx);
        for (int it = bx; it < 1024 + 544; it += G) {
#ifdef P2_PROBE
            if (rep_ == 1 && ((P2_PROBE == 1) == (it >= 1024))) continue;
#endif
            LBAR2();
            if (it == 1024 + bx) STAMP(20);
            if (it < 1024) {
                const int bh = it >> 5, c = it & 31, b = bh >> 3, h = bh & 7;
                const int row0 = b * 2048 + c * 64;
                LAS bf16* KEt = (LAS bf16*)lds;
                LAS bf16* Vt = (LAS bf16*)(lds + 18432);
                LAS float* Tq = (LAS float*)(lds + 36864);
                const int k = tid & 127, qtr = __builtin_amdgcn_readfirstlane(tid >> 7);
                float lf[16], kk[16]; unsigned short iv[16];
#pragma unroll
                for (int s_ = 0; s_ < 16; ++s_) { const float f = pf[s_]; lf[s_] = __builtin_amdgcn_logf(f); kk[s_] = 1.0f - f; iv[s_] = pi[s_]; }
                if (it + G < 1024) P2_LOAD(it + G);
                float run = 0.f; float suf[16];
#pragma unroll
                for (int s_ = 15; s_ >= 0; --s_) { suf[s_] = run; run += lf[s_]; }
                Tq[qtr * 128 + k] = run;
                { v4u w0, w1;
                  w0.x = iv[0] | ((unsigned)iv[1] << 16); w0.y = iv[2] | ((unsigned)iv[3] << 16); w0.z = iv[4] | ((unsigned)iv[5] << 16); w0.w = iv[6] | ((unsigned)iv[7] << 16);
                  w1.x = iv[8] | ((unsigned)iv[9] << 16); w1.y = iv[10] | ((unsigned)iv[11] << 16); w1.z = iv[12] | ((unsigned)iv[13] << 16); w1.w = iv[14] | ((unsigned)iv[15] << 16);
                  *(LAS v4u*)(Vt + k * 72 + qtr * 16) = w0; *(LAS v4u*)(Vt + k * 72 + qtr * 16 + 8) = w1; }
                LBAR2();
                float later = 0.f, total = 0.f;
#pragma unroll
                for (int q2 = 0; q2 < 4; ++q2) { const float tq = Tq[q2 * 128 + k]; total += tq; later += q2 > qtr ? tq : 0.f; }
                { float ke[16];
#pragma unroll
                  for (int s_ = 0; s_ < 16; ++s_) ke[s_] = kk[s_] * __builtin_amdgcn_exp2f(suf[s_] + later);
                  v4u w0, w1;
                  w0.x = pg8::cvt_pk_bf16(ke[0], ke[1]); w0.y = pg8::cvt_pk_bf16(ke[2], ke[3]); w0.z = pg8::cvt_pk_bf16(ke[4], ke[5]); w0.w = pg8::cvt_pk_bf16(ke[6], ke[7]);
                  w1.x = pg8::cvt_pk_bf16(ke[8], ke[9]); w1.y = pg8::cvt_pk_bf16(ke[10], ke[11]); w1.z = pg8::cvt_pk_bf16(ke[12], ke[13]); w1.w = pg8::cvt_pk_bf16(ke[14], ke[15]);
                  *(LAS v4u*)(KEt + k * 72 + qtr * 16) = w0; *(LAS v4u*)(KEt + k * 72 + qtr * 16 + 8) = w1; }
                if (qtr == 0) DC[it * 128 + k] = exp2f(total);
                LBAR2();
                { const int r = lane & 15, q = lane >> 4;
                  const pg8::bf16x8 a0 = *(const LAS pg8::bf16x8*)(Vt + (16 * wave + r) * 72 + 8 * q), a1 = *(const LAS pg8::bf16x8*)(Vt + (16 * wave + r) * 72 + 8 * q + 32);
                  float* sp = ST + (size_t)it * 16384 + (size_t)(16 * wave + 4 * q) * 128 + r;
#pragma unroll
                  for (int kt = 0; kt < 8; ++kt) {
                      const pg8::bf16x8 b0 = *(const LAS pg8::bf16x8*)(KEt + (16 * kt + r) * 72 + 8 * q), b1 = *(const LAS pg8::bf16x8*)(KEt + (16 * kt + r) * 72 + 8 * q + 32);
                      f32x4 acc = (f32x4){0.f, 0.f, 0.f, 0.f};
                      acc = __builtin_amdgcn_mfma_f32_16x16x32_bf16(a0, b0, acc, 0, 0, 0);
                      acc = __builtin_amdgcn_mfma_f32_16x16x32_bf16(a1, b1, acc, 0, 0, 0);
#pragma unroll
                      for (int j = 0; j < 4; ++j) sp[j * 128 + 16 * kt] = acc[j];
                  } }
            } else {
                const int m0 = (it - 1024) * 16;
                const bool samp = m0 >= MP;
                int t0, seq0; const float* hist = cache_conv;
                if (!samp) { t0 = m0 & 2047; seq0 = m0 - t0; }
                else { t0 = 0; seq0 = m0; hist = cache_conv + (size_t)((m0 - MP) >> 4) * 30 * 1024; }
                const int hrow0 = samp ? ((m0 - MP) >> 4) * 30 : 0;
                const __amdgpu_buffer_rsrc_t rU = __builtin_amdgcn_make_buffer_rsrc((void*)U, 0, M * 1024 * 2, 0x00020000);
                const __amdgpu_buffer_rsrc_t rH = __builtin_amdgcn_make_buffer_rsrc((void*)cache_conv, 0, 32 * 30 * 1024 * 4, 0x00020000);
                const __amdgpu_buffer_rsrc_t rW = __builtin_amdgcn_make_buffer_rsrc((void*)w_dw, 0, 31 * 1024 * 4, 0x00020000);
                const bool interior = t0 >= 30;
                LAS float* hbuf = (LAS float*)(lds + 16384);
                LAS f32x2* stat = (LAS f32x2*)(lds + 16384 + 65536);
                const int c = 2 * tid;
                f32x2 acc[16];
                { const f32x2 bb = *(const f32x2*)(b_dw + c);
#pragma unroll
                  for (int t = 0; t < 16; ++t) acc[t] = bb; }
#pragma unroll
                for (int ch = 0; ch < 2; ++ch) {
                    const int j0 = ch * 16, nj = ch ? 15 : 16;
                    f32x2 win[31];
                    if (interior) {
                        const int rb = (seq0 + t0 - 30 + j0) * 2048;
#pragma unroll
                        for (int xi = 0; xi < 31; ++xi) if (xi < nj + 15) { const unsigned pw = __builtin_amdgcn_raw_buffer_load_b32(rU, 4 * tid, rb + xi * 2048, 0); win[xi] = (f32x2){__uint_as_float(pw << 16), __uint_as_float(pw & 0xffff0000u)}; }
                    } else {
#pragma unroll
                        for (int xi = 0; xi < 31; ++xi) if (xi < nj + 15) {
                            const int tr = t0 - 30 + j0 + xi;
                            f32x2 wv = (f32x2){0.f, 0.f};
                            if (tr >= 0) { const unsigned pw = __builtin_amdgcn_raw_buffer_load_b32(rU, 4 * tid, (seq0 + tr) * 2048, 0); wv = (f32x2){__uint_as_float(pw << 16), __uint_as_float(pw & 0xffff0000u)}; }
                            else if (samp) { const v2u hv = __builtin_amdgcn_raw_buffer_load_b64(rH, 8 * tid, (hrow0 + 30 + tr) * 4096, 0); wv = (f32x2){__uint_as_float(hv.x), __uint_as_float(hv.y)}; }
                            win[xi] = wv;
                        }
                    }
#pragma unroll
                    for (int jj = 0; jj < 16; ++jj) if (jj < nj) { const v2u wu = __builtin_amdgcn_raw_buffer_load_b64(rW, 8 * tid, (j0 + jj) * 4096, 0); const f32x2 w2 = (f32x2){__uint_as_float(wu.x), __uint_as_float(wu.y)};
#pragma unroll
                        for (int t = 0; t < 16; ++t) acc[t] += w2 * win[t + jj]; }
                    asm volatile("" ::: "memory");
                }
#pragma unroll
                for (int t = 0; t < 16; ++t) *(LAS f32x2*)(hbuf + t * 1024 + c) = acc[t];
                __syncthreads();
#pragma unroll
                for (int tt = 0; tt < 2; ++tt) { const int t = 2 * wave + tt; float s1 = 0.f, s2 = 0.f;
#pragma unroll
                    for (int i = 0; i < 4; ++i) { const f32x4 x = *(const LAS f32x4*)(hbuf + t * 1024 + 4 * lane + 256 * i); s1 += (x.x + x.y) + (x.z + x.w); s2 += (x.x * x.x + x.y * x.y) + (x.z * x.z + x.w * x.w); }
                    s1 = wave_sum(s1); s2 = wave_sum(s2);
                    const float mu = s1 * (1.f / 1024.f); float var = s2 * (1.f / 1024.f) - mu * mu; var = var > 0.f ? var : 0.f;
                    if (lane == 0) stat[t] = (f32x2){mu, 1.f / sqrtf(var + LN_EPS)}; }
                __syncthreads();
                const f32x2 gg = *(const f32x2*)(cn_g + c), bb2 = *(const f32x2*)(cn_b + c);
#pragma unroll
                for (int t = 0; t < 16; ++t) {
                    const f32x2 st2 = stat[t];
                    float y0 = (acc[t].x - st2.x) * st2.y * gg.x + bb2.x, y1 = (acc[t].y - st2.x) * st2.y * gg.y + bb2.y;
                    y0 = y0 * sigm(y0); y1 = y1 * sigm(y1);
                    *(unsigned*)(MIX + (size_t)(m0 + t) * 2048 + c) = pk2(y0, y1);
                }
            }
        }
        STAMP(21);
        { const int nx = (1024 + 544) % G;
          const int first = (nx > 0 && nx < G) ? nx : 0, nwg = G - first;
          if (bx >= first) {
              const int gt2 = (bx - first) * 512 + tid, NT2 = nwg * 512;
              for (int i = gt2; i < 4 * 30 * 1024; i += NT2) { const int b = i / 30720, j = (i >> 10) % 30, c = i & 1023;
                  out[O_NCP + i] = bf2f(U[(size_t)(b * 2048 + 2018 + j) * 1024 + c]); }
              for (int i = gt2; i < 32 * 30 * 1024; i += NT2) { const int sb = i / 30720, j = (i >> 10) % 30, c = i & 1023;
                  out[O_NCS + i] = j < 14 ? cache_conv[(size_t)sb * 30720 + (16 + j) * 1024 + c] : bf2f(U[(size_t)(MP + sb * 16 + j - 14) * 1024 + c]); }
          } }
    }
    SEAM(2);

    if (IN(3)) {
        for (int e = gt; e < 32 * 4096; e += NT) {
            const int bh = e >> 12, r = e & 4095, v = r >> 5, k4 = r & 31;
            f32x4 S = (f32x4){0.f, 0.f, 0.f, 0.f};
#pragma unroll 8
            for (int c = 0; c < 32; ++c) {
                f32x4* p = (f32x4*)(ST + ((size_t)(bh * 32 + c) * 128 + v) * 128 + k4 * 4);
                const f32x4 A = *p; const f32x4 d = *(const f32x4*)(DC + (bh * 32 + c) * 128 + k4 * 4);
                *p = S; S = S * d + A;
            }
            float* o = out + O_NHP + (size_t)bh * 16384 + (size_t)(k4 * 4) * 128 + v;
            o[0] = S.x; o[128] = S.y; o[256] = S.z; o[384] = S.w;
        }
    }
    SEAM(3);

    if (IN(4)) for (int rep_ = 0; rep_ < NREP(4); ++rep_) { if (rep_) xcd_barrier(xbar);
        LAS float* vl = (LAS float*)lds; LAS float* red = (LAS float*)(lds + 8192);
        LAS float* fl2 = (LAS float*)(lds + 73728); LAS float* ql2 = (LAS float*)(lds + 81920);
#define LBAR() do { asm volatile("s_waitcnt lgkmcnt(0)" ::: "memory"); __builtin_amdgcn_s_barrier(); asm volatile("" ::: "memory"); } while (0)
        float fr[16]; unsigned short qh[16], ih[16]; unsigned gq[8]; f32x4 sv[8];
#define P4_LOAD(IT) do { const int bh_ = (IT) >> 5, c_ = (IT) & 31, h_ = bh_ & 7, row0_ = (bh_ >> 3) * 2048 + c_ * 64; const int k_ = tid & 127, qtr_ = __builtin_amdgcn_readfirstlane(tid >> 7); \
            _Pragma("unroll") for (int s_ = 0; s_ < 16; ++s_) { const size_t gi = (size_t)(row0_ + qtr_ * 16 + s_) * 1024 + h_ * 128 + k_; fr[s_] = F[gi]; qh[s_] = Q[gi]; ih[s_] = I[gi]; } \
            _Pragma("unroll") for (int j = 0; j < 8; ++j) sv[j] = *(const f32x4*)(ST + (size_t)(IT) * 16384 + (size_t)(tid + 512 * j) * 4); \
            _Pragma("unroll") for (int tt = 0; tt < 8; ++tt) { const size_t m = (size_t)(row0_ + wave * 8 + tt); gq[tt] = *(const unsigned*)(Gt + m * 1024 + h_ * 128 + 2 * lane); } } while (0)
        if (bx < 1024) P4_LOAD(bx);
        float ng0 = hg_ng[2 * lane], ng1 = hg_ng[2 * lane + 1];
        asm volatile("" : "+v"(ng0), "+v"(ng1));
        for (int it = bx; it < 1024; it += G) {
          {
            const int bh = it >> 5, c = it & 31, h = bh & 7, row0 = (bh >> 3) * 2048 + c * 64;
            LAS bf16* St = (LAS bf16*)lds;
            LAS bf16* QD = (LAS bf16*)(lds + 34816);
            LAS bf16* Vt = (LAS bf16*)(lds + 52224);
            LAS bf16* Pm = (LAS bf16*)(lds + 70656);
            LAS bf16* QDI = (LAS bf16*)(lds + 79872);
            LAS bf16* KD = (LAS bf16*)(lds + 97280);
            LAS float* Tq = (LAS float*)(lds + 140800);
            LAS float* Ob = (LAS float*)(lds + 79872);
            LBAR();
            const int k = tid & 127, qtr = __builtin_amdgcn_readfirstlane(tid >> 7);
            float pre[16], kk[16], qq[16]; unsigned short iv[16];
#pragma unroll
            for (int s_ = 0; s_ < 16; ++s_) { const float f = fr[s_]; pre[s_] = __builtin_amdgcn_logf(f); kk[s_] = 1.0f - f; qq[s_] = bf2f(qh[s_]); iv[s_] = ih[s_]; }
#pragma unroll
            for (int j = 0; j < 8; ++j) { const int e = tid + 512 * j, v = e >> 5, k4 = e & 31; const f32x4 x = sv[j];
                v2u w; w.x = pk2(x.x, x.y); w.y = pk2(x.z, x.w); *(LAS v2u*)(St + v * 136 + k4 * 4) = w; }
#pragma unroll
            for (int s_ = 1; s_ < 16; ++s_) pre[s_] += pre[s_ - 1];
            const float tot = pre[15];
            Tq[qtr * 128 + k] = tot;
            { v4u w0, w1;
              w0.x = iv[0] | ((unsigned)iv[1] << 16); w0.y = iv[2] | ((unsigned)iv[3] << 16); w0.z = iv[4] | ((unsigned)iv[5] << 16); w0.w = iv[6] | ((unsigned)iv[7] << 16);
              w1.x = iv[8] | ((unsigned)iv[9] << 16); w1.y = iv[10] | ((unsigned)iv[11] << 16); w1.z = iv[12] | ((unsigned)iv[13] << 16); w1.w = iv[14] | ((unsigned)iv[15] << 16);
              *(LAS v4u*)(Vt + k * 72 + qtr * 16) = w0; *(LAS v4u*)(Vt + k * 72 + qtr * 16 + 8) = w1; }
            const int kdoff = qtr == 0 ? 0 : (qtr == 1 ? 16 : (qtr == 2 ? 48 : 96));
#pragma unroll
            for (int s_ = 0; s_ < 16; ++s_) {
                QDI[(16 * qtr + s_) * 136 + k] = bfr(qq[s_] * __builtin_amdgcn_exp2f(pre[s_]));
                KD[(kdoff + 16 * qtr + s_) * 136 + k] = bfr(kk[s_] * __builtin_amdgcn_exp2f(fminf(-pre[s_], 120.f)));
            }
            LBAR();
            { float lb_ = 0.f;
#pragma unroll
              for (int q2 = 0; q2 < 4; ++q2) lb_ += q2 < qtr ? Tq[q2 * 128 + k] : 0.f;
#pragma unroll
              for (int s_ = 0; s_ < 16; ++s_) QD[(16 * qtr + s_) * 136 + k] = bfr(qq[s_] * __builtin_amdgcn_exp2f(pre[s_] + lb_));
              float gap = 0.f;
              for (int i = qtr + 1; i < 4; ++i) {
                  const int off = i == 1 ? 16 : (i == 2 ? 48 : 96);
#pragma unroll
                  for (int s_ = 0; s_ < 16; ++s_) KD[(off + 16 * qtr + s_) * 136 + k] = bfr(kk[s_] * __builtin_amdgcn_exp2f((tot - pre[s_]) + gap));
                  gap += Tq[i * 128 + k];
              } }
            unsigned gpre[8];
#pragma unroll
            for (int i = 0; i < 8; ++i) gpre[i] = gq[i];
            if (it + G < 1024) P4_LOAD(it + G);
            LBAR();
            const int r = lane & 15, q = lane >> 4;
            for (int n = wave; n < 10; n += 8) {
                const int i = n == 0 ? 0 : (n < 3 ? 1 : (n < 6 ? 2 : 3)), j = n - (i == 0 ? 0 : (i == 1 ? 1 : (i == 2 ? 3 : 6)));
                const int off = i == 0 ? 0 : (i == 1 ? 16 : (i == 2 ? 48 : 96));
                f32x4 acc = (f32x4){0.f, 0.f, 0.f, 0.f};
#pragma unroll
                for (int ks = 0; ks < 4; ++ks) {
                    const pg8::bf16x8 a = *(const LAS pg8::bf16x8*)(QDI + (16 * i + r) * 136 + 8 * q + 32 * ks);
                    const pg8::bf16x8 bq = *(const LAS pg8::bf16x8*)(KD + (off + 16 * j + r) * 136 + 8 * q + 32 * ks);
                    acc = __builtin_amdgcn_mfma_f32_16x16x32_bf16(a, bq, acc, 0, 0, 0);
                }
#pragma unroll
                for (int jj = 0; jj < 4; ++jj) { const float x = (i != j || r <= 4 * q + jj) ? acc[jj] : 0.f; Pm[(16 * i + 4 * q + jj) * 72 + 16 * j + r] = bfr(x); }
            }
            if (wave == 2 || wave == 3) { const int i = wave == 2 ? 0 : 2, j = i + 1;
#pragma unroll
                for (int jj = 0; jj < 4; ++jj) Pm[(16 * i + 4 * q + jj) * 72 + 16 * j + r] = (bf16)0; }
            LBAR();
            { const int i = wave >> 1, vt0 = 4 * (wave & 1);
              pg8::bf16x8 pa[2], qa[4];
#pragma unroll
              for (int ks = 0; ks < 2; ++ks) pa[ks] = *(const LAS pg8::bf16x8*)(Pm + (16 * i + r) * 72 + 8 * q + 32 * ks);
#pragma unroll
              for (int ks = 0; ks < 4; ++ks) qa[ks] = *(const LAS pg8::bf16x8*)(QD + (16 * i + r) * 136 + 8 * q + 32 * ks);
#pragma unroll
              for (int vv = 0; vv < 4; ++vv) { const int vt = vt0 + vv;
                  f32x4 acc = (f32x4){0.f, 0.f, 0.f, 0.f};
                  acc = __builtin_amdgcn_mfma_f32_16x16x32_bf16(pa[0], *(const LAS pg8::bf16x8*)(Vt + (16 * vt + r) * 72 + 8 * q), acc, 0, 0, 0);
                  if (i >= 2) acc = __builtin_amdgcn_mfma_f32_16x16x32_bf16(pa[1], *(const LAS pg8::bf16x8*)(Vt + (16 * vt + r) * 72 + 8 * q + 32), acc, 0, 0, 0);
#pragma unroll
                  for (int ks = 0; ks < 4; ++ks) acc = __builtin_amdgcn_mfma_f32_16x16x32_bf16(qa[ks], *(const LAS pg8::bf16x8*)(St + (16 * vt + r) * 136 + 8 * q + 32 * ks), acc, 0, 0, 0);
#pragma unroll
                  for (int jj = 0; jj < 4; ++jj) Ob[(16 * i + 4 * q + jj) * 132 + 16 * vt + r] = acc[jj];
              } }
            LBAR();
            { float o0[8], o1[8], ss[8];
#pragma unroll
              for (int tt = 0; tt < 8; ++tt) { const int t = wave * 8 + tt; const f32x2 ov = *(const LAS f32x2*)(Ob + t * 132 + 2 * lane); o0[tt] = ov.x; o1[tt] = ov.y; ss[tt] = o0[tt] * o0[tt] + o1[tt] * o1[tt]; }
#pragma unroll
              for (int o = 1; o < 64; o <<= 1) {
#pragma unroll
                  for (int tt = 0; tt < 8; ++tt) ss[tt] += __shfl_xor(ss[tt], o); }
#pragma unroll
              for (int tt = 0; tt < 8; ++tt) {
                  const float rr = __builtin_amdgcn_rsqf(ss[tt] * (1.f / 128.f) + LN_EPS);
                  const size_t m = (size_t)(row0 + wave * 8 + tt);
                  const float g0 = __uint_as_float(gpre[tt] << 16), g1 = __uint_as_float(gpre[tt] & 0xffff0000u);
                  *(unsigned*)(MIX + m * 2048 + 1024 + h * 128 + 2 * lane) = pg8::cvt_pk_bf16(o0[tt] * rr * ng0 * g0, o1[tt] * rr * ng1 * g1);
              } }
          }
        }
#undef P4_LOAD
#undef LBAR
        __syncthreads();
        STAMP(22);
        for (int it = 1024 + bx; it < 1024 + 256; it += G) {
          {
            int row0, h, nsb; const float* sinit; float* sfin = nullptr;
            if (it < 1024) { const int bh = it >> 5, c = it & 31; h = bh & 7; row0 = (bh >> 3) * 2048 + c * 64; nsb = 4; sinit = ST + (size_t)it * 16384; }
            else { const int j = it - 1024; h = j & 7; row0 = MP + (j >> 3) * 16; nsb = 1; sinit = state_hgrn + (size_t)j * 16384; sfin = out + O_NHS + (size_t)j * 16384; }
            f32x2 Sa[8], Sb[8];
            { const float* sp = sinit + (size_t)(wave * 16) * 128 + lane;
#pragma unroll
              for (int i = 0; i < 8; ++i) { Sa[i] = (f32x2){sp[(2 * i) * 128], sp[(2 * i + 1) * 128]}; Sb[i] = (f32x2){sp[(2 * i) * 128 + 64], sp[(2 * i + 1) * 128 + 64]}; } }
            for (int sb = 0; sb < nsb; ++sb) {
                __syncthreads();
#pragma unroll
                for (int e4 = 0; e4 < 4; ++e4) { const int e = tid + e4 * 512, t = e >> 7, k = e & 127; const size_t gi = (size_t)(row0 + sb * 16 + t) * 1024 + h * 128 + k;
                    vl[e] = bf2f(I[gi]); fl2[e] = F[gi]; ql2[e] = bf2f(Q[gi]); }
                __syncthreads();
#pragma unroll 2
                for (int t = 0; t < 16; ++t) {
                    f32x4 f4[4], q4[4];
#pragma unroll
                    for (int i = 0; i < 4; ++i) { f4[i] = *(const LAS f32x4*)(fl2 + t * 128 + wave * 16 + 4 * i); q4[i] = *(const LAS f32x4*)(ql2 + t * 128 + wave * 16 + 4 * i); }
                    const float va = vl[t * 128 + lane], vb = vl[t * 128 + 64 + lane];
                    const f32x2 va2 = (f32x2){va, va}, vb2 = (f32x2){vb, vb};
                    f32x2 oa = (f32x2){0.f, 0.f}, ob = (f32x2){0.f, 0.f};
#pragma unroll
                    for (int i = 0; i < 8; ++i) { const f32x2 f2 = (f32x2){f4[i >> 1][2 * (i & 1)], f4[i >> 1][2 * (i & 1) + 1]};
                        const f32x2 q2 = (f32x2){q4[i >> 1][2 * (i & 1)], q4[i >> 1][2 * (i & 1) + 1]};
                        Sa[i] = f2 * (Sa[i] - va2) + va2; Sb[i] = f2 * (Sb[i] - vb2) + vb2;
                        oa += q2 * Sa[i]; ob += q2 * Sb[i]; }
                    red[(wave * 16 + t) * 128 + lane] = oa.x + oa.y; red[(wave * 16 + t) * 128 + 64 + lane] = ob.x + ob.y;
                }
                __syncthreads();
#pragma unroll
                for (int tt = 0; tt < 2; ++tt) {
                    const int t = wave * 2 + tt;
                    float o0 = 0.f, o1 = 0.f;
#pragma unroll
                    for (int q8 = 0; q8 < 8; ++q8) { o0 += red[(q8 * 16 + t) * 128 + lane]; o1 += red[(q8 * 16 + t) * 128 + 64 + lane]; }
                    const float ss = wave_sum(o0 * o0 + o1 * o1);
                    const float r = 1.f / sqrtf(ss * (1.f / 128.f) + LN_EPS);
                    const size_t m = (size_t)(row0 + sb * 16 + t);
                    const float g0 = bf2f(Gt[m * 1024 + h * 128 + lane]), g1 = bf2f(Gt[m * 1024 + h * 128 + 64 + lane]);
                    MIX[m * 2048 + 1024 + h * 128 + lane] = (bf16)f2bf(o0 * r * hg_ng[lane] * g0);
                    MIX[m * 2048 + 1024 + h * 128 + 64 + lane] = (bf16)f2bf(o1 * r * hg_ng[64 + lane] * g1);
                }
            }
            if (sfin) { float* sp = sfin + (size_t)(wave * 16) * 128 + lane;
#pragma unroll
                for (int i = 0; i < 8; ++i) { sp[(2 * i) * 128] = Sa[i].x; sp[(2 * i + 1) * 128] = Sa[i].y; sp[(2 * i) * 128 + 64] = Sb[i].x; sp[(2 * i + 1) * 128 + 64] = Sb[i].y; } }
          }
        }
        __syncthreads();
    }
    SEAM(4);

    if (IN(5)) for (int rep_ = 0; rep_ < NREP(5); ++rep_) { if (rep_) xcd_barrier(xbar);
        pg8::Gemm g{MIX, WOUT, M, D, D}; pg8::StaticOrder S; S.init(M, D, D, G, bx, MP, SPLIT5);
        pg8::EpiResB<true> E{XB, XB, MP, ALPHA, (pg8::bf16_t*)(ws + WS_PB5)};
        pg8::gemm_phase<pg8::EpiResB<true>, pg8::StaticOrder, true, true>(lds, g, S, E);
        { const int nlast = S.nitems % G, first = nlast > 0 ? nlast : 0, nwg = G - first;
          if (bx >= first) {
              LAS float* scr = (LAS float*)(lds + wave * 16384);
              constexpr int I_G = 32 * 176;
              const int gw2 = (bx - first) * NWAVES + wave, NGW2 = nwg * NWAVES;
              transpose_stream<0>(w_down, FF, D, WDN, gw2, W_DN_SPLIT, NGW2, scr, lane);
          } }
    }
    SEAM(5);

    if (IN(6)) {
        ln_rows_bf16(XB, nullptr, XB, ln1_g, ln1_b, gw, NGW, MP, lane);
        if ((gw & 3) == 0) for (int m = MP + (gw >> 2); m < M; m += (NGW + 3) >> 2)
            ln_row<false, SPLIT5>(x_sample + (size_t)(m - MP) * D, (const bf16*)(ws + WS_PB5) + (size_t)(m - MP) * D, (size_t)MS * D, ALPHA, nullptr, XB + (size_t)m * D, ln1_g, ln1_b, lane);
    }
    SEAM(6);

    if (IN(7)) for (int rep_ = 0; rep_ < NREP(7); ++rep_) { if (rep_) xcd_barrier(xbar);
        pg8::Gemm g{XB, WGU, M, 2 * FF, D}; pg8::StaticOrder S; S.init(M, 2 * FF, D, G, bx);
        pg8::EpiGateUp E{ACT, FF};
        pg8::gemm_phase<pg8::EpiGateUp, pg8::StaticOrder, true, true>(lds, g, S, E);
        const int nlast = S.nitems % G;
        {
            const int first = nlast > 0 ? nlast : 0, nwg = G - first;
            if (bx >= first) {
                LAS float* scr = (LAS float*)(lds + wave * 16384);
                constexpr int I_DN = 88 * 64;
                const int gw2 = (bx - first) * NWAVES + wave, NGW2 = nwg * NWAVES;
                transpose_stream<0>(w_down, FF, D, WDN, W_DN_SPLIT + gw2, I_DN, NGW2, scr, lane);
            }
        }
    }
    SEAM(7);

    if (IN(8)) {
        pg8::Gemm g{ACT, WDN, M, D, FF}; pg8::StaticOrder S; S.init(M, D, FF, G, bx, MP, SPLIT8);
        pg8::EpiResB<true> E{XB, MIX, MP, ALPHA, (pg8::bf16_t*)(ws + WS_PB8)};
        pg8::gemm_phase<pg8::EpiResB<true>, pg8::StaticOrder, true, true>(lds, g, S, E);
    }
    SEAM(8);

    if (IN(9)) {
        ln_rows_bf16(MIX, out, nullptr, ln2_g, ln2_b, gw, NGW, MP, lane);
        if ((gw & 3) == 0) for (int m = MP + (gw >> 2); m < M; m += (NGW + 3) >> 2)
            ln_row<true, SPLIT8>(XB + (size_t)m * D, (const bf16*)(ws + WS_PB8) + (size_t)(m - MP) * D, (size_t)MS * D, ALPHA, out + (size_t)m * D, nullptr, ln2_g, ln2_b, lane);
    }
    STAMP(10);
#ifdef TS_A
    __syncthreads();
    if (bx == 0 && tid == 0) { asm volatile("s_waitcnt vmcnt(0)" ::: "memory"); out[0] = out[0] + (float)(ts_b - ts_a) * 1e-4f; }
#endif
#undef IN
#undef SEAM
}

#undef x_prompt
#undef x_sample
#undef cache_conv
#undef state_hgrn
#undef w_in
#undef b_in
#undef w_dw
#undef b_dw
#undef cn_g
#undef cn_b
#undef hlb
#undef hg_ng
#undef w_out
#undef ln1_g
#undef ln1_b
#undef w_gate
#undef w_up
#undef w_down
#undef ln2_g
#undef ln2_b
#undef out
#undef ws
#undef LB
#undef BIASP
#undef WIN
#undef WOUT
#undef WGU
#undef WDN
#undef XB
#undef MIX
#undef U
#undef Q
#undef F
#undef I
#undef Gt
#undef ACT
#undef ST
#undef DC

extern "C" void kernel_launch(void* const* d_in, const int* in_sizes, int n_in, void* d_out, int out_size, void* d_ws, size_t ws_size, hipStream_t stream) {
    static int grid = 0;
    if (grid == 0) {
        int dev = 0, cus = 0, per_cu = 0;
        if (n_in != 20 || ws_size < WS_END) { fprintf(stderr, "kernel_launch: unexpected n_in %d / ws_size %zu\n", n_in, ws_size); grid = -1; return; }
        if (hipGetDevice(&dev) != hipSuccess || hipDeviceGetAttribute(&cus, hipDeviceAttributeMultiprocessorCount, dev) != hipSuccess) { grid = -1; return; }
        if (hipFuncSetAttribute((const void*)fwd_kernel, hipFuncAttributeMaxDynamicSharedMemorySize, LDS_BYTES) != hipSuccess) { fprintf(stderr, "kernel_launch: hipFuncSetAttribute failed\n"); grid = -1; return; }
        if (hipOccupancyMaxActiveBlocksPerMultiprocessor(&per_cu, (const void*)fwd_kernel, NWAVES * 64, LDS_BYTES) != hipSuccess || per_cu < 1) { fprintf(stderr, "kernel_launch: occupancy query says %d\n", per_cu); }
        (void)hipGetLastError();
        grid = cus;
    }
    if (grid < 0) return;
    if (hipMemsetAsync(d_ws, 0, 16384, stream) != hipSuccess) { fprintf(stderr, "kernel_launch: memset failed\n"); return; }
    Args a{};
    for (int i = 0; i < 20; ++i) a.in[i] = (const float*)d_in[i];
    a.out = (float*)d_out; a.ws = (unsigned char*)d_ws;
#if MK_ONE_LAUNCH
    a.ph_lo = 0; a.ph_hi = N_PHASES;
    void* kargs[] = {&a};
    hipError_t e = hipLaunchCooperativeKernel((const void*)fwd_kernel, dim3(grid), dim3(NWAVES * 64), kargs, LDS_BYTES, stream);
    if (e != hipSuccess) fprintf(stderr, "cooperative launch failed: %s (grid %d)\n", hipGetErrorString(e), grid);
#else
    for (int p = 0; p < N_PHASES; ++p) {
        a.ph_lo = p; a.ph_hi = p + 1;
        hipLaunchKernelGGL(fwd_kernel, dim3(grid), dim3(NWAVES * 64), LDS_BYTES, stream, a);
    }
#endif
}
```

```cpp
#include <hip/hip_runtime.h>
#include <hip/hip_cooperative_groups.h>
#include <cstdio>
#include <cstdint>
namespace cg = cooperative_groups;

#ifndef MK_ONE_LAUNCH
#define MK_ONE_LAUNCH 1
#endif

namespace pg8 {
#define PG8_LAS __attribute__((address_space(3)))
typedef unsigned short bf16_t;
typedef short bf16x8 __attribute__((ext_vector_type(8)));
typedef float f32x4 __attribute__((ext_vector_type(4)));
typedef unsigned u32x4 __attribute__((ext_vector_type(4)));
typedef unsigned u32x2 __attribute__((ext_vector_type(2)));
constexpr int BM = 256, BK = 64, HALF = 128, HTB = HALF * BK * 2, STAGE_BYTES = 8 * HTB, NXCD = 8, WGM = 8;

__host__ __device__ __forceinline__ int lds_byte(int r, int c) { const int st = (r >> 4) * 2 + (c >> 5), rr = r & 15, cc = c & 31, ob = rr * 64 + cc * 2; return st * 1024 + (ob ^ (((ob >> 9) & 1) << 5)); }
__host__ __device__ __forceinline__ void stage_rc(int b, int& R, int& C) { const int st = b / 1024, sb = b % 1024, swz = sb ^ (((sb >> 9) & 1) << 5); R = (st >> 1) * 16 + swz / 64; C = (st & 1) * 32 + (swz % 64) / 2; }
__host__ __device__ __forceinline__ int perm32(int rho) { const int n = rho >> 4, i = rho & 15; return 8 * (i >> 2) + 4 * n + (i & 3); }

struct Unit { int pm, pn, kt0, nkt, ks; };
struct Gemm { const bf16_t* A; const bf16_t* Bt; int M, N, K; };

struct StaticOrder {
    int nM, nMf, nN, nfull, nitems, G, c, nt, nsplit;
    __host__ __device__ void init(int M, int N, int K, int G_, int c_, int Mfull = -1, int nsplit_ = 1) {
        nM = M / BM; nMf = Mfull < 0 ? nM : Mfull / BM; nN = N / BM; nt = K / BK; nsplit = nsplit_; nfull = nMf * nN; nitems = nfull + (nM - nMf) * nN * nsplit; G = G_; c = c_; }
    __host__ __device__ bool next(int i, Unit& u) const {
        const long L = (long)i * G + c; if (L >= nitems) return false;
        if (L >= nfull) { const int sidx = (int)L - nfull, un = sidx / nsplit, ks = sidx % nsplit, per = nt / nsplit;
            u.pm = nMf + un / nN; u.pn = un % nN; u.kt0 = ks * per; u.nkt = per; u.ks = ks; return true; }
        int wgid = (int)L; { const int q = nfull / NXCD, r = nfull % NXCD, xcd = wgid % NXCD, off = wgid / NXCD; wgid = (xcd < r ? xcd * (q + 1) : r * (q + 1) + (xcd - r) * q) + off; }
        const int nig = WGM * nN, gid = wgid / nig, fm = gid * WGM, gsz = (nMf - fm) < WGM ? (nMf - fm) : WGM;
        u.pm = fm + ((wgid % nig) % gsz); u.pn = (wgid % nig) / gsz; u.kt0 = 0; u.nkt = nt; u.ks = -1; return true;
    }
    __device__ __forceinline__ void a_ready(const Unit&) const {}
    __device__ __forceinline__ void done(const Unit&) const {}
};

__device__ __forceinline__ unsigned cvt_pk_bf16(float lo, float hi) { unsigned r; asm volatile("v_cvt_pk_bf16_f32 %0, %1, %2" : "=v"(r) : "v"(lo), "v"(hi)); return r; }
__device__ __forceinline__ float sigm(float x) { return __builtin_amdgcn_rcpf(1.0f + __expf(-x)); }

struct EpiProj {
    static constexpr bool PERM = true, AFTER_DRAIN = false;
    bf16_t *U, *QIG; float* F; const float* bias; const float* lb;
    __device__ __forceinline__ void operator()(const f32x4 (&acc)[2][2][4][2], const Unit& u, int wr, int wc, int fr, int fq) const {
        const int row0 = u.pm * BM + wr * 64 + fr;
        const int cl = wc * 32 + 8 * fq;
        const int bcol = u.pn * BM + cl;
        f32x4 bv[2][2];
#pragma unroll
        for (int bj = 0; bj < 2; ++bj)
#pragma unroll
            for (int n = 0; n < 2; ++n) bv[bj][n] = *(const f32x4*)(bias + bcol + bj * HALF + 4 * n);
        if (u.pn < 8) {
#pragma unroll
            for (int ai = 0; ai < 2; ++ai)
#pragma unroll
                for (int m = 0; m < 4; ++m) {
                    const size_t row = (size_t)(row0 + ai * HALF + m * 16);
                    float o[8];
#pragma unroll
                    for (int n = 0; n < 2; ++n) { const f32x4 a = acc[ai][0][m][n] + bv[0][n], g = acc[ai][1][m][n] + bv[1][n];
#pragma unroll
                        for (int e = 0; e < 4; ++e) o[n * 4 + e] = a[e] * sigm(g[e]); }
                    u32x4 w; w.x = cvt_pk_bf16(o[0], o[1]); w.y = cvt_pk_bf16(o[2], o[3]); w.z = cvt_pk_bf16(o[4], o[5]); w.w = cvt_pk_bf16(o[6], o[7]);
                    *(u32x4*)(U + row * 1024 + u.pn * HALF + cl) = w;
                }
        } else {
            const int grp = (u.pn - 8) >> 2;
            const int cbase = ((u.pn - 8) & 3) * BM + cl;
            if (grp == 1) {
                f32x4 lv[2][2];
#pragma unroll
                for (int bj = 0; bj < 2; ++bj)
#pragma unroll
                    for (int n = 0; n < 2; ++n) lv[bj][n] = *(const f32x4*)(lb + cbase + bj * HALF + 4 * n);
#pragma unroll
                for (int ai = 0; ai < 2; ++ai)
#pragma unroll
                    for (int m = 0; m < 4; ++m) {
                        const size_t row = (size_t)(row0 + ai * HALF + m * 16);
#pragma unroll
                        for (int bj = 0; bj < 2; ++bj)
#pragma unroll
                            for (int n = 0; n < 2; ++n) { const f32x4 x = acc[ai][bj][m][n] + bv[bj][n]; const f32x4 l = lv[bj][n]; f32x4 o;
#pragma unroll
                                for (int e = 0; e < 4; ++e) o[e] = l[e] + (1.0f - l[e]) * sigm(x[e]);
                                *(f32x4*)(F + row * 1024 + cbase + bj * HALF + 4 * n) = o; }
                    }
            } else {
                bf16_t* O = QIG + (size_t)(grp - (grp > 0 ? 1 : 0)) * ((size_t)8704 * 1024);
                const bool act = grp != 2;
#pragma unroll
                for (int ai = 0; ai < 2; ++ai)
#pragma unroll
                    for (int m = 0; m < 4; ++m) {
                        const size_t row = (size_t)(row0 + ai * HALF + m * 16);
#pragma unroll
                        for (int bj = 0; bj < 2; ++bj) { float o[8];
#pragma unroll
                            for (int n = 0; n < 2; ++n) { const f32x4 x = acc[ai][bj][m][n] + bv[bj][n];
#pragma unroll
                                for (int e = 0; e < 4; ++e) o[n * 4 + e] = act ? x[e] * sigm(x[e]) : x[e]; }
                            u32x4 w; w.x = cvt_pk_bf16(o[0], o[1]); w.y = cvt_pk_bf16(o[2], o[3]); w.z = cvt_pk_bf16(o[4], o[5]); w.w = cvt_pk_bf16(o[6], o[7]);
                            *(u32x4*)(O + row * 1024 + cbase + bj * HALF) = w; }
                    }
            }
        }
    }
};
struct EpiRes {
    static constexpr bool PERM = false, AFTER_DRAIN = false;
    const float* baseP; const float* baseS; float* out; int split; float alpha; float* part;
    __device__ __forceinline__ void operator()(const f32x4 (&acc)[2][2][4][2], const Unit& u, int wr, int wc, int fr, int fq) const {
        const int row0 = u.pm * BM + wr * 64 + fr;
        const int col0 = u.pn * BM + wc * 32 + 4 * fq;
        if (u.ks >= 0) {
            float* pb = part + (size_t)u.ks * 512 * 2048;
#pragma unroll
            for (int ai = 0; ai < 2; ++ai)
#pragma unroll
                for (int m = 0; m < 4; ++m) { float* op = pb + (size_t)(row0 + ai * HALF + m * 16 - split) * 2048;
#pragma unroll
                    for (int bj = 0; bj < 2; ++bj)
#pragma unroll
                        for (int n = 0; n < 2; ++n) *(f32x4*)(op + col0 + bj * HALF + n * 16) = acc[ai][bj][m][n]; }
            return;
        }
#pragma unroll
        for (int ai = 0; ai < 2; ++ai)
#pragma unroll
            for (int m = 0; m < 4; ++m) {
                const int row = row0 + ai * HALF + m * 16;
                const float* bp = row < split ? baseP + (size_t)row * 2048 : baseS + (size_t)(row - split) * 2048;
                float* op = out + (size_t)row * 2048;
#pragma unroll
                for (int bj = 0; bj < 2; ++bj)
#pragma unroll
                    for (int n = 0; n < 2; ++n) { const int c = col0 + bj * HALF + n * 16; const f32x4 b = *(const f32x4*)(bp + c); *(f32x4*)(op + c) = b * alpha + acc[ai][bj][m][n]; }
            }
    }
};
template <bool BASE_BF16> struct EpiResB {
    static constexpr bool PERM = true, AFTER_DRAIN = false;
    const void* base; bf16_t* out; int split; float alpha; bf16_t* part;
    __device__ __forceinline__ void operator()(const f32x4 (&acc)[2][2][4][2], const Unit& u, int wr, int wc, int fr, int fq) const {
        const int row0 = u.pm * BM + wr * 64 + fr;
        const int col0 = u.pn * BM + wc * 32 + 8 * fq;
        if (u.ks >= 0) {
            bf16_t* pb = part + (size_t)u.ks * 512 * 2048;
#pragma unroll
            for (int ai = 0; ai < 2; ++ai)
#pragma unroll
                for (int m = 0; m < 4; ++m) { bf16_t* op = pb + (size_t)(row0 + ai * HALF + m * 16 - split) * 2048;
#pragma unroll
                    for (int bj = 0; bj < 2; ++bj) { const f32x4 v0 = acc[ai][bj][m][0], v1 = acc[ai][bj][m][1];
                        u32x4 w; w.x = cvt_pk_bf16(v0[0], v0[1]); w.y = cvt_pk_bf16(v0[2], v0[3]); w.z = cvt_pk_bf16(v1[0], v1[1]); w.w = cvt_pk_bf16(v1[2], v1[3]);
                        *(u32x4*)(op + col0 + bj * HALF) = w; } }
            return;
        }
#pragma unroll
        for (int ai = 0; ai < 2; ++ai)
#pragma unroll
            for (int m = 0; m < 4; ++m) {
                const size_t row = (size_t)(row0 + ai * HALF + m * 16);
#pragma unroll
                for (int bj = 0; bj < 2; ++bj) { const int c = col0 + bj * HALF; f32x4 b0, b1;
                    if constexpr (BASE_BF16) { const u32x4 w = *(const u32x4*)((const bf16_t*)base + row * 2048 + c);
                        b0 = (f32x4){__uint_as_float(w.x << 16), __uint_as_float(w.x & 0xffff0000u), __uint_as_float(w.y << 16), __uint_as_float(w.y & 0xffff0000u)};
                        b1 = (f32x4){__uint_as_float(w.z << 16), __uint_as_float(w.z & 0xffff0000u), __uint_as_float(w.w << 16), __uint_as_float(w.w & 0xffff0000u)}; }
                    else { const float* bp = (const float*)base + row * 2048 + c; b0 = *(const f32x4*)bp; b1 = *(const f32x4*)(bp + 4); }
                    const f32x4 v0 = b0 * alpha + acc[ai][bj][m][0], v1 = b1 * alpha + acc[ai][bj][m][1];
                    u32x4 w; w.x = cvt_pk_bf16(v0[0], v0[1]); w.y = cvt_pk_bf16(v0[2], v0[3]); w.z = cvt_pk_bf16(v1[0], v1[1]); w.w = cvt_pk_bf16(v1[2], v1[3]);
                    *(u32x4*)(out + row * 2048 + c) = w; }
            }
    }
};
struct EpiGateUp {
    static constexpr bool PERM = true, AFTER_DRAIN = false;
    bf16_t* O; int ldc;
    __device__ __forceinline__ void operator()(const f32x4 (&acc)[2][2][4][2], const Unit& u, int wr, int wc, int fr, int fq) const {
        const int row0 = u.pm * BM + wr * 64 + fr;
        const int cl = wc * 32 + 8 * fq;
#pragma unroll
        for (int ai = 0; ai < 2; ++ai)
#pragma unroll
            for (int m = 0; m < 4; ++m) {
                const size_t row = (size_t)(row0 + ai * HALF + m * 16);
                float o[8];
#pragma unroll
                for (int n = 0; n < 2; ++n) { const f32x4 g = acc[ai][0][m][n], up = acc[ai][1][m][n];
#pragma unroll
                    for (int e = 0; e < 4; ++e) o[n * 4 + e] = g[e] * sigm(g[e]) * up[e]; }
                u32x4 w; w.x = cvt_pk_bf16(o[0], o[1]); w.y = cvt_pk_bf16(o[2], o[3]); w.z = cvt_pk_bf16(o[4], o[5]); w.w = cvt_pk_bf16(o[6], o[7]);
                *(u32x4*)(O + row * ldc + u.pn * HALF + cl) = w;
            }
    }
};

template <class Epi, class Sched, bool ALIGN_EPI = false, bool SP2 = false>
__device__ __forceinline__ void gemm_phase(PG8_LAS unsigned char* lds, const Gemm g, const Sched& S, const Epi& E) {
    int tid_ = threadIdx.x; asm volatile("" : "+v"(tid_));
    const int tid = tid_, wid = __builtin_amdgcn_readfirstlane(tid >> 6), lane = tid & 63, wr = wid >> 2, wc = wid & 3, fr = lane & 15, fq = lane >> 4;
    const int K = g.K;
    unsigned voffA[2], voffB[2];
#pragma unroll
    for (int i = 0; i < 2; ++i) { int R, C; stage_rc(tid * 16 + i * 8192, R, C); const int Rb = Epi::PERM ? ((R & ~31) + perm32(R & 31)) : R;
        voffA[i] = (unsigned)(R * K + C) * 2u; voffB[i] = (unsigned)(Rb * K + C) * 2u; }
    const size_t kstep = (size_t)(BK * 2);
    const size_t hstep = (size_t)HALF * K * 2;
    const size_t tstep = 2 * hstep;
    const unsigned ldsw = (unsigned)wid * 1024u;
    const int aoff = lds_byte(wr * 64 + fr, fq * 8), boff = lds_byte(wc * 32 + fr, fq * 8);
#define PG8_SA(b, h) (((b) * 2 + (h)) * HTB)
#define PG8_SB(b, h) ((4 + (b) * 2 + (h)) * HTB)
#define PG8_STAGE(bufoff, gbase, voff) do { _Pragma("unroll") for (int _i = 0; _i < 2; ++_i) \
        __builtin_amdgcn_global_load_lds((const unsigned*)((const char*)(gbase) + (voff)[_i]), (PG8_LAS unsigned*)(lds + (bufoff) + ldsw + _i * 8192), 16, 0, 0); } while (0)
#define PG8_LDA(dst, b, h) do { _Pragma("unroll") for (int m = 0; m < 4; ++m) _Pragma("unroll") for (int k = 0; k < 2; ++k) dst[m][k] = *(const PG8_LAS bf16x8*)(lds + PG8_SA(b, h) + aoff + m * 2048 + k * 1024); } while (0)
#define PG8_LDB(dst, b, h) do { _Pragma("unroll") for (int n = 0; n < 2; ++n) _Pragma("unroll") for (int k = 0; k < 2; ++k) dst[n][k] = *(const PG8_LAS bf16x8*)(lds + PG8_SB(b, h) + boff + n * 2048 + k * 1024); } while (0)
#define PG8_MMA(ai, bj, At, Bt) do { __builtin_amdgcn_s_setprio(1); _Pragma("unroll") for (int m = 0; m < 4; ++m) _Pragma("unroll") for (int n = 0; n < 2; ++n) _Pragma("unroll") for (int k = 0; k < 2; ++k) \
        acc[ai][bj][m][n] = __builtin_amdgcn_mfma_f32_16x16x32_bf16(Bt[n][k], At[m][k], acc[ai][bj][m][n], 0, 0, 0); __builtin_amdgcn_s_setprio(0); } while (0)
#define PG8_WAIT_V(n) asm volatile("s_waitcnt vmcnt(" #n ")" ::: "memory")
#define PG8_WAIT_L(n) asm volatile("s_waitcnt lgkmcnt(" #n ")" ::: "memory")
#define PG8_BAR __builtin_amdgcn_s_barrier()
#define PG8_SCHED __builtin_amdgcn_sched_barrier(0)
    Unit cur, nxt; int ui = 0;
    if (!S.next(0, cur)) return;
    f32x4 acc[2][2][4][2];
#pragma unroll
    for (int a = 0; a < 2; ++a)
#pragma unroll
        for (int b = 0; b < 2; ++b)
#pragma unroll
            for (int m = 0; m < 4; ++m)
#pragma unroll
                for (int n = 0; n < 2; ++n) acc[a][b][m][n] = (f32x4){0.f, 0.f, 0.f, 0.f};
    bf16x8 At[4][2], B0[2][2], B1[2][2];
    const char* cA = (const char*)g.A + (size_t)cur.pm * tstep + (size_t)cur.kt0 * kstep; const char* cB = (const char*)g.Bt + (size_t)cur.pn * tstep + (size_t)cur.kt0 * kstep;
    S.a_ready(cur);
    if constexpr (SP2) {
        PG8_STAGE(PG8_SB(0, 0), cB, voffB); PG8_STAGE(PG8_SB(0, 1), cB + hstep, voffB); PG8_STAGE(PG8_SA(0, 0), cA, voffA); PG8_STAGE(PG8_SA(0, 1), cA + hstep, voffA);
        if (wr == 1) PG8_BAR;
        PG8_WAIT_V(2); PG8_BAR;
        PG8_STAGE(PG8_SB(1, 0), cB + kstep, voffB); PG8_STAGE(PG8_SA(1, 0), cA + kstep, voffA); PG8_STAGE(PG8_SB(1, 1), cB + hstep + kstep, voffB);
        PG8_WAIT_V(6); PG8_BAR;
    } else {
        PG8_STAGE(PG8_SB(0, 0), cB, voffB); PG8_STAGE(PG8_SA(0, 0), cA, voffA); PG8_STAGE(PG8_SB(0, 1), cB + hstep, voffB); PG8_STAGE(PG8_SA(0, 1), cA + hstep, voffA);
        if (wr == 1) PG8_BAR;
        PG8_WAIT_V(4); PG8_BAR;
        PG8_STAGE(PG8_SB(1, 0), cB + kstep, voffB); PG8_STAGE(PG8_SA(1, 0), cA + kstep, voffA); PG8_STAGE(PG8_SB(1, 1), cB + hstep + kstep, voffB);
        PG8_WAIT_V(6); PG8_BAR;
    }
    for (;;) {
        const bool has_next = S.next(ui + 1, nxt);
        const char* nA = has_next ? (const char*)g.A + (size_t)nxt.pm * tstep + (size_t)nxt.kt0 * kstep : cA; const char* nB = has_next ? (const char*)g.Bt + (size_t)nxt.pn * tstep + (size_t)nxt.kt0 * kstep : cB;
        const int nt = cur.nkt;
        for (int t = 0; t < nt; t += 2) {
            const bool last = (t == nt - 2);
            const char* a1 = cA + (size_t)(t + 1) * kstep;
            const char* a2 = last ? nA : cA + (size_t)(t + 2) * kstep; const char* b2 = last ? nB : cB + (size_t)(t + 2) * kstep;
            const char* a3 = a2 + kstep; const char* b3 = b2 + kstep;
            if (last && has_next) S.a_ready(nxt);
            if constexpr (SP2) {
            PG8_LDB(B0, 0, 0); PG8_LDB(B1, 0, 1); PG8_SCHED; PG8_LDA(At, 0, 0); PG8_STAGE(PG8_SA(1, 1), a1 + hstep, voffA);
            PG8_WAIT_V(8); PG8_WAIT_L(0); PG8_BAR; PG8_MMA(0, 0, At, B0); PG8_MMA(0, 1, At, B1); PG8_BAR; PG8_SCHED;
            PG8_LDA(At, 0, 1); PG8_STAGE(PG8_SB(0, 0), b2, voffB); PG8_STAGE(PG8_SB(0, 1), b2 + hstep, voffB); PG8_STAGE(PG8_SA(0, 0), a2, voffA);
            PG8_WAIT_V(8); PG8_WAIT_L(0); PG8_BAR; PG8_MMA(1, 0, At, B0); PG8_MMA(1, 1, At, B1); PG8_BAR; PG8_SCHED;
            PG8_LDB(B0, 1, 0); PG8_LDB(B1, 1, 1); PG8_SCHED; PG8_LDA(At, 1, 0); PG8_STAGE(PG8_SA(0, 1), a2 + hstep, voffA);
            PG8_WAIT_V(8); PG8_WAIT_L(0); PG8_BAR; PG8_MMA(0, 0, At, B0); PG8_MMA(0, 1, At, B1); PG8_BAR; PG8_SCHED;
            PG8_LDA(At, 1, 1); PG8_STAGE(PG8_SB(1, 0), b3, voffB); PG8_STAGE(PG8_SB(1, 1), b3 + hstep, voffB); PG8_STAGE(PG8_SA(1, 0), a3, voffA);
            PG8_WAIT_V(8); PG8_WAIT_L(0); PG8_BAR; PG8_MMA(1, 0, At, B0); PG8_MMA(1, 1, At, B1); PG8_BAR; PG8_SCHED;
            } else {
            PG8_LDB(B0, 0, 0); PG8_SCHED; PG8_LDA(At, 0, 0); PG8_STAGE(PG8_SA(1, 1), a1 + hstep, voffA);
            PG8_WAIT_L(8); PG8_BAR; PG8_WAIT_L(0); PG8_MMA(0, 0, At, B0); PG8_BAR; PG8_SCHED;
            PG8_LDB(B1, 0, 1); PG8_STAGE(PG8_SB(0, 0), b2, voffB);
            PG8_BAR; PG8_WAIT_L(0); PG8_MMA(0, 1, At, B1); PG8_BAR;
            PG8_LDA(At, 0, 1); PG8_STAGE(PG8_SA(0, 0), a2, voffA);
            PG8_BAR; PG8_WAIT_L(0); PG8_MMA(1, 0, At, B0); PG8_BAR; PG8_SCHED;
            PG8_STAGE(PG8_SB(0, 1), b2 + hstep, voffB);
            PG8_WAIT_V(6); PG8_BAR; PG8_MMA(1, 1, At, B1); PG8_BAR;
            PG8_LDB(B0, 1, 0); PG8_SCHED; PG8_LDA(At, 1, 0); PG8_STAGE(PG8_SA(0, 1), a2 + hstep, voffA);
            PG8_WAIT_L(8); PG8_BAR; PG8_WAIT_L(0); PG8_MMA(0, 0, At, B0); PG8_BAR; PG8_SCHED;
            PG8_LDB(B1, 1, 1); PG8_STAGE(PG8_SB(1, 0), b3, voffB);
            PG8_BAR; PG8_WAIT_L(0); PG8_MMA(0, 1, At, B1); PG8_BAR;
            PG8_LDA(At, 1, 1); PG8_STAGE(PG8_SA(1, 0), a3, voffA);
            PG8_BAR; PG8_WAIT_L(0); PG8_MMA(1, 0, At, B0); PG8_BAR; PG8_SCHED;
            PG8_STAGE(PG8_SB(1, 1), b3 + hstep, voffB);
            PG8_WAIT_V(6); PG8_BAR; PG8_MMA(1, 1, At, B1); PG8_BAR;
            }
        }
        if constexpr (ALIGN_EPI) { if (wr == 0) PG8_BAR; }
        if constexpr (!Epi::AFTER_DRAIN) { E(acc, cur, wr, wc, fr, fq); S.done(cur); }
        if (!has_next) break;
#pragma unroll
        for (int a = 0; a < 2; ++a)
#pragma unroll
            for (int b = 0; b < 2; ++b)
#pragma unroll
                for (int m = 0; m < 4; ++m)
#pragma unroll
                    for (int n = 0; n < 2; ++n) acc[a][b][m][n] = (f32x4){0.f, 0.f, 0.f, 0.f};
        cur = nxt; cA = nA; cB = nB; ++ui;
        if constexpr (ALIGN_EPI) { if (wr == 1) PG8_BAR; }
    }
    PG8_WAIT_V(0);
    if constexpr (!ALIGN_EPI) { if (wr == 0) PG8_BAR; }
    PG8_BAR;
#undef PG8_SA
#undef PG8_SB
#undef PG8_STAGE
#undef PG8_LDA
#undef PG8_LDB
#undef PG8_MMA
#undef PG8_WAIT_V
#undef PG8_WAIT_L
#undef PG8_BAR
#undef PG8_SCHED
}
}

constexpr int D = 2048, MP = 8192, MS = 512, M = MP + MS, CW = 1024, NH = 8, HD = 128, FF = 5632, NIN = 6144;
constexpr float LN_EPS = 1e-5f;
constexpr float ALPHA = 1.189207115002721f;
constexpr int NWAVES = 8;
constexpr int LDS_BYTES = 147456;
constexpr int N_PHASES = 10;

constexpr size_t MiB = 1u << 20;
constexpr size_t WS_LB = 64 * 1024, WS_BIASP = 128 * 1024;
constexpr size_t WS_WIN = 1 * MiB, WS_WOUT = 25 * MiB, WS_WGU = 33 * MiB, WS_WDN = 77 * MiB;
constexpr size_t WS_XB = 99 * MiB, WS_MIX = 133 * MiB;
constexpr size_t WS_U = 167 * MiB, WS_Q = 184 * MiB, WS_I = 201 * MiB, WS_G = 218 * MiB, WS_F = 235 * MiB, WS_END = 269 * MiB;
constexpr size_t WS_ACT = 167 * MiB;
constexpr int SPLIT5 = 4, SPLIT8 = 11;
constexpr int W_DN_SPLIT = 44 * 64;
constexpr size_t WS_PB5 = 167 * MiB;
constexpr size_t WS_PB8 = 33 * MiB;
static_assert(WS_PB8 + (size_t)SPLIT8 * 512 * 2048 * 4 <= 77 * MiB && (32 % SPLIT5) == 0 && (88 % SPLIT8) == 0 && (32 / SPLIT5) % 2 == 0 && (88 / SPLIT8) % 2 == 0 && 32 / SPLIT5 >= 4 && 88 / SPLIT8 >= 4, "split-K layout");
static_assert(WS_ACT + (size_t)M * FF * 2 <= WS_END, "act overlay");
constexpr size_t O_Y = 0, O_NCP = (size_t)M * D, O_NHP = O_NCP + 4 * 30 * 1024, O_NCS = O_NHP + 4 * 8 * 128 * 128, O_NHS = O_NCS + 32 * 30 * 1024;
constexpr size_t O_ST = 0, O_DC = (size_t)1024 * 16384;

#define LAS __attribute__((address_space(3)))
typedef unsigned short bf16;
typedef float f32x4 __attribute__((ext_vector_type(4)));
typedef float f32x2 __attribute__((ext_vector_type(2)));
typedef unsigned v4u __attribute__((ext_vector_type(4)));
typedef unsigned v2u __attribute__((ext_vector_type(2)));
typedef float f32x16 __attribute__((ext_vector_type(16)));
typedef unsigned u32x8 __attribute__((ext_vector_type(8)));
#define CAS __attribute__((address_space(4)))
#define LDS_WAIT() asm volatile("s_waitcnt lgkmcnt(0)" ::: "memory")

__device__ __forceinline__ unsigned f2bf(float f) { unsigned u = __builtin_bit_cast(unsigned, f); return (u + 0x7fffu + ((u >> 16) & 1u)) >> 16; }
__device__ __forceinline__ unsigned pk2(float lo, float hi) { return f2bf(lo) | (f2bf(hi) << 16); }
__device__ __forceinline__ bf16 bfr(float x) { return (bf16)(pg8::cvt_pk_bf16(x, 0.f) & 0xffffu); }
__device__ __forceinline__ float bf2f(unsigned short b) { return __uint_as_float((unsigned)b << 16); }
__device__ __forceinline__ float sigm(float x) { return __builtin_amdgcn_rcpf(1.0f + __expf(-x)); }
__device__ __forceinline__ float wave_sum(float v) {
#pragma unroll
    for (int o = 1; o < 64; o <<= 1) v += __shfl_xor(v, o);
    return v;
}

__device__ __forceinline__ void transpose_item(const float* W, int K, int N, bf16* WT, int k0, int n0, int dst_row0, LAS float* scr, int lane) {
    { f32x4 v[8];
      const int kq = lane >> 3, n4 = (lane & 7) * 4;
#pragma unroll
      for (int i = 0; i < 8; ++i) v[i] = *(const f32x4*)(W + (size_t)(k0 + 8 * i + kq) * N + n0 + n4);
#pragma unroll
      for (int i = 0; i < 8; ++i) { LAS float* d = scr + (8 * i + kq) * 33 + n4; d[0] = v[i].x; d[1] = v[i].y; d[2] = v[i].z; d[3] = v[i].w; } }
    LDS_WAIT(); asm volatile("" ::: "memory");
    const int c = lane & 7;
#pragma unroll
    for (int j = 0; j < 4; ++j) { const int n = (lane >> 3) + 8 * j; const LAS float* s = scr + (8 * c) * 33 + n;
        v4u o; o.x = pk2(s[0 * 33], s[1 * 33]); o.y = pk2(s[2 * 33], s[3 * 33]); o.z = pk2(s[4 * 33], s[5 * 33]); o.w = pk2(s[6 * 33], s[7 * 33]);
        *(v4u*)(WT + (size_t)(dst_row0 + n) * K + k0 + 8 * c) = o; }
    LDS_WAIT(); asm volatile("" ::: "memory");
}

template <int KIND> __device__ __forceinline__ void transpose_stream(const float* W, int K, int N, bf16* WT, int first, int end, int stride, LAS float* scr, int lane) {
    const int nblk = N / 32, kq = lane >> 3, n4 = (lane & 7) * 4, c = lane & 7;
    f32x4 v[8];
    if (first < end) { const int kb = first / nblk, nb = first % nblk;
#pragma unroll
        for (int i = 0; i < 8; ++i) v[i] = __builtin_nontemporal_load((const f32x4*)(W + (size_t)(64 * kb + 8 * i + kq) * N + 32 * nb + n4)); }
    for (int it = first; it < end; it += stride) {
        const int kb = it / nblk, nb = it % nblk, k0 = 64 * kb, n0 = 32 * nb;
        int dst;
        if (KIND == 1) dst = n0 < 2048 ? ((n0 & 1023) >> 7) * 256 + (n0 >> 10) * 128 + (n0 & 127) : n0;
        else if (KIND == 2) dst = (n0 >> 7) * 256 + (n0 & 127);
        else if (KIND == 3) dst = (n0 >> 7) * 256 + 128 + (n0 & 127);
        else dst = n0;
#pragma unroll
        for (int i = 0; i < 8; ++i) { LAS float* d = scr + (8 * i + kq) * 33 + n4; d[0] = v[i].x; d[1] = v[i].y; d[2] = v[i].z; d[3] = v[i].w; }
        { const int nx = it + stride;
          if (nx < end) { const int kb2 = nx / nblk, nb2 = nx % nblk;
#pragma unroll
              for (int i = 0; i < 8; ++i) v[i] = __builtin_nontemporal_load((const f32x4*)(W + (size_t)(64 * kb2 + 8 * i + kq) * N + 32 * nb2 + n4)); } }
        LDS_WAIT(); asm volatile("" ::: "memory");
#pragma unroll
        for (int j = 0; j < 4; ++j) { const int n = (lane >> 3) + 8 * j; const LAS float* sp = scr + (8 * c) * 33 + n;
            v4u o; o.x = pg8::cvt_pk_bf16(sp[0 * 33], sp[1 * 33]); o.y = pg8::cvt_pk_bf16(sp[2 * 33], sp[3 * 33]); o.z = pg8::cvt_pk_bf16(sp[4 * 33], sp[5 * 33]); o.w = pg8::cvt_pk_bf16(sp[6 * 33], sp[7 * 33]);
            *(v4u*)(WT + (size_t)(dst + n) * K + k0 + 8 * c) = o; }
        LDS_WAIT(); asm volatile("" ::: "memory");
    }
}

template <bool SRC_BF16, int NP> __device__ __forceinline__ void ln_row(const void* src, const bf16* part, size_t pstride, float alpha, float* dstf, bf16* dstb, const float* g, const float* b, int lane) {
    f32x4 v[8]; float s = 0.f;
    if constexpr (SRC_BF16) {
#pragma unroll
        for (int j = 0; j < 8; ++j) { const v2u w = ((const v2u*)src)[lane + 64 * j]; v[j] = (f32x4){__uint_as_float(w.x << 16), __uint_as_float(w.x & 0xffff0000u), __uint_as_float(w.y << 16), __uint_as_float(w.y & 0xffff0000u)}; }
    } else {
#pragma unroll
        for (int j = 0; j < 8; ++j) v[j] = __builtin_nontemporal_load((const f32x4*)src + lane + 64 * j);
    }
    if constexpr (NP > 0) {
#pragma unroll
        for (int j = 0; j < 8; ++j) v[j] = v[j] * alpha;
#pragma unroll
        for (int p0 = 0; p0 < NP; p0 += 4) {
            v2u w[4][8];
#pragma unroll
            for (int pp = 0; pp < 4; ++pp) if (p0 + pp < NP) { const v2u* pr = (const v2u*)(part + (size_t)(p0 + pp) * pstride) + lane;
#pragma unroll
                for (int j = 0; j < 8; ++j) w[pp][j] = __builtin_nontemporal_load(pr + 64 * j); }
#pragma unroll
            for (int pp = 0; pp < 4; ++pp) if (p0 + pp < NP) {
#pragma unroll
                for (int j = 0; j < 8; ++j) v[j] += (f32x4){__uint_as_float(w[pp][j].x << 16), __uint_as_float(w[pp][j].x & 0xffff0000u), __uint_as_float(w[pp][j].y << 16), __uint_as_float(w[pp][j].y & 0xffff0000u)}; }
        }
    }
#pragma unroll
    for (int j = 0; j < 8; ++j) s += (v[j].x + v[j].y) + (v[j].z + v[j].w);
    const float mean = wave_sum(s) * (1.f / D); float s2 = 0.f;
#pragma unroll
    for (int j = 0; j < 8; ++j) { v[j] = v[j] - mean; s2 += (v[j].x * v[j].x + v[j].y * v[j].y) + (v[j].z * v[j].z + v[j].w * v[j].w); }
    const float rstd = 1.f / sqrtf(wave_sum(s2) * (1.f / D) + LN_EPS);
#pragma unroll
    for (int j = 0; j < 8; ++j) {
        const f32x4 gg = ((const f32x4*)g)[lane + 64 * j], bb = ((const f32x4*)b)[lane + 64 * j];
        const f32x4 o = v[j] * rstd * gg + bb;
        if (dstf) __builtin_nontemporal_store(o, (f32x4*)dstf + lane + 64 * j);
        if (dstb) { v2u w; w.x = pk2(o.x, o.y); w.y = pk2(o.z, o.w); ((v2u*)dstb)[lane + 64 * j] = w; }
    }
}

__device__ __forceinline__ void ln_core(f32x4 (&v)[8], const f32x4 (&gg)[8], const f32x4 (&bb)[8], float* dstf, bf16* dstb, int lane) {
    float s = 0.f;
#pragma unroll
    for (int j = 0; j < 8; ++j) s += (v[j].x + v[j].y) + (v[j].z + v[j].w);
    const float mean = wave_sum(s) * (1.f / D); float s2 = 0.f;
#pragma unroll
    for (int j = 0; j < 8; ++j) { v[j] = v[j] - mean; s2 += (v[j].x * v[j].x + v[j].y * v[j].y) + (v[j].z * v[j].z + v[j].w * v[j].w); }
    const float rstd = 1.f / sqrtf(wave_sum(s2) * (1.f / D) + LN_EPS);
#pragma unroll
    for (int j = 0; j < 8; ++j) {
        const f32x4 o = v[j] * rstd * gg[j] + bb[j];
        if (dstf) __builtin_nontemporal_store(o, (f32x4*)dstf + lane + 64 * j);
        if (dstb) { v2u w; w.x = pk2(o.x, o.y); w.y = pk2(o.z, o.w); ((v2u*)dstb)[lane + 64 * j] = w; }
    }
}
__device__ __forceinline__ void ln_rows_bf16(const bf16* src, float* dstf, bf16* dstb, const float* g, const float* b, int gw, int NGW, int nrows, int lane) {
    f32x4 gg[8], bb[8];
#pragma unroll
    for (int j = 0; j < 8; ++j) { gg[j] = ((const f32x4*)g)[lane + 64 * j]; bb[j] = ((const f32x4*)b)[lane + 64 * j]; }
    v2u cur[8];
    if (gw < nrows) {
#pragma unroll
        for (int j = 0; j < 8; ++j) cur[j] = __builtin_nontemporal_load((const v2u*)(src + (size_t)gw * D) + lane + 64 * j);
    }
    for (int m = gw; m < nrows; m += NGW) {
        v2u nxt[8];
        const bool hn = m + NGW < nrows;
        if (hn) {
#pragma unroll
            for (int j = 0; j < 8; ++j) nxt[j] = __builtin_nontemporal_load((const v2u*)(src + (size_t)(m + NGW) * D) + lane + 64 * j);
        }
        f32x4 v[8];
#pragma unroll
        for (int j = 0; j < 8; ++j) v[j] = (f32x4){__uint_as_float(cur[j].x << 16), __uint_as_float(cur[j].x & 0xffff0000u), __uint_as_float(cur[j].y << 16), __uint_as_float(cur[j].y & 0xffff0000u)};
        ln_core(v, gg, bb, dstf ? dstf + (size_t)m * D : nullptr, dstb ? dstb + (size_t)m * D : nullptr, lane);
        if (hn) {
#pragma unroll
            for (int j = 0; j < 8; ++j) cur[j] = nxt[j];
        }
    }
}

#define XB_TMO      128
#define XB_XCNT(j)  (256  + 64 * (j))
#define XB_XSUB(j)  (1280 + 64 * (j))
#define XB_XGEN(j)  (2304 + 64 * (j))
#define XB_TOP      3328
#define XB_TOPGEN   3392
#define XCD_BAR_WORDS 3456
#define XB_SPIN_CAP (1u << 18)
__device__ __forceinline__ unsigned xb_ld(unsigned* p)              { return __hip_atomic_load(p, __ATOMIC_RELAXED, __HIP_MEMORY_SCOPE_AGENT); }
__device__ __forceinline__ unsigned xb_add(unsigned* p, unsigned v) { return __hip_atomic_fetch_add(p, v, __ATOMIC_RELAXED, __HIP_MEMORY_SCOPE_AGENT); }
__device__ __forceinline__ unsigned xb_xcc_id() { return (unsigned)__builtin_amdgcn_s_getreg((3 << 11) | 20) & 0xFu; }
#define XB_SPIN(cond, bar) do { unsigned _sp = 0; while (cond) { __builtin_amdgcn_s_sleep(1); \
    if ((++_sp & 255u) == 0u) { if (xb_ld(&(bar)[XB_TMO])) break; if (_sp > XB_SPIN_CAP) { atomicAdd(&(bar)[XB_TMO], 1u); break; } } } } while (0)
struct XcdBarrier { unsigned* bar; unsigned x; volatile LAS unsigned* st; };
__device__ __forceinline__ XcdBarrier xcd_barrier_post(unsigned* bar, volatile LAS unsigned* st) {
    XcdBarrier b; b.bar = bar; b.x = xb_xcc_id(); b.st = st;
    if (threadIdx.x == 0) (void)xb_add(&bar[XB_XCNT(b.x)], 1u);
    return b;
}
__device__ __forceinline__ void xcd_barrier_complete(unsigned* bar, unsigned x, unsigned& nloc, unsigned& nx) {
    const unsigned G = gridDim.x * gridDim.y * gridDim.z;
    unsigned sum, cnt, mine, sp = 0u;
    for (;;) {
        sum = 0u; cnt = 0u; mine = 0u;
#pragma unroll
        for (unsigned j = 0; j < 16; ++j) { const unsigned c = xb_ld(&bar[XB_XCNT(j)]); sum += c; cnt += (c > 0u) ? 1u : 0u; mine = (j == x) ? c : mine; }
        if (sum == G) break;
        __builtin_amdgcn_s_sleep(1);
        if ((++sp & 255u) == 0u) { if (xb_ld(&bar[XB_TMO])) break; if (sp > XB_SPIN_CAP) { atomicAdd(&bar[XB_TMO], 1u); break; } }
    }
    nloc = mine > 0u ? mine : 1u; nx = cnt > 0u ? cnt : 1u;
}
__device__ __forceinline__ void xcd_barrier(const XcdBarrier& b) {
    asm volatile("s_waitcnt vmcnt(0)" ::: "memory");
    __syncthreads();
    if (threadIdx.x == 0) {
        unsigned* bar = b.bar;
        __builtin_amdgcn_s_waitcnt(0);
        unsigned nloc = b.st[0], nx = b.st[1];
        if (nloc == 0u) { xcd_barrier_complete(bar, b.x, nloc, nx); b.st[0] = nloc; b.st[1] = nx; }
        const unsigned old = xb_add(&bar[XB_XSUB(b.x)], 1u);
        const unsigned gen = old / nloc;
        if (old + 1u == (gen + 1u) * nloc) {
            __builtin_amdgcn_fence(__ATOMIC_RELEASE, "agent");
            asm volatile("s_waitcnt vmcnt(0)" ::: "memory");
            const unsigned og = xb_add(&bar[XB_TOP], 1u);
            const unsigned tg = og / nx;
            if (og + 1u == (tg + 1u) * nx) xb_add(&bar[XB_TOPGEN], 1u);
            else XB_SPIN(xb_ld(&bar[XB_TOPGEN]) == tg, bar);
            __builtin_amdgcn_fence(__ATOMIC_ACQUIRE, "agent");
            xb_add(&bar[XB_XGEN(b.x)], 1u);
            asm volatile("s_waitcnt vmcnt(0)" ::: "memory");
        } else {
            XB_SPIN(xb_ld(&bar[XB_XGEN(b.x)]) == gen, bar);
            __builtin_amdgcn_fence(__ATOMIC_ACQUIRE, "agent");
            asm volatile("s_waitcnt vmcnt(0)" ::: "memory");
        }
    }
    __syncthreads();
}

struct Args { const float* in[20]; float* out; unsigned char* ws; int ph_lo, ph_hi; };

__global__ void __launch_bounds__(NWAVES * 64, 2) fwd_kernel(Args args) {
    extern __shared__ __attribute__((aligned(16))) unsigned char lds_raw[];
    LAS unsigned char* lds = (LAS unsigned char*)lds_raw;
    const int tid = threadIdx.x, lane = tid & 63, wave = __builtin_amdgcn_readfirstlane(tid >> 6);
    const int G = gridDim.x, bx = blockIdx.x;
    const int gt = bx * 512 + tid, NT = G * 512;
    const int gw = bx * NWAVES + wave, NGW = G * NWAVES;

#define x_prompt (args.in[0])
#define x_sample (args.in[1])
#define cache_conv (args.in[2])
#define state_hgrn (args.in[3])
#define w_in (args.in[4])
#define b_in (args.in[5])
#define w_dw (args.in[6])
#define b_dw (args.in[7])
#define cn_g (args.in[8])
#define cn_b (args.in[9])
#define hlb (args.in[10])
#define hg_ng (args.in[11])
#define w_out (args.in[12])
#define ln1_g (args.in[13])
#define ln1_b (args.in[14])
#define w_gate (args.in[15])
#define w_up (args.in[16])
#define w_down (args.in[17])
#define ln2_g (args.in[18])
#define ln2_b (args.in[19])
#define out (args.out)
#define ws (args.ws)
#define LB ((float*)(ws + WS_LB))
#define BIASP ((float*)(ws + WS_BIASP))
#define WIN ((bf16*)(ws + WS_WIN))
#define WOUT ((bf16*)(ws + WS_WOUT))
#define WGU ((bf16*)(ws + WS_WGU))
#define WDN ((bf16*)(ws + WS_WDN))
#define XB ((bf16*)(ws + WS_XB))
#define MIX ((bf16*)(ws + WS_MIX))
#define U ((bf16*)(ws + WS_U))
#define Q ((bf16*)(ws + WS_Q))
#define F ((float*)(ws + WS_F))
#define I ((bf16*)(ws + WS_I))
#define Gt ((bf16*)(ws + WS_G))
#define ACT ((bf16*)(ws + WS_ACT))
#define ST (out + O_ST)
#define DC (out + O_DC)

    const int lo = args.ph_lo, hi = args.ph_hi;
    volatile LAS unsigned* MISC = (volatile LAS unsigned*)(lds + LDS_BYTES - 64);
    if (tid < 16) MISC[tid] = 0u;
    __syncthreads();
    XcdBarrier xbar = xcd_barrier_post((unsigned*)ws, MISC + 8);
#ifndef PH_MASK
#define PH_MASK 0x3ff
#endif
#define IN(k) (((PH_MASK >> (k)) & 1) && lo <= (k) && (k) < hi)
#ifndef REP_MASK
#define REP_MASK 0
#endif
#define NREP(k) (1 + ((REP_MASK >> (k)) & 1))
#ifdef TS_A
    unsigned long long ts_a = 0, ts_b = 0;
#define STAMP(k) do { if ((k) == TS_A) ts_a = __builtin_amdgcn_s_memrealtime(); if ((k) == TS_B) ts_b = __builtin_amdgcn_s_memrealtime(); } while (0)
#else
#define STAMP(k) do { } while (0)
#endif
#define SEAM(k) do { if (IN(k) && IN((k) + 1)) { xcd_barrier(xbar); } STAMP((k) + 1); } while (0)
    STAMP(0);
    if (hi > 1000) cg::this_grid().sync();

    if (IN(0)) for (int rep_ = 0; rep_ < NREP(0); ++rep_) { if (rep_) xcd_barrier(xbar);
        LAS float* scr = (LAS float*)(lds + wave * 16384);
        constexpr int I_IN = 32 * 192;
        transpose_stream<1>(w_in, D, NIN, WIN, gw, I_IN, NGW, scr, lane);
        constexpr int NV = M * D / 8, NVP = MP * D / 8;
#pragma unroll 4
        for (int i = gt; i < NV; i += NT) {
            const float* src = i < NVP ? x_prompt + (size_t)i * 8 : x_sample + (size_t)(i - NVP) * 8;
            const f32x4 a = __builtin_nontemporal_load((const f32x4*)src), b = __builtin_nontemporal_load((const f32x4*)(src + 4));
            v4u o; o.x = pk2(a.x, a.y); o.y = pk2(a.z, a.w); o.z = pk2(b.x, b.y); o.w = pk2(b.z, b.w);
            *(v4u*)(XB + (size_t)i * 8) = o;
        }
        for (int i = gt; i < 1024; i += NT) LB[i] = sigm(hlb[i] - hlb[1024 + i]);
        for (int i = gt; i < NIN; i += NT) { const int orig = i < 2048 ? ((i & 255) >> 7) * 1024 + (i >> 8) * 128 + (i & 127) : i; BIASP[i] = b_in[orig]; }
    }
    SEAM(0);
#ifdef EXTRA_SYNCS
    for (int i_ = 0; i_ < EXTRA_SYNCS; ++i_) cg::this_grid().sync();
#endif

    if (IN(1)) for (int rep_ = 0; rep_ < NREP(1); ++rep_) { if (rep_) xcd_barrier(xbar);
        pg8::Gemm g{XB, WIN, M, NIN, D}; pg8::StaticOrder S; S.init(M, NIN, D, G, bx);
        pg8::EpiProj E{U, Q, F, BIASP, LB};
        pg8::gemm_phase<pg8::EpiProj, pg8::StaticOrder, true, true>(lds, g, S, E);
        const int nlast = S.nitems % G;
        if (nlast > 0 && bx >= nlast) {
            LAS float* scr = (LAS float*)(lds + wave * 16384);
            constexpr int I_OUT = 32 * 64, I_G = 32 * 176, I_DN = 88 * 64;
            const int gw2 = (bx - nlast) * NWAVES + wave, NGW2 = (G - nlast) * NWAVES;
            transpose_stream<0>(w_out, D, D, WOUT, gw2, I_OUT, NGW2, scr, lane);
            transpose_stream<2>(w_gate, D, FF, WGU, gw2, I_G, NGW2, scr, lane);
            transpose_stream<3>(w_up, D, FF, WGU, gw2, I_G, NGW2, scr, lane);
        }
    }
    SEAM(1);

    if (IN(2)) for (int rep_ = 0; rep_ < NREP(2); ++rep_) { if (rep_) xcd_barrier(xbar);
#define LBAR2() do { asm volatile("s_waitcnt lgkmcnt(0)" ::: "memory"); __builtin_amdgcn_s_barrier(); asm volatile("" ::: "memory"); } while (0)
        float pf[16]; unsigned short pi[16];
#define P2_LOAD(IT) do { const int bh_ = (IT) >> 5, c_ = (IT) & 31, h_ = bh_ & 7, row0_ = (bh_ >> 3) * 2048 + c_ * 64; const int k_ = tid & 127, qtr_ = __builtin_amdgcn_readfirstlane(tid >> 7); \
            _Pragma("unroll") for (int s_ = 0; s_ < 16; ++s_) { const size_t gi = (size_t)(row0_ + qtr_ * 16 + s_) * 1024 + h_ * 128 + k_; pf[s_] = F[gi]; pi[s_] = I[gi]; } } while (0)
        if (bx < 1024) P2_LOAD(bx);
        for (int it = bx; it < 1024 + 544; it += G) {
#ifdef P2_PROBE
            if (rep_ == 1 && ((P2_PROBE == 1) == (it >= 1024))) continue;
#endif
            LBAR2();
            if (it == 1024 + bx) STAMP(20);
            if (it < 1024) {
                const int bh = it >> 5, c = it & 31, b = bh >> 3, h = bh & 7;
                const int row0 = b * 2048 + c * 64;
                LAS bf16* KEt = (LAS bf16*)lds;
                LAS bf16* Vt = (LAS bf16*)(lds + 18432);
                LAS float* Tq = (LAS float*)(lds + 36864);
                const int k = tid & 127, qtr = __builtin_amdgcn_readfirstlane(tid >> 7);
                float lf[16], kk[16]; unsigned short iv[16];
#pragma unroll
                for (int s_ = 0; s_ < 16; ++s_) { const float f = pf[s_]; lf[s_] = __builtin_amdgcn_logf(f); kk[s_] = 1.0f - f; iv[s_] = pi[s_]; }
                if (it + G < 1024) P2_LOAD(it + G);
                float run = 0.f; float suf[16];
#pragma unroll
                for (int s_ = 15; s_ >= 0; --s_) { suf[s_] = run; run += lf[s_]; }
                Tq[qtr * 128 + k] = run;
                { v4u w0, w1;
                  w0.x = iv[0] | ((unsigned)iv[1] << 16); w0.y = iv[2] | ((unsigned)iv[3] << 16); w0.z = iv[4] | ((unsigned)iv[5] << 16); w0.w = iv[6] | ((unsigned)iv[7] << 16);
                  w1.x = iv[8] | ((unsigned)iv[9] << 16); w1.y = iv[10] | ((unsigned)iv[11] << 16); w1.z = iv[12] | ((unsigned)iv[13] << 16); w1.w = iv[14] | ((unsigned)iv[15] << 16);
                  *(LAS v4u*)(Vt + k * 72 + qtr * 16) = w0; *(LAS v4u*)(Vt + k * 72 + qtr * 16 + 8) = w1; }
                LBAR2();
                float later = 0.f, total = 0.f;
#pragma unroll
                for (int q2 = 0; q2 < 4; ++q2) { const float tq = Tq[q2 * 128 + k]; total += tq; later += q2 > qtr ? tq : 0.f; }
                { float ke[16];
#pragma unroll
                  for (int s_ = 0; s_ < 16; ++s_) ke[s_] = kk[s_] * __builtin_amdgcn_exp2f(suf[s_] + later);
                  v4u w0, w1;
                  w0.x = pg8::cvt_pk_bf16(ke[0], ke[1]); w0.y = pg8::cvt_pk_bf16(ke[2], ke[3]); w0.z = pg8::cvt_pk_bf16(ke[4], ke[5]); w0.w = pg8::cvt_pk_bf16(ke[6], ke[7]);
                  w1.x = pg8::cvt_pk_bf16(ke[8], ke[9]); w1.y = pg8::cvt_pk_bf16(ke[10], ke[11]); w1.z = pg8::cvt_pk_bf16(ke[12], ke[13]); w1.w = pg8::cvt_pk_bf16(ke[14], ke[15]);
                  *(LAS v4u*)(KEt + k * 72 + qtr * 16) = w0; *(LAS v4u*)(KEt + k * 72 + qtr * 16 + 8) = w1; }
                if (qtr == 0) DC[it * 128 + k] = exp2f(total);
                LBAR2();
                { const int r = lane & 15, q = lane >> 4;
                  const pg8::bf16x8 a0 = *(const LAS pg8::bf16x8*)(Vt + (16 * wave + r) * 72 + 8 * q), a1 = *(const LAS pg8::bf16x8*)(Vt + (16 * wave + r) * 72 + 8 * q + 32);
                  float* sp = ST + (size_t)it * 16384 + (size_t)(16 * wave + 4 * q) * 128 + r;
#pragma unroll
                  for (int kt = 0; kt < 8; ++kt) {
                      const pg8::bf16x8 b0 = *(const LAS pg8::bf16x8*)(KEt + (16 * kt + r) * 72 + 8 * q), b1 = *(const LAS pg8::bf16x8*)(KEt + (16 * kt + r) * 72 + 8 * q + 32);
                      f32x4 acc = (f32x4){0.f, 0.f, 0.f, 0.f};
                      acc = __builtin_amdgcn_mfma_f32_16x16x32_bf16(a0, b0, acc, 0, 0, 0);
                      acc = __builtin_amdgcn_mfma_f32_16x16x32_bf16(a1, b1, acc, 0, 0, 0);
#pragma unroll
                      for (int j = 0; j < 4; ++j) sp[j * 128 + 16 * kt] = acc[j];
                  } }
            } else {
                const int m0 = (it - 1024) * 16;
                const bool samp = m0 >= MP;
                int t0, seq0; const float* hist = cache_conv;
                if (!samp) { t0 = m0 & 2047; seq0 = m0 - t0; }
                else { t0 = 0; seq0 = m0; hist = cache_conv + (size_t)((m0 - MP) >> 4) * 30 * 1024; }
                const int hrow0 = samp ? ((m0 - MP) >> 4) * 30 : 0;
                const __amdgpu_buffer_rsrc_t rU = __builtin_amdgcn_make_buffer_rsrc((void*)U, 0, M * 1024 * 2, 0x00020000);
                const __amdgpu_buffer_rsrc_t rH = __builtin_amdgcn_make_buffer_rsrc((void*)cache_conv, 0, 32 * 30 * 1024 * 4, 0x00020000);
                const __amdgpu_buffer_rsrc_t rW = __builtin_amdgcn_make_buffer_rsrc((void*)w_dw, 0, 31 * 1024 * 4, 0x00020000);
                const bool interior = t0 >= 30;
                LAS float* hbuf = (LAS float*)(lds + 16384);
                LAS f32x2* stat = (LAS f32x2*)(lds + 16384 + 65536);
                const int c = 2 * tid;
                f32x2 acc[16];
                { const f32x2 bb = *(const f32x2*)(b_dw + c);
#pragma unroll
                  for (int t = 0; t < 16; ++t) acc[t] = bb; }
#pragma unroll
                for (int ch = 0; ch < 2; ++ch) {
                    const int j0 = ch * 16, nj = ch ? 15 : 16;
                    f32x2 win[31];
                    if (interior) {
                        const int rb = (seq0 + t0 - 30 + j0) * 2048;
#pragma unroll
                        for (int xi = 0; xi < 31; ++xi) if (xi < nj + 15) { const unsigned pw = __builtin_amdgcn_raw_buffer_load_b32(rU, 4 * tid, rb + xi * 2048, 0); win[xi] = (f32x2){__uint_as_float(pw << 16), __uint_as_float(pw & 0xffff0000u)}; }
                    } else {
#pragma unroll
                        for (int xi = 0; xi < 31; ++xi) if (xi < nj + 15) {
                            const int tr = t0 - 30 + j0 + xi;
                            f32x2 wv = (f32x2){0.f, 0.f};
                            if (tr >= 0) { const unsigned pw = __builtin_amdgcn_raw_buffer_load_b32(rU, 4 * tid, (seq0 + tr) * 2048, 0); wv = (f32x2){__uint_as_float(pw << 16), __uint_as_float(pw & 0xffff0000u)}; }
                            else if (samp) { const v2u hv = __builtin_amdgcn_raw_buffer_load_b64(rH, 8 * tid, (hrow0 + 30 + tr) * 4096, 0); wv = (f32x2){__uint_as_float(hv.x), __uint_as_float(hv.y)}; }
                            win[xi] = wv;
                        }
                    }
#pragma unroll
                    for (int jj = 0; jj < 16; ++jj) if (jj < nj) { const v2u wu = __builtin_amdgcn_raw_buffer_load_b64(rW, 8 * tid, (j0 + jj) * 4096, 0); const f32x2 w2 = (f32x2){__uint_as_float(wu.x), __uint_as_float(wu.y)};
#pragma unroll
                        for (int t = 0; t < 16; ++t) acc[t] += w2 * win[t + jj]; }
                    asm volatile("" ::: "memory");
                }
#pragma unroll
                for (int t = 0; t < 16; ++t) *(LAS f32x2*)(hbuf + t * 1024 + c) = acc[t];
                __syncthreads();
#pragma unroll
                for (int tt = 0; tt < 2; ++tt) { const int t = 2 * wave + tt; float s1 = 0.f, s2 = 0.f;
#pragma unroll
                    for (int i = 0; i < 4; ++i) { const f32x4 x = *(const LAS f32x4*)(hbuf + t * 1024 + 4 * lane + 256 * i); s1 += (x.x + x.y) + (x.z + x.w); s2 += (x.x * x.x + x.y * x.y) + (x.z * x.z + x.w * x.w); }
                    s1 = wave_sum(s1); s2 = wave_sum(s2);
                    const float mu = s1 * (1.f / 1024.f); float var = s2 * (1.f / 1024.f) - mu * mu; var = var > 0.f ? var : 0.f;
                    if (lane == 0) stat[t] = (f32x2){mu, 1.f / sqrtf(var + LN_EPS)}; }
                __syncthreads();
                const f32x2 gg = *(const f32x2*)(cn_g + c), bb2 = *(const f32x2*)(cn_b + c);
#pragma unroll
                for (int t = 0; t < 16; ++t) {
                    const f32x2 st2 = stat[t];
                    float y0 = (acc[t].x - st2.x) * st2.y * gg.x + bb2.x, y1 = (acc[t].y - st2.x) * st2.y * gg.y + bb2.y;
                    y0 = y0 * sigm(y0); y1 = y1 * sigm(y1);
                    *(unsigned*)(MIX + (size_t)(m0 + t) * 2048 + c) = pk2(y0, y1);
                }
            }
        }
        STAMP(21);
        { const int nx = (1024 + 544) % G;
          const int first = (nx > 0 && nx < G) ? nx : 0, nwg = G - first;
          if (bx >= first) {
              const int gt2 = (bx - first) * 512 + tid, NT2 = nwg * 512;
              for (int i = gt2; i < 4 * 30 * 1024; i += NT2) { const int b = i / 30720, j = (i >> 10) % 30, c = i & 1023;
                  __builtin_nontemporal_store(bf2f(U[(size_t)(b * 2048 + 2018 + j) * 1024 + c]), out + O_NCP + i); }
              for (int i = gt2; i < 32 * 30 * 1024; i += NT2) { const int sb = i / 30720, j = (i >> 10) % 30, c = i & 1023;
                  __builtin_nontemporal_store(j < 14 ? cache_conv[(size_t)sb * 30720 + (16 + j) * 1024 + c] : bf2f(U[(size_t)(MP + sb * 16 + j - 14) * 1024 + c]), out + O_NCS + i); }
          } }
    }
    SEAM(2);

    if (IN(3)) {
        for (int e = gt; e < 32 * 4096; e += NT) {
            const int bh = e >> 12, r = e & 4095, v = r >> 5, k4 = r & 31;
            f32x4 S = (f32x4){0.f, 0.f, 0.f, 0.f};
#pragma unroll 8
            for (int c = 0; c < 32; ++c) {
                f32x4* p = (f32x4*)(ST + ((size_t)(bh * 32 + c) * 128 + v) * 128 + k4 * 4);
                const f32x4 A = __builtin_nontemporal_load(p); const f32x4 d = *(const f32x4*)(DC + (bh * 32 + c) * 128 + k4 * 4);
                *p = S; S = S * d + A;
            }
            float* o = out + O_NHP + (size_t)bh * 16384 + (size_t)(k4 * 4) * 128 + v;
            __builtin_nontemporal_store(S.x, o); __builtin_nontemporal_store(S.y, o + 128); __builtin_nontemporal_store(S.z, o + 256); __builtin_nontemporal_store(S.w, o + 384);
        }
    }
    SEAM(3);

    if (IN(4)) for (int rep_ = 0; rep_ < NREP(4); ++rep_) { if (rep_) xcd_barrier(xbar);
        LAS float* vl = (LAS float*)lds; LAS float* red = (LAS float*)(lds + 8192);
        LAS float* fl2 = (LAS float*)(lds + 73728); LAS float* ql2 = (LAS float*)(lds + 81920);
#define LBAR() do { asm volatile("s_waitcnt lgkmcnt(0)" ::: "memory"); __builtin_amdgcn_s_barrier(); asm volatile("" ::: "memory"); } while (0)
        float fr[16]; unsigned short qh[16], ih[16]; unsigned gq[8]; f32x4 sv[8];
#define P4_LOAD(IT) do { const int bh_ = (IT) >> 5, c_ = (IT) & 31, h_ = bh_ & 7, row0_ = (bh_ >> 3) * 2048 + c_ * 64; const int k_ = tid & 127, qtr_ = __builtin_amdgcn_readfirstlane(tid >> 7); \
            _Pragma("unroll") for (int s_ = 0; s_ < 16; ++s_) { const size_t gi = (size_t)(row0_ + qtr_ * 16 + s_) * 1024 + h_ * 128 + k_; fr[s_] = __builtin_nontemporal_load(F + gi); qh[s_] = __builtin_nontemporal_load(Q + gi); ih[s_] = __builtin_nontemporal_load(I + gi); } \
            _Pragma("unroll") for (int j = 0; j < 8; ++j) sv[j] = __builtin_nontemporal_load((const f32x4*)(ST + (size_t)(IT) * 16384 + (size_t)(tid + 512 * j) * 4)); \
            _Pragma("unroll") for (int tt = 0; tt < 8; ++tt) { const size_t m = (size_t)(row0_ + wave * 8 + tt); gq[tt] = __builtin_nontemporal_load((const unsigned*)(Gt + m * 1024 + h_ * 128 + 2 * lane)); } } while (0)
        if (bx < 1024) P4_LOAD(bx);
        float ng0 = hg_ng[2 * lane], ng1 = hg_ng[2 * lane + 1];
        asm volatile("" : "+v"(ng0), "+v"(ng1));
        for (int it = bx; it < 1024; it += G) {
          {
            const int bh = it >> 5, c = it & 31, h = bh & 7, row0 = (bh >> 3) * 2048 + c * 64;
            LAS bf16* St = (LAS bf16*)lds;
            LAS bf16* QD = (LAS bf16*)(lds + 34816);
            LAS bf16* Vt = (LAS bf16*)(lds + 52224);
            LAS bf16* Pm = (LAS bf16*)(lds + 70656);
            LAS bf16* QDI = (LAS bf16*)(lds + 79872);
            LAS bf16* KD = (LAS bf16*)(lds + 97280);
            LAS float* Tq = (LAS float*)(lds + 140800);
            LAS float* Ob = (LAS float*)(lds + 79872);
            LBAR();
            const int k = tid & 127, qtr = __builtin_amdgcn_readfirstlane(tid >> 7);
            float pre[16], kk[16], qq[16]; unsigned short iv[16];
#pragma unroll
            for (int s_ = 0; s_ < 16; ++s_) { const float f = fr[s_]; pre[s_] = __builtin_amdgcn_logf(f); kk[s_] = 1.0f - f; qq[s_] = bf2f(qh[s_]); iv[s_] = ih[s_]; }
#pragma unroll
            for (int j = 0; j < 8; ++j) { const int e = tid + 512 * j, v = e >> 5, k4 = e & 31; const f32x4 x = sv[j];
                v2u w; w.x = pk2(x.x, x.y); w.y = pk2(x.z, x.w); *(LAS v2u*)(St + v * 136 + k4 * 4) = w; }
#pragma unroll
            for (int s_ = 1; s_ < 16; ++s_) pre[s_] += pre[s_ - 1];
            const float tot = pre[15];
            Tq[qtr * 128 + k] = tot;
            { v4u w0, w1;
              w0.x = iv[0] | ((unsigned)iv[1] << 16); w0.y = iv[2] | ((unsigned)iv[3] << 16); w0.z = iv[4] | ((unsigned)iv[5] << 16); w0.w = iv[6] | ((unsigned)iv[7] << 16);
              w1.x = iv[8] | ((unsigned)iv[9] << 16); w1.y = iv[10] | ((unsigned)iv[11] << 16); w1.z = iv[12] | ((unsigned)iv[13] << 16); w1.w = iv[14] | ((unsigned)iv[15] << 16);
              *(LAS v4u*)(Vt + k * 72 + qtr * 16) = w0; *(LAS v4u*)(Vt + k * 72 + qtr * 16 + 8) = w1; }
            const int kdoff = qtr == 0 ? 0 : (qtr == 1 ? 16 : (qtr == 2 ? 48 : 96));
#pragma unroll
            for (int s_ = 0; s_ < 16; ++s_) {
                QDI[(16 * qtr + s_) * 136 + k] = bfr(qq[s_] * __builtin_amdgcn_exp2f(pre[s_]));
                KD[(kdoff + 16 * qtr + s_) * 136 + k] = bfr(kk[s_] * __builtin_amdgcn_exp2f(fminf(-pre[s_], 120.f)));
            }
            LBAR();
            { float lb_ = 0.f;
#pragma unroll
              for (int q2 = 0; q2 < 4; ++q2) lb_ += q2 < qtr ? Tq[q2 * 128 + k] : 0.f;
#pragma unroll
              for (int s_ = 0; s_ < 16; ++s_) QD[(16 * qtr + s_) * 136 + k] = bfr(qq[s_] * __builtin_amdgcn_exp2f(pre[s_] + lb_));
              float gap = 0.f;
              for (int i = qtr + 1; i < 4; ++i) {
                  const int off = i == 1 ? 16 : (i == 2 ? 48 : 96);
#pragma unroll
                  for (int s_ = 0; s_ < 16; ++s_) KD[(off + 16 * qtr + s_) * 136 + k] = bfr(kk[s_] * __builtin_amdgcn_exp2f((tot - pre[s_]) + gap));
                  gap += Tq[i * 128 + k];
              } }
            unsigned gpre[8];
#pragma unroll
            for (int i = 0; i < 8; ++i) gpre[i] = gq[i];
            if (it + G < 1024) P4_LOAD(it + G);
            LBAR();
            const int r = lane & 15, q = lane >> 4;
            for (int n = wave; n < 10; n += 8) {
                const int i = n == 0 ? 0 : (n < 3 ? 1 : (n < 6 ? 2 : 3)), j = n - (i == 0 ? 0 : (i == 1 ? 1 : (i == 2 ? 3 : 6)));
                const int off = i == 0 ? 0 : (i == 1 ? 16 : (i == 2 ? 48 : 96));
                f32x4 acc = (f32x4){0.f, 0.f, 0.f, 0.f};
#pragma unroll
                for (int ks = 0; ks < 4; ++ks) {
                    const pg8::bf16x8 a = *(const LAS pg8::bf16x8*)(QDI + (16 * i + r) * 136 + 8 * q + 32 * ks);
                    const pg8::bf16x8 bq = *(const LAS pg8::bf16x8*)(KD + (off + 16 * j + r) * 136 + 8 * q + 32 * ks);
                    acc = __builtin_amdgcn_mfma_f32_16x16x32_bf16(a, bq, acc, 0, 0, 0);
                }
#pragma unroll
                for (int jj = 0; jj < 4; ++jj) { const float x = (i != j || r <= 4 * q + jj) ? acc[jj] : 0.f; Pm[(16 * i + 4 * q + jj) * 72 + 16 * j + r] = bfr(x); }
            }
            if (wave == 2 || wave == 3) { const int i = wave == 2 ? 0 : 2, j = i + 1;
#pragma unroll
                for (int jj = 0; jj < 4; ++jj) Pm[(16 * i + 4 * q + jj) * 72 + 16 * j + r] = (bf16)0; }
            LBAR();
            { const int i = wave >> 1, vt0 = 4 * (wave & 1);
              pg8::bf16x8 pa[2], qa[4];
#pragma unroll
              for (int ks = 0; ks < 2; ++ks) pa[ks] = *(const LAS pg8::bf16x8*)(Pm + (16 * i + r) * 72 + 8 * q + 32 * ks);
#pragma unroll
              for (int ks = 0; ks < 4; ++ks) qa[ks] = *(const LAS pg8::bf16x8*)(QD + (16 * i + r) * 136 + 8 * q + 32 * ks);
#pragma unroll
              for (int vv = 0; vv < 4; ++vv) { const int vt = vt0 + vv;
                  f32x4 acc = (f32x4){0.f, 0.f, 0.f, 0.f};
                  acc = __builtin_amdgcn_mfma_f32_16x16x32_bf16(pa[0], *(const LAS pg8::bf16x8*)(Vt + (16 * vt + r) * 72 + 8 * q), acc, 0, 0, 0);
                  if (i >= 2) acc = __builtin_amdgcn_mfma_f32_16x16x32_bf16(pa[1], *(const LAS pg8::bf16x8*)(Vt + (16 * vt + r) * 72 + 8 * q + 32), acc, 0, 0, 0);
#pragma unroll
                  for (int ks = 0; ks < 4; ++ks) acc = __builtin_amdgcn_mfma_f32_16x16x32_bf16(qa[ks], *(const LAS pg8::bf16x8*)(St + (16 * vt + r) * 136 + 8 * q + 32 * ks), acc, 0, 0, 0);
#pragma unroll
                  for (int jj = 0; jj < 4; ++jj) Ob[(16 * i + 4 * q + jj) * 132 + 16 * vt + r] = acc[jj];
              } }
            LBAR();
            { float o0[8], o1[8], ss[8];
#pragma unroll
              for (int tt = 0; tt < 8; ++tt) { const int t = wave * 8 + tt; const f32x2 ov = *(const LAS f32x2*)(Ob + t * 132 + 2 * lane); o0[tt] = ov.x; o1[tt] = ov.y; ss[tt] = o0[tt] * o0[tt] + o1[tt] * o1[tt]; }
#pragma unroll
              for (int o = 1; o < 64; o <<= 1) {
#pragma unroll
                  for (int tt = 0; tt < 8; ++tt) ss[tt] += __shfl_xor(ss[tt], o); }
#pragma unroll
              for (int tt = 0; tt < 8; ++tt) {
                  const float rr = __builtin_amdgcn_rsqf(ss[tt] * (1.f / 128.f) + LN_EPS);
                  const size_t m = (size_t)(row0 + wave * 8 + tt);
                  const float g0 = __uint_as_float(gpre[tt] << 16), g1 = __uint_as_float(gpre[tt] & 0xffff0000u);
                  *(unsigned*)(MIX + m * 2048 + 1024 + h * 128 + 2 * lane) = pg8::cvt_pk_bf16(o0[tt] * rr * ng0 * g0, o1[tt] * rr * ng1 * g1);
              } }
          }
        }
#undef P4_LOAD
#undef LBAR
        __syncthreads();
        STAMP(22);
        for (int it = 1024 + bx; it < 1024 + 256; it += G) {
          {
            int row0, h, nsb; const float* sinit; float* sfin = nullptr;
            if (it < 1024) { const int bh = it >> 5, c = it & 31; h = bh & 7; row0 = (bh >> 3) * 2048 + c * 64; nsb = 4; sinit = ST + (size_t)it * 16384; }
            else { const int j = it - 1024; h = j & 7; row0 = MP + (j >> 3) * 16; nsb = 1; sinit = state_hgrn + (size_t)j * 16384; sfin = out + O_NHS + (size_t)j * 16384; }
            f32x2 Sa[8], Sb[8];
            { const float* sp = sinit + (size_t)(wave * 16) * 128 + lane;
#pragma unroll
              for (int i = 0; i < 8; ++i) { Sa[i] = (f32x2){__builtin_nontemporal_load(sp + (2 * i) * 128), __builtin_nontemporal_load(sp + (2 * i + 1) * 128)}; Sb[i] = (f32x2){__builtin_nontemporal_load(sp + (2 * i) * 128 + 64), __builtin_nontemporal_load(sp + (2 * i + 1) * 128 + 64)}; } }
            for (int sb = 0; sb < nsb; ++sb) {
                __syncthreads();
#pragma unroll
                for (int e4 = 0; e4 < 4; ++e4) { const int e = tid + e4 * 512, t = e >> 7, k = e & 127; const size_t gi = (size_t)(row0 + sb * 16 + t) * 1024 + h * 128 + k;
                    vl[e] = bf2f(I[gi]); fl2[e] = F[gi]; ql2[e] = bf2f(Q[gi]); }
                __syncthreads();
#pragma unroll 2
                for (int t = 0; t < 16; ++t) {
                    f32x4 f4[4], q4[4];
#pragma unroll
                    for (int i = 0; i < 4; ++i) { f4[i] = *(const LAS f32x4*)(fl2 + t * 128 + wave * 16 + 4 * i); q4[i] = *(const LAS f32x4*)(ql2 + t * 128 + wave * 16 + 4 * i); }
                    const float va = vl[t * 128 + lane], vb = vl[t * 128 + 64 + lane];
                    const f32x2 va2 = (f32x2){va, va}, vb2 = (f32x2){vb, vb};
                    f32x2 oa = (f32x2){0.f, 0.f}, ob = (f32x2){0.f, 0.f};
#pragma unroll
                    for (int i = 0; i < 8; ++i) { const f32x2 f2 = (f32x2){f4[i >> 1][2 * (i & 1)], f4[i >> 1][2 * (i & 1) + 1]};
                        const f32x2 q2 = (f32x2){q4[i >> 1][2 * (i & 1)], q4[i >> 1][2 * (i & 1) + 1]};
                        Sa[i] = f2 * (Sa[i] - va2) + va2; Sb[i] = f2 * (Sb[i] - vb2) + vb2;
                        oa += q2 * Sa[i]; ob += q2 * Sb[i]; }
                    red[(wave * 16 + t) * 128 + lane] = oa.x + oa.y; red[(wave * 16 + t) * 128 + 64 + lane] = ob.x + ob.y;
                }
                __syncthreads();
#pragma unroll
                for (int tt = 0; tt < 2; ++tt) {
                    const int t = wave * 2 + tt;
                    float o0 = 0.f, o1 = 0.f;
#pragma unroll
                    for (int q8 = 0; q8 < 8; ++q8) { o0 += red[(q8 * 16 + t) * 128 + lane]; o1 += red[(q8 * 16 + t) * 128 + 64 + lane]; }
                    const float ss = wave_sum(o0 * o0 + o1 * o1);
                    const float r = 1.f / sqrtf(ss * (1.f / 128.f) + LN_EPS);
                    const size_t m = (size_t)(row0 + sb * 16 + t);
                    const float g0 = bf2f(Gt[m * 1024 + h * 128 + lane]), g1 = bf2f(Gt[m * 1024 + h * 128 + 64 + lane]);
                    MIX[m * 2048 + 1024 + h * 128 + lane] = (bf16)f2bf(o0 * r * hg_ng[lane] * g0);
                    MIX[m * 2048 + 1024 + h * 128 + 64 + lane] = (bf16)f2bf(o1 * r * hg_ng[64 + lane] * g1);
                }
            }
            if (sfin) { float* sp = sfin + (size_t)(wave * 16) * 128 + lane;
#pragma unroll
                for (int i = 0; i < 8; ++i) { __builtin_nontemporal_store(Sa[i].x, sp + (2 * i) * 128); __builtin_nontemporal_store(Sa[i].y, sp + (2 * i + 1) * 128); __builtin_nontemporal_store(Sb[i].x, sp + (2 * i) * 128 + 64); __builtin_nontemporal_store(Sb[i].y, sp + (2 * i + 1) * 128 + 64); } }
          }
        }
        __syncthreads();
    }
    SEAM(4);

    if (IN(5)) for (int rep_ = 0; rep_ < NREP(5); ++rep_) { if (rep_) xcd_barrier(xbar);
        pg8::Gemm g{MIX, WOUT, M, D, D}; pg8::StaticOrder S; S.init(M, D, D, G, bx, MP, SPLIT5);
        pg8::EpiResB<true> E{XB, XB, MP, ALPHA, (pg8::bf16_t*)(ws + WS_PB5)};
        pg8::gemm_phase<pg8::EpiResB<true>, pg8::StaticOrder, true, true>(lds, g, S, E);
        { const int nlast = S.nitems % G, first = nlast > 0 ? nlast : 0, nwg = G - first;
          if (bx >= first) {
              LAS float* scr = (LAS float*)(lds + wave * 16384);
              constexpr int I_G = 32 * 176;
              const int gw2 = (bx - first) * NWAVES + wave, NGW2 = nwg * NWAVES;
              transpose_stream<0>(w_down, FF, D, WDN, gw2, W_DN_SPLIT, NGW2, scr, lane);
          } }
    }
    SEAM(5);

    if (IN(6)) {
        ln_rows_bf16(XB, nullptr, XB, ln1_g, ln1_b, gw, NGW, MP, lane);
        if ((gw & 3) == 0) for (int m = MP + (gw >> 2); m < M; m += (NGW + 3) >> 2)
            ln_row<false, SPLIT5>(x_sample + (size_t)(m - MP) * D, (const bf16*)(ws + WS_PB5) + (size_t)(m - MP) * D, (size_t)MS * D, ALPHA, nullptr, XB + (size_t)m * D, ln1_g, ln1_b, lane);
    }
    SEAM(6);

    if (IN(7)) for (int rep_ = 0; rep_ < NREP(7); ++rep_) { if (rep_) xcd_barrier(xbar);
        pg8::Gemm g{XB, WGU, M, 2 * FF, D}; pg8::StaticOrder S; S.init(M, 2 * FF, D, G, bx);
        pg8::EpiGateUp E{ACT, FF};
        pg8::gemm_phase<pg8::EpiGateUp, pg8::StaticOrder, true, true>(lds, g, S, E);
        const int nlast = S.nitems % G;
        {
            const int first = nlast > 0 ? nlast : 0, nwg = G - first;
            if (bx >= first) {
                LAS float* scr = (LAS float*)(lds + wave * 16384);
                constexpr int I_DN = 88 * 64;
                const int gw2 = (bx - first) * NWAVES + wave, NGW2 = nwg * NWAVES;
                transpose_stream<0>(w_down, FF, D, WDN, W_DN_SPLIT + gw2, I_DN, NGW2, scr, lane);
            }
        }
    }
    SEAM(7);

    if (IN(8)) {
        pg8::Gemm g{ACT, WDN, M, D, FF}; pg8::StaticOrder S; S.init(M, D, FF, G, bx, MP, SPLIT8);
        pg8::EpiResB<true> E{XB, MIX, MP, ALPHA, (pg8::bf16_t*)(ws + WS_PB8)};
        pg8::gemm_phase<pg8::EpiResB<true>, pg8::StaticOrder, true, true>(lds, g, S, E);
    }
    SEAM(8);

    if (IN(9)) {
        ln_rows_bf16(MIX, out, nullptr, ln2_g, ln2_b, gw, NGW, MP, lane);
        if ((gw & 3) == 0) for (int m = MP + (gw >> 2); m < M; m += (NGW + 3) >> 2)
            ln_row<true, SPLIT8>(XB + (size_t)m * D, (const bf16*)(ws + WS_PB8) + (size_t)(m - MP) * D, (size_t)MS * D, ALPHA, out + (size_t)m * D, nullptr, ln2_g, ln2_b, lane);
    }
    STAMP(10);
#ifdef TS_A
    __syncthreads();
    if (bx == 0 && tid == 0) { asm volatile("s_waitcnt vmcnt(0)" ::: "memory"); out[0] = out[0] + (float)(ts_b - ts_a) * 1e-4f; }
#endif
#undef IN
#undef SEAM
}

#undef x_prompt
#undef x_sample
#undef cache_conv
#undef state_hgrn
#undef w_in
#undef b_in
#undef w_dw
#undef b_dw
#undef cn_g
#undef cn_b
#undef hlb
#undef hg_ng
#undef w_out
#undef ln1_g
#undef ln1_b
#undef w_gate
#undef w_up
#undef w_down
#undef ln2_g
#undef ln2_b
#undef out
#undef ws
#undef LB
#undef BIASP
#undef WIN
#undef WOUT
#undef WGU
#undef WDN
#undef XB
#undef MIX
#undef U
#undef Q
#undef F
#undef I
#undef Gt
#undef ACT
#undef ST
#undef DC

extern "C" void kernel_launch(void* const* d_in, const int* in_sizes, int n_in, void* d_out, int out_size, void* d_ws, size_t ws_size, hipStream_t stream) {
    static int grid = 0;
    if (grid == 0) {
        int dev = 0, cus = 0, per_cu = 0;
        if (n_in != 20 || ws_size < WS_END) { fprintf(stderr, "kernel_launch: unexpected n_in %d / ws_size %zu\n", n_in, ws_size); grid = -1; return; }
        if (hipGetDevice(&dev) != hipSuccess || hipDeviceGetAttribute(&cus, hipDeviceAttributeMultiprocessorCount, dev) != hipSuccess) { grid = -1; return; }
        if (hipFuncSetAttribute((const void*)fwd_kernel, hipFuncAttributeMaxDynamicSharedMemorySize, LDS_BYTES) != hipSuccess) { fprintf(stderr, "kernel_launch: hipFuncSetAttribute failed\n"); grid = -1; return; }
        if (hipOccupancyMaxActiveBlocksPerMultiprocessor(&per_cu, (const void*)fwd_kernel, NWAVES * 64, LDS_BYTES) != hipSuccess || per_cu < 1) { fprintf(stderr, "kernel_launch: occupancy query says %d\n", per_cu); }
        (void)hipGetLastError();
        grid = cus;
    }
    if (grid < 0) return;
    if (hipMemsetAsync(d_ws, 0, 16384, stream) != hipSuccess) { fprintf(stderr, "kernel_launch: memset failed\n"); return; }
    Args a{};
    for (int i = 0; i < 20; ++i) a.in[i] = (const float*)d_in[i];
    a.out = (float*)d_out; a.ws = (unsigned char*)d_ws;
#if MK_ONE_LAUNCH
    a.ph_lo = 0; a.ph_hi = N_PHASES;
    void* kargs[] = {&a};
    hipError_t e = hipLaunchCooperativeKernel((const void*)fwd_kernel, dim3(grid), dim3(NWAVES * 64), kargs, LDS_BYTES, stream);
    if (e != hipSuccess) fprintf(stderr, "cooperative launch failed: %s (grid %d)\n", hipGetErrorString(e), grid);
#else
    for (int p = 0; p < N_PHASES; ++p) {
        a.ph_lo = p; a.ph_hi = p + 1;
        hipLaunchKernelGGL(fwd_kernel, dim3(grid), dim3(NWAVES * 64), LDS_BYTES, stream, a);
    }
#endif
}
```

```cpp
#include <hip/hip_runtime.h>
#include <hip/hip_cooperative_groups.h>
#include <cstdio>
#include <cstdint>
namespace cg = cooperative_groups;

#ifndef MK_ONE_LAUNCH
#define MK_ONE_LAUNCH 1
#endif

namespace pg8 {
#define PG8_LAS __attribute__((address_space(3)))
typedef unsigned short bf16_t;
typedef short bf16x8 __attribute__((ext_vector_type(8)));
typedef float f32x4 __attribute__((ext_vector_type(4)));
typedef unsigned u32x4 __attribute__((ext_vector_type(4)));
typedef unsigned u32x2 __attribute__((ext_vector_type(2)));
constexpr int BM = 256, BK = 64, HALF = 128, HTB = HALF * BK * 2, STAGE_BYTES = 8 * HTB, NXCD = 8, WGM = 8;

__host__ __device__ __forceinline__ int lds_byte(int r, int c) { const int st = (r >> 4) * 2 + (c >> 5), rr = r & 15, cc = c & 31, ob = rr * 64 + cc * 2; return st * 1024 + (ob ^ (((ob >> 9) & 1) << 5)); }
__host__ __device__ __forceinline__ void stage_rc(int b, int& R, int& C) { const int st = b / 1024, sb = b % 1024, swz = sb ^ (((sb >> 9) & 1) << 5); R = (st >> 1) * 16 + swz / 64; C = (st & 1) * 32 + (swz % 64) / 2; }
__host__ __device__ __forceinline__ int perm32(int rho) { const int n = rho >> 4, i = rho & 15; return 8 * (i >> 2) + 4 * n + (i & 3); }

struct Unit { int pm, pn, kt0, nkt, ks; };
struct Gemm { const bf16_t* A; const bf16_t* Bt; int M, N, K; };

struct StaticOrder {
    int nM, nMf, nN, nfull, nitems, G, c, nt, nsplit;
    __host__ __device__ void init(int M, int N, int K, int G_, int c_, int Mfull = -1, int nsplit_ = 1) {
        nM = M / BM; nMf = Mfull < 0 ? nM : Mfull / BM; nN = N / BM; nt = K / BK; nsplit = nsplit_; nfull = nMf * nN; nitems = nfull + (nM - nMf) * nN * nsplit; G = G_; c = c_; }
    __host__ __device__ bool next(int i, Unit& u) const {
        const long L = (long)i * G + c; if (L >= nitems) return false;
        if (L >= nfull) { const int sidx = (int)L - nfull, un = sidx / nsplit, ks = sidx % nsplit, per = nt / nsplit;
            u.pm = nMf + un / nN; u.pn = un % nN; u.kt0 = ks * per; u.nkt = per; u.ks = ks; return true; }
        int wgid = (int)L; { const int q = nfull / NXCD, r = nfull % NXCD, xcd = wgid % NXCD, off = wgid / NXCD; wgid = (xcd < r ? xcd * (q + 1) : r * (q + 1) + (xcd - r) * q) + off; }
        const int nig = WGM * nN, gid = wgid / nig, fm = gid * WGM, gsz = (nMf - fm) < WGM ? (nMf - fm) : WGM;
        u.pm = fm + ((wgid % nig) % gsz); u.pn = (wgid % nig) / gsz; u.kt0 = 0; u.nkt = nt; u.ks = -1; return true;
    }
    __device__ __forceinline__ void a_ready(const Unit&) const {}
    __device__ __forceinline__ void done(const Unit&) const {}
};

__device__ __forceinline__ unsigned cvt_pk_bf16(float lo, float hi) { unsigned r; asm volatile("v_cvt_pk_bf16_f32 %0, %1, %2" : "=v"(r) : "v"(lo), "v"(hi)); return r; }
__device__ __forceinline__ float sigm(float x) { return __builtin_amdgcn_rcpf(1.0f + __expf(-x)); }

struct EpiProj {
    static constexpr bool PERM = true, AFTER_DRAIN = false;
    bf16_t *U, *QIG; float* F; const float* bias; const float* lb;
    __device__ __forceinline__ void operator()(const f32x4 (&acc)[2][2][4][2], const Unit& u, int wr, int wc, int fr, int fq) const {
        const int row0 = u.pm * BM + wr * 64 + fr;
        const int cl = wc * 32 + 8 * fq;
        const int bcol = u.pn * BM + cl;
        f32x4 bv[2][2];
#pragma unroll
        for (int bj = 0; bj < 2; ++bj)
#pragma unroll
            for (int n = 0; n < 2; ++n) bv[bj][n] = *(const f32x4*)(bias + bcol + bj * HALF + 4 * n);
        if (u.pn < 8) {
#pragma unroll
            for (int ai = 0; ai < 2; ++ai)
#pragma unroll
                for (int m = 0; m < 4; ++m) {
                    const size_t row = (size_t)(row0 + ai * HALF + m * 16);
                    float o[8];
#pragma unroll
                    for (int n = 0; n < 2; ++n) { const f32x4 a = acc[ai][0][m][n] + bv[0][n], g = acc[ai][1][m][n] + bv[1][n];
#pragma unroll
                        for (int e = 0; e < 4; ++e) o[n * 4 + e] = a[e] * sigm(g[e]); }
                    u32x4 w; w.x = cvt_pk_bf16(o[0], o[1]); w.y = cvt_pk_bf16(o[2], o[3]); w.z = cvt_pk_bf16(o[4], o[5]); w.w = cvt_pk_bf16(o[6], o[7]);
                    *(u32x4*)(U + row * 1024 + u.pn * HALF + cl) = w;
                }
        } else {
            const int grp = (u.pn - 8) >> 2;
            const int cbase = ((u.pn - 8) & 3) * BM + cl;
            if (grp == 1) {
                f32x4 lv[2][2];
#pragma unroll
                for (int bj = 0; bj < 2; ++bj)
#pragma unroll
                    for (int n = 0; n < 2; ++n) lv[bj][n] = *(const f32x4*)(lb + cbase + bj * HALF + 4 * n);
#pragma unroll
                for (int ai = 0; ai < 2; ++ai)
#pragma unroll
                    for (int m = 0; m < 4; ++m) {
                        const size_t row = (size_t)(row0 + ai * HALF + m * 16);
#pragma unroll
                        for (int bj = 0; bj < 2; ++bj)
#pragma unroll
                            for (int n = 0; n < 2; ++n) { const f32x4 x = acc[ai][bj][m][n] + bv[bj][n]; const f32x4 l = lv[bj][n]; f32x4 o;
#pragma unroll
                                for (int e = 0; e < 4; ++e) o[e] = l[e] + (1.0f - l[e]) * sigm(x[e]);
                                *(f32x4*)(F + row * 1024 + cbase + bj * HALF + 4 * n) = o; }
                    }
            } else {
                bf16_t* O = QIG + (size_t)(grp - (grp > 0 ? 1 : 0)) * ((size_t)8704 * 1024);
                const bool act = grp != 2;
#pragma unroll
                for (int ai = 0; ai < 2; ++ai)
#pragma unroll
                    for (int m = 0; m < 4; ++m) {
                        const size_t row = (size_t)(row0 + ai * HALF + m * 16);
#pragma unroll
                        for (int bj = 0; bj < 2; ++bj) { float o[8];
#pragma unroll
                            for (int n = 0; n < 2; ++n) { const f32x4 x = acc[ai][bj][m][n] + bv[bj][n];
#pragma unroll
                                for (int e = 0; e < 4; ++e) o[n * 4 + e] = act ? x[e] * sigm(x[e]) : x[e]; }
                            u32x4 w; w.x = cvt_pk_bf16(o[0], o[1]); w.y = cvt_pk_bf16(o[2], o[3]); w.z = cvt_pk_bf16(o[4], o[5]); w.w = cvt_pk_bf16(o[6], o[7]);
                            *(u32x4*)(O + row * 1024 + cbase + bj * HALF) = w; }
                    }
            }
        }
    }
};
struct EpiRes {
    static constexpr bool PERM = false, AFTER_DRAIN = false;
    const float* baseP; const float* baseS; float* out; int split; float alpha; float* part;
    __device__ __forceinline__ void operator()(const f32x4 (&acc)[2][2][4][2], const Unit& u, int wr, int wc, int fr, int fq) const {
        const int row0 = u.pm * BM + wr * 64 + fr;
        const int col0 = u.pn * BM + wc * 32 + 4 * fq;
        if (u.ks >= 0) {
            float* pb = part + (size_t)u.ks * 512 * 2048;
#pragma unroll
            for (int ai = 0; ai < 2; ++ai)
#pragma unroll
                for (int m = 0; m < 4; ++m) { float* op = pb + (size_t)(row0 + ai * HALF + m * 16 - split) * 2048;
#pragma unroll
                    for (int bj = 0; bj < 2; ++bj)
#pragma unroll
                        for (int n = 0; n < 2; ++n) *(f32x4*)(op + col0 + bj * HALF + n * 16) = acc[ai][bj][m][n]; }
            return;
        }
#pragma unroll
        for (int ai = 0; ai < 2; ++ai)
#pragma unroll
            for (int m = 0; m < 4; ++m) {
                const int row = row0 + ai * HALF + m * 16;
                const float* bp = row < split ? baseP + (size_t)row * 2048 : baseS + (size_t)(row - split) * 2048;
                float* op = out + (size_t)row * 2048;
#pragma unroll
                for (int bj = 0; bj < 2; ++bj)
#pragma unroll
                    for (int n = 0; n < 2; ++n) { const int c = col0 + bj * HALF + n * 16; const f32x4 b = *(const f32x4*)(bp + c); *(f32x4*)(op + c) = b * alpha + acc[ai][bj][m][n]; }
            }
    }
};
template <bool BASE_BF16> struct EpiResB {
    static constexpr bool PERM = true, AFTER_DRAIN = false;
    const void* base; bf16_t* out; int split; float alpha; bf16_t* part;
    __device__ __forceinline__ void operator()(const f32x4 (&acc)[2][2][4][2], const Unit& u, int wr, int wc, int fr, int fq) const {
        const int row0 = u.pm * BM + wr * 64 + fr;
        const int col0 = u.pn * BM + wc * 32 + 8 * fq;
        if (u.ks >= 0) {
            bf16_t* pb = part + (size_t)u.ks * 512 * 2048;
#pragma unroll
            for (int ai = 0; ai < 2; ++ai)
#pragma unroll
                for (int m = 0; m < 4; ++m) { bf16_t* op = pb + (size_t)(row0 + ai * HALF + m * 16 - split) * 2048;
#pragma unroll
                    for (int bj = 0; bj < 2; ++bj) { const f32x4 v0 = acc[ai][bj][m][0], v1 = acc[ai][bj][m][1];
                        u32x4 w; w.x = cvt_pk_bf16(v0[0], v0[1]); w.y = cvt_pk_bf16(v0[2], v0[3]); w.z = cvt_pk_bf16(v1[0], v1[1]); w.w = cvt_pk_bf16(v1[2], v1[3]);
                        *(u32x4*)(op + col0 + bj * HALF) = w; } }
            return;
        }
#pragma unroll
        for (int ai = 0; ai < 2; ++ai)
#pragma unroll
            for (int m = 0; m < 4; ++m) {
                const size_t row = (size_t)(row0 + ai * HALF + m * 16);
#pragma unroll
                for (int bj = 0; bj < 2; ++bj) { const int c = col0 + bj * HALF; f32x4 b0, b1;
                    if constexpr (BASE_BF16) { const u32x4 w = *(const u32x4*)((const bf16_t*)base + row * 2048 + c);
                        b0 = (f32x4){__uint_as_float(w.x << 16), __uint_as_float(w.x & 0xffff0000u), __uint_as_float(w.y << 16), __uint_as_float(w.y & 0xffff0000u)};
                        b1 = (f32x4){__uint_as_float(w.z << 16), __uint_as_float(w.z & 0xffff0000u), __uint_as_float(w.w << 16), __uint_as_float(w.w & 0xffff0000u)}; }
                    else { const float* bp = (const float*)base + row * 2048 + c; b0 = *(const f32x4*)bp; b1 = *(const f32x4*)(bp + 4); }
                    const f32x4 v0 = b0 * alpha + acc[ai][bj][m][0], v1 = b1 * alpha + acc[ai][bj][m][1];
                    u32x4 w; w.x = cvt_pk_bf16(v0[0], v0[1]); w.y = cvt_pk_bf16(v0[2], v0[3]); w.z = cvt_pk_bf16(v1[0], v1[1]); w.w = cvt_pk_bf16(v1[2], v1[3]);
                    *(u32x4*)(out + row * 2048 + c) = w; }
            }
    }
};
struct EpiGateUp {
    static constexpr bool PERM = true, AFTER_DRAIN = false;
    bf16_t* O; int ldc;
    __device__ __forceinline__ void operator()(const f32x4 (&acc)[2][2][4][2], const Unit& u, int wr, int wc, int fr, int fq) const {
        const int row0 = u.pm * BM + wr * 64 + fr;
        const int cl = wc * 32 + 8 * fq;
#pragma unroll
        for (int ai = 0; ai < 2; ++ai)
#pragma unroll
            for (int m = 0; m < 4; ++m) {
                const size_t row = (size_t)(row0 + ai * HALF + m * 16);
                float o[8];
#pragma unroll
                for (int n = 0; n < 2; ++n) { const f32x4 g = acc[ai][0][m][n], up = acc[ai][1][m][n];
#pragma unroll
                    for (int e = 0; e < 4; ++e) o[n * 4 + e] = g[e] * sigm(g[e]) * up[e]; }
                u32x4 w; w.x = cvt_pk_bf16(o[0], o[1]); w.y = cvt_pk_bf16(o[2], o[3]); w.z = cvt_pk_bf16(o[4], o[5]); w.w = cvt_pk_bf16(o[6], o[7]);
                *(u32x4*)(O + row * ldc + u.pn * HALF + cl) = w;
            }
    }
};

template <class Epi, class Sched, bool ALIGN_EPI = false, bool SP2 = false>
__device__ __forceinline__ void gemm_phase(PG8_LAS unsigned char* lds, const Gemm g, const Sched& S, const Epi& E) {
    int tid_ = threadIdx.x; asm volatile("" : "+v"(tid_));
    const int tid = tid_, wid = __builtin_amdgcn_readfirstlane(tid >> 6), lane = tid & 63, wr = wid >> 2, wc = wid & 3, fr = lane & 15, fq = lane >> 4;
    const int K = g.K;
    unsigned voffA[2], voffB[2];
#pragma unroll
    for (int i = 0; i < 2; ++i) { int R, C; stage_rc(tid * 16 + i * 8192, R, C); const int Rb = Epi::PERM ? ((R & ~31) + perm32(R & 31)) : R;
        voffA[i] = (unsigned)(R * K + C) * 2u; voffB[i] = (unsigned)(Rb * K + C) * 2u; }
    const size_t kstep = (size_t)(BK * 2);
    const size_t hstep = (size_t)HALF * K * 2;
    const size_t tstep = 2 * hstep;
    const unsigned ldsw = (unsigned)wid * 1024u;
    const int aoff = lds_byte(wr * 64 + fr, fq * 8), boff = lds_byte(wc * 32 + fr, fq * 8);
#define PG8_SA(b, h) (((b) * 2 + (h)) * HTB)
#define PG8_SB(b, h) ((4 + (b) * 2 + (h)) * HTB)
#define PG8_STAGE(bufoff, gbase, voff) do { _Pragma("unroll") for (int _i = 0; _i < 2; ++_i) \
        __builtin_amdgcn_global_load_lds((const unsigned*)((const char*)(gbase) + (voff)[_i]), (PG8_LAS unsigned*)(lds + (bufoff) + ldsw + _i * 8192), 16, 0, 0); } while (0)
#define PG8_LDA(dst, b, h) do { _Pragma("unroll") for (int m = 0; m < 4; ++m) _Pragma("unroll") for (int k = 0; k < 2; ++k) dst[m][k] = *(const PG8_LAS bf16x8*)(lds + PG8_SA(b, h) + aoff + m * 2048 + k * 1024); } while (0)
#define PG8_LDB(dst, b, h) do { _Pragma("unroll") for (int n = 0; n < 2; ++n) _Pragma("unroll") for (int k = 0; k < 2; ++k) dst[n][k] = *(const PG8_LAS bf16x8*)(lds + PG8_SB(b, h) + boff + n * 2048 + k * 1024); } while (0)
#define PG8_MMA(ai, bj, At, Bt) do { __builtin_amdgcn_s_setprio(1); _Pragma("unroll") for (int m = 0; m < 4; ++m) _Pragma("unroll") for (int n = 0; n < 2; ++n) _Pragma("unroll") for (int k = 0; k < 2; ++k) \
        acc[ai][bj][m][n] = __builtin_amdgcn_mfma_f32_16x16x32_bf16(Bt[n][k], At[m][k], acc[ai][bj][m][n], 0, 0, 0); __builtin_amdgcn_s_setprio(0); } while (0)
#define PG8_WAIT_V(n) asm volatile("s_waitcnt vmcnt(" #n ")" ::: "memory")
#define PG8_WAIT_L(n) asm volatile("s_waitcnt lgkmcnt(" #n ")" ::: "memory")
#define PG8_BAR __builtin_amdgcn_s_barrier()
#define PG8_SCHED __builtin_amdgcn_sched_barrier(0)
    Unit cur, nxt; int ui = 0;
    if (!S.next(0, cur)) return;
    f32x4 acc[2][2][4][2];
#pragma unroll
    for (int a = 0; a < 2; ++a)
#pragma unroll
        for (int b = 0; b < 2; ++b)
#pragma unroll
            for (int m = 0; m < 4; ++m)
#pragma unroll
                for (int n = 0; n < 2; ++n) acc[a][b][m][n] = (f32x4){0.f, 0.f, 0.f, 0.f};
    bf16x8 At[4][2], B0[2][2], B1[2][2];
    const char* cA = (const char*)g.A + (size_t)cur.pm * tstep + (size_t)cur.kt0 * kstep; const char* cB = (const char*)g.Bt + (size_t)cur.pn * tstep + (size_t)cur.kt0 * kstep;
    S.a_ready(cur);
    if constexpr (SP2) {
        PG8_STAGE(PG8_SB(0, 0), cB, voffB); PG8_STAGE(PG8_SB(0, 1), cB + hstep, voffB); PG8_STAGE(PG8_SA(0, 0), cA, voffA); PG8_STAGE(PG8_SA(0, 1), cA + hstep, voffA);
        if (wr == 1) PG8_BAR;
        PG8_WAIT_V(2); PG8_BAR;
        PG8_STAGE(PG8_SB(1, 0), cB + kstep, voffB); PG8_STAGE(PG8_SA(1, 0), cA + kstep, voffA); PG8_STAGE(PG8_SB(1, 1), cB + hstep + kstep, voffB);
        PG8_WAIT_V(6); PG8_BAR;
    } else {
        PG8_STAGE(PG8_SB(0, 0), cB, voffB); PG8_STAGE(PG8_SA(0, 0), cA, voffA); PG8_STAGE(PG8_SB(0, 1), cB + hstep, voffB); PG8_STAGE(PG8_SA(0, 1), cA + hstep, voffA);
        if (wr == 1) PG8_BAR;
        PG8_WAIT_V(4); PG8_BAR;
        PG8_STAGE(PG8_SB(1, 0), cB + kstep, voffB); PG8_STAGE(PG8_SA(1, 0), cA + kstep, voffA); PG8_STAGE(PG8_SB(1, 1), cB + hstep + kstep, voffB);
        PG8_WAIT_V(6); PG8_BAR;
    }
    for (;;) {
        const bool has_next = S.next(ui + 1, nxt);
        const char* nA = has_next ? (const char*)g.A + (size_t)nxt.pm * tstep + (size_t)nxt.kt0 * kstep : cA; const char* nB = has_next ? (const char*)g.Bt + (size_t)nxt.pn * tstep + (size_t)nxt.kt0 * kstep : cB;
        const int nt = cur.nkt;
        for (int t = 0; t < nt; t += 2) {
            const bool last = (t == nt - 2);
            const char* a1 = cA + (size_t)(t + 1) * kstep;
            const char* a2 = last ? nA : cA + (size_t)(t + 2) * kstep; const char* b2 = last ? nB : cB + (size_t)(t + 2) * kstep;
            const char* a3 = a2 + kstep; const char* b3 = b2 + kstep;
            if (last && has_next) S.a_ready(nxt);
            if constexpr (SP2) {
            PG8_LDB(B0, 0, 0); PG8_LDB(B1, 0, 1); PG8_SCHED; PG8_LDA(At, 0, 0); PG8_STAGE(PG8_SA(1, 1), a1 + hstep, voffA);
            PG8_WAIT_V(8); PG8_WAIT_L(0); PG8_BAR; PG8_MMA(0, 0, At, B0); PG8_MMA(0, 1, At, B1); PG8_BAR; PG8_SCHED;
            PG8_LDA(At, 0, 1); PG8_STAGE(PG8_SB(0, 0), b2, voffB); PG8_STAGE(PG8_SB(0, 1), b2 + hstep, voffB); PG8_STAGE(PG8_SA(0, 0), a2, voffA);
            PG8_WAIT_V(8); PG8_WAIT_L(0); PG8_BAR; PG8_MMA(1, 0, At, B0); PG8_MMA(1, 1, At, B1); PG8_BAR; PG8_SCHED;
            PG8_LDB(B0, 1, 0); PG8_LDB(B1, 1, 1); PG8_SCHED; PG8_LDA(At, 1, 0); PG8_STAGE(PG8_SA(0, 1), a2 + hstep, voffA);
            PG8_WAIT_V(8); PG8_WAIT_L(0); PG8_BAR; PG8_MMA(0, 0, At, B0); PG8_MMA(0, 1, At, B1); PG8_BAR; PG8_SCHED;
            PG8_LDA(At, 1, 1); PG8_STAGE(PG8_SB(1, 0), b3, voffB); PG8_STAGE(PG8_SB(1, 1), b3 + hstep, voffB); PG8_STAGE(PG8_SA(1, 0), a3, voffA);
            PG8_WAIT_V(8); PG8_WAIT_L(0); PG8_BAR; PG8_MMA(1, 0, At, B0); PG8_MMA(1, 1, At, B1); PG8_BAR; PG8_SCHED;
            } else {
            PG8_LDB(B0, 0, 0); PG8_SCHED; PG8_LDA(At, 0, 0); PG8_STAGE(PG8_SA(1, 1), a1 + hstep, voffA);
            PG8_WAIT_L(8); PG8_BAR; PG8_WAIT_L(0); PG8_MMA(0, 0, At, B0); PG8_BAR; PG8_SCHED;
            PG8_LDB(B1, 0, 1); PG8_STAGE(PG8_SB(0, 0), b2, voffB);
            PG8_BAR; PG8_WAIT_L(0); PG8_MMA(0, 1, At, B1); PG8_BAR;
            PG8_LDA(At, 0, 1); PG8_STAGE(PG8_SA(0, 0), a2, voffA);
            PG8_BAR; PG8_WAIT_L(0); PG8_MMA(1, 0, At, B0); PG8_BAR; PG8_SCHED;
            PG8_STAGE(PG8_SB(0, 1), b2 + hstep, voffB);
            PG8_WAIT_V(6); PG8_BAR; PG8_MMA(1, 1, At, B1); PG8_BAR;
            PG8_LDB(B0, 1, 0); PG8_SCHED; PG8_LDA(At, 1, 0); PG8_STAGE(PG8_SA(0, 1), a2 + hstep, voffA);
            PG8_WAIT_L(8); PG8_BAR; PG8_WAIT_L(0); PG8_MMA(0, 0, At, B0); PG8_BAR; PG8_SCHED;
            PG8_LDB(B1, 1, 1); PG8_STAGE(PG8_SB(1, 0), b3, voffB);
            PG8_BAR; PG8_WAIT_L(0); PG8_MMA(0, 1, At, B1); PG8_BAR;
            PG8_LDA(At, 1, 1); PG8_STAGE(PG8_SA(1, 0), a3, voffA);
            PG8_BAR; PG8_WAIT_L(0); PG8_MMA(1, 0, At, B0); PG8_BAR; PG8_SCHED;
            PG8_STAGE(PG8_SB(1, 1), b3 + hstep, voffB);
            PG8_WAIT_V(6); PG8_BAR; PG8_MMA(1, 1, At, B1); PG8_BAR;
            }
        }
        if constexpr (ALIGN_EPI) { if (wr == 0) PG8_BAR; }
        if constexpr (!Epi::AFTER_DRAIN) { E(acc, cur, wr, wc, fr, fq); S.done(cur); }
        if (!has_next) break;
#pragma unroll
        for (int a = 0; a < 2; ++a)
#pragma unroll
            for (int b = 0; b < 2; ++b)
#pragma unroll
                for (int m = 0; m < 4; ++m)
#pragma unroll
                    for (int n = 0; n < 2; ++n) acc[a][b][m][n] = (f32x4){0.f, 0.f, 0.f, 0.f};
        cur = nxt; cA = nA; cB = nB; ++ui;
        if constexpr (ALIGN_EPI) { if (wr == 1) PG8_BAR; }
    }
    PG8_WAIT_V(0);
    if constexpr (!ALIGN_EPI) { if (wr == 0) PG8_BAR; }
    PG8_BAR;
#undef PG8_SA
#undef PG8_SB
#undef PG8_STAGE
#undef PG8_LDA
#undef PG8_LDB
#undef PG8_MMA
#undef PG8_WAIT_V
#undef PG8_WAIT_L
#undef PG8_BAR
#undef PG8_SCHED
}
}

constexpr int D = 2048, MP = 8192, MS = 512, M = MP + MS, CW = 1024, NH = 8, HD = 128, FF = 5632, NIN = 6144;
constexpr float LN_EPS = 1e-5f;
constexpr float ALPHA = 1.189207115002721f;
constexpr int NWAVES = 8;
constexpr int LDS_BYTES = 147456;
constexpr int N_PHASES = 10;

constexpr size_t MiB = 1u << 20;
constexpr size_t WS_LB = 64 * 1024, WS_BIASP = 128 * 1024;
constexpr size_t WS_WIN = 1 * MiB, WS_WOUT = 25 * MiB, WS_WGU = 33 * MiB, WS_WDN = 77 * MiB;
constexpr size_t WS_XB = 99 * MiB, WS_MIX = 133 * MiB;
constexpr size_t WS_U = 167 * MiB, WS_Q = 184 * MiB, WS_I = 201 * MiB, WS_G = 218 * MiB, WS_F = 235 * MiB, WS_END = 269 * MiB;
constexpr size_t WS_ACT = 167 * MiB;
constexpr int SPLIT5 = 4, SPLIT8 = 11;
constexpr int W_DN_SPLIT = 44 * 64;
constexpr size_t WS_PB5 = 167 * MiB;
constexpr size_t WS_PB8 = 33 * MiB;
static_assert(WS_PB8 + (size_t)SPLIT8 * 512 * 2048 * 4 <= 77 * MiB && (32 % SPLIT5) == 0 && (88 % SPLIT8) == 0 && (32 / SPLIT5) % 2 == 0 && (88 / SPLIT8) % 2 == 0 && 32 / SPLIT5 >= 4 && 88 / SPLIT8 >= 4, "split-K layout");
static_assert(WS_ACT + (size_t)M * FF * 2 <= WS_END, "act overlay");
constexpr size_t O_Y = 0, O_NCP = (size_t)M * D, O_NHP = O_NCP + 4 * 30 * 1024, O_NCS = O_NHP + 4 * 8 * 128 * 128, O_NHS = O_NCS + 32 * 30 * 1024;
constexpr size_t O_ST = 0, O_DC = (size_t)1024 * 16384;

#define LAS __attribute__((address_space(3)))
typedef unsigned short bf16;
typedef float f32x4 __attribute__((ext_vector_type(4)));
typedef float f32x2 __attribute__((ext_vector_type(2)));
typedef unsigned v4u __attribute__((ext_vector_type(4)));
typedef unsigned v2u __attribute__((ext_vector_type(2)));
typedef float f32x16 __attribute__((ext_vector_type(16)));
typedef unsigned u32x8 __attribute__((ext_vector_type(8)));
#define CAS __attribute__((address_space(4)))
#define LDS_WAIT() asm volatile("s_waitcnt lgkmcnt(0)" ::: "memory")

__device__ __forceinline__ unsigned f2bf(float f) { unsigned u = __builtin_bit_cast(unsigned, f); return (u + 0x7fffu + ((u >> 16) & 1u)) >> 16; }
__device__ __forceinline__ unsigned pk2(float lo, float hi) { return f2bf(lo) | (f2bf(hi) << 16); }
__device__ __forceinline__ bf16 bfr(float x) { return (bf16)(pg8::cvt_pk_bf16(x, 0.f) & 0xffffu); }
__device__ __forceinline__ float bf2f(unsigned short b) { return __uint_as_float((unsigned)b << 16); }
__device__ __forceinline__ float sigm(float x) { return __builtin_amdgcn_rcpf(1.0f + __expf(-x)); }
__device__ __forceinline__ float wave_sum(float v) {
    v += __builtin_bit_cast(float, __builtin_amdgcn_mov_dpp(__builtin_bit_cast(int, v), 0xB1, 0xF, 0xF, true));
    v += __builtin_bit_cast(float, __builtin_amdgcn_mov_dpp(__builtin_bit_cast(int, v), 0x4E, 0xF, 0xF, true));
    v += __builtin_bit_cast(float, __builtin_amdgcn_mov_dpp(__builtin_bit_cast(int, v), 0x141, 0xF, 0xF, true));
    v += __builtin_bit_cast(float, __builtin_amdgcn_mov_dpp(__builtin_bit_cast(int, v), 0x140, 0xF, 0xF, true));
    const int vi = __builtin_bit_cast(int, v);
    const float r0 = __builtin_bit_cast(float, __builtin_amdgcn_readlane(vi, 0)), r1 = __builtin_bit_cast(float, __builtin_amdgcn_readlane(vi, 16));
    const float r2 = __builtin_bit_cast(float, __builtin_amdgcn_readlane(vi, 32)), r3 = __builtin_bit_cast(float, __builtin_amdgcn_readlane(vi, 48));
    return (r0 + r1) + (r2 + r3);
}

__device__ __forceinline__ void transpose_item(const float* W, int K, int N, bf16* WT, int k0, int n0, int dst_row0, LAS float* scr, int lane) {
    { f32x4 v[8];
      const int kq = lane >> 3, n4 = (lane & 7) * 4;
#pragma unroll
      for (int i = 0; i < 8; ++i) v[i] = *(const f32x4*)(W + (size_t)(k0 + 8 * i + kq) * N + n0 + n4);
#pragma unroll
      for (int i = 0; i < 8; ++i) { LAS float* d = scr + (8 * i + kq) * 33 + n4; d[0] = v[i].x; d[1] = v[i].y; d[2] = v[i].z; d[3] = v[i].w; } }
    LDS_WAIT(); asm volatile("" ::: "memory");
    const int c = lane & 7;
#pragma unroll
    for (int j = 0; j < 4; ++j) { const int n = (lane >> 3) + 8 * j; const LAS float* s = scr + (8 * c) * 33 + n;
        v4u o; o.x = pk2(s[0 * 33], s[1 * 33]); o.y = pk2(s[2 * 33], s[3 * 33]); o.z = pk2(s[4 * 33], s[5 * 33]); o.w = pk2(s[6 * 33], s[7 * 33]);
        *(v4u*)(WT + (size_t)(dst_row0 + n) * K + k0 + 8 * c) = o; }
    LDS_WAIT(); asm volatile("" ::: "memory");
}

template <int KIND> __device__ __forceinline__ void transpose_stream(const float* W, int K, int N, bf16* WT, int first, int end, int stride, LAS float* scr, int lane) {
    const int nblk = N / 32, kq = lane >> 3, n4 = (lane & 7) * 4, c = lane & 7;
    f32x4 v[8];
    if (first < end) { const int kb = first / nblk, nb = first % nblk;
#pragma unroll
        for (int i = 0; i < 8; ++i) v[i] = __builtin_nontemporal_load((const f32x4*)(W + (size_t)(64 * kb + 8 * i + kq) * N + 32 * nb + n4)); }
    for (int it = first; it < end; it += stride) {
        const int kb = it / nblk, nb = it % nblk, k0 = 64 * kb, n0 = 32 * nb;
        int dst;
        if (KIND == 1) dst = n0 < 2048 ? ((n0 & 1023) >> 7) * 256 + (n0 >> 10) * 128 + (n0 & 127) : n0;
        else if (KIND == 2) dst = (n0 >> 7) * 256 + (n0 & 127);
        else if (KIND == 3) dst = (n0 >> 7) * 256 + 128 + (n0 & 127);
        else dst = n0;
#pragma unroll
        for (int i = 0; i < 8; ++i) { LAS float* d = scr + (8 * i + kq) * 33 + n4; d[0] = v[i].x; d[1] = v[i].y; d[2] = v[i].z; d[3] = v[i].w; }
        { const int nx = it + stride;
          if (nx < end) { const int kb2 = nx / nblk, nb2 = nx % nblk;
#pragma unroll
              for (int i = 0; i < 8; ++i) v[i] = __builtin_nontemporal_load((const f32x4*)(W + (size_t)(64 * kb2 + 8 * i + kq) * N + 32 * nb2 + n4)); } }
        LDS_WAIT(); asm volatile("" ::: "memory");
#pragma unroll
        for (int j = 0; j < 4; ++j) { const int n = (lane >> 3) + 8 * j; const LAS float* sp = scr + (8 * c) * 33 + n;
            v4u o; o.x = pg8::cvt_pk_bf16(sp[0 * 33], sp[1 * 33]); o.y = pg8::cvt_pk_bf16(sp[2 * 33], sp[3 * 33]); o.z = pg8::cvt_pk_bf16(sp[4 * 33], sp[5 * 33]); o.w = pg8::cvt_pk_bf16(sp[6 * 33], sp[7 * 33]);
            *(v4u*)(WT + (size_t)(dst + n) * K + k0 + 8 * c) = o; }
        LDS_WAIT(); asm volatile("" ::: "memory");
    }
}

template <bool SRC_BF16, int NP> __device__ __forceinline__ void ln_row(const void* src, const bf16* part, size_t pstride, float alpha, float* dstf, bf16* dstb, const float* g, const float* b, int lane) {
    f32x4 v[8]; float s = 0.f;
    if constexpr (SRC_BF16) {
#pragma unroll
        for (int j = 0; j < 8; ++j) { const v2u w = ((const v2u*)src)[lane + 64 * j]; v[j] = (f32x4){__uint_as_float(w.x << 16), __uint_as_float(w.x & 0xffff0000u), __uint_as_float(w.y << 16), __uint_as_float(w.y & 0xffff0000u)}; }
    } else {
#pragma unroll
        for (int j = 0; j < 8; ++j) v[j] = __builtin_nontemporal_load((const f32x4*)src + lane + 64 * j);
    }
    if constexpr (NP > 0) {
#pragma unroll
        for (int j = 0; j < 8; ++j) v[j] = v[j] * alpha;
#pragma unroll
        for (int p0 = 0; p0 < NP; p0 += 4) {
            v2u w[4][8];
#pragma unroll
            for (int pp = 0; pp < 4; ++pp) if (p0 + pp < NP) { const v2u* pr = (const v2u*)(part + (size_t)(p0 + pp) * pstride) + lane;
#pragma unroll
                for (int j = 0; j < 8; ++j) w[pp][j] = __builtin_nontemporal_load(pr + 64 * j); }
#pragma unroll
            for (int pp = 0; pp < 4; ++pp) if (p0 + pp < NP) {
#pragma unroll
                for (int j = 0; j < 8; ++j) v[j] += (f32x4){__uint_as_float(w[pp][j].x << 16), __uint_as_float(w[pp][j].x & 0xffff0000u), __uint_as_float(w[pp][j].y << 16), __uint_as_float(w[pp][j].y & 0xffff0000u)}; }
        }
    }
#pragma unroll
    for (int j = 0; j < 8; ++j) s += (v[j].x + v[j].y) + (v[j].z + v[j].w);
    const float mean = wave_sum(s) * (1.f / D); float s2 = 0.f;
#pragma unroll
    for (int j = 0; j < 8; ++j) { v[j] = v[j] - mean; s2 += (v[j].x * v[j].x + v[j].y * v[j].y) + (v[j].z * v[j].z + v[j].w * v[j].w); }
    const float rstd = 1.f / sqrtf(wave_sum(s2) * (1.f / D) + LN_EPS);
#pragma unroll
    for (int j = 0; j < 8; ++j) {
        const f32x4 gg = ((const f32x4*)g)[lane + 64 * j], bb = ((const f32x4*)b)[lane + 64 * j];
        const f32x4 o = v[j] * rstd * gg + bb;
        if (dstf) __builtin_nontemporal_store(o, (f32x4*)dstf + lane + 64 * j);
        if (dstb) { v2u w; w.x = pk2(o.x, o.y); w.y = pk2(o.z, o.w); ((v2u*)dstb)[lane + 64 * j] = w; }
    }
}

__device__ __forceinline__ void ln_core(f32x4 (&v)[8], const f32x4 (&gg)[8], const f32x4 (&bb)[8], float* dstf, bf16* dstb, int lane) {
    float s = 0.f;
#pragma unroll
    for (int j = 0; j < 8; ++j) s += (v[j].x + v[j].y) + (v[j].z + v[j].w);
    const float mean = wave_sum(s) * (1.f / D); float s2 = 0.f;
#pragma unroll
    for (int j = 0; j < 8; ++j) { v[j] = v[j] - mean; s2 += (v[j].x * v[j].x + v[j].y * v[j].y) + (v[j].z * v[j].z + v[j].w * v[j].w); }
    const float rstd = 1.f / sqrtf(wave_sum(s2) * (1.f / D) + LN_EPS);
#pragma unroll
    for (int j = 0; j < 8; ++j) {
        const f32x4 o = v[j] * rstd * gg[j] + bb[j];
        if (dstf) __builtin_nontemporal_store(o, (f32x4*)dstf + lane + 64 * j);
        if (dstb) { v2u w; w.x = pk2(o.x, o.y); w.y = pk2(o.z, o.w); ((v2u*)dstb)[lane + 64 * j] = w; }
    }
}
__device__ __forceinline__ void ln_rows_bf16(const bf16* src, float* dstf, bf16* dstb, const float* g, const float* b, int gw, int NGW, int nrows, int lane) {
    f32x4 gg[8], bb[8];
#pragma unroll
    for (int j = 0; j < 8; ++j) { gg[j] = ((const f32x4*)g)[lane + 64 * j]; bb[j] = ((const f32x4*)b)[lane + 64 * j]; }
    v2u cur[8];
    if (gw < nrows) {
#pragma unroll
        for (int j = 0; j < 8; ++j) cur[j] = __builtin_nontemporal_load((const v2u*)(src + (size_t)gw * D) + lane + 64 * j);
    }
    for (int m = gw; m < nrows; m += NGW) {
        v2u nxt[8];
        const bool hn = m + NGW < nrows;
        if (hn) {
#pragma unroll
            for (int j = 0; j < 8; ++j) nxt[j] = __builtin_nontemporal_load((const v2u*)(src + (size_t)(m + NGW) * D) + lane + 64 * j);
        }
        f32x4 v[8];
#pragma unroll
        for (int j = 0; j < 8; ++j) v[j] = (f32x4){__uint_as_float(cur[j].x << 16), __uint_as_float(cur[j].x & 0xffff0000u), __uint_as_float(cur[j].y << 16), __uint_as_float(cur[j].y & 0xffff0000u)};
        ln_core(v, gg, bb, dstf ? dstf + (size_t)m * D : nullptr, dstb ? dstb + (size_t)m * D : nullptr, lane);
        if (hn) {
#pragma unroll
            for (int j = 0; j < 8; ++j) cur[j] = nxt[j];
        }
    }
}

#define XB_TMO      128
#define XB_XCNT(j)  (256  + 64 * (j))
#define XB_XSUB(j)  (1280 + 64 * (j))
#define XB_XGEN(j)  (2304 + 64 * (j))
#define XB_TOP      3328
#define XB_TOPGEN   3392
#define XCD_BAR_WORDS 3456
#define XB_SPIN_CAP (1u << 18)
__device__ __forceinline__ unsigned xb_ld(unsigned* p)              { return __hip_atomic_load(p, __ATOMIC_RELAXED, __HIP_MEMORY_SCOPE_AGENT); }
__device__ __forceinline__ unsigned xb_add(unsigned* p, unsigned v) { return __hip_atomic_fetch_add(p, v, __ATOMIC_RELAXED, __HIP_MEMORY_SCOPE_AGENT); }
__device__ __forceinline__ unsigned xb_xcc_id() { return (unsigned)__builtin_amdgcn_s_getreg((3 << 11) | 20) & 0xFu; }
#define XB_SPIN(cond, bar) do { unsigned _sp = 0; while (cond) { __builtin_amdgcn_s_sleep(1); \
    if ((++_sp & 255u) == 0u) { if (xb_ld(&(bar)[XB_TMO])) break; if (_sp > XB_SPIN_CAP) { atomicAdd(&(bar)[XB_TMO], 1u); break; } } } } while (0)
struct XcdBarrier { unsigned* bar; unsigned x; volatile LAS unsigned* st; };
__device__ __forceinline__ XcdBarrier xcd_barrier_post(unsigned* bar, volatile LAS unsigned* st) {
    XcdBarrier b; b.bar = bar; b.x = xb_xcc_id(); b.st = st;
    if (threadIdx.x == 0) (void)xb_add(&bar[XB_XCNT(b.x)], 1u);
    return b;
}
__device__ __forceinline__ void xcd_barrier_complete(unsigned* bar, unsigned x, unsigned& nloc, unsigned& nx) {
    const unsigned G = gridDim.x * gridDim.y * gridDim.z;
    unsigned sum, cnt, mine, sp = 0u;
    for (;;) {
        sum = 0u; cnt = 0u; mine = 0u;
#pragma unroll
        for (unsigned j = 0; j < 16; ++j) { const unsigned c = xb_ld(&bar[XB_XCNT(j)]); sum += c; cnt += (c > 0u) ? 1u : 0u; mine = (j == x) ? c : mine; }
        if (sum == G) break;
        __builtin_amdgcn_s_sleep(1);
        if ((++sp & 255u) == 0u) { if (xb_ld(&bar[XB_TMO])) break; if (sp > XB_SPIN_CAP) { atomicAdd(&bar[XB_TMO], 1u); break; } }
    }
    nloc = mine > 0u ? mine : 1u; nx = cnt > 0u ? cnt : 1u;
}
__device__ __forceinline__ void xcd_barrier(const XcdBarrier& b) {
    asm volatile("s_waitcnt vmcnt(0)" ::: "memory");
    __syncthreads();
    if (threadIdx.x == 0) {
        unsigned* bar = b.bar;
        __builtin_amdgcn_s_waitcnt(0);
        unsigned nloc = b.st[0], nx = b.st[1];
        if (nloc == 0u) { xcd_barrier_complete(bar, b.x, nloc, nx); b.st[0] = nloc; b.st[1] = nx; }
        const unsigned old = xb_add(&bar[XB_XSUB(b.x)], 1u);
        const unsigned gen = old / nloc;
        if (old + 1u == (gen + 1u) * nloc) {
            __builtin_amdgcn_fence(__ATOMIC_RELEASE, "agent");
            asm volatile("s_waitcnt vmcnt(0)" ::: "memory");
            const unsigned og = xb_add(&bar[XB_TOP], 1u);
            const unsigned tg = og / nx;
            if (og + 1u == (tg + 1u) * nx) xb_add(&bar[XB_TOPGEN], 1u);
            else XB_SPIN(xb_ld(&bar[XB_TOPGEN]) == tg, bar);
            __builtin_amdgcn_fence(__ATOMIC_ACQUIRE, "agent");
            xb_add(&bar[XB_XGEN(b.x)], 1u);
            asm volatile("s_waitcnt vmcnt(0)" ::: "memory");
        } else {
            XB_SPIN(xb_ld(&bar[XB_XGEN(b.x)]) == gen, bar);
            __builtin_amdgcn_fence(__ATOMIC_ACQUIRE, "agent");
            asm volatile("s_waitcnt vmcnt(0)" ::: "memory");
        }
    }
    __syncthreads();
}

struct Args { const float* in[20]; float* out; unsigned char* ws; int ph_lo, ph_hi; };

__global__ void __launch_bounds__(NWAVES * 64, 2) fwd_kernel(Args args) {
    extern __shared__ __attribute__((aligned(16))) unsigned char lds_raw[];
    LAS unsigned char* lds = (LAS unsigned char*)lds_raw;
    const int tid = threadIdx.x, lane = tid & 63, wave = __builtin_amdgcn_readfirstlane(tid >> 6);
    const int G = gridDim.x, bx = blockIdx.x;
    const int gt = bx * 512 + tid, NT = G * 512;
    const int gw = bx * NWAVES + wave, NGW = G * NWAVES;

#define x_prompt (args.in[0])
#define x_sample (args.in[1])
#define cache_conv (args.in[2])
#define state_hgrn (args.in[3])
#define w_in (args.in[4])
#define b_in (args.in[5])
#define w_dw (args.in[6])
#define b_dw (args.in[7])
#define cn_g (args.in[8])
#define cn_b (args.in[9])
#define hlb (args.in[10])
#define hg_ng (args.in[11])
#define w_out (args.in[12])
#define ln1_g (args.in[13])
#define ln1_b (args.in[14])
#define w_gate (args.in[15])
#define w_up (args.in[16])
#define w_down (args.in[17])
#define ln2_g (args.in[18])
#define ln2_b (args.in[19])
#define out (args.out)
#define ws (args.ws)
#define LB ((float*)(ws + WS_LB))
#define BIASP ((float*)(ws + WS_BIASP))
#define WIN ((bf16*)(ws + WS_WIN))
#define WOUT ((bf16*)(ws + WS_WOUT))
#define WGU ((bf16*)(ws + WS_WGU))
#define WDN ((bf16*)(ws + WS_WDN))
#define XB ((bf16*)(ws + WS_XB))
#define MIX ((bf16*)(ws + WS_MIX))
#define U ((bf16*)(ws + WS_U))
#define Q ((bf16*)(ws + WS_Q))
#define F ((float*)(ws + WS_F))
#define I ((bf16*)(ws + WS_I))
#define Gt ((bf16*)(ws + WS_G))
#define ACT ((bf16*)(ws + WS_ACT))
#define ST (out + O_ST)
#define DC (out + O_DC)

    const int lo = args.ph_lo, hi = args.ph_hi;
    volatile LAS unsigned* MISC = (volatile LAS unsigned*)(lds + LDS_BYTES - 64);
    if (tid < 16) MISC[tid] = 0u;
    __syncthreads();
    XcdBarrier xbar = xcd_barrier_post((unsigned*)ws, MISC + 8);
#ifndef PH_MASK
#define PH_MASK 0x3ff
#endif
#define IN(k) (((PH_MASK >> (k)) & 1) && lo <= (k) && (k) < hi)
#ifndef REP_MASK
#define REP_MASK 0
#endif
#define NREP(k) (1 + ((REP_MASK >> (k)) & 1))
#ifdef TS_A
    unsigned long long ts_a = 0, ts_b = 0;
#define STAMP(k) do { if ((k) == TS_A) ts_a = __builtin_amdgcn_s_memrealtime(); if ((k) == TS_B) ts_b = __builtin_amdgcn_s_memrealtime(); } while (0)
#else
#define STAMP(k) do { } while (0)
#endif
#define SEAM(k) do { if (IN(k) && IN((k) + 1)) { xcd_barrier(xbar); } STAMP((k) + 1); } while (0)
    STAMP(0);
    if (hi > 1000) cg::this_grid().sync();

    if (IN(0)) for (int rep_ = 0; rep_ < NREP(0); ++rep_) { if (rep_) xcd_barrier(xbar);
        LAS float* scr = (LAS float*)(lds + wave * 16384);
        constexpr int I_IN = 32 * 192;
        transpose_stream<1>(w_in, D, NIN, WIN, gw, I_IN, NGW, scr, lane);
        constexpr int NV = M * D / 8, NVP = MP * D / 8;
#pragma unroll 4
        for (int i = gt; i < NV; i += NT) {
            const float* src = i < NVP ? x_prompt + (size_t)i * 8 : x_sample + (size_t)(i - NVP) * 8;
            const f32x4 a = __builtin_nontemporal_load((const f32x4*)src), b = __builtin_nontemporal_load((const f32x4*)(src + 4));
            v4u o; o.x = pk2(a.x, a.y); o.y = pk2(a.z, a.w); o.z = pk2(b.x, b.y); o.w = pk2(b.z, b.w);
            *(v4u*)(XB + (size_t)i * 8) = o;
        }
        for (int i = gt; i < 1024; i += NT) LB[i] = sigm(hlb[i] - hlb[1024 + i]);
        for (int i = gt; i < NIN; i += NT) { const int orig = i < 2048 ? ((i & 255) >> 7) * 1024 + (i >> 8) * 128 + (i & 127) : i; BIASP[i] = b_in[orig]; }
    }
    SEAM(0);
#ifdef EXTRA_SYNCS
    for (int i_ = 0; i_ < EXTRA_SYNCS; ++i_) cg::this_grid().sync();
#endif

    if (IN(1)) for (int rep_ = 0; rep_ < NREP(1); ++rep_) { if (rep_) xcd_barrier(xbar);
        pg8::Gemm g{XB, WIN, M, NIN, D}; pg8::StaticOrder S; S.init(M, NIN, D, G, bx);
        pg8::EpiProj E{U, Q, F, BIASP, LB};
        pg8::gemm_phase<pg8::EpiProj, pg8::StaticOrder, true, true>(lds, g, S, E);
        const int nlast = S.nitems % G;
        if (nlast > 0 && bx >= nlast) {
            LAS float* scr = (LAS float*)(lds + wave * 16384);
            constexpr int I_OUT = 32 * 64, I_G = 32 * 176, I_DN = 88 * 64;
            const int gw2 = (bx - nlast) * NWAVES + wave, NGW2 = (G - nlast) * NWAVES;
            transpose_stream<0>(w_out, D, D, WOUT, gw2, I_OUT, NGW2, scr, lane);
            transpose_stream<2>(w_gate, D, FF, WGU, gw2, I_G, NGW2, scr, lane);
            transpose_stream<3>(w_up, D, FF, WGU, gw2, I_G, NGW2, scr, lane);
        }
    }
    SEAM(1);

    if (IN(2)) for (int rep_ = 0; rep_ < NREP(2); ++rep_) { if (rep_) xcd_barrier(xbar);
#define LBAR2() do { asm volatile("s_waitcnt lgkmcnt(0)" ::: "memory"); __builtin_amdgcn_s_barrier(); asm volatile("" ::: "memory"); } while (0)
        float pf[16]; unsigned short pi[16];
#define P2_LOAD(IT) do { const int bh_ = (IT) >> 5, c_ = (IT) & 31, h_ = bh_ & 7, row0_ = (bh_ >> 3) * 2048 + c_ * 64; const int k_ = tid & 127, qtr_ = __builtin_amdgcn_readfirstlane(tid >> 7); \
            _Pragma("unroll") for (int s_ = 0; s_ < 16; ++s_) { const size_t gi = (size_t)(row0_ + qtr_ * 16 + s_) * 1024 + h_ * 128 + k_; pf[s_] = F[gi]; pi[s_] = I[gi]; } } while (0)
        if (bx < 1024) P2_LOAD(bx);
        for (int it = bx; it < 1024 + 544; it += G) {
#ifdef P2_PROBE
            if (rep_ == 1 && ((P2_PROBE == 1) == (it >= 1024))) continue;
#endif
            LBAR2();
            if (it == 1024 + bx) STAMP(20);
            if (it < 1024) {
                const int bh = it >> 5, c = it & 31, b = bh >> 3, h = bh & 7;
                const int row0 = b * 2048 + c * 64;
                LAS bf16* KEt = (LAS bf16*)lds;
                LAS bf16* Vt = (LAS bf16*)(lds + 18432);
                LAS float* Tq = (LAS float*)(lds + 36864);
                const int k = tid & 127, qtr = __builtin_amdgcn_readfirstlane(tid >> 7);
                float lf[16], kk[16]; unsigned short iv[16];
#pragma unroll
                for (int s_ = 0; s_ < 16; ++s_) { const float f = pf[s_]; lf[s_] = __builtin_amdgcn_logf(f); kk[s_] = 1.0f - f; iv[s_] = pi[s_]; }
                if (it + G < 1024) P2_LOAD(it + G);
                float run = 0.f; float suf[16];
#pragma unroll
                for (int s_ = 15; s_ >= 0; --s_) { suf[s_] = run; run += lf[s_]; }
                Tq[qtr * 128 + k] = run;
                { v4u w0, w1;
                  w0.x = iv[0] | ((unsigned)iv[1] << 16); w0.y = iv[2] | ((unsigned)iv[3] << 16); w0.z = iv[4] | ((unsigned)iv[5] << 16); w0.w = iv[6] | ((unsigned)iv[7] << 16);
                  w1.x = iv[8] | ((unsigned)iv[9] << 16); w1.y = iv[10] | ((unsigned)iv[11] << 16); w1.z = iv[12] | ((unsigned)iv[13] << 16); w1.w = iv[14] | ((unsigned)iv[15] << 16);
                  *(LAS v4u*)(Vt + k * 72 + qtr * 16) = w0; *(LAS v4u*)(Vt + k * 72 + qtr * 16 + 8) = w1; }
                LBAR2();
                float later = 0.f, total = 0.f;
#pragma unroll
                for (int q2 = 0; q2 < 4; ++q2) { const float tq = Tq[q2 * 128 + k]; total += tq; later += q2 > qtr ? tq : 0.f; }
                { float ke[16];
#pragma unroll
                  for (int s_ = 0; s_ < 16; ++s_) ke[s_] = kk[s_] * __builtin_amdgcn_exp2f(suf[s_] + later);
                  v4u w0, w1;
                  w0.x = pg8::cvt_pk_bf16(ke[0], ke[1]); w0.y = pg8::cvt_pk_bf16(ke[2], ke[3]); w0.z = pg8::cvt_pk_bf16(ke[4], ke[5]); w0.w = pg8::cvt_pk_bf16(ke[6], ke[7]);
                  w1.x = pg8::cvt_pk_bf16(ke[8], ke[9]); w1.y = pg8::cvt_pk_bf16(ke[10], ke[11]); w1.z = pg8::cvt_pk_bf16(ke[12], ke[13]); w1.w = pg8::cvt_pk_bf16(ke[14], ke[15]);
                  *(LAS v4u*)(KEt + k * 72 + qtr * 16) = w0; *(LAS v4u*)(KEt + k * 72 + qtr * 16 + 8) = w1; }
                if (qtr == 0) DC[it * 128 + k] = exp2f(total);
                LBAR2();
                { const int r = lane & 15, q = lane >> 4;
                  const pg8::bf16x8 a0 = *(const LAS pg8::bf16x8*)(Vt + (16 * wave + r) * 72 + 8 * q), a1 = *(const LAS pg8::bf16x8*)(Vt + (16 * wave + r) * 72 + 8 * q + 32);
                  float* sp = ST + (size_t)it * 16384 + (size_t)(16 * wave + 4 * q) * 128 + r;
#pragma unroll
                  for (int kt = 0; kt < 8; ++kt) {
                      const pg8::bf16x8 b0 = *(const LAS pg8::bf16x8*)(KEt + (16 * kt + r) * 72 + 8 * q), b1 = *(const LAS pg8::bf16x8*)(KEt + (16 * kt + r) * 72 + 8 * q + 32);
                      f32x4 acc = (f32x4){0.f, 0.f, 0.f, 0.f};
                      acc = __builtin_amdgcn_mfma_f32_16x16x32_bf16(a0, b0, acc, 0, 0, 0);
                      acc = __builtin_amdgcn_mfma_f32_16x16x32_bf16(a1, b1, acc, 0, 0, 0);
#pragma unroll
                      for (int j = 0; j < 4; ++j) sp[j * 128 + 16 * kt] = acc[j];
                  } }
            } else {
                const int m0 = (it - 1024) * 16;
                const bool samp = m0 >= MP;
                int t0, seq0; const float* hist = cache_conv;
                if (!samp) { t0 = m0 & 2047; seq0 = m0 - t0; }
                else { t0 = 0; seq0 = m0; hist = cache_conv + (size_t)((m0 - MP) >> 4) * 30 * 1024; }
                const int hrow0 = samp ? ((m0 - MP) >> 4) * 30 : 0;
                const __amdgpu_buffer_rsrc_t rU = __builtin_amdgcn_make_buffer_rsrc((void*)U, 0, M * 1024 * 2, 0x00020000);
                const __amdgpu_buffer_rsrc_t rH = __builtin_amdgcn_make_buffer_rsrc((void*)cache_conv, 0, 32 * 30 * 1024 * 4, 0x00020000);
                const __amdgpu_buffer_rsrc_t rW = __builtin_amdgcn_make_buffer_rsrc((void*)w_dw, 0, 31 * 1024 * 4, 0x00020000);
                const bool interior = t0 >= 30;
                LAS float* hbuf = (LAS float*)(lds + 16384);
                LAS f32x2* stat = (LAS f32x2*)(lds + 16384 + 65536);
                const int c = 2 * tid;
                f32x2 acc[16];
                { const f32x2 bb = *(const f32x2*)(b_dw + c);
#pragma unroll
                  for (int t = 0; t < 16; ++t) acc[t] = bb; }
#pragma unroll
                for (int ch = 0; ch < 2; ++ch) {
                    const int j0 = ch * 16, nj = ch ? 15 : 16;
                    f32x2 win[31];
                    if (interior) {
                        const int rb = (seq0 + t0 - 30 + j0) * 2048;
#pragma unroll
                        for (int xi = 0; xi < 31; ++xi) if (xi < nj + 15) { const unsigned pw = __builtin_amdgcn_raw_buffer_load_b32(rU, 4 * tid, rb + xi * 2048, 0); win[xi] = (f32x2){__uint_as_float(pw << 16), __uint_as_float(pw & 0xffff0000u)}; }
                    } else {
#pragma unroll
                        for (int xi = 0; xi < 31; ++xi) if (xi < nj + 15) {
                            const int tr = t0 - 30 + j0 + xi;
                            f32x2 wv = (f32x2){0.f, 0.f};
                            if (tr >= 0) { const unsigned pw = __builtin_amdgcn_raw_buffer_load_b32(rU, 4 * tid, (seq0 + tr) * 2048, 0); wv = (f32x2){__uint_as_float(pw << 16), __uint_as_float(pw & 0xffff0000u)}; }
                            else if (samp) { const v2u hv = __builtin_amdgcn_raw_buffer_load_b64(rH, 8 * tid, (hrow0 + 30 + tr) * 4096, 0); wv = (f32x2){__uint_as_float(hv.x), __uint_as_float(hv.y)}; }
                            win[xi] = wv;
                        }
                    }
#pragma unroll
                    for (int jj = 0; jj < 16; ++jj) if (jj < nj) { const v2u wu = __builtin_amdgcn_raw_buffer_load_b64(rW, 8 * tid, (j0 + jj) * 4096, 0); const f32x2 w2 = (f32x2){__uint_as_float(wu.x), __uint_as_float(wu.y)};
#pragma unroll
                        for (int t = 0; t < 16; ++t) acc[t] += w2 * win[t + jj]; }
                    asm volatile("" ::: "memory");
                }
#pragma unroll
                for (int t = 0; t < 16; ++t) *(LAS f32x2*)(hbuf + t * 1024 + c) = acc[t];
                __syncthreads();
#pragma unroll
                for (int tt = 0; tt < 2; ++tt) { const int t = 2 * wave + tt; float s1 = 0.f, s2 = 0.f;
#pragma unroll
                    for (int i = 0; i < 4; ++i) { const f32x4 x = *(const LAS f32x4*)(hbuf + t * 1024 + 4 * lane + 256 * i); s1 += (x.x + x.y) + (x.z + x.w); s2 += (x.x * x.x + x.y * x.y) + (x.z * x.z + x.w * x.w); }
                    s1 = wave_sum(s1); s2 = wave_sum(s2);
                    const float mu = s1 * (1.f / 1024.f); float var = s2 * (1.f / 1024.f) - mu * mu; var = var > 0.f ? var : 0.f;
                    if (lane == 0) stat[t] = (f32x2){mu, 1.f / sqrtf(var + LN_EPS)}; }
                __syncthreads();
                const f32x2 gg = *(const f32x2*)(cn_g + c), bb2 = *(const f32x2*)(cn_b + c);
#pragma unroll
                for (int t = 0; t < 16; ++t) {
                    const f32x2 st2 = stat[t];
                    float y0 = (acc[t].x - st2.x) * st2.y * gg.x + bb2.x, y1 = (acc[t].y - st2.x) * st2.y * gg.y + bb2.y;
                    y0 = y0 * sigm(y0); y1 = y1 * sigm(y1);
                    *(unsigned*)(MIX + (size_t)(m0 + t) * 2048 + c) = pk2(y0, y1);
                }
            }
        }
        STAMP(21);
        { const int nx = (1024 + 544) % G;
          const int first = (nx > 0 && nx < G) ? nx : 0, nwg = G - first;
          if (bx >= first) {
              const int gt2 = (bx - first) * 512 + tid, NT2 = nwg * 512;
              for (int i = gt2; i < 4 * 30 * 1024; i += NT2) { const int b = i / 30720, j = (i >> 10) % 30, c = i & 1023;
                  __builtin_nontemporal_store(bf2f(U[(size_t)(b * 2048 + 2018 + j) * 1024 + c]), out + O_NCP + i); }
              for (int i = gt2; i < 32 * 30 * 1024; i += NT2) { const int sb = i / 30720, j = (i >> 10) % 30, c = i & 1023;
                  __builtin_nontemporal_store(j < 14 ? cache_conv[(size_t)sb * 30720 + (16 + j) * 1024 + c] : bf2f(U[(size_t)(MP + sb * 16 + j - 14) * 1024 + c]), out + O_NCS + i); }
          } }
    }
    SEAM(2);

    if (IN(3)) {
        for (int e = gt; e < 32 * 4096; e += NT) {
            const int bh = e >> 12, r = e & 4095, v = r >> 5, k4 = r & 31;
            f32x4 S = (f32x4){0.f, 0.f, 0.f, 0.f};
#pragma unroll 8
            for (int c = 0; c < 32; ++c) {
                f32x4* p = (f32x4*)(ST + ((size_t)(bh * 32 + c) * 128 + v) * 128 + k4 * 4);
                const f32x4 A = __builtin_nontemporal_load(p); const f32x4 d = *(const f32x4*)(DC + (bh * 32 + c) * 128 + k4 * 4);
                *p = S; S = S * d + A;
            }
            float* o = out + O_NHP + (size_t)bh * 16384 + (size_t)(k4 * 4) * 128 + v;
            __builtin_nontemporal_store(S.x, o); __builtin_nontemporal_store(S.y, o + 128); __builtin_nontemporal_store(S.z, o + 256); __builtin_nontemporal_store(S.w, o + 384);
        }
    }
    SEAM(3);

    if (IN(4)) for (int rep_ = 0; rep_ < NREP(4); ++rep_) { if (rep_) xcd_barrier(xbar);
        LAS float* vl = (LAS float*)lds; LAS float* red = (LAS float*)(lds + 8192);
        LAS float* fl2 = (LAS float*)(lds + 73728); LAS float* ql2 = (LAS float*)(lds + 81920);
#define LBAR() do { asm volatile("s_waitcnt lgkmcnt(0)" ::: "memory"); __builtin_amdgcn_s_barrier(); asm volatile("" ::: "memory"); } while (0)
        float fr[16]; unsigned short qh[16], ih[16]; unsigned gq[8]; f32x4 sv[8];
#define P4_LOAD(IT) do { const int bh_ = (IT) >> 5, c_ = (IT) & 31, h_ = bh_ & 7, row0_ = (bh_ >> 3) * 2048 + c_ * 64; const int k_ = tid & 127, qtr_ = __builtin_amdgcn_readfirstlane(tid >> 7); \
            _Pragma("unroll") for (int s_ = 0; s_ < 16; ++s_) { const size_t gi = (size_t)(row0_ + qtr_ * 16 + s_) * 1024 + h_ * 128 + k_; fr[s_] = __builtin_nontemporal_load(F + gi); qh[s_] = __builtin_nontemporal_load(Q + gi); ih[s_] = __builtin_nontemporal_load(I + gi); } \
            _Pragma("unroll") for (int j = 0; j < 8; ++j) sv[j] = __builtin_nontemporal_load((const f32x4*)(ST + (size_t)(IT) * 16384 + (size_t)(tid + 512 * j) * 4)); \
            _Pragma("unroll") for (int tt = 0; tt < 8; ++tt) { const size_t m = (size_t)(row0_ + wave * 8 + tt); gq[tt] = __builtin_nontemporal_load((const unsigned*)(Gt + m * 1024 + h_ * 128 + 2 * lane)); } } while (0)
        if (bx < 1024) P4_LOAD(bx);
        float ng0 = hg_ng[2 * lane], ng1 = hg_ng[2 * lane + 1];
        asm volatile("" : "+v"(ng0), "+v"(ng1));
        for (int it = bx; it < 1024; it += G) {
          {
            const int bh = it >> 5, c = it & 31, h = bh & 7, row0 = (bh >> 3) * 2048 + c * 64;
            LAS bf16* St = (LAS bf16*)lds;
            LAS bf16* QD = (LAS bf16*)(lds + 34816);
            LAS bf16* Vt = (LAS bf16*)(lds + 52224);
            LAS bf16* Pm = (LAS bf16*)(lds + 70656);
            LAS bf16* QDI = (LAS bf16*)(lds + 79872);
            LAS bf16* KD = (LAS bf16*)(lds + 97280);
            LAS float* Tq = (LAS float*)(lds + 140800);
            LAS float* Ob = (LAS float*)(lds + 79872);
            LBAR();
            const int k = tid & 127, qtr = __builtin_amdgcn_readfirstlane(tid >> 7);
            float pre[16], kk[16], qq[16]; unsigned short iv[16];
#pragma unroll
            for (int s_ = 0; s_ < 16; ++s_) { const float f = fr[s_]; pre[s_] = __builtin_amdgcn_logf(f); kk[s_] = 1.0f - f; qq[s_] = bf2f(qh[s_]); iv[s_] = ih[s_]; }
#pragma unroll
            for (int j = 0; j < 8; ++j) { const int e = tid + 512 * j, v = e >> 5, k4 = e & 31; const f32x4 x = sv[j];
                v2u w; w.x = pk2(x.x, x.y); w.y = pk2(x.z, x.w); *(LAS v2u*)(St + v * 136 + k4 * 4) = w; }
#pragma unroll
            for (int s_ = 1; s_ < 16; ++s_) pre[s_] += pre[s_ - 1];
            const float tot = pre[15];
            Tq[qtr * 128 + k] = tot;
            { v4u w0, w1;
              w0.x = iv[0] | ((unsigned)iv[1] << 16); w0.y = iv[2] | ((unsigned)iv[3] << 16); w0.z = iv[4] | ((unsigned)iv[5] << 16); w0.w = iv[6] | ((unsigned)iv[7] << 16);
              w1.x = iv[8] | ((unsigned)iv[9] << 16); w1.y = iv[10] | ((unsigned)iv[11] << 16); w1.z = iv[12] | ((unsigned)iv[13] << 16); w1.w = iv[14] | ((unsigned)iv[15] << 16);
              *(LAS v4u*)(Vt + k * 72 + qtr * 16) = w0; *(LAS v4u*)(Vt + k * 72 + qtr * 16 + 8) = w1; }
            const int kdoff = qtr == 0 ? 0 : (qtr == 1 ? 16 : (qtr == 2 ? 48 : 96));
#pragma unroll
            for (int s_ = 0; s_ < 16; ++s_) {
                QDI[(16 * qtr + s_) * 136 + k] = bfr(qq[s_] * __builtin_amdgcn_exp2f(pre[s_]));
                KD[(kdoff + 16 * qtr + s_) * 136 + k] = bfr(kk[s_] * __builtin_amdgcn_exp2f(fminf(-pre[s_], 120.f)));
            }
            LBAR();
            { float lb_ = 0.f;
#pragma unroll
              for (int q2 = 0; q2 < 4; ++q2) lb_ += q2 < qtr ? Tq[q2 * 128 + k] : 0.f;
#pragma unroll
              for (int s_ = 0; s_ < 16; ++s_) QD[(16 * qtr + s_) * 136 + k] = bfr(qq[s_] * __builtin_amdgcn_exp2f(pre[s_] + lb_));
              float gap = 0.f;
              for (int i = qtr + 1; i < 4; ++i) {
                  const int off = i == 1 ? 16 : (i == 2 ? 48 : 96);
#pragma unroll
                  for (int s_ = 0; s_ < 16; ++s_) KD[(off + 16 * qtr + s_) * 136 + k] = bfr(kk[s_] * __builtin_amdgcn_exp2f((tot - pre[s_]) + gap));
                  gap += Tq[i * 128 + k];
              } }
            unsigned gpre[8];
#pragma unroll
            for (int i = 0; i < 8; ++i) gpre[i] = gq[i];
            if (it + G < 1024) P4_LOAD(it + G);
            LBAR();
            const int r = lane & 15, q = lane >> 4;
            for (int n = wave; n < 10; n += 8) {
                const int i = n == 0 ? 0 : (n < 3 ? 1 : (n < 6 ? 2 : 3)), j = n - (i == 0 ? 0 : (i == 1 ? 1 : (i == 2 ? 3 : 6)));
                const int off = i == 0 ? 0 : (i == 1 ? 16 : (i == 2 ? 48 : 96));
                f32x4 acc = (f32x4){0.f, 0.f, 0.f, 0.f};
#pragma unroll
                for (int ks = 0; ks < 4; ++ks) {
                    const pg8::bf16x8 a = *(const LAS pg8::bf16x8*)(QDI + (16 * i + r) * 136 + 8 * q + 32 * ks);
                    const pg8::bf16x8 bq = *(const LAS pg8::bf16x8*)(KD + (off + 16 * j + r) * 136 + 8 * q + 32 * ks);
                    acc = __builtin_amdgcn_mfma_f32_16x16x32_bf16(a, bq, acc, 0, 0, 0);
                }
#pragma unroll
                for (int jj = 0; jj < 4; ++jj) { const float x = (i != j || r <= 4 * q + jj) ? acc[jj] : 0.f; Pm[(16 * i + 4 * q + jj) * 72 + 16 * j + r] = bfr(x); }
            }
            if (wave == 2 || wave == 3) { const int i = wave == 2 ? 0 : 2, j = i + 1;
#pragma unroll
                for (int jj = 0; jj < 4; ++jj) Pm[(16 * i + 4 * q + jj) * 72 + 16 * j + r] = (bf16)0; }
            LBAR();
            { const int i = wave >> 1, vt0 = 4 * (wave & 1);
              pg8::bf16x8 pa[2], qa[4];
#pragma unroll
              for (int ks = 0; ks < 2; ++ks) pa[ks] = *(const LAS pg8::bf16x8*)(Pm + (16 * i + r) * 72 + 8 * q + 32 * ks);
#pragma unroll
              for (int ks = 0; ks < 4; ++ks) qa[ks] = *(const LAS pg8::bf16x8*)(QD + (16 * i + r) * 136 + 8 * q + 32 * ks);
#pragma unroll
              for (int vv = 0; vv < 4; ++vv) { const int vt = vt0 + vv;
                  f32x4 acc = (f32x4){0.f, 0.f, 0.f, 0.f};
                  acc = __builtin_amdgcn_mfma_f32_16x16x32_bf16(pa[0], *(const LAS pg8::bf16x8*)(Vt + (16 * vt + r) * 72 + 8 * q), acc, 0, 0, 0);
                  if (i >= 2) acc = __builtin_amdgcn_mfma_f32_16x16x32_bf16(pa[1], *(const LAS pg8::bf16x8*)(Vt + (16 * vt + r) * 72 + 8 * q + 32), acc, 0, 0, 0);
#pragma unroll
                  for (int ks = 0; ks < 4; ++ks) acc = __builtin_amdgcn_mfma_f32_16x16x32_bf16(qa[ks], *(const LAS pg8::bf16x8*)(St + (16 * vt + r) * 136 + 8 * q + 32 * ks), acc, 0, 0, 0);
#pragma unroll
                  for (int jj = 0; jj < 4; ++jj) Ob[(16 * i + 4 * q + jj) * 132 + 16 * vt + r] = acc[jj];
              } }
            LBAR();
            { float o0[8], o1[8], ss[8];
#pragma unroll
              for (int tt = 0; tt < 8; ++tt) { const int t = wave * 8 + tt; const f32x2 ov = *(const LAS f32x2*)(Ob + t * 132 + 2 * lane); o0[tt] = ov.x; o1[tt] = ov.y; ss[tt] = o0[tt] * o0[tt] + o1[tt] * o1[tt]; }
#pragma unroll
              for (int tt = 0; tt < 8; ++tt) ss[tt] = wave_sum(ss[tt]);
#pragma unroll
              for (int tt = 0; tt < 8; ++tt) {
                  const float rr = __builtin_amdgcn_rsqf(ss[tt] * (1.f / 128.f) + LN_EPS);
                  const size_t m = (size_t)(row0 + wave * 8 + tt);
                  const float g0 = __uint_as_float(gpre[tt] << 16), g1 = __uint_as_float(gpre[tt] & 0xffff0000u);
                  *(unsigned*)(MIX + m * 2048 + 1024 + h * 128 + 2 * lane) = pg8::cvt_pk_bf16(o0[tt] * rr * ng0 * g0, o1[tt] * rr * ng1 * g1);
              } }
          }
        }
#undef P4_LOAD
#undef LBAR
        __syncthreads();
        STAMP(22);
        for (int it = 1024 + bx; it < 1024 + 256; it += G) {
          {
            int row0, h, nsb; const float* sinit; float* sfin = nullptr;
            if (it < 1024) { const int bh = it >> 5, c = it & 31; h = bh & 7; row0 = (bh >> 3) * 2048 + c * 64; nsb = 4; sinit = ST + (size_t)it * 16384; }
            else { const int j = it - 1024; h = j & 7; row0 = MP + (j >> 3) * 16; nsb = 1; sinit = state_hgrn + (size_t)j * 16384; sfin = out + O_NHS + (size_t)j * 16384; }
            f32x2 Sa[8], Sb[8];
            { const float* sp = sinit + (size_t)(wave * 16) * 128 + lane;
#pragma unroll
              for (int i = 0; i < 8; ++i) { Sa[i] = (f32x2){__builtin_nontemporal_load(sp + (2 * i) * 128), __builtin_nontemporal_load(sp + (2 * i + 1) * 128)}; Sb[i] = (f32x2){__builtin_nontemporal_load(sp + (2 * i) * 128 + 64), __builtin_nontemporal_load(sp + (2 * i + 1) * 128 + 64)}; } }
            for (int sb = 0; sb < nsb; ++sb) {
                __syncthreads();
#pragma unroll
                for (int e4 = 0; e4 < 4; ++e4) { const int e = tid + e4 * 512, t = e >> 7, k = e & 127; const size_t gi = (size_t)(row0 + sb * 16 + t) * 1024 + h * 128 + k;
                    vl[e] = bf2f(I[gi]); fl2[e] = F[gi]; ql2[e] = bf2f(Q[gi]); }
                __syncthreads();
#pragma unroll 2
                for (int t = 0; t < 16; ++t) {
                    f32x4 f4[4], q4[4];
#pragma unroll
                    for (int i = 0; i < 4; ++i) { f4[i] = *(const LAS f32x4*)(fl2 + t * 128 + wave * 16 + 4 * i); q4[i] = *(const LAS f32x4*)(ql2 + t * 128 + wave * 16 + 4 * i); }
                    const float va = vl[t * 128 + lane], vb = vl[t * 128 + 64 + lane];
                    const f32x2 va2 = (f32x2){va, va}, vb2 = (f32x2){vb, vb};
                    f32x2 oa = (f32x2){0.f, 0.f}, ob = (f32x2){0.f, 0.f};
#pragma unroll
                    for (int i = 0; i < 8; ++i) { const f32x2 f2 = (f32x2){f4[i >> 1][2 * (i & 1)], f4[i >> 1][2 * (i & 1) + 1]};
                        const f32x2 q2 = (f32x2){q4[i >> 1][2 * (i & 1)], q4[i >> 1][2 * (i & 1) + 1]};
                        Sa[i] = f2 * (Sa[i] - va2) + va2; Sb[i] = f2 * (Sb[i] - vb2) + vb2;
                        oa += q2 * Sa[i]; ob += q2 * Sb[i]; }
                    red[(wave * 16 + t) * 128 + lane] = oa.x + oa.y; red[(wave * 16 + t) * 128 + 64 + lane] = ob.x + ob.y;
                }
                __syncthreads();
#pragma unroll
                for (int tt = 0; tt < 2; ++tt) {
                    const int t = wave * 2 + tt;
                    float o0 = 0.f, o1 = 0.f;
#pragma unroll
                    for (int q8 = 0; q8 < 8; ++q8) { o0 += red[(q8 * 16 + t) * 128 + lane]; o1 += red[(q8 * 16 + t) * 128 + 64 + lane]; }
                    const float ss = wave_sum(o0 * o0 + o1 * o1);
                    const float r = 1.f / sqrtf(ss * (1.f / 128.f) + LN_EPS);
                    const size_t m = (size_t)(row0 + sb * 16 + t);
                    const float g0 = bf2f(Gt[m * 1024 + h * 128 + lane]), g1 = bf2f(Gt[m * 1024 + h * 128 + 64 + lane]);
                    MIX[m * 2048 + 1024 + h * 128 + lane] = (bf16)f2bf(o0 * r * hg_ng[lane] * g0);
                    MIX[m * 2048 + 1024 + h * 128 + 64 + lane] = (bf16)f2bf(o1 * r * hg_ng[64 + lane] * g1);
                }
            }
            if (sfin) { float* sp = sfin + (size_t)(wave * 16) * 128 + lane;
#pragma unroll
                for (int i = 0; i < 8; ++i) { __builtin_nontemporal_store(Sa[i].x, sp + (2 * i) * 128); __builtin_nontemporal_store(Sa[i].y, sp + (2 * i + 1) * 128); __builtin_nontemporal_store(Sb[i].x, sp + (2 * i) * 128 + 64); __builtin_nontemporal_store(Sb[i].y, sp + (2 * i + 1) * 128 + 64); } }
          }
        }
        __syncthreads();
    }
    SEAM(4);

    if (IN(5)) for (int rep_ = 0; rep_ < NREP(5); ++rep_) { if (rep_) xcd_barrier(xbar);
        pg8::Gemm g{MIX, WOUT, M, D, D}; pg8::StaticOrder S; S.init(M, D, D, G, bx, MP, SPLIT5);
        pg8::EpiResB<true> E{XB, XB, MP, ALPHA, (pg8::bf16_t*)(ws + WS_PB5)};
        pg8::gemm_phase<pg8::EpiResB<true>, pg8::StaticOrder, true, true>(lds, g, S, E);
        { const int nlast = S.nitems % G, first = nlast > 0 ? nlast : 0, nwg = G - first;
          if (bx >= first) {
              LAS float* scr = (LAS float*)(lds + wave * 16384);
              constexpr int I_G = 32 * 176;
              const int gw2 = (bx - first) * NWAVES + wave, NGW2 = nwg * NWAVES;
              transpose_stream<0>(w_down, FF, D, WDN, gw2, W_DN_SPLIT, NGW2, scr, lane);
          } }
    }
    SEAM(5);

    if (IN(6)) {
        ln_rows_bf16(XB, nullptr, XB, ln1_g, ln1_b, gw, NGW, MP, lane);
        if ((gw & 3) == 0) for (int m = MP + (gw >> 2); m < M; m += (NGW + 3) >> 2)
            ln_row<false, SPLIT5>(x_sample + (size_t)(m - MP) * D, (const bf16*)(ws + WS_PB5) + (size_t)(m - MP) * D, (size_t)MS * D, ALPHA, nullptr, XB + (size_t)m * D, ln1_g, ln1_b, lane);
    }
    SEAM(6);

    if (IN(7)) for (int rep_ = 0; rep_ < NREP(7); ++rep_) { if (rep_) xcd_barrier(xbar);
        pg8::Gemm g{XB, WGU, M, 2 * FF, D}; pg8::StaticOrder S; S.init(M, 2 * FF, D, G, bx);
        pg8::EpiGateUp E{ACT, FF};
        pg8::gemm_phase<pg8::EpiGateUp, pg8::StaticOrder, true, true>(lds, g, S, E);
        const int nlast = S.nitems % G;
        {
            const int first = nlast > 0 ? nlast : 0, nwg = G - first;
            if (bx >= first) {
                LAS float* scr = (LAS float*)(lds + wave * 16384);
                constexpr int I_DN = 88 * 64;
                const int gw2 = (bx - first) * NWAVES + wave, NGW2 = nwg * NWAVES;
                transpose_stream<0>(w_down, FF, D, WDN, W_DN_SPLIT + gw2, I_DN, NGW2, scr, lane);
            }
        }
    }
    SEAM(7);

    if (IN(8)) {
        pg8::Gemm g{ACT, WDN, M, D, FF}; pg8::StaticOrder S; S.init(M, D, FF, G, bx, MP, SPLIT8);
        pg8::EpiResB<true> E{XB, MIX, MP, ALPHA, (pg8::bf16_t*)(ws + WS_PB8)};
        pg8::gemm_phase<pg8::EpiResB<true>, pg8::StaticOrder, true, true>(lds, g, S, E);
    }
    SEAM(8);

    if (IN(9)) {
        ln_rows_bf16(MIX, out, nullptr, ln2_g, ln2_b, gw, NGW, MP, lane);
        if ((gw & 3) == 0) for (int m = MP + (gw >> 2); m < M; m += (NGW + 3) >> 2)
            ln_row<true, SPLIT8>(XB + (size_t)m * D, (const bf16*)(ws + WS_PB8) + (size_t)(m - MP) * D, (size_t)MS * D, ALPHA, out + (size_t)m * D, nullptr, ln2_g, ln2_b, lane);
    }
    STAMP(10);
#ifdef TS_A
    __syncthreads();
    if (bx == 0 && tid == 0) { asm volatile("s_waitcnt vmcnt(0)" ::: "memory"); out[0] = out[0] + (float)(ts_b - ts_a) * 1e-4f; }
#endif
#undef IN
#undef SEAM
}

#undef x_prompt
#undef x_sample
#undef cache_conv
#undef state_hgrn
#undef w_in
#undef b_in
#undef w_dw
#undef b_dw
#undef cn_g
#undef cn_b
#undef hlb
#undef hg_ng
#undef w_out
#undef ln1_g
#undef ln1_b
#undef w_gate
#undef w_up
#undef w_down
#undef ln2_g
#undef ln2_b
#undef out
#undef ws
#undef LB
#undef BIASP
#undef WIN
#undef WOUT
#undef WGU
#undef WDN
#undef XB
#undef MIX
#undef U
#undef Q
#undef F
#undef I
#undef Gt
#undef ACT
#undef ST
#undef DC

extern "C" void kernel_launch(void* const* d_in, const int* in_sizes, int n_in, void* d_out, int out_size, void* d_ws, size_t ws_size, hipStream_t stream) {
    static int grid = 0;
    if (grid == 0) {
        int dev = 0, cus = 0, per_cu = 0;
        if (n_in != 20 || ws_size < WS_END) { fprintf(stderr, "kernel_launch: unexpected n_in %d / ws_size %zu\n", n_in, ws_size); grid = -1; return; }
        if (hipGetDevice(&dev) != hipSuccess || hipDeviceGetAttribute(&cus, hipDeviceAttributeMultiprocessorCount, dev) != hipSuccess) { grid = -1; return; }
        if (hipFuncSetAttribute((const void*)fwd_kernel, hipFuncAttributeMaxDynamicSharedMemorySize, LDS_BYTES) != hipSuccess) { fprintf(stderr, "kernel_launch: hipFuncSetAttribute failed\n"); grid = -1; return; }
        if (hipOccupancyMaxActiveBlocksPerMultiprocessor(&per_cu, (const void*)fwd_kernel, NWAVES * 64, LDS_BYTES) != hipSuccess || per_cu < 1) { fprintf(stderr, "kernel_launch: occupancy query says %d\n", per_cu); }
        (void)hipGetLastError();
        grid = cus;
    }
    if (grid < 0) return;
    if (hipMemsetAsync(d_ws, 0, 16384, stream) != hipSuccess) { fprintf(stderr, "kernel_launch: memset failed\n"); return; }
    Args a{};
    for (int i = 0; i < 20; ++i) a.in[i] = (const float*)d_in[i];
    a.out = (float*)d_out; a.ws = (unsigned char*)d_ws;
#if MK_ONE_LAUNCH
    a.ph_lo = 0; a.ph_hi = N_PHASES;
    void* kargs[] = {&a};
    hipError_t e = hipLaunchCooperativeKernel((const void*)fwd_kernel, dim3(grid), dim3(NWAVES * 64), kargs, LDS_BYTES, stream);
    if (e != hipSuccess) fprintf(stderr, "cooperative launch failed: %s (grid %d)\n", hipGetErrorString(e), grid);
#else
    for (int p = 0; p < N_PHASES; ++p) {
        a.ph_lo = p; a.ph_hi = p + 1;
        hipLaunchKernelGGL(fwd_kernel, dim3(grid), dim3(NWAVES * 64), LDS_BYTES, stream, a);
    }
#endif
}
```

```cpp
#include <hip/hip_runtime.h>
#include <hip/hip_cooperative_groups.h>
#include <cstdio>
#include <cstdint>
namespace cg = cooperative_groups;

#ifndef MK_ONE_LAUNCH
#define MK_ONE_LAUNCH 1
#endif

namespace pg8 {
#define PG8_LAS __attribute__((address_space(3)))
typedef unsigned short bf16_t;
typedef short bf16x8 __attribute__((ext_vector_type(8)));
typedef float f32x4 __attribute__((ext_vector_type(4)));
typedef unsigned u32x4 __attribute__((ext_vector_type(4)));
typedef unsigned u32x2 __attribute__((ext_vector_type(2)));
constexpr int BM = 256, BK = 64, HALF = 128, HTB = HALF * BK * 2, STAGE_BYTES = 8 * HTB, NXCD = 8, WGM = 4;

__host__ __device__ __forceinline__ int lds_byte(int r, int c) { const int st = (r >> 4) * 2 + (c >> 5), rr = r & 15, cc = c & 31, ob = rr * 64 + cc * 2; return st * 1024 + (ob ^ (((ob >> 9) & 1) << 5)); }
__host__ __device__ __forceinline__ void stage_rc(int b, int& R, int& C) { const int st = b / 1024, sb = b % 1024, swz = sb ^ (((sb >> 9) & 1) << 5); R = (st >> 1) * 16 + swz / 64; C = (st & 1) * 32 + (swz % 64) / 2; }
__host__ __device__ __forceinline__ int perm32(int rho) { const int n = rho >> 4, i = rho & 15; return 8 * (i >> 2) + 4 * n + (i & 3); }

struct Unit { int pm, pn, kt0, nkt, ks; };
struct Gemm { const bf16_t* A; const bf16_t* Bt; int M, N, K; };

struct StaticOrder {
    int nM, nMf, nN, nfull, nitems, G, c, nt, nsplit;
    __host__ __device__ void init(int M, int N, int K, int G_, int c_, int Mfull = -1, int nsplit_ = 1) {
        nM = M / BM; nMf = Mfull < 0 ? nM : Mfull / BM; nN = N / BM; nt = K / BK; nsplit = nsplit_; nfull = nMf * nN; nitems = nfull + (nM - nMf) * nN * nsplit; G = G_; c = c_; }
    __host__ __device__ bool next(int i, Unit& u) const {
        const long L = (long)i * G + c; if (L >= nitems) return false;
        if (L >= nfull) { const int sidx = (int)L - nfull, un = sidx / nsplit, ks = sidx % nsplit, per = nt / nsplit;
            u.pm = nMf + un / nN; u.pn = un % nN; u.kt0 = ks * per; u.nkt = per; u.ks = ks; return true; }
        int wgid = (int)L; { const int q = nfull / NXCD, r = nfull % NXCD, xcd = wgid % NXCD, off = wgid / NXCD; wgid = (xcd < r ? xcd * (q + 1) : r * (q + 1) + (xcd - r) * q) + off; }
        const int nig = WGM * nN, gid = wgid / nig, fm = gid * WGM, gsz = (nMf - fm) < WGM ? (nMf - fm) : WGM;
        u.pm = fm + ((wgid % nig) % gsz); u.pn = (wgid % nig) / gsz; u.kt0 = 0; u.nkt = nt; u.ks = -1; return true;
    }
    __device__ __forceinline__ void a_ready(const Unit&) const {}
    __device__ __forceinline__ void done(const Unit&) const {}
};

__device__ __forceinline__ unsigned cvt_pk_bf16(float lo, float hi) { unsigned r; asm volatile("v_cvt_pk_bf16_f32 %0, %1, %2" : "=v"(r) : "v"(lo), "v"(hi)); return r; }
__device__ __forceinline__ float sigm(float x) { return __builtin_amdgcn_rcpf(1.0f + __expf(-x)); }

struct EpiProj {
    static constexpr bool PERM = true, AFTER_DRAIN = false;
    bf16_t *U, *QIG; float* F; const float* bias; const float* lb;
    __device__ __forceinline__ void operator()(const f32x4 (&acc)[2][2][4][2], const Unit& u, int wr, int wc, int fr, int fq) const {
        const int row0 = u.pm * BM + wr * 64 + fr;
        const int cl = wc * 32 + 8 * fq;
        const int bcol = u.pn * BM + cl;
        f32x4 bv[2][2];
#pragma unroll
        for (int bj = 0; bj < 2; ++bj)
#pragma unroll
            for (int n = 0; n < 2; ++n) bv[bj][n] = *(const f32x4*)(bias + bcol + bj * HALF + 4 * n);
        if (u.pn < 8) {
#pragma unroll
            for (int ai = 0; ai < 2; ++ai)
#pragma unroll
                for (int m = 0; m < 4; ++m) {
                    const size_t row = (size_t)(row0 + ai * HALF + m * 16);
                    float o[8];
#pragma unroll
                    for (int n = 0; n < 2; ++n) { const f32x4 a = acc[ai][0][m][n] + bv[0][n], g = acc[ai][1][m][n] + bv[1][n];
#pragma unroll
                        for (int e = 0; e < 4; ++e) o[n * 4 + e] = a[e] * sigm(g[e]); }
                    u32x4 w; w.x = cvt_pk_bf16(o[0], o[1]); w.y = cvt_pk_bf16(o[2], o[3]); w.z = cvt_pk_bf16(o[4], o[5]); w.w = cvt_pk_bf16(o[6], o[7]);
                    *(u32x4*)(U + row * 1024 + u.pn * HALF + cl) = w;
                }
        } else {
            const int grp = (u.pn - 8) >> 2;
            const int cbase = ((u.pn - 8) & 3) * BM + cl;
            if (grp == 1) {
                f32x4 lv[2][2];
#pragma unroll
                for (int bj = 0; bj < 2; ++bj)
#pragma unroll
                    for (int n = 0; n < 2; ++n) lv[bj][n] = *(const f32x4*)(lb + cbase + bj * HALF + 4 * n);
#pragma unroll
                for (int ai = 0; ai < 2; ++ai)
#pragma unroll
                    for (int m = 0; m < 4; ++m) {
                        const size_t row = (size_t)(row0 + ai * HALF + m * 16);
#pragma unroll
                        for (int bj = 0; bj < 2; ++bj)
#pragma unroll
                            for (int n = 0; n < 2; ++n) { const f32x4 x = acc[ai][bj][m][n] + bv[bj][n]; const f32x4 l = lv[bj][n]; f32x4 o;
#pragma unroll
                                for (int e = 0; e < 4; ++e) o[e] = l[e] + (1.0f - l[e]) * sigm(x[e]);
                                *(f32x4*)(F + row * 1024 + cbase + bj * HALF + 4 * n) = o; }
                    }
            } else {
                bf16_t* O = QIG + (size_t)(grp - (grp > 0 ? 1 : 0)) * ((size_t)8704 * 1024);
                const bool act = grp != 2;
#pragma unroll
                for (int ai = 0; ai < 2; ++ai)
#pragma unroll
                    for (int m = 0; m < 4; ++m) {
                        const size_t row = (size_t)(row0 + ai * HALF + m * 16);
#pragma unroll
                        for (int bj = 0; bj < 2; ++bj) { float o[8];
#pragma unroll
                            for (int n = 0; n < 2; ++n) { const f32x4 x = acc[ai][bj][m][n] + bv[bj][n];
#pragma unroll
                                for (int e = 0; e < 4; ++e) o[n * 4 + e] = act ? x[e] * sigm(x[e]) : x[e]; }
                            u32x4 w; w.x = cvt_pk_bf16(o[0], o[1]); w.y = cvt_pk_bf16(o[2], o[3]); w.z = cvt_pk_bf16(o[4], o[5]); w.w = cvt_pk_bf16(o[6], o[7]);
                            *(u32x4*)(O + row * 1024 + cbase + bj * HALF) = w; }
                    }
            }
        }
    }
};
struct EpiRes {
    static constexpr bool PERM = false, AFTER_DRAIN = false;
    const float* baseP; const float* baseS; float* out; int split; float alpha; float* part;
    __device__ __forceinline__ void operator()(const f32x4 (&acc)[2][2][4][2], const Unit& u, int wr, int wc, int fr, int fq) const {
        const int row0 = u.pm * BM + wr * 64 + fr;
        const int col0 = u.pn * BM + wc * 32 + 4 * fq;
        if (u.ks >= 0) {
            float* pb = part + (size_t)u.ks * 512 * 2048;
#pragma unroll
            for (int ai = 0; ai < 2; ++ai)
#pragma unroll
                for (int m = 0; m < 4; ++m) { float* op = pb + (size_t)(row0 + ai * HALF + m * 16 - split) * 2048;
#pragma unroll
                    for (int bj = 0; bj < 2; ++bj)
#pragma unroll
                        for (int n = 0; n < 2; ++n) *(f32x4*)(op + col0 + bj * HALF + n * 16) = acc[ai][bj][m][n]; }
            return;
        }
#pragma unroll
        for (int ai = 0; ai < 2; ++ai)
#pragma unroll
            for (int m = 0; m < 4; ++m) {
                const int row = row0 + ai * HALF + m * 16;
                const float* bp = row < split ? baseP + (size_t)row * 2048 : baseS + (size_t)(row - split) * 2048;
                float* op = out + (size_t)row * 2048;
#pragma unroll
                for (int bj = 0; bj < 2; ++bj)
#pragma unroll
                    for (int n = 0; n < 2; ++n) { const int c = col0 + bj * HALF + n * 16; const f32x4 b = *(const f32x4*)(bp + c); *(f32x4*)(op + c) = b * alpha + acc[ai][bj][m][n]; }
            }
    }
};
template <bool BASE_BF16> struct EpiResB {
    static constexpr bool PERM = true, AFTER_DRAIN = false;
    const void* base; bf16_t* out; int split; float alpha; bf16_t* part;
    __device__ __forceinline__ void operator()(const f32x4 (&acc)[2][2][4][2], const Unit& u, int wr, int wc, int fr, int fq) const {
        const int row0 = u.pm * BM + wr * 64 + fr;
        const int col0 = u.pn * BM + wc * 32 + 8 * fq;
        if (u.ks >= 0) {
            bf16_t* pb = part + (size_t)u.ks * 512 * 2048;
#pragma unroll
            for (int ai = 0; ai < 2; ++ai)
#pragma unroll
                for (int m = 0; m < 4; ++m) { bf16_t* op = pb + (size_t)(row0 + ai * HALF + m * 16 - split) * 2048;
#pragma unroll
                    for (int bj = 0; bj < 2; ++bj) { const f32x4 v0 = acc[ai][bj][m][0], v1 = acc[ai][bj][m][1];
                        u32x4 w; w.x = cvt_pk_bf16(v0[0], v0[1]); w.y = cvt_pk_bf16(v0[2], v0[3]); w.z = cvt_pk_bf16(v1[0], v1[1]); w.w = cvt_pk_bf16(v1[2], v1[3]);
                        *(u32x4*)(op + col0 + bj * HALF) = w; } }
            return;
        }
#pragma unroll
        for (int ai = 0; ai < 2; ++ai)
#pragma unroll
            for (int m = 0; m < 4; ++m) {
                const size_t row = (size_t)(row0 + ai * HALF + m * 16);
#pragma unroll
                for (int bj = 0; bj < 2; ++bj) { const int c = col0 + bj * HALF; f32x4 b0, b1;
                    if constexpr (BASE_BF16) { const u32x4 w = *(const u32x4*)((const bf16_t*)base + row * 2048 + c);
                        b0 = (f32x4){__uint_as_float(w.x << 16), __uint_as_float(w.x & 0xffff0000u), __uint_as_float(w.y << 16), __uint_as_float(w.y & 0xffff0000u)};
                        b1 = (f32x4){__uint_as_float(w.z << 16), __uint_as_float(w.z & 0xffff0000u), __uint_as_float(w.w << 16), __uint_as_float(w.w & 0xffff0000u)}; }
                    else { const float* bp = (const float*)base + row * 2048 + c; b0 = *(const f32x4*)bp; b1 = *(const f32x4*)(bp + 4); }
                    const f32x4 v0 = b0 * alpha + acc[ai][bj][m][0], v1 = b1 * alpha + acc[ai][bj][m][1];
                    u32x4 w; w.x = cvt_pk_bf16(v0[0], v0[1]); w.y = cvt_pk_bf16(v0[2], v0[3]); w.z = cvt_pk_bf16(v1[0], v1[1]); w.w = cvt_pk_bf16(v1[2], v1[3]);
                    *(u32x4*)(out + row * 2048 + c) = w; }
            }
    }
};
struct EpiGateUp {
    static constexpr bool PERM = true, AFTER_DRAIN = false;
    bf16_t* O; int ldc;
    __device__ __forceinline__ void operator()(const f32x4 (&acc)[2][2][4][2], const Unit& u, int wr, int wc, int fr, int fq) const {
        const int row0 = u.pm * BM + wr * 64 + fr;
        const int cl = wc * 32 + 8 * fq;
#pragma unroll
        for (int ai = 0; ai < 2; ++ai)
#pragma unroll
            for (int m = 0; m < 4; ++m) {
                const size_t row = (size_t)(row0 + ai * HALF + m * 16);
                float o[8];
#pragma unroll
                for (int n = 0; n < 2; ++n) { const f32x4 g = acc[ai][0][m][n], up = acc[ai][1][m][n];
#pragma unroll
                    for (int e = 0; e < 4; ++e) o[n * 4 + e] = g[e] * sigm(g[e]) * up[e]; }
                u32x4 w; w.x = cvt_pk_bf16(o[0], o[1]); w.y = cvt_pk_bf16(o[2], o[3]); w.z = cvt_pk_bf16(o[4], o[5]); w.w = cvt_pk_bf16(o[6], o[7]);
                *(u32x4*)(O + row * ldc + u.pn * HALF + cl) = w;
            }
    }
};

template <class Epi, class Sched, bool ALIGN_EPI = false, bool SP2 = false>
__device__ __forceinline__ void gemm_phase(PG8_LAS unsigned char* lds, const Gemm g, const Sched& S, const Epi& E) {
    int tid_ = threadIdx.x; asm volatile("" : "+v"(tid_));
    const int tid = tid_, wid = __builtin_amdgcn_readfirstlane(tid >> 6), lane = tid & 63, wr = wid >> 2, wc = wid & 3, fr = lane & 15, fq = lane >> 4;
    const int K = g.K;
    unsigned voffA[2], voffB[2];
#pragma unroll
    for (int i = 0; i < 2; ++i) { int R, C; stage_rc(tid * 16 + i * 8192, R, C); const int Rb = Epi::PERM ? ((R & ~31) + perm32(R & 31)) : R;
        voffA[i] = (unsigned)(R * K + C) * 2u; voffB[i] = (unsigned)(Rb * K + C) * 2u; }
    const size_t kstep = (size_t)(BK * 2);
    const size_t hstep = (size_t)HALF * K * 2;
    const size_t tstep = 2 * hstep;
    const unsigned ldsw = (unsigned)wid * 1024u;
    const int aoff = lds_byte(wr * 64 + fr, fq * 8), boff = lds_byte(wc * 32 + fr, fq * 8);
#define PG8_SA(b, h) (((b) * 2 + (h)) * HTB)
#define PG8_SB(b, h) ((4 + (b) * 2 + (h)) * HTB)
#define PG8_STAGE(bufoff, gbase, voff) do { _Pragma("unroll") for (int _i = 0; _i < 2; ++_i) \
        __builtin_amdgcn_global_load_lds((const unsigned*)((const char*)(gbase) + (voff)[_i]), (PG8_LAS unsigned*)(lds + (bufoff) + ldsw + _i * 8192), 16, 0, 0); } while (0)
#define PG8_LDA(dst, b, h) do { _Pragma("unroll") for (int m = 0; m < 4; ++m) _Pragma("unroll") for (int k = 0; k < 2; ++k) dst[m][k] = *(const PG8_LAS bf16x8*)(lds + PG8_SA(b, h) + aoff + m * 2048 + k * 1024); } while (0)
#define PG8_LDB(dst, b, h) do { _Pragma("unroll") for (int n = 0; n < 2; ++n) _Pragma("unroll") for (int k = 0; k < 2; ++k) dst[n][k] = *(const PG8_LAS bf16x8*)(lds + PG8_SB(b, h) + boff + n * 2048 + k * 1024); } while (0)
#define PG8_MMA(ai, bj, At, Bt) do { __builtin_amdgcn_s_setprio(1); _Pragma("unroll") for (int m = 0; m < 4; ++m) _Pragma("unroll") for (int n = 0; n < 2; ++n) _Pragma("unroll") for (int k = 0; k < 2; ++k) \
        acc[ai][bj][m][n] = __builtin_amdgcn_mfma_f32_16x16x32_bf16(Bt[n][k], At[m][k], acc[ai][bj][m][n], 0, 0, 0); __builtin_amdgcn_s_setprio(0); } while (0)
#define PG8_WAIT_V(n) asm volatile("s_waitcnt vmcnt(" #n ")" ::: "memory")
#define PG8_WAIT_L(n) asm volatile("s_waitcnt lgkmcnt(" #n ")" ::: "memory")
#define PG8_BAR __builtin_amdgcn_s_barrier()
#define PG8_SCHED __builtin_amdgcn_sched_barrier(0)
    Unit cur, nxt; int ui = 0;
    if (!S.next(0, cur)) return;
    f32x4 acc[2][2][4][2];
#pragma unroll
    for (int a = 0; a < 2; ++a)
#pragma unroll
        for (int b = 0; b < 2; ++b)
#pragma unroll
            for (int m = 0; m < 4; ++m)
#pragma unroll
                for (int n = 0; n < 2; ++n) acc[a][b][m][n] = (f32x4){0.f, 0.f, 0.f, 0.f};
    bf16x8 At[4][2], B0[2][2], B1[2][2];
    const char* cA = (const char*)g.A + (size_t)cur.pm * tstep + (size_t)cur.kt0 * kstep; const char* cB = (const char*)g.Bt + (size_t)cur.pn * tstep + (size_t)cur.kt0 * kstep;
    S.a_ready(cur);
    if constexpr (SP2) {
        PG8_STAGE(PG8_SB(0, 0), cB, voffB); PG8_STAGE(PG8_SB(0, 1), cB + hstep, voffB); PG8_STAGE(PG8_SA(0, 0), cA, voffA); PG8_STAGE(PG8_SA(0, 1), cA + hstep, voffA);
        if (wr == 1) PG8_BAR;
        PG8_WAIT_V(2); PG8_BAR;
        PG8_STAGE(PG8_SB(1, 0), cB + kstep, voffB); PG8_STAGE(PG8_SA(1, 0), cA + kstep, voffA); PG8_STAGE(PG8_SB(1, 1), cB + hstep + kstep, voffB);
        PG8_WAIT_V(6); PG8_BAR;
    } else {
        PG8_STAGE(PG8_SB(0, 0), cB, voffB); PG8_STAGE(PG8_SA(0, 0), cA, voffA); PG8_STAGE(PG8_SB(0, 1), cB + hstep, voffB); PG8_STAGE(PG8_SA(0, 1), cA + hstep, voffA);
        if (wr == 1) PG8_BAR;
        PG8_WAIT_V(4); PG8_BAR;
        PG8_STAGE(PG8_SB(1, 0), cB + kstep, voffB); PG8_STAGE(PG8_SA(1, 0), cA + kstep, voffA); PG8_STAGE(PG8_SB(1, 1), cB + hstep + kstep, voffB);
        PG8_WAIT_V(6); PG8_BAR;
    }
    for (;;) {
        const bool has_next = S.next(ui + 1, nxt);
        const char* nA = has_next ? (const char*)g.A + (size_t)nxt.pm * tstep + (size_t)nxt.kt0 * kstep : cA; const char* nB = has_next ? (const char*)g.Bt + (size_t)nxt.pn * tstep + (size_t)nxt.kt0 * kstep : cB;
        const int nt = cur.nkt;
        for (int t = 0; t < nt; t += 2) {
            const bool last = (t == nt - 2);
            const char* a1 = cA + (size_t)(t + 1) * kstep;
            const char* a2 = last ? nA : cA + (size_t)(t + 2) * kstep; const char* b2 = last ? nB : cB + (size_t)(t + 2) * kstep;
            const char* a3 = a2 + kstep; const char* b3 = b2 + kstep;
            if (last && has_next) S.a_ready(nxt);
            if constexpr (SP2) {
            PG8_LDB(B0, 0, 0); PG8_LDB(B1, 0, 1); PG8_SCHED; PG8_LDA(At, 0, 0); PG8_STAGE(PG8_SA(1, 1), a1 + hstep, voffA);
            PG8_WAIT_V(8); PG8_WAIT_L(0); PG8_BAR; PG8_MMA(0, 0, At, B0); PG8_MMA(0, 1, At, B1); PG8_BAR; PG8_SCHED;
            PG8_LDA(At, 0, 1); PG8_STAGE(PG8_SB(0, 0), b2, voffB); PG8_STAGE(PG8_SB(0, 1), b2 + hstep, voffB); PG8_STAGE(PG8_SA(0, 0), a2, voffA);
            PG8_WAIT_V(8); PG8_WAIT_L(0); PG8_BAR; PG8_MMA(1, 0, At, B0); PG8_MMA(1, 1, At, B1); PG8_BAR; PG8_SCHED;
            PG8_LDB(B0, 1, 0); PG8_LDB(B1, 1, 1); PG8_SCHED; PG8_LDA(At, 1, 0); PG8_STAGE(PG8_SA(0, 1), a2 + hstep, voffA);
            PG8_WAIT_V(8); PG8_WAIT_L(0); PG8_BAR; PG8_MMA(0, 0, At, B0); PG8_MMA(0, 1, At, B1); PG8_BAR; PG8_SCHED;
            PG8_LDA(At, 1, 1); PG8_STAGE(PG8_SB(1, 0), b3, voffB); PG8_STAGE(PG8_SB(1, 1), b3 + hstep, voffB); PG8_STAGE(PG8_SA(1, 0), a3, voffA);
            PG8_WAIT_V(8); PG8_WAIT_L(0); PG8_BAR; PG8_MMA(1, 0, At, B0); PG8_MMA(1, 1, At, B1); PG8_BAR; PG8_SCHED;
            } else {
            PG8_LDB(B0, 0, 0); PG8_SCHED; PG8_LDA(At, 0, 0); PG8_STAGE(PG8_SA(1, 1), a1 + hstep, voffA);
            PG8_WAIT_L(8); PG8_BAR; PG8_WAIT_L(0); PG8_MMA(0, 0, At, B0); PG8_BAR; PG8_SCHED;
            PG8_LDB(B1, 0, 1); PG8_STAGE(PG8_SB(0, 0), b2, voffB);
            PG8_BAR; PG8_WAIT_L(0); PG8_MMA(0, 1, At, B1); PG8_BAR;
            PG8_LDA(At, 0, 1); PG8_STAGE(PG8_SA(0, 0), a2, voffA);
            PG8_BAR; PG8_WAIT_L(0); PG8_MMA(1, 0, At, B0); PG8_BAR; PG8_SCHED;
            PG8_STAGE(PG8_SB(0, 1), b2 + hstep, voffB);
            PG8_WAIT_V(6); PG8_BAR; PG8_MMA(1, 1, At, B1); PG8_BAR;
            PG8_LDB(B0, 1, 0); PG8_SCHED; PG8_LDA(At, 1, 0); PG8_STAGE(PG8_SA(0, 1), a2 + hstep, voffA);
            PG8_WAIT_L(8); PG8_BAR; PG8_WAIT_L(0); PG8_MMA(0, 0, At, B0); PG8_BAR; PG8_SCHED;
            PG8_LDB(B1, 1, 1); PG8_STAGE(PG8_SB(1, 0), b3, voffB);
            PG8_BAR; PG8_WAIT_L(0); PG8_MMA(0, 1, At, B1); PG8_BAR;
            PG8_LDA(At, 1, 1); PG8_STAGE(PG8_SA(1, 0), a3, voffA);
            PG8_BAR; PG8_WAIT_L(0); PG8_MMA(1, 0, At, B0); PG8_BAR; PG8_SCHED;
            PG8_STAGE(PG8_SB(1, 1), b3 + hstep, voffB);
            PG8_WAIT_V(6); PG8_BAR; PG8_MMA(1, 1, At, B1); PG8_BAR;
            }
        }
        if constexpr (ALIGN_EPI) { if (wr == 0) PG8_BAR; }
        if constexpr (!Epi::AFTER_DRAIN) { E(acc, cur, wr, wc, fr, fq); S.done(cur); }
        if (!has_next) break;
#pragma unroll
        for (int a = 0; a < 2; ++a)
#pragma unroll
            for (int b = 0; b < 2; ++b)
#pragma unroll
                for (int m = 0; m < 4; ++m)
#pragma unroll
                    for (int n = 0; n < 2; ++n) acc[a][b][m][n] = (f32x4){0.f, 0.f, 0.f, 0.f};
        cur = nxt; cA = nA; cB = nB; ++ui;
        if constexpr (ALIGN_EPI) { if (wr == 1) PG8_BAR; }
    }
    PG8_WAIT_V(0);
    if constexpr (!ALIGN_EPI) { if (wr == 0) PG8_BAR; }
    PG8_BAR;
#undef PG8_SA
#undef PG8_SB
#undef PG8_STAGE
#undef PG8_LDA
#undef PG8_LDB
#undef PG8_MMA
#undef PG8_WAIT_V
#undef PG8_WAIT_L
#undef PG8_BAR
#undef PG8_SCHED
}
}

constexpr int D = 2048, MP = 8192, MS = 512, M = MP + MS, CW = 1024, NH = 8, HD = 128, FF = 5632, NIN = 6144;
constexpr float LN_EPS = 1e-5f;
constexpr float ALPHA = 1.189207115002721f;
constexpr int NWAVES = 8;
constexpr int LDS_BYTES = 147456;
constexpr int N_PHASES = 10;

constexpr size_t MiB = 1u << 20;
constexpr size_t WS_LB = 64 * 1024, WS_BIASP = 128 * 1024;
constexpr size_t WS_WIN = 1 * MiB, WS_WOUT = 25 * MiB, WS_WGU = 33 * MiB, WS_WDN = 77 * MiB;
constexpr size_t WS_XB = 99 * MiB, WS_MIX = 133 * MiB;
constexpr size_t WS_U = 167 * MiB, WS_Q = 184 * MiB, WS_I = 201 * MiB, WS_G = 218 * MiB, WS_F = 235 * MiB, WS_END = 269 * MiB;
constexpr size_t WS_ACT = 167 * MiB;
constexpr int SPLIT5 = 4, SPLIT8 = 11;
constexpr int W_DN_SPLIT = 44 * 64;
constexpr size_t WS_PB5 = 167 * MiB;
constexpr size_t WS_PB8 = 33 * MiB;
static_assert(WS_PB8 + (size_t)SPLIT8 * 512 * 2048 * 4 <= 77 * MiB && (32 % SPLIT5) == 0 && (88 % SPLIT8) == 0 && (32 / SPLIT5) % 2 == 0 && (88 / SPLIT8) % 2 == 0 && 32 / SPLIT5 >= 4 && 88 / SPLIT8 >= 4, "split-K layout");
static_assert(WS_ACT + (size_t)M * FF * 2 <= WS_END, "act overlay");
constexpr size_t O_Y = 0, O_NCP = (size_t)M * D, O_NHP = O_NCP + 4 * 30 * 1024, O_NCS = O_NHP + 4 * 8 * 128 * 128, O_NHS = O_NCS + 32 * 30 * 1024;
constexpr size_t O_ST = 0, O_DC = (size_t)1024 * 16384;

#define LAS __attribute__((address_space(3)))
typedef unsigned short bf16;
typedef float f32x4 __attribute__((ext_vector_type(4)));
typedef float f32x2 __attribute__((ext_vector_type(2)));
typedef unsigned v4u __attribute__((ext_vector_type(4)));
typedef unsigned v2u __attribute__((ext_vector_type(2)));
typedef float f32x16 __attribute__((ext_vector_type(16)));
typedef unsigned u32x8 __attribute__((ext_vector_type(8)));
#define CAS __attribute__((address_space(4)))
#define LDS_WAIT() asm volatile("s_waitcnt lgkmcnt(0)" ::: "memory")

__device__ __forceinline__ unsigned f2bf(float f) { unsigned u = __builtin_bit_cast(unsigned, f); return (u + 0x7fffu + ((u >> 16) & 1u)) >> 16; }
__device__ __forceinline__ unsigned pk2(float lo, float hi) { return f2bf(lo) | (f2bf(hi) << 16); }
__device__ __forceinline__ bf16 bfr(float x) { return (bf16)(pg8::cvt_pk_bf16(x, 0.f) & 0xffffu); }
__device__ __forceinline__ float bf2f(unsigned short b) { return __uint_as_float((unsigned)b << 16); }
__device__ __forceinline__ float sigm(float x) { return __builtin_amdgcn_rcpf(1.0f + __expf(-x)); }
__device__ __forceinline__ float wave_sum(float v) {
    v += __builtin_bit_cast(float, __builtin_amdgcn_mov_dpp(__builtin_bit_cast(int, v), 0xB1, 0xF, 0xF, true));
    v += __builtin_bit_cast(float, __builtin_amdgcn_mov_dpp(__builtin_bit_cast(int, v), 0x4E, 0xF, 0xF, true));
    v += __builtin_bit_cast(float, __builtin_amdgcn_mov_dpp(__builtin_bit_cast(int, v), 0x141, 0xF, 0xF, true));
    v += __builtin_bit_cast(float, __builtin_amdgcn_mov_dpp(__builtin_bit_cast(int, v), 0x140, 0xF, 0xF, true));
    const int vi = __builtin_bit_cast(int, v);
    const float r0 = __builtin_bit_cast(float, __builtin_amdgcn_readlane(vi, 0)), r1 = __builtin_bit_cast(float, __builtin_amdgcn_readlane(vi, 16));
    const float r2 = __builtin_bit_cast(float, __builtin_amdgcn_readlane(vi, 32)), r3 = __builtin_bit_cast(float, __builtin_amdgcn_readlane(vi, 48));
    return (r0 + r1) + (r2 + r3);
}

__device__ __forceinline__ void transpose_item(const float* W, int K, int N, bf16* WT, int k0, int n0, int dst_row0, LAS float* scr, int lane) {
    { f32x4 v[8];
      const int kq = lane >> 3, n4 = (lane & 7) * 4;
#pragma unroll
      for (int i = 0; i < 8; ++i) v[i] = *(const f32x4*)(W + (size_t)(k0 + 8 * i + kq) * N + n0 + n4);
#pragma unroll
      for (int i = 0; i < 8; ++i) { LAS float* d = scr + (8 * i + kq) * 33 + n4; d[0] = v[i].x; d[1] = v[i].y; d[2] = v[i].z; d[3] = v[i].w; } }
    LDS_WAIT(); asm volatile("" ::: "memory");
    const int c = lane & 7;
#pragma unroll
    for (int j = 0; j < 4; ++j) { const int n = (lane >> 3) + 8 * j; const LAS float* s = scr + (8 * c) * 33 + n;
        v4u o; o.x = pk2(s[0 * 33], s[1 * 33]); o.y = pk2(s[2 * 33], s[3 * 33]); o.z = pk2(s[4 * 33], s[5 * 33]); o.w = pk2(s[6 * 33], s[7 * 33]);
        *(v4u*)(WT + (size_t)(dst_row0 + n) * K + k0 + 8 * c) = o; }
    LDS_WAIT(); asm volatile("" ::: "memory");
}

template <int KIND> __device__ __forceinline__ void transpose_stream(const float* W, int K, int N, bf16* WT, int first, int end, int stride, LAS float* scr, int lane) {
    const int nblk = N / 32, kq = lane >> 3, n4 = (lane & 7) * 4, c = lane & 7;
    f32x4 v[8];
    if (first < end) { const int kb = first / nblk, nb = first % nblk;
#pragma unroll
        for (int i = 0; i < 8; ++i) v[i] = __builtin_nontemporal_load((const f32x4*)(W + (size_t)(64 * kb + 8 * i + kq) * N + 32 * nb + n4)); }
    for (int it = first; it < end; it += stride) {
        const int kb = it / nblk, nb = it % nblk, k0 = 64 * kb, n0 = 32 * nb;
        int dst;
        if (KIND == 1) dst = n0 < 2048 ? ((n0 & 1023) >> 7) * 256 + (n0 >> 10) * 128 + (n0 & 127) : n0;
        else if (KIND == 2) dst = (n0 >> 7) * 256 + (n0 & 127);
        else if (KIND == 3) dst = (n0 >> 7) * 256 + 128 + (n0 & 127);
        else dst = n0;
#pragma unroll
        for (int i = 0; i < 8; ++i) { LAS float* d = scr + (8 * i + kq) * 33 + n4; d[0] = v[i].x; d[1] = v[i].y; d[2] = v[i].z; d[3] = v[i].w; }
        { const int nx = it + stride;
          if (nx < end) { const int kb2 = nx / nblk, nb2 = nx % nblk;
#pragma unroll
              for (int i = 0; i < 8; ++i) v[i] = __builtin_nontemporal_load((const f32x4*)(W + (size_t)(64 * kb2 + 8 * i + kq) * N + 32 * nb2 + n4)); } }
        LDS_WAIT(); asm volatile("" ::: "memory");
#pragma unroll
        for (int j = 0; j < 4; ++j) { const int n = (lane >> 3) + 8 * j; const LAS float* sp = scr + (8 * c) * 33 + n;
            v4u o; o.x = pg8::cvt_pk_bf16(sp[0 * 33], sp[1 * 33]); o.y = pg8::cvt_pk_bf16(sp[2 * 33], sp[3 * 33]); o.z = pg8::cvt_pk_bf16(sp[4 * 33], sp[5 * 33]); o.w = pg8::cvt_pk_bf16(sp[6 * 33], sp[7 * 33]);
            *(v4u*)(WT + (size_t)(dst + n) * K + k0 + 8 * c) = o; }
        LDS_WAIT(); asm volatile("" ::: "memory");
    }
}

template <bool SRC_BF16, int NP> __device__ __forceinline__ void ln_row(const void* src, const bf16* part, size_t pstride, float alpha, float* dstf, bf16* dstb, const float* g, const float* b, int lane) {
    f32x4 v[8]; float s = 0.f;
    if constexpr (SRC_BF16) {
#pragma unroll
        for (int j = 0; j < 8; ++j) { const v2u w = ((const v2u*)src)[lane + 64 * j]; v[j] = (f32x4){__uint_as_float(w.x << 16), __uint_as_float(w.x & 0xffff0000u), __uint_as_float(w.y << 16), __uint_as_float(w.y & 0xffff0000u)}; }
    } else {
#pragma unroll
        for (int j = 0; j < 8; ++j) v[j] = __builtin_nontemporal_load((const f32x4*)src + lane + 64 * j);
    }
    if constexpr (NP > 0) {
#pragma unroll
        for (int j = 0; j < 8; ++j) v[j] = v[j] * alpha;
#pragma unroll
        for (int p0 = 0; p0 < NP; p0 += 4) {
            v2u w[4][8];
#pragma unroll
            for (int pp = 0; pp < 4; ++pp) if (p0 + pp < NP) { const v2u* pr = (const v2u*)(part + (size_t)(p0 + pp) * pstride) + lane;
#pragma unroll
                for (int j = 0; j < 8; ++j) w[pp][j] = __builtin_nontemporal_load(pr + 64 * j); }
#pragma unroll
            for (int pp = 0; pp < 4; ++pp) if (p0 + pp < NP) {
#pragma unroll
                for (int j = 0; j < 8; ++j) v[j] += (f32x4){__uint_as_float(w[pp][j].x << 16), __uint_as_float(w[pp][j].x & 0xffff0000u), __uint_as_float(w[pp][j].y << 16), __uint_as_float(w[pp][j].y & 0xffff0000u)}; }
        }
    }
#pragma unroll
    for (int j = 0; j < 8; ++j) s += (v[j].x + v[j].y) + (v[j].z + v[j].w);
    const float mean = wave_sum(s) * (1.f / D); float s2 = 0.f;
#pragma unroll
    for (int j = 0; j < 8; ++j) { v[j] = v[j] - mean; s2 += (v[j].x * v[j].x + v[j].y * v[j].y) + (v[j].z * v[j].z + v[j].w * v[j].w); }
    const float rstd = 1.f / sqrtf(wave_sum(s2) * (1.f / D) + LN_EPS);
#pragma unroll
    for (int j = 0; j < 8; ++j) {
        const f32x4 gg = ((const f32x4*)g)[lane + 64 * j], bb = ((const f32x4*)b)[lane + 64 * j];
        const f32x4 o = v[j] * rstd * gg + bb;
        if (dstf) __builtin_nontemporal_store(o, (f32x4*)dstf + lane + 64 * j);
        if (dstb) { v2u w; w.x = pk2(o.x, o.y); w.y = pk2(o.z, o.w); ((v2u*)dstb)[lane + 64 * j] = w; }
    }
}

__device__ __forceinline__ void ln_core(f32x4 (&v)[8], const f32x4 (&gg)[8], const f32x4 (&bb)[8], float* dstf, bf16* dstb, int lane) {
    float s = 0.f;
#pragma unroll
    for (int j = 0; j < 8; ++j) s += (v[j].x + v[j].y) + (v[j].z + v[j].w);
    const float mean = wave_sum(s) * (1.f / D); float s2 = 0.f;
#pragma unroll
    for (int j = 0; j < 8; ++j) { v[j] = v[j] - mean; s2 += (v[j].x * v[j].x + v[j].y * v[j].y) + (v[j].z * v[j].z + v[j].w * v[j].w); }
    const float rstd = 1.f / sqrtf(wave_sum(s2) * (1.f / D) + LN_EPS);
#pragma unroll
    for (int j = 0; j < 8; ++j) {
        const f32x4 o = v[j] * rstd * gg[j] + bb[j];
        if (dstf) __builtin_nontemporal_store(o, (f32x4*)dstf + lane + 64 * j);
        if (dstb) { v2u w; w.x = pk2(o.x, o.y); w.y = pk2(o.z, o.w); ((v2u*)dstb)[lane + 64 * j] = w; }
    }
}
__device__ __forceinline__ void ln_rows_bf16(const bf16* src, float* dstf, bf16* dstb, const float* g, const float* b, int gw, int NGW, int nrows, int lane) {
    f32x4 gg[8], bb[8];
#pragma unroll
    for (int j = 0; j < 8; ++j) { gg[j] = ((const f32x4*)g)[lane + 64 * j]; bb[j] = ((const f32x4*)b)[lane + 64 * j]; }
    v2u cur[8];
    if (gw < nrows) {
#pragma unroll
        for (int j = 0; j < 8; ++j) cur[j] = __builtin_nontemporal_load((const v2u*)(src + (size_t)gw * D) + lane + 64 * j);
    }
    for (int m = gw; m < nrows; m += NGW) {
        v2u nxt[8];
        const bool hn = m + NGW < nrows;
        if (hn) {
#pragma unroll
            for (int j = 0; j < 8; ++j) nxt[j] = __builtin_nontemporal_load((const v2u*)(src + (size_t)(m + NGW) * D) + lane + 64 * j);
        }
        f32x4 v[8];
#pragma unroll
        for (int j = 0; j < 8; ++j) v[j] = (f32x4){__uint_as_float(cur[j].x << 16), __uint_as_float(cur[j].x & 0xffff0000u), __uint_as_float(cur[j].y << 16), __uint_as_float(cur[j].y & 0xffff0000u)};
        ln_core(v, gg, bb, dstf ? dstf + (size_t)m * D : nullptr, dstb ? dstb + (size_t)m * D : nullptr, lane);
        if (hn) {
#pragma unroll
            for (int j = 0; j < 8; ++j) cur[j] = nxt[j];
        }
    }
}

#define XB_TMO      128
#define XB_XCNT(j)  (256  + 64 * (j))
#define XB_XSUB(j)  (1280 + 64 * (j))
#define XB_XGEN(j)  (2304 + 64 * (j))
#define XB_TOP      3328
#define XB_TOPGEN   3392
#define XCD_BAR_WORDS 3456
#define XB_SPIN_CAP (1u << 18)
__device__ __forceinline__ unsigned xb_ld(unsigned* p)              { return __hip_atomic_load(p, __ATOMIC_RELAXED, __HIP_MEMORY_SCOPE_AGENT); }
__device__ __forceinline__ unsigned xb_add(unsigned* p, unsigned v) { return __hip_atomic_fetch_add(p, v, __ATOMIC_RELAXED, __HIP_MEMORY_SCOPE_AGENT); }
__device__ __forceinline__ unsigned xb_xcc_id() { return (unsigned)__builtin_amdgcn_s_getreg((3 << 11) | 20) & 0xFu; }
#define XB_SPIN(cond, bar) do { unsigned _sp = 0; while (cond) { __builtin_amdgcn_s_sleep(1); \
    if ((++_sp & 255u) == 0u) { if (xb_ld(&(bar)[XB_TMO])) break; if (_sp > XB_SPIN_CAP) { atomicAdd(&(bar)[XB_TMO], 1u); break; } } } } while (0)
struct XcdBarrier { unsigned* bar; unsigned x; volatile LAS unsigned* st; };
__device__ __forceinline__ XcdBarrier xcd_barrier_post(unsigned* bar, volatile LAS unsigned* st) {
    XcdBarrier b; b.bar = bar; b.x = xb_xcc_id(); b.st = st;
    if (threadIdx.x == 0) (void)xb_add(&bar[XB_XCNT(b.x)], 1u);
    return b;
}
__device__ __forceinline__ void xcd_barrier_complete(unsigned* bar, unsigned x, unsigned& nloc, unsigned& nx) {
    const unsigned G = gridDim.x * gridDim.y * gridDim.z;
    unsigned sum, cnt, mine, sp = 0u;
    for (;;) {
        sum = 0u; cnt = 0u; mine = 0u;
#pragma unroll
        for (unsigned j = 0; j < 16; ++j) { const unsigned c = xb_ld(&bar[XB_XCNT(j)]); sum += c; cnt += (c > 0u) ? 1u : 0u; mine = (j == x) ? c : mine; }
        if (sum == G) break;
        __builtin_amdgcn_s_sleep(1);
        if ((++sp & 255u) == 0u) { if (xb_ld(&bar[XB_TMO])) break; if (sp > XB_SPIN_CAP) { atomicAdd(&bar[XB_TMO], 1u); break; } }
    }
    nloc = mine > 0u ? mine : 1u; nx = cnt > 0u ? cnt : 1u;
}
__device__ __forceinline__ void xcd_barrier(const XcdBarrier& b) {
    asm volatile("s_waitcnt vmcnt(0)" ::: "memory");
    __syncthreads();
    if (threadIdx.x == 0) {
        unsigned* bar = b.bar;
        __builtin_amdgcn_s_waitcnt(0);
        unsigned nloc = b.st[0], nx = b.st[1];
        if (nloc == 0u) { xcd_barrier_complete(bar, b.x, nloc, nx); b.st[0] = nloc; b.st[1] = nx; }
        const unsigned old = xb_add(&bar[XB_XSUB(b.x)], 1u);
        const unsigned gen = old / nloc;
        if (old + 1u == (gen + 1u) * nloc) {
            __builtin_amdgcn_fence(__ATOMIC_RELEASE, "agent");
            asm volatile("s_waitcnt vmcnt(0)" ::: "memory");
            const unsigned og = xb_add(&bar[XB_TOP], 1u);
            const unsigned tg = og / nx;
            if (og + 1u == (tg + 1u) * nx) xb_add(&bar[XB_TOPGEN], 1u);
            else XB_SPIN(xb_ld(&bar[XB_TOPGEN]) == tg, bar);
            __builtin_amdgcn_fence(__ATOMIC_ACQUIRE, "agent");
            xb_add(&bar[XB_XGEN(b.x)], 1u);
            asm volatile("s_waitcnt vmcnt(0)" ::: "memory");
        } else {
            XB_SPIN(xb_ld(&bar[XB_XGEN(b.x)]) == gen, bar);
            __builtin_amdgcn_fence(__ATOMIC_ACQUIRE, "agent");
            asm volatile("s_waitcnt vmcnt(0)" ::: "memory");
        }
    }
    __syncthreads();
}

struct Args { const float* in[20]; float* out; unsigned char* ws; int ph_lo, ph_hi; };

__global__ void __launch_bounds__(NWAVES * 64, 2) fwd_kernel(Args args) {
    extern __shared__ __attribute__((aligned(16))) unsigned char lds_raw[];
    LAS unsigned char* lds = (LAS unsigned char*)lds_raw;
    const int tid = threadIdx.x, lane = tid & 63, wave = __builtin_amdgcn_readfirstlane(tid >> 6);
    const int G = gridDim.x, bx = blockIdx.x;
    const int gt = bx * 512 + tid, NT = G * 512;
    const int gw = bx * NWAVES + wave, NGW = G * NWAVES;

#define x_prompt (args.in[0])
#define x_sample (args.in[1])
#define cache_conv (args.in[2])
#define state_hgrn (args.in[3])
#define w_in (args.in[4])
#define b_in (args.in[5])
#define w_dw (args.in[6])
#define b_dw (args.in[7])
#define cn_g (args.in[8])
#define cn_b (args.in[9])
#define hlb (args.in[10])
#define hg_ng (args.in[11])
#define w_out (args.in[12])
#define ln1_g (args.in[13])
#define ln1_b (args.in[14])
#define w_gate (args.in[15])
#define w_up (args.in[16])
#define w_down (args.in[17])
#define ln2_g (args.in[18])
#define ln2_b (args.in[19])
#define out (args.out)
#define ws (args.ws)
#define LB ((float*)(ws + WS_LB))
#define BIASP ((float*)(ws + WS_BIASP))
#define WIN ((bf16*)(ws + WS_WIN))
#define WOUT ((bf16*)(ws + WS_WOUT))
#define WGU ((bf16*)(ws + WS_WGU))
#define WDN ((bf16*)(ws + WS_WDN))
#define XB ((bf16*)(ws + WS_XB))
#define MIX ((bf16*)(ws + WS_MIX))
#define U ((bf16*)(ws + WS_U))
#define Q ((bf16*)(ws + WS_Q))
#define F ((float*)(ws + WS_F))
#define I ((bf16*)(ws + WS_I))
#define Gt ((bf16*)(ws + WS_G))
#define ACT ((bf16*)(ws + WS_ACT))
#define ST (out + O_ST)
#define DC (out + O_DC)

    const int lo = args.ph_lo, hi = args.ph_hi;
    volatile LAS unsigned* MISC = (volatile LAS unsigned*)(lds + LDS_BYTES - 64);
    if (tid < 16) MISC[tid] = 0u;
    __syncthreads();
    XcdBarrier xbar = xcd_barrier_post((unsigned*)ws, MISC + 8);
#ifndef PH_MASK
#define PH_MASK 0x3ff
#endif
#define IN(k) (((PH_MASK >> (k)) & 1) && lo <= (k) && (k) < hi)
#ifndef REP_MASK
#define REP_MASK 0
#endif
#define NREP(k) (1 + ((REP_MASK >> (k)) & 1))
#ifdef TS_A
    unsigned long long ts_a = 0, ts_b = 0;
#define STAMP(k) do { if ((k) == TS_A) ts_a = __builtin_amdgcn_s_memrealtime(); if ((k) == TS_B) ts_b = __builtin_amdgcn_s_memrealtime(); } while (0)
#else
#define STAMP(k) do { } while (0)
#endif
#define SEAM(k) do { if (IN(k) && IN((k) + 1)) { xcd_barrier(xbar); } STAMP((k) + 1); } while (0)
    STAMP(0);
    if (hi > 1000) cg::this_grid().sync();

    if (IN(0)) for (int rep_ = 0; rep_ < NREP(0); ++rep_) { if (rep_) xcd_barrier(xbar);
        LAS float* scr = (LAS float*)(lds + wave * 16384);
        constexpr int I_IN = 32 * 192;
        transpose_stream<1>(w_in, D, NIN, WIN, gw, I_IN, NGW, scr, lane);
        constexpr int NV = M * D / 8, NVP = MP * D / 8;
#pragma unroll 4
        for (int i = gt; i < NV; i += NT) {
            const float* src = i < NVP ? x_prompt + (size_t)i * 8 : x_sample + (size_t)(i - NVP) * 8;
            const f32x4 a = __builtin_nontemporal_load((const f32x4*)src), b = __builtin_nontemporal_load((const f32x4*)(src + 4));
            v4u o; o.x = pk2(a.x, a.y); o.y = pk2(a.z, a.w); o.z = pk2(b.x, b.y); o.w = pk2(b.z, b.w);
            *(v4u*)(XB + (size_t)i * 8) = o;
        }
        for (int i = gt; i < 1024; i += NT) LB[i] = sigm(hlb[i] - hlb[1024 + i]);
        for (int i = gt; i < NIN; i += NT) { const int orig = i < 2048 ? ((i & 255) >> 7) * 1024 + (i >> 8) * 128 + (i & 127) : i; BIASP[i] = b_in[orig]; }
    }
    SEAM(0);
#ifdef EXTRA_SYNCS
    for (int i_ = 0; i_ < EXTRA_SYNCS; ++i_) cg::this_grid().sync();
#endif

    if (IN(1)) for (int rep_ = 0; rep_ < NREP(1); ++rep_) { if (rep_) xcd_barrier(xbar);
        pg8::Gemm g{XB, WIN, M, NIN, D}; pg8::StaticOrder S; S.init(M, NIN, D, G, bx);
        pg8::EpiProj E{U, Q, F, BIASP, LB};
        pg8::gemm_phase<pg8::EpiProj, pg8::StaticOrder, true, true>(lds, g, S, E);
        const int nlast = S.nitems % G;
        if (nlast > 0 && bx >= nlast) {
            LAS float* scr = (LAS float*)(lds + wave * 16384);
            constexpr int I_OUT = 32 * 64, I_G = 32 * 176, I_DN = 88 * 64;
            const int gw2 = (bx - nlast) * NWAVES + wave, NGW2 = (G - nlast) * NWAVES;
            transpose_stream<0>(w_out, D, D, WOUT, gw2, I_OUT, NGW2, scr, lane);
            transpose_stream<2>(w_gate, D, FF, WGU, gw2, I_G, NGW2, scr, lane);
            transpose_stream<3>(w_up, D, FF, WGU, gw2, I_G, NGW2, scr, lane);
        }
    }
    SEAM(1);

    if (IN(2)) for (int rep_ = 0; rep_ < NREP(2); ++rep_) { if (rep_) xcd_barrier(xbar);
#define LBAR2() do { asm volatile("s_waitcnt lgkmcnt(0)" ::: "memory"); __builtin_amdgcn_s_barrier(); asm volatile("" ::: "memory"); } while (0)
        float pf[16]; unsigned short pi[16];
#define P2_LOAD(IT) do { const int bh_ = (IT) >> 5, c_ = (IT) & 31, h_ = bh_ & 7, row0_ = (bh_ >> 3) * 2048 + c_ * 64; const int k_ = tid & 127, qtr_ = __builtin_amdgcn_readfirstlane(tid >> 7); \
            _Pragma("unroll") for (int s_ = 0; s_ < 16; ++s_) { const size_t gi = (size_t)(row0_ + qtr_ * 16 + s_) * 1024 + h_ * 128 + k_; pf[s_] = F[gi]; pi[s_] = I[gi]; } } while (0)
        if (bx < 1024) P2_LOAD(bx);
        for (int it = bx; it < 1024 + 544; it += G) {
#ifdef P2_PROBE
            if (rep_ == 1 && ((P2_PROBE == 1) == (it >= 1024))) continue;
#endif
            LBAR2();
            if (it == 1024 + bx) STAMP(20);
            if (it < 1024) {
                const int bh = it >> 5, c = it & 31, b = bh >> 3, h = bh & 7;
                const int row0 = b * 2048 + c * 64;
                LAS bf16* KEt = (LAS bf16*)lds;
                LAS bf16* Vt = (LAS bf16*)(lds + 18432);
                LAS float* Tq = (LAS float*)(lds + 36864);
                const int k = tid & 127, qtr = __builtin_amdgcn_readfirstlane(tid >> 7);
                float lf[16], kk[16]; unsigned short iv[16];
#pragma unroll
                for (int s_ = 0; s_ < 16; ++s_) { const float f = pf[s_]; lf[s_] = __builtin_amdgcn_logf(f); kk[s_] = 1.0f - f; iv[s_] = pi[s_]; }
                if (it + G < 1024) P2_LOAD(it + G);
                float run = 0.f; float suf[16];
#pragma unroll
                for (int s_ = 15; s_ >= 0; --s_) { suf[s_] = run; run += lf[s_]; }
                Tq[qtr * 128 + k] = run;
                { v4u w0, w1;
                  w0.x = iv[0] | ((unsigned)iv[1] << 16); w0.y = iv[2] | ((unsigned)iv[3] << 16); w0.z = iv[4] | ((unsigned)iv[5] << 16); w0.w = iv[6] | ((unsigned)iv[7] << 16);
                  w1.x = iv[8] | ((unsigned)iv[9] << 16); w1.y = iv[10] | ((unsigned)iv[11] << 16); w1.z = iv[12] | ((unsigned)iv[13] << 16); w1.w = iv[14] | ((unsigned)iv[15] << 16);
                  *(LAS v4u*)(Vt + k * 72 + qtr * 16) = w0; *(LAS v4u*)(Vt + k * 72 + qtr * 16 + 8) = w1; }
                LBAR2();
                float later = 0.f, total = 0.f;
#pragma unroll
                for (int q2 = 0; q2 < 4; ++q2) { const float tq = Tq[q2 * 128 + k]; total += tq; later += q2 > qtr ? tq : 0.f; }
                { float ke[16];
#pragma unroll
                  for (int s_ = 0; s_ < 16; ++s_) ke[s_] = kk[s_] * __builtin_amdgcn_exp2f(suf[s_] + later);
                  v4u w0, w1;
                  w0.x = pg8::cvt_pk_bf16(ke[0], ke[1]); w0.y = pg8::cvt_pk_bf16(ke[2], ke[3]); w0.z = pg8::cvt_pk_bf16(ke[4], ke[5]); w0.w = pg8::cvt_pk_bf16(ke[6], ke[7]);
                  w1.x = pg8::cvt_pk_bf16(ke[8], ke[9]); w1.y = pg8::cvt_pk_bf16(ke[10], ke[11]); w1.z = pg8::cvt_pk_bf16(ke[12], ke[13]); w1.w = pg8::cvt_pk_bf16(ke[14], ke[15]);
                  *(LAS v4u*)(KEt + k * 72 + qtr * 16) = w0; *(LAS v4u*)(KEt + k * 72 + qtr * 16 + 8) = w1; }
                if (qtr == 0) DC[it * 128 + k] = exp2f(total);
                LBAR2();
                { const int r = lane & 15, q = lane >> 4;
                  const pg8::bf16x8 a0 = *(const LAS pg8::bf16x8*)(Vt + (16 * wave + r) * 72 + 8 * q), a1 = *(const LAS pg8::bf16x8*)(Vt + (16 * wave + r) * 72 + 8 * q + 32);
                  float* sp = ST + (size_t)it * 16384 + (size_t)(16 * wave + 4 * q) * 128 + r;
#pragma unroll
                  for (int kt = 0; kt < 8; ++kt) {
                      const pg8::bf16x8 b0 = *(const LAS pg8::bf16x8*)(KEt + (16 * kt + r) * 72 + 8 * q), b1 = *(const LAS pg8::bf16x8*)(KEt + (16 * kt + r) * 72 + 8 * q + 32);
                      f32x4 acc = (f32x4){0.f, 0.f, 0.f, 0.f};
                      acc = __builtin_amdgcn_mfma_f32_16x16x32_bf16(a0, b0, acc, 0, 0, 0);
                      acc = __builtin_amdgcn_mfma_f32_16x16x32_bf16(a1, b1, acc, 0, 0, 0);
#pragma unroll
                      for (int j = 0; j < 4; ++j) sp[j * 128 + 16 * kt] = acc[j];
                  } }
            } else {
                const int m0 = (it - 1024) * 16;
                const bool samp = m0 >= MP;
                int t0, seq0; const float* hist = cache_conv;
                if (!samp) { t0 = m0 & 2047; seq0 = m0 - t0; }
                else { t0 = 0; seq0 = m0; hist = cache_conv + (size_t)((m0 - MP) >> 4) * 30 * 1024; }
                const int hrow0 = samp ? ((m0 - MP) >> 4) * 30 : 0;
                const __amdgpu_buffer_rsrc_t rU = __builtin_amdgcn_make_buffer_rsrc((void*)U, 0, M * 1024 * 2, 0x00020000);
                const __amdgpu_buffer_rsrc_t rH = __builtin_amdgcn_make_buffer_rsrc((void*)cache_conv, 0, 32 * 30 * 1024 * 4, 0x00020000);
                const __amdgpu_buffer_rsrc_t rW = __builtin_amdgcn_make_buffer_rsrc((void*)w_dw, 0, 31 * 1024 * 4, 0x00020000);
                const bool interior = t0 >= 30;
                LAS float* hbuf = (LAS float*)(lds + 16384);
                LAS f32x2* stat = (LAS f32x2*)(lds + 16384 + 65536);
                const int c = 2 * tid;
                f32x2 acc[16];
                { const f32x2 bb = *(const f32x2*)(b_dw + c);
#pragma unroll
                  for (int t = 0; t < 16; ++t) acc[t] = bb; }
#pragma unroll
                for (int ch = 0; ch < 2; ++ch) {
                    const int j0 = ch * 16, nj = ch ? 15 : 16;
                    f32x2 win[31];
                    if (interior) {
                        const int rb = (seq0 + t0 - 30 + j0) * 2048;
#pragma unroll
                        for (int xi = 0; xi < 31; ++xi) if (xi < nj + 15) { const unsigned pw = __builtin_amdgcn_raw_buffer_load_b32(rU, 4 * tid, rb + xi * 2048, 0); win[xi] = (f32x2){__uint_as_float(pw << 16), __uint_as_float(pw & 0xffff0000u)}; }
                    } else {
#pragma unroll
                        for (int xi = 0; xi < 31; ++xi) if (xi < nj + 15) {
                            const int tr = t0 - 30 + j0 + xi;
                            f32x2 wv = (f32x2){0.f, 0.f};
                            if (tr >= 0) { const unsigned pw = __builtin_amdgcn_raw_buffer_load_b32(rU, 4 * tid, (seq0 + tr) * 2048, 0); wv = (f32x2){__uint_as_float(pw << 16), __uint_as_float(pw & 0xffff0000u)}; }
                            else if (samp) { const v2u hv = __builtin_amdgcn_raw_buffer_load_b64(rH, 8 * tid, (hrow0 + 30 + tr) * 4096, 0); wv = (f32x2){__uint_as_float(hv.x), __uint_as_float(hv.y)}; }
                            win[xi] = wv;
                        }
                    }
#pragma unroll
                    for (int jj = 0; jj < 16; ++jj) if (jj < nj) { const v2u wu = __builtin_amdgcn_raw_buffer_load_b64(rW, 8 * tid, (j0 + jj) * 4096, 0); const f32x2 w2 = (f32x2){__uint_as_float(wu.x), __uint_as_float(wu.y)};
#pragma unroll
                        for (int t = 0; t < 16; ++t) acc[t] += w2 * win[t + jj]; }
                    asm volatile("" ::: "memory");
                }
#pragma unroll
                for (int t = 0; t < 16; ++t) *(LAS f32x2*)(hbuf + t * 1024 + c) = acc[t];
                __syncthreads();
#pragma unroll
                for (int tt = 0; tt < 2; ++tt) { const int t = 2 * wave + tt; float s1 = 0.f, s2 = 0.f;
#pragma unroll
                    for (int i = 0; i < 4; ++i) { const f32x4 x = *(const LAS f32x4*)(hbuf + t * 1024 + 4 * lane + 256 * i); s1 += (x.x + x.y) + (x.z + x.w); s2 += (x.x * x.x + x.y * x.y) + (x.z * x.z + x.w * x.w); }
                    s1 = wave_sum(s1); s2 = wave_sum(s2);
                    const float mu = s1 * (1.f / 1024.f); float var = s2 * (1.f / 1024.f) - mu * mu; var = var > 0.f ? var : 0.f;
                    if (lane == 0) stat[t] = (f32x2){mu, 1.f / sqrtf(var + LN_EPS)}; }
                __syncthreads();
                const f32x2 gg = *(const f32x2*)(cn_g + c), bb2 = *(const f32x2*)(cn_b + c);
#pragma unroll
                for (int t = 0; t < 16; ++t) {
                    const f32x2 st2 = stat[t];
                    float y0 = (acc[t].x - st2.x) * st2.y * gg.x + bb2.x, y1 = (acc[t].y - st2.x) * st2.y * gg.y + bb2.y;
                    y0 = y0 * sigm(y0); y1 = y1 * sigm(y1);
                    *(unsigned*)(MIX + (size_t)(m0 + t) * 2048 + c) = pk2(y0, y1);
                }
            }
        }
        STAMP(21);
        { const int nx = (1024 + 544) % G;
          const int first = (nx > 0 && nx < G) ? nx : 0, nwg = G - first;
          if (bx >= first) {
              const int gt2 = (bx - first) * 512 + tid, NT2 = nwg * 512;
              for (int i = gt2; i < 4 * 30 * 1024; i += NT2) { const int b = i / 30720, j = (i >> 10) % 30, c = i & 1023;
                  __builtin_nontemporal_store(bf2f(U[(size_t)(b * 2048 + 2018 + j) * 1024 + c]), out + O_NCP + i); }
              for (int i = gt2; i < 32 * 30 * 1024; i += NT2) { const int sb = i / 30720, j = (i >> 10) % 30, c = i & 1023;
                  __builtin_nontemporal_store(j < 14 ? cache_conv[(size_t)sb * 30720 + (16 + j) * 1024 + c] : bf2f(U[(size_t)(MP + sb * 16 + j - 14) * 1024 + c]), out + O_NCS + i); }
          } }
    }
    SEAM(2);

    if (IN(3)) {
        for (int e = gt; e < 32 * 4096; e += NT) {
            const int bh = e >> 12, r = e & 4095, v = r >> 5, k4 = r & 31;
            f32x4 S = (f32x4){0.f, 0.f, 0.f, 0.f};
#pragma unroll 8
            for (int c = 0; c < 32; ++c) {
                f32x4* p = (f32x4*)(ST + ((size_t)(bh * 32 + c) * 128 + v) * 128 + k4 * 4);
                const f32x4 A = __builtin_nontemporal_load(p); const f32x4 d = *(const f32x4*)(DC + (bh * 32 + c) * 128 + k4 * 4);
                *p = S; S = S * d + A;
            }
            float* o = out + O_NHP + (size_t)bh * 16384 + (size_t)(k4 * 4) * 128 + v;
            __builtin_nontemporal_store(S.x, o); __builtin_nontemporal_store(S.y, o + 128); __builtin_nontemporal_store(S.z, o + 256); __builtin_nontemporal_store(S.w, o + 384);
        }
    }
    SEAM(3);

    if (IN(4)) for (int rep_ = 0; rep_ < NREP(4); ++rep_) { if (rep_) xcd_barrier(xbar);
        LAS float* vl = (LAS float*)lds; LAS float* red = (LAS float*)(lds + 8192);
        LAS float* fl2 = (LAS float*)(lds + 73728); LAS float* ql2 = (LAS float*)(lds + 81920);
#define LBAR() do { asm volatile("s_waitcnt lgkmcnt(0)" ::: "memory"); __builtin_amdgcn_s_barrier(); asm volatile("" ::: "memory"); } while (0)
        float fr[16]; unsigned short qh[16], ih[16]; unsigned gq[8]; f32x4 sv[8];
#define P4_LOAD(IT) do { const int bh_ = (IT) >> 5, c_ = (IT) & 31, h_ = bh_ & 7, row0_ = (bh_ >> 3) * 2048 + c_ * 64; const int k_ = tid & 127, qtr_ = __builtin_amdgcn_readfirstlane(tid >> 7); \
            _Pragma("unroll") for (int s_ = 0; s_ < 16; ++s_) { const size_t gi = (size_t)(row0_ + qtr_ * 16 + s_) * 1024 + h_ * 128 + k_; fr[s_] = __builtin_nontemporal_load(F + gi); qh[s_] = __builtin_nontemporal_load(Q + gi); ih[s_] = __builtin_nontemporal_load(I + gi); } \
            _Pragma("unroll") for (int j = 0; j < 8; ++j) sv[j] = __builtin_nontemporal_load((const f32x4*)(ST + (size_t)(IT) * 16384 + (size_t)(tid + 512 * j) * 4)); \
            _Pragma("unroll") for (int tt = 0; tt < 8; ++tt) { const size_t m = (size_t)(row0_ + wave * 8 + tt); gq[tt] = __builtin_nontemporal_load((const unsigned*)(Gt + m * 1024 + h_ * 128 + 2 * lane)); } } while (0)
        if (bx < 1024) P4_LOAD(bx);
        float ng0 = hg_ng[2 * lane], ng1 = hg_ng[2 * lane + 1];
        asm volatile("" : "+v"(ng0), "+v"(ng1));
        for (int it = bx; it < 1024; it += G) {
          {
            const int bh = it >> 5, c = it & 31, h = bh & 7, row0 = (bh >> 3) * 2048 + c * 64;
            LAS bf16* St = (LAS bf16*)lds;
            LAS bf16* QD = (LAS bf16*)(lds + 34816);
            LAS bf16* Vt = (LAS bf16*)(lds + 52224);
            LAS bf16* Pm = (LAS bf16*)(lds + 70656);
            LAS bf16* QDI = (LAS bf16*)(lds + 79872);
            LAS bf16* KD = (LAS bf16*)(lds + 97280);
            LAS float* Tq = (LAS float*)(lds + 140800);
            LAS float* Ob = (LAS float*)(lds + 79872);
            LBAR();
            const int k = tid & 127, qtr = __builtin_amdgcn_readfirstlane(tid >> 7);
            float pre[16], kk[16], qq[16]; unsigned short iv[16];
#pragma unroll
            for (int s_ = 0; s_ < 16; ++s_) { const float f = fr[s_]; pre[s_] = __builtin_amdgcn_logf(f); kk[s_] = 1.0f - f; qq[s_] = bf2f(qh[s_]); iv[s_] = ih[s_]; }
#pragma unroll
            for (int j = 0; j < 8; ++j) { const int e = tid + 512 * j, v = e >> 5, k4 = e & 31; const f32x4 x = sv[j];
                v2u w; w.x = pk2(x.x, x.y); w.y = pk2(x.z, x.w); *(LAS v2u*)(St + v * 136 + k4 * 4) = w; }
#pragma unroll
            for (int s_ = 1; s_ < 16; ++s_) pre[s_] += pre[s_ - 1];
            const float tot = pre[15];
            Tq[qtr * 128 + k] = tot;
            { v4u w0, w1;
              w0.x = iv[0] | ((unsigned)iv[1] << 16); w0.y = iv[2] | ((unsigned)iv[3] << 16); w0.z = iv[4] | ((unsigned)iv[5] << 16); w0.w = iv[6] | ((unsigned)iv[7] << 16);
              w1.x = iv[8] | ((unsigned)iv[9] << 16); w1.y = iv[10] | ((unsigned)iv[11] << 16); w1.z = iv[12] | ((unsigned)iv[13] << 16); w1.w = iv[14] | ((unsigned)iv[15] << 16);
              *(LAS v4u*)(Vt + k * 72 + qtr * 16) = w0; *(LAS v4u*)(Vt + k * 72 + qtr * 16 + 8) = w1; }
            const int kdoff = qtr == 0 ? 0 : (qtr == 1 ? 16 : (qtr == 2 ? 48 : 96));
#pragma unroll
            for (int s_ = 0; s_ < 16; ++s_) {
                QDI[(16 * qtr + s_) * 136 + k] = bfr(qq[s_] * __builtin_amdgcn_exp2f(pre[s_]));
                KD[(kdoff + 16 * qtr + s_) * 136 + k] = bfr(kk[s_] * __builtin_amdgcn_exp2f(fminf(-pre[s_], 120.f)));
            }
            LBAR();
            { float lb_ = 0.f;
#pragma unroll
              for (int q2 = 0; q2 < 4; ++q2) lb_ += q2 < qtr ? Tq[q2 * 128 + k] : 0.f;
#pragma unroll
              for (int s_ = 0; s_ < 16; ++s_) QD[(16 * qtr + s_) * 136 + k] = bfr(qq[s_] * __builtin_amdgcn_exp2f(pre[s_] + lb_));
              float gap = 0.f;
              for (int i = qtr + 1; i < 4; ++i) {
                  const int off = i == 1 ? 16 : (i == 2 ? 48 : 96);
#pragma unroll
                  for (int s_ = 0; s_ < 16; ++s_) KD[(off + 16 * qtr + s_) * 136 + k] = bfr(kk[s_] * __builtin_amdgcn_exp2f((tot - pre[s_]) + gap));
                  gap += Tq[i * 128 + k];
              } }
            unsigned gpre[8];
#pragma unroll
            for (int i = 0; i < 8; ++i) gpre[i] = gq[i];
            if (it + G < 1024) P4_LOAD(it + G);
            LBAR();
            const int r = lane & 15, q = lane >> 4;
            for (int n = wave; n < 10; n += 8) {
                const int i = n == 0 ? 0 : (n < 3 ? 1 : (n < 6 ? 2 : 3)), j = n - (i == 0 ? 0 : (i == 1 ? 1 : (i == 2 ? 3 : 6)));
                const int off = i == 0 ? 0 : (i == 1 ? 16 : (i == 2 ? 48 : 96));
                f32x4 acc = (f32x4){0.f, 0.f, 0.f, 0.f};
#pragma unroll
                for (int ks = 0; ks < 4; ++ks) {
                    const pg8::bf16x8 a = *(const LAS pg8::bf16x8*)(QDI + (16 * i + r) * 136 + 8 * q + 32 * ks);
                    const pg8::bf16x8 bq = *(const LAS pg8::bf16x8*)(KD + (off + 16 * j + r) * 136 + 8 * q + 32 * ks);
                    acc = __builtin_amdgcn_mfma_f32_16x16x32_bf16(a, bq, acc, 0, 0, 0);
                }
#pragma unroll
                for (int jj = 0; jj < 4; ++jj) { const float x = (i != j || r <= 4 * q + jj) ? acc[jj] : 0.f; Pm[(16 * i + 4 * q + jj) * 72 + 16 * j + r] = bfr(x); }
            }
            if (wave == 2 || wave == 3) { const int i = wave == 2 ? 0 : 2, j = i + 1;
#pragma unroll
                for (int jj = 0; jj < 4; ++jj) Pm[(16 * i + 4 * q + jj) * 72 + 16 * j + r] = (bf16)0; }
            LBAR();
            { const int i = wave >> 1, vt0 = 4 * (wave & 1);
              pg8::bf16x8 pa[2], qa[4];
#pragma unroll
              for (int ks = 0; ks < 2; ++ks) pa[ks] = *(const LAS pg8::bf16x8*)(Pm + (16 * i + r) * 72 + 8 * q + 32 * ks);
#pragma unroll
              for (int ks = 0; ks < 4; ++ks) qa[ks] = *(const LAS pg8::bf16x8*)(QD + (16 * i + r) * 136 + 8 * q + 32 * ks);
#pragma unroll
              for (int vv = 0; vv < 4; ++vv) { const int vt = vt0 + vv;
                  f32x4 acc = (f32x4){0.f, 0.f, 0.f, 0.f};
                  acc = __builtin_amdgcn_mfma_f32_16x16x32_bf16(pa[0], *(const LAS pg8::bf16x8*)(Vt + (16 * vt + r) * 72 + 8 * q), acc, 0, 0, 0);
                  if (i >= 2) acc = __builtin_amdgcn_mfma_f32_16x16x32_bf16(pa[1], *(const LAS pg8::bf16x8*)(Vt + (16 * vt + r) * 72 + 8 * q + 32), acc, 0, 0, 0);
#pragma unroll
                  for (int ks = 0; ks < 4; ++ks) acc = __builtin_amdgcn_mfma_f32_16x16x32_bf16(qa[ks], *(const LAS pg8::bf16x8*)(St + (16 * vt + r) * 136 + 8 * q + 32 * ks), acc, 0, 0, 0);
#pragma unroll
                  for (int jj = 0; jj < 4; ++jj) Ob[(16 * i + 4 * q + jj) * 132 + 16 * vt + r] = acc[jj];
              } }
            LBAR();
            { float o0[8], o1[8], ss[8];
#pragma unroll
              for (int tt = 0; tt < 8; ++tt) { const int t = wave * 8 + tt; const f32x2 ov = *(const LAS f32x2*)(Ob + t * 132 + 2 * lane); o0[tt] = ov.x; o1[tt] = ov.y; ss[tt] = o0[tt] * o0[tt] + o1[tt] * o1[tt]; }
#pragma unroll
              for (int tt = 0; tt < 8; ++tt) ss[tt] = wave_sum(ss[tt]);
#pragma unroll
              for (int tt = 0; tt < 8; ++tt) {
                  const float rr = __builtin_amdgcn_rsqf(ss[tt] * (1.f / 128.f) + LN_EPS);
                  const size_t m = (size_t)(row0 + wave * 8 + tt);
                  const float g0 = __uint_as_float(gpre[tt] << 16), g1 = __uint_as_float(gpre[tt] & 0xffff0000u);
                  *(unsigned*)(MIX + m * 2048 + 1024 + h * 128 + 2 * lane) = pg8::cvt_pk_bf16(o0[tt] * rr * ng0 * g0, o1[tt] * rr * ng1 * g1);
              } }
          }
        }
#undef P4_LOAD
#undef LBAR
        __syncthreads();
        STAMP(22);
        for (int it = 1024 + bx; it < 1024 + 256; it += G) {
          {
            int row0, h, nsb; const float* sinit; float* sfin = nullptr;
            if (it < 1024) { const int bh = it >> 5, c = it & 31; h = bh & 7; row0 = (bh >> 3) * 2048 + c * 64; nsb = 4; sinit = ST + (size_t)it * 16384; }
            else { const int j = it - 1024; h = j & 7; row0 = MP + (j >> 3) * 16; nsb = 1; sinit = state_hgrn + (size_t)j * 16384; sfin = out + O_NHS + (size_t)j * 16384; }
            f32x2 Sa[8], Sb[8];
            { const float* sp = sinit + (size_t)(wave * 16) * 128 + lane;
#pragma unroll
              for (int i = 0; i < 8; ++i) { Sa[i] = (f32x2){__builtin_nontemporal_load(sp + (2 * i) * 128), __builtin_nontemporal_load(sp + (2 * i + 1) * 128)}; Sb[i] = (f32x2){__builtin_nontemporal_load(sp + (2 * i) * 128 + 64), __builtin_nontemporal_load(sp + (2 * i + 1) * 128 + 64)}; } }
            for (int sb = 0; sb < nsb; ++sb) {
                __syncthreads();
#pragma unroll
                for (int e4 = 0; e4 < 4; ++e4) { const int e = tid + e4 * 512, t = e >> 7, k = e & 127; const size_t gi = (size_t)(row0 + sb * 16 + t) * 1024 + h * 128 + k;
                    vl[e] = bf2f(I[gi]); fl2[e] = F[gi]; ql2[e] = bf2f(Q[gi]); }
                __syncthreads();
#pragma unroll 2
                for (int t = 0; t < 16; ++t) {
                    f32x4 f4[4], q4[4];
#pragma unroll
                    for (int i = 0; i < 4; ++i) { f4[i] = *(const LAS f32x4*)(fl2 + t * 128 + wave * 16 + 4 * i); q4[i] = *(const LAS f32x4*)(ql2 + t * 128 + wave * 16 + 4 * i); }
                    const float va = vl[t * 128 + lane], vb = vl[t * 128 + 64 + lane];
                    const f32x2 va2 = (f32x2){va, va}, vb2 = (f32x2){vb, vb};
                    f32x2 oa = (f32x2){0.f, 0.f}, ob = (f32x2){0.f, 0.f};
#pragma unroll
                    for (int i = 0; i < 8; ++i) { const f32x2 f2 = (f32x2){f4[i >> 1][2 * (i & 1)], f4[i >> 1][2 * (i & 1) + 1]};
                        const f32x2 q2 = (f32x2){q4[i >> 1][2 * (i & 1)], q4[i >> 1][2 * (i & 1) + 1]};
                        Sa[i] = f2 * (Sa[i] - va2) + va2; Sb[i] = f2 * (Sb[i] - vb2) + vb2;
                        oa += q2 * Sa[i]; ob += q2 * Sb[i]; }
                    red[(wave * 16 + t) * 128 + lane] = oa.x + oa.y; red[(wave * 16 + t) * 128 + 64 + lane] = ob.x + ob.y;
                }
                __syncthreads();
#pragma unroll
                for (int tt = 0; tt < 2; ++tt) {
                    const int t = wave * 2 + tt;
                    float o0 = 0.f, o1 = 0.f;
#pragma unroll
                    for (int q8 = 0; q8 < 8; ++q8) { o0 += red[(q8 * 16 + t) * 128 + lane]; o1 += red[(q8 * 16 + t) * 128 + 64 + lane]; }
                    const float ss = wave_sum(o0 * o0 + o1 * o1);
                    const float r = 1.f / sqrtf(ss * (1.f / 128.f) + LN_EPS);
                    const size_t m = (size_t)(row0 + sb * 16 + t);
                    const float g0 = bf2f(Gt[m * 1024 + h * 128 + lane]), g1 = bf2f(Gt[m * 1024 + h * 128 + 64 + lane]);
                    MIX[m * 2048 + 1024 + h * 128 + lane] = (bf16)f2bf(o0 * r * hg_ng[lane] * g0);
                    MIX[m * 2048 + 1024 + h * 128 + 64 + lane] = (bf16)f2bf(o1 * r * hg_ng[64 + lane] * g1);
                }
            }
            if (sfin) { float* sp = sfin + (size_t)(wave * 16) * 128 + lane;
#pragma unroll
                for (int i = 0; i < 8; ++i) { __builtin_nontemporal_store(Sa[i].x, sp + (2 * i) * 128); __builtin_nontemporal_store(Sa[i].y, sp + (2 * i + 1) * 128); __builtin_nontemporal_store(Sb[i].x, sp + (2 * i) * 128 + 64); __builtin_nontemporal_store(Sb[i].y, sp + (2 * i + 1) * 128 + 64); } }
          }
        }
        __syncthreads();
    }
    SEAM(4);

    if (IN(5)) for (int rep_ = 0; rep_ < NREP(5); ++rep_) { if (rep_) xcd_barrier(xbar);
        pg8::Gemm g{MIX, WOUT, M, D, D}; pg8::StaticOrder S; S.init(M, D, D, G, bx, MP, SPLIT5);
        pg8::EpiResB<true> E{XB, XB, MP, ALPHA, (pg8::bf16_t*)(ws + WS_PB5)};
        pg8::gemm_phase<pg8::EpiResB<true>, pg8::StaticOrder, true, true>(lds, g, S, E);
        { const int nlast = S.nitems % G, first = nlast > 0 ? nlast : 0, nwg = G - first;
          if (bx >= first) {
              LAS float* scr = (LAS float*)(lds + wave * 16384);
              constexpr int I_G = 32 * 176;
              const int gw2 = (bx - first) * NWAVES + wave, NGW2 = nwg * NWAVES;
              transpose_stream<0>(w_down, FF, D, WDN, gw2, W_DN_SPLIT, NGW2, scr, lane);
          } }
    }
    SEAM(5);

    if (IN(6)) {
        ln_rows_bf16(XB, nullptr, XB, ln1_g, ln1_b, gw, NGW, MP, lane);
        if ((gw & 3) == 0) for (int m = MP + (gw >> 2); m < M; m += (NGW + 3) >> 2)
            ln_row<false, SPLIT5>(x_sample + (size_t)(m - MP) * D, (const bf16*)(ws + WS_PB5) + (size_t)(m - MP) * D, (size_t)MS * D, ALPHA, nullptr, XB + (size_t)m * D, ln1_g, ln1_b, lane);
    }
    SEAM(6);

    if (IN(7)) for (int rep_ = 0; rep_ < NREP(7); ++rep_) { if (rep_) xcd_barrier(xbar);
        pg8::Gemm g{XB, WGU, M, 2 * FF, D}; pg8::StaticOrder S; S.init(M, 2 * FF, D, G, bx);
        pg8::EpiGateUp E{ACT, FF};
        pg8::gemm_phase<pg8::EpiGateUp, pg8::StaticOrder, true, true>(lds, g, S, E);
        const int nlast = S.nitems % G;
        {
            const int first = nlast > 0 ? nlast : 0, nwg = G - first;
            if (bx >= first) {
                LAS float* scr = (LAS float*)(lds + wave * 16384);
                constexpr int I_DN = 88 * 64;
                const int gw2 = (bx - first) * NWAVES + wave, NGW2 = nwg * NWAVES;
                transpose_stream<0>(w_down, FF, D, WDN, W_DN_SPLIT + gw2, I_DN, NGW2, scr, lane);
            }
        }
    }
    SEAM(7);

    if (IN(8)) {
        pg8::Gemm g{ACT, WDN, M, D, FF}; pg8::StaticOrder S; S.init(M, D, FF, G, bx, MP, SPLIT8);
        pg8::EpiResB<true> E{XB, MIX, MP, ALPHA, (pg8::bf16_t*)(ws + WS_PB8)};
        pg8::gemm_phase<pg8::EpiResB<true>, pg8::StaticOrder, true, true>(lds, g, S, E);
    }
    SEAM(8);

    if (IN(9)) {
        ln_rows_bf16(MIX, out, nullptr, ln2_g, ln2_b, gw, NGW, MP, lane);
        if ((gw & 3) == 0) for (int m = MP + (gw >> 2); m < M; m += (NGW + 3) >> 2)
            ln_row<true, SPLIT8>(XB + (size_t)m * D, (const bf16*)(ws + WS_PB8) + (size_t)(m - MP) * D, (size_t)MS * D, ALPHA, out + (size_t)m * D, nullptr, ln2_g, ln2_b, lane);
    }
    STAMP(10);
#ifdef TS_A
    __syncthreads();
    if (bx == 0 && tid == 0) { asm volatile("s_waitcnt vmcnt(0)" ::: "memory"); out[0] = out[0] + (float)(ts_b - ts_a) * 1e-4f; }
#endif
#undef IN
#undef SEAM
}

#undef x_prompt
#undef x_sample
#undef cache_conv
#undef state_hgrn
#undef w_in
#undef b_in
#undef w_dw
#undef b_dw
#undef cn_g
#undef cn_b
#undef hlb
#undef hg_ng
#undef w_out
#undef ln1_g
#undef ln1_b
#undef w_gate
#undef w_up
#undef w_down
#undef ln2_g
#undef ln2_b
#undef out
#undef ws
#undef LB
#undef BIASP
#undef WIN
#undef WOUT
#undef WGU
#undef WDN
#undef XB
#undef MIX
#undef U
#undef Q
#undef F
#undef I
#undef Gt
#undef ACT
#undef ST
#undef DC

extern "C" void kernel_launch(void* const* d_in, const int* in_sizes, int n_in, void* d_out, int out_size, void* d_ws, size_t ws_size, hipStream_t stream) {
    static int grid = 0;
    if (grid == 0) {
        int dev = 0, cus = 0, per_cu = 0;
        if (n_in != 20 || ws_size < WS_END) { fprintf(stderr, "kernel_launch: unexpected n_in %d / ws_size %zu\n", n_in, ws_size); grid = -1; return; }
        if (hipGetDevice(&dev) != hipSuccess || hipDeviceGetAttribute(&cus, hipDeviceAttributeMultiprocessorCount, dev) != hipSuccess) { grid = -1; return; }
        if (hipFuncSetAttribute((const void*)fwd_kernel, hipFuncAttributeMaxDynamicSharedMemorySize, LDS_BYTES) != hipSuccess) { fprintf(stderr, "kernel_launch: hipFuncSetAttribute failed\n"); grid = -1; return; }
        if (hipOccupancyMaxActiveBlocksPerMultiprocessor(&per_cu, (const void*)fwd_kernel, NWAVES * 64, LDS_BYTES) != hipSuccess || per_cu < 1) { fprintf(stderr, "kernel_launch: occupancy query says %d\n", per_cu); }
        (void)hipGetLastError();
        grid = cus;
    }
    if (grid < 0) return;
    if (hipMemsetAsync(d_ws, 0, 16384, stream) != hipSuccess) { fprintf(stderr, "kernel_launch: memset failed\n"); return; }
    Args a{};
    for (int i = 0; i < 20; ++i) a.in[i] = (const float*)d_in[i];
    a.out = (float*)d_out; a.ws = (unsigned char*)d_ws;
#if MK_ONE_LAUNCH
    a.ph_lo = 0; a.ph_hi = N_PHASES;
    void* kargs[] = {&a};
    hipError_t e = hipLaunchCooperativeKernel((const void*)fwd_kernel, dim3(grid), dim3(NWAVES * 64), kargs, LDS_BYTES, stream);
    if (e != hipSuccess) fprintf(stderr, "cooperative launch failed: %s (grid %d)\n", hipGetErrorString(e), grid);
#else
    for (int p = 0; p < N_PHASES; ++p) {
        a.ph_lo = p; a.ph_hi = p + 1;
        hipLaunchKernelGGL(fwd_kernel, dim3(grid), dim3(NWAVES * 64), LDS_BYTES, stream, a);
    }
#endif
}
```
